# Optimizing an MI355X kernel written in HIP

```python
import jax, jax.numpy as jnp
from jax import lax
import numpy as np

D_MODEL = 1024
BATCH = 16
SEQ = 256
DEPTH = 2
DEC_BATCH = 2
DEC_SEQ = 1024
PAST_LEN = 256

GRID_W = 64
N_MIXERS = 2
BRANCH_WIDTH = D_MODEL
N_FOURIER_GROUPS = 4
HEAD_DIM = 64
N_HEADS = BRANCH_WIDTH // HEAD_DIM
N_KV_HEADS = 4
GQA_GROUP = N_HEADS // N_KV_HEADS
KV_WIDTH = N_KV_HEADS * HEAD_DIM
WINDOW = 128
BLOCK = 128
ROPE_THETA = 10000.0
EPS = 1e-6
NEG_INF = -1e30

kernel_name = "hybrid_fnet_swa_dit_step"


def rms_norm(x, w):
    xf = x.astype(jnp.float32)
    y = xf * lax.rsqrt(jnp.mean(xf * xf, axis=-1, keepdims=True) + EPS)
    return (y * w.astype(jnp.float32)).astype(x.dtype)


def modulation(cond, w_mod, b_mod):
    m = jax.nn.silu(cond) @ w_mod + b_mod
    shift, scale, gate = jnp.split(m[:, None, :], 3, axis=-1)
    return shift, scale, gate


def modulated_norm(x, cond, norm_w, w_mod, b_mod):
    shift, scale, gate = modulation(cond, w_mod, b_mod)
    return rms_norm(x, norm_w) * (1 + scale) + shift, gate


def fourier_mix(u):
    b, s, e = u.shape
    ug = u.astype(jnp.float32).reshape(b, s, N_FOURIER_GROUPS, e // N_FOURIER_GROUPS)
    f = jnp.fft.fft2(ug, axes=(1, 3), norm="ortho")
    return jnp.real(f).reshape(b, s, e).astype(u.dtype)


def fourier_layer(x, cond, norm_w, w_mod, b_mod, w_in, w_out):
    h, gate = modulated_norm(x, cond, norm_w, w_mod, b_mod)
    u, z = jnp.split(h @ w_in, 2, axis=-1)
    y = fourier_mix(u) * jax.nn.silu(z)
    return x + gate * (y @ w_out)


def attn_project(h, w_in, q_norm_w, k_norm_w):
    b, s, _ = h.shape
    q, k, v, z = jnp.split(h @ w_in, [BRANCH_WIDTH, BRANCH_WIDTH + KV_WIDTH,
                                      BRANCH_WIDTH + 2 * KV_WIDTH], axis=-1)
    q = rms_norm(q.reshape(b, s, N_KV_HEADS, GQA_GROUP, HEAD_DIM), q_norm_w)
    k = rms_norm(k.reshape(b, s, N_KV_HEADS, HEAD_DIM), k_norm_w)
    v = v.reshape(b, s, N_KV_HEADS, HEAD_DIM)
    return q, k, v, z


def axial_rope_tables(s):
    rows = s // GRID_W
    row = jnp.repeat(jnp.arange(rows, dtype=jnp.float32), GRID_W)
    col = jnp.tile(jnp.arange(GRID_W, dtype=jnp.float32), rows)
    n_freq = HEAD_DIM // 4
    inv = ROPE_THETA ** (-jnp.arange(n_freq, dtype=jnp.float32) / n_freq)
    ang = jnp.concatenate([row[:, None] * inv, col[:, None] * inv], axis=-1)
    return jnp.cos(ang), jnp.sin(ang)


def apply_rope(x, cos, sin):
    shp = (cos.shape[0],) + (1,) * (x.ndim - 3) + (cos.shape[1],)
    c, s_ = cos.reshape(shp), sin.reshape(shp)
    xf = x.astype(jnp.float32)
    x1, x2 = jnp.split(xf, 2, axis=-1)
    return jnp.concatenate([x1 * c - x2 * s_, x1 * s_ + x2 * c], axis=-1).astype(x.dtype)


def sink_softmax(scores, sink):
    s_col = jnp.broadcast_to(sink.astype(jnp.float32).reshape(N_KV_HEADS, GQA_GROUP, 1, 1),
                             scores.shape[:-1] + (1,))
    p = jax.nn.softmax(jnp.concatenate([scores, s_col], axis=-1), axis=-1)
    return p[..., :-1]


def context_attention(q, k, v, sink):
    b, s = q.shape[:2]
    nq = s // BLOCK
    scale = HEAD_DIM ** -0.5
    qb = jnp.moveaxis(q.reshape(b, nq, BLOCK, N_KV_HEADS, GQA_GROUP, HEAD_DIM), 1, 0)
    kf, vf = k.astype(jnp.float32), v.astype(jnp.float32)

    def one_block(qi):
        sc = jnp.einsum("bqkgd,bjkd->bkgqj", qi.astype(jnp.float32), kf) * scale
        p = sink_softmax(sc, sink)
        return jnp.einsum("bkgqj,bjkd->bqkgd", p, vf)

    o = lax.map(one_block, qb)
    return jnp.moveaxis(o, 0, 1).reshape(b, s, BRANCH_WIDTH).astype(q.dtype)


def latent_attention(q, k, v, k_ctx, v_ctx, sink):
    b, s = q.shape[:2]
    nb = s // BLOCK
    scale = HEAD_DIM ** -0.5
    pad = ((0, 0), (BLOCK, BLOCK), (0, 0), (0, 0))
    kp = jnp.pad(k.astype(jnp.float32), pad).reshape(b, nb + 2, BLOCK, N_KV_HEADS, HEAD_DIM)
    vp = jnp.pad(v.astype(jnp.float32), pad).reshape(b, nb + 2, BLOCK, N_KV_HEADS, HEAD_DIM)
    kb = jnp.concatenate([kp[:, :-2], kp[:, 1:-1], kp[:, 2:]], axis=2)
    vb = jnp.concatenate([vp[:, :-2], vp[:, 1:-1], vp[:, 2:]], axis=2)
    qb = q.astype(jnp.float32).reshape(b, nb, BLOCK, N_KV_HEADS, GQA_GROUP, HEAD_DIM)
    kc, vc = k_ctx.astype(jnp.float32), v_ctx.astype(jnp.float32)

    s_loc = jnp.einsum("bnqkgd,bnjkd->bnkgqj", qb, kb) * scale
    n_i = jnp.arange(nb)[:, None, None]
    q_i = jnp.arange(BLOCK)[None, :, None]
    k_j = jnp.arange(3 * BLOCK)[None, None, :]
    kpos = n_i * BLOCK + k_j - BLOCK
    qpos = n_i * BLOCK + q_i
    valid = (jnp.abs(kpos - qpos) <= WINDOW) & (kpos >= 0) & (kpos < s)
    s_loc = jnp.where(valid[None, :, None, None], s_loc, NEG_INF)
    s_ctx = jnp.einsum("bnqkgd,bjkd->bnkgqj", qb, kc) * scale

    p = sink_softmax(jnp.concatenate([s_loc, s_ctx], axis=-1), sink)
    p_loc, p_ctx = p[..., :3 * BLOCK], p[..., 3 * BLOCK:]
    o = (jnp.einsum("bnkgqj,bnjkd->bnqkgd", p_loc, vb)
         + jnp.einsum("bnkgqj,bjkd->bnqkgd", p_ctx, vc))
    return o.reshape(b, s, BRANCH_WIDTH).astype(q.dtype)


def attn_layer_context(x, cond, norm_w, w_mod, b_mod, w_in, q_norm_w, k_norm_w, sink, w_out):
    h, gate = modulated_norm(x, cond, norm_w, w_mod, b_mod)
    q, k, v, z = attn_project(h, w_in, q_norm_w, k_norm_w)
    o = context_attention(q, k, v, sink)
    return x + gate * ((o * jax.nn.silu(z)) @ w_out), k, v


def attn_layer_latent(x, cond, k_ctx, v_ctx, norm_w, w_mod, b_mod, w_in, q_norm_w, k_norm_w,
                      sink, w_out):
    h, gate = modulated_norm(x, cond, norm_w, w_mod, b_mod)
    q, k, v, z = attn_project(h, w_in, q_norm_w, k_norm_w)
    cos, sin = axial_rope_tables(x.shape[1])
    q, k = apply_rope(q, cos, sin), apply_rope(k, cos, sin)
    o = latent_attention(q, k, v, k_ctx, v_ctx, sink)
    return x + gate * ((o * jax.nn.silu(z)) @ w_out)


def setup_inputs(seed: int = 0) -> dict:
    key = jax.random.key(seed)
    ks = jax.random.split(key, 24)
    f32 = jnp.float32
    D, E = D_MODEL, BRANCH_WIDTH
    nrm = lambda k, shape, s: jax.random.normal(k, shape, f32) * s
    return {
        "x_prompt": nrm(ks[0], (BATCH, SEQ, D), 1.0),
        "x_sample": nrm(ks[1], (DEC_BATCH, DEC_SEQ, D), 1.0),
        "cache_k_l1": nrm(ks[2], (DEC_BATCH, PAST_LEN, N_KV_HEADS, HEAD_DIM), 1.0),
        "cache_v_l1": nrm(ks[3], (DEC_BATCH, PAST_LEN, N_KV_HEADS, HEAD_DIM), 1.0),
        "c": nrm(ks[4], (DEC_BATCH, D), 1.0),
        "c_ctx": nrm(ks[5], (D,), 1.0),
        "norm_w_l0": 1.0 + nrm(ks[6], (D,), 0.02),
        "w_mod_l0": nrm(ks[7], (D, 3 * D), 0.5 * D ** -0.5),
        "b_mod_l0": nrm(ks[8], (3 * D,), 0.02),
        "w_in_l0": nrm(ks[9], (D, 2 * E), D ** -0.5),
        "w_out_l0": nrm(ks[10], (E, D), E ** -0.5),
        "norm_w_l1": 1.0 + nrm(ks[11], (D,), 0.02),
        "w_mod_l1": nrm(ks[12], (D, 3 * D), 0.5 * D ** -0.5),
        "b_mod_l1": nrm(ks[13], (3 * D,), 0.02),
        "w_in_l1": nrm(ks[14], (D, 2 * E + 2 * KV_WIDTH), D ** -0.5),
        "q_norm_w_l1": 1.0 + nrm(ks[15], (HEAD_DIM,), 0.02),
        "k_norm_w_l1": 1.0 + nrm(ks[16], (HEAD_DIM,), 0.02),
        "sink_l1": nrm(ks[17], (N_HEADS,), 0.5),
        "w_out_l1": nrm(ks[18], (E, D), E ** -0.5),
    }


def reference(x_prompt, x_sample, cache_k_l1, cache_v_l1, c, c_ctx,
              norm_w_l0, w_mod_l0, b_mod_l0, w_in_l0, w_out_l0,
              norm_w_l1, w_mod_l1, b_mod_l1, w_in_l1, q_norm_w_l1, k_norm_w_l1, sink_l1,
              w_out_l1):
    fourier_params = (norm_w_l0, w_mod_l0, b_mod_l0, w_in_l0, w_out_l0)
    attn_params = (norm_w_l1, w_mod_l1, b_mod_l1, w_in_l1, q_norm_w_l1, k_norm_w_l1, sink_l1,
                   w_out_l1)
    layer_params = (fourier_params, attn_params)
    cond_ctx = c_ctx[None, :]
    xp, xs = x_prompt, x_sample
    new_k_l1, new_v_l1 = None, None
    for i in range(DEPTH):
        p = layer_params[i]
        if i % N_MIXERS == 0:
            xp = fourier_layer(xp, cond_ctx, *p)
            xs = fourier_layer(xs, c, *p)
        else:
            xp, new_k_l1, new_v_l1 = attn_layer_context(xp, cond_ctx, *p)
            xs = attn_layer_latent(xs, c, cache_k_l1, cache_v_l1, *p)
    return (xp, xs, new_k_l1, new_v_l1)
```

```cpp
#include <hip/hip_runtime.h>
#include <hip/hip_cooperative_groups.h>
#include <stdint.h>
#include <cstdio>
namespace cg = cooperative_groups;

#ifndef SINGLE_LAUNCH
#define SINGLE_LAUNCH 0
#endif

typedef unsigned short bf16_t;
typedef short bf16x8 __attribute__((ext_vector_type(8)));
typedef float f32x16 __attribute__((ext_vector_type(16)));
typedef float f32x4 __attribute__((ext_vector_type(4)));
typedef unsigned u32x4 __attribute__((ext_vector_type(4)));
typedef unsigned u32x2 __attribute__((ext_vector_type(2)));
#define DEVI __device__ __forceinline__

constexpr int NTOK = 6144, NCTX = 4096, D = 1024;
constexpr float EPSV = 1e-6f;
constexpr float LOG2E = 1.4426950408889634f;

constexpr size_t WS_MOD = 0;
constexpr size_t WS_WT0IN = 1 << 20;
constexpr size_t WS_WT0OUT = WS_WT0IN + (size_t)2048 * 1024 * 2;
constexpr size_t WS_WT1IN = WS_WT0OUT + (size_t)1024 * 1024 * 2;
constexpr size_t WS_WT1OUT = WS_WT1IN + (size_t)2560 * 1024 * 2;
constexpr size_t WS_TW256 = WS_WT1OUT + (size_t)1024 * 1024 * 2;
constexpr size_t WS_TS256 = WS_TW256 + (size_t)512 * 256 * 2;
constexpr size_t WS_TS1024 = WS_TS256 + (size_t)256 * 512 * 2;
constexpr size_t WS_ROPEC = WS_TS1024 + (size_t)1024 * 2048 * 2;
constexpr size_t WS_ROPES = WS_ROPEC + (size_t)1024 * 32 * 4;
constexpr size_t WS_KC = WS_ROPES + (size_t)1024 * 32 * 4;
constexpr size_t WS_VCT = WS_KC + (size_t)2 * 256 * 256 * 2;
constexpr size_t WS_H = WS_VCT + (size_t)2 * 256 * 256 * 2;
constexpr size_t WS_U = WS_H + (size_t)NTOK * D * 2;
constexpr size_t WS_SZ = WS_U + (size_t)NTOK * D * 2;
constexpr size_t WS_VT = WS_SZ + (size_t)NTOK * D * 2;
constexpr size_t WS_Y = WS_VT + (size_t)NTOK * 2048 * 2;
constexpr size_t WS_X1 = WS_Y + (size_t)NTOK * D * 2;
constexpr size_t WS_Q = WS_X1 + (size_t)NTOK * D * 4;
constexpr size_t WS_KB = WS_Q + (size_t)NTOK * D * 2;
constexpr size_t WS_VTB = WS_KB + (size_t)NTOK * 256 * 2;
constexpr size_t WS_END = WS_VTB + (size_t)NTOK * 256 * 2;

struct Params {
    const float *x_prompt, *x_sample, *cache_k, *cache_v, *c, *c_ctx;
    const float *norm_w0, *w_mod0, *b_mod0, *w_in0, *w_out0;
    const float *norm_w1, *w_mod1, *b_mod1, *w_in1, *qnw, *knw, *sink, *w_out1;
    float* out;
    unsigned char* ws;
    long long ph_lo, ph_hi;
};

DEVI unsigned cvt_pk_bf16(float lo, float hi) { unsigned r; asm("v_cvt_pk_bf16_f32 %0, %1, %2" : "=v"(r) : "v"(lo), "v"(hi)); return r; }
DEVI bf16_t f2bf(float f) { return (bf16_t)(cvt_pk_bf16(f, 0.f) & 0xffffu); }
DEVI float silu_f(float v) { return v / (1.f + __expf(-v)); }
DEVI int swap23(int x) { return (x & ~12) | ((x & 4) << 1) | ((x & 8) >> 1); }
DEVI int cond_of(int m) { return m < NCTX ? 0 : 1 + ((m - NCTX) >> 10); }

DEVI void glds16(const void* g, void* l) { __builtin_amdgcn_global_load_lds(g, l, 16, 0, 0); }

template <class Epi>
DEVI void gemm_tile(const bf16_t* __restrict__ A, int lda, const bf16_t* __restrict__ B, int ldb, int nk,
                    unsigned char* lds, const Epi& epi, int m0, int n0) {
    const int tid = threadIdx.x, lane = tid & 63, wid = tid >> 6, wr = wid >> 1, wc = wid & 1;
    const int srow = tid >> 3;
    const int slc = (tid & 7) ^ ((tid >> 4) & 7);
    const bf16_t* gA = A + (size_t)(m0 + srow) * lda + slc * 8;
    const bf16_t* gB = B + (size_t)(n0 + srow) * ldb + slc * 8;
    const int fr = lane & 31, fh = lane >> 5, sw = (lane >> 1) & 7;
    const unsigned aoff = (wr * 64 + fr) * 128, boff = 16384 + (wc * 64 + fr) * 128;
    f32x16 acc[2][2];
#pragma unroll
    for (int i = 0; i < 2; ++i)
#pragma unroll
        for (int j = 0; j < 2; ++j)
#pragma unroll
            for (int r = 0; r < 16; ++r) acc[i][j][r] = 0.f;
    {
        unsigned char* la = lds + tid * 16;
#pragma unroll
        for (int i = 0; i < 4; ++i) {
            glds16(gA + (size_t)i * 32 * lda, la + i * 4096);
            glds16(gB + (size_t)i * 32 * ldb, la + 16384 + i * 4096);
        }
    }
    for (int kt = 0; kt < nk; ++kt) {
        asm volatile("s_waitcnt vmcnt(0)" ::: "memory");
        __syncthreads();
        if (kt + 1 < nk) {
            unsigned char* la = lds + ((kt + 1) & 1) * 32768 + tid * 16;
            const int ko = (kt + 1) * 64;
#pragma unroll
            for (int i = 0; i < 4; ++i) {
                glds16(gA + (size_t)i * 32 * lda + ko, la + i * 4096);
                glds16(gB + (size_t)i * 32 * ldb + ko, la + 16384 + i * 4096);
            }
        }
        const unsigned char* base = lds + (kt & 1) * 32768;
#pragma unroll
        for (int ks = 0; ks < 4; ++ks) {
            const int ch = ((2 * ks + fh) ^ sw) * 16;
            const bf16x8 a0 = *(const bf16x8*)(base + aoff + ch);
            const bf16x8 a1 = *(const bf16x8*)(base + aoff + 4096 + ch);
            const bf16x8 b0 = *(const bf16x8*)(base + boff + ch);
            const bf16x8 b1 = *(const bf16x8*)(base + boff + 4096 + ch);
            acc[0][0] = __builtin_amdgcn_mfma_f32_32x32x16_bf16(b0, a0, acc[0][0], 0, 0, 0);
            acc[0][1] = __builtin_amdgcn_mfma_f32_32x32x16_bf16(b1, a0, acc[0][1], 0, 0, 0);
            acc[1][0] = __builtin_amdgcn_mfma_f32_32x32x16_bf16(b0, a1, acc[1][0], 0, 0, 0);
            acc[1][1] = __builtin_amdgcn_mfma_f32_32x32x16_bf16(b1, a1, acc[1][1], 0, 0, 0);
        }
    }
    epi(acc, m0 + wr * 64, n0 + wc * 64, fr, fh);
    __syncthreads();
}

DEVI int xcd_remap(int t, int T) { return (t & 7) * (T >> 3) + (t >> 3); }

DEVI void mod_item(const Params& p, int it, unsigned char* lds) {
    const int tid = threadIdx.x;
    const int l = it / 48, cc = it % 48;
    float* sc = (float*)lds;
    for (int i = tid; i < 3072; i += 256) {
        const int cv = i >> 10, k = i & 1023;
        const float cval = cv == 0 ? p.c_ctx[k] : p.c[(cv - 1) * 1024 + k];
        sc[i] = silu_f(cval);
    }
    __syncthreads();
    const float* W = l ? p.w_mod1 : p.w_mod0;
    const float* bm = l ? p.b_mod1 : p.b_mod0;
    const int cg4 = tid & 15, rg = tid >> 4, c0 = cc * 64 + cg4 * 4;
    f32x4 a0 = {0.f, 0.f, 0.f, 0.f}, a1 = a0, a2 = a0;
#pragma unroll 8
    for (int k = rg; k < 1024; k += 16) {
        const f32x4 w = *(const f32x4*)(W + (size_t)k * 3072 + c0);
        a0 += sc[k] * w; a1 += sc[1024 + k] * w; a2 += sc[2048 + k] * w;
    }
    float* red = (float*)(lds + 12288);
#pragma unroll
    for (int e = 0; e < 4; ++e) {
        red[(rg * 3 + 0) * 64 + cg4 * 4 + e] = a0[e];
        red[(rg * 3 + 1) * 64 + cg4 * 4 + e] = a1[e];
        red[(rg * 3 + 2) * 64 + cg4 * 4 + e] = a2[e];
    }
    __syncthreads();
    if (tid < 192) {
        const int cv = tid >> 6, j = tid & 63;
        float s = 0.f;
#pragma unroll
        for (int r = 0; r < 16; ++r) s += red[(r * 3 + cv) * 64 + j];
        float* mod = (float*)(p.ws + WS_MOD);
        mod[(l * 3 + cv) * 3072 + cc * 64 + j] = s + bm[cc * 64 + j];
    }
    __syncthreads();
}

DEVI void transpose_item(const Params& p, int idx, unsigned char* lds) {
    const int tid = threadIdx.x;
    const float* src; bf16_t* dst; int N;
    if (idx < 512) { src = p.w_in0; dst = (bf16_t*)(p.ws + WS_WT0IN); N = 2048; }
    else if (idx < 768) { idx -= 512; src = p.w_out0; dst = (bf16_t*)(p.ws + WS_WT0OUT); N = 1024; }
    else if (idx < 1408) { idx -= 768; src = p.w_in1; dst = (bf16_t*)(p.ws + WS_WT1IN); N = 2560; }
    else { idx -= 1408; src = p.w_out1; dst = (bf16_t*)(p.ws + WS_WT1OUT); N = 1024; }
    const int ntn = N >> 6;
    const int kt = idx / ntn, nt = idx % ntn;
    float* tl = (float*)lds;
#pragma unroll
    for (int pass = 0; pass < 4; ++pass) {
        const int r = pass * 16 + (tid >> 4), c4 = (tid & 15) * 4;
        const f32x4 v = *(const f32x4*)(src + (size_t)(kt * 64 + r) * N + nt * 64 + c4);
#pragma unroll
        for (int e = 0; e < 4; ++e) tl[r * 65 + c4 + e] = v[e];
    }
    __syncthreads();
#pragma unroll
    for (int pass = 0; pass < 2; ++pass) {
        const int n = pass * 32 + (tid >> 3), kc = tid & 7;
        float v[8];
#pragma unroll
        for (int j = 0; j < 8; ++j) v[j] = tl[(kc * 8 + j) * 65 + n];
        u32x4 w;
        w.x = cvt_pk_bf16(v[0], v[1]); w.y = cvt_pk_bf16(v[2], v[3]); w.z = cvt_pk_bf16(v[4], v[5]); w.w = cvt_pk_bf16(v[6], v[7]);
        *(u32x4*)(dst + (size_t)(nt * 64 + n) * 1024 + kt * 64 + kc * 8) = w;
    }
    __syncthreads();
}

DEVI void phase0(const Params& p, unsigned char* lds) {
    constexpr int NMOD = 96, NTR = 1664;
    for (int it = blockIdx.x; it < NMOD + NTR; it += gridDim.x) {
        if (it < NMOD) mod_item(p, it, lds); else transpose_item(p, it - NMOD, lds);
    }
    const int gt = blockIdx.x * 256 + threadIdx.x, gs = gridDim.x * 256;
    bf16_t* tw256 = (bf16_t*)(p.ws + WS_TW256);
    bf16_t* ts256 = (bf16_t*)(p.ws + WS_TS256);
    bf16_t* ts1024 = (bf16_t*)(p.ws + WS_TS1024);
    for (int i = gt; i < 512 * 256; i += gs) {
        const int m = i >> 8, j = i & 255, which = m >> 8, cp = m & 255;
        const int r = (cp * j) & 255;
        float s, c; sincospif((float)r * (1.f / 128.f), &s, &c);
        tw256[i] = f2bf(which ? s : c);
    }
    for (int i = gt; i < 256 * 512; i += gs) {
        const int sp = i >> 9, k2 = i & 511, which = k2 >> 8, s0 = k2 & 255;
        const int r = (sp * s0) & 255;
        float s, c; sincospif((float)r * (1.f / 128.f), &s, &c);
        ts256[i] = f2bf((which ? -s : c) * (1.f / 256.f));
    }
    for (int i = gt; i < 1024 * 2048; i += gs) {
        const int sp = i >> 11, k2 = i & 2047, which = k2 >> 10, s0 = k2 & 1023;
        const int r = (sp * s0) & 1023;
        float s, c; sincospif((float)r * (1.f / 512.f), &s, &c);
        ts1024[i] = f2bf((which ? -s : c) * (1.f / 512.f));
    }
    float* ropec = (float*)(p.ws + WS_ROPEC);
    float* ropes = (float*)(p.ws + WS_ROPES);
    for (int i = gt; i < 1024 * 32; i += gs) {
        const int pos = i >> 5, f = i & 31;
        const int row = pos >> 6, col = pos & 63;
        const float inv = powf(10000.f, -(float)(f & 15) * (1.f / 16.f));
        const float ang = (float)(f < 16 ? row : col) * inv;
        float s, c; sincosf(ang, &s, &c);
        ropec[i] = c; ropes[i] = s;
    }
    bf16_t* kc = (bf16_t*)(p.ws + WS_KC);
    bf16_t* vct = (bf16_t*)(p.ws + WS_VCT);
    for (int i = gt; i < 2 * 256 * 256; i += gs) {
        kc[i] = f2bf(p.cache_k[i]);
        const int b = i >> 16, kvh = (i >> 14) & 3, d = (i >> 8) & 63, pp = i & 255;
        const int key = swap23(pp);
        vct[i] = f2bf(p.cache_v[((b * 256 + key) * 4 + kvh) * 64 + d]);
    }
}

DEVI void phase_norm(const Params& p, int layer) {
    const int lane = threadIdx.x & 63, wid = threadIdx.x >> 6;
    const float* mod = (const float*)(p.ws + WS_MOD) + layer * 3 * 3072;
    const float* nw = layer ? p.norm_w1 : p.norm_w0;
    bf16_t* H = (bf16_t*)(p.ws + WS_H);
    for (int row = blockIdx.x * 4 + wid; row < NTOK; row += gridDim.x * 4) {
        const float* xr;
        if (layer == 0) xr = row < NCTX ? p.x_prompt + (size_t)row * D : p.x_sample + (size_t)(row - NCTX) * D;
        else xr = (const float*)(p.ws + WS_X1) + (size_t)row * D;
        const float* mv = mod + cond_of(row) * 3072;
        f32x4 v[4];
        float ss = 0.f;
#pragma unroll
        for (int i = 0; i < 4; ++i) {
            v[i] = *(const f32x4*)(xr + i * 256 + lane * 4);
            ss += v[i][0] * v[i][0] + v[i][1] * v[i][1] + v[i][2] * v[i][2] + v[i][3] * v[i][3];
        }
#pragma unroll
        for (int o = 32; o >= 1; o >>= 1) ss += __shfl_xor(ss, o);
        const float rstd = rsqrtf(ss * (1.f / 1024.f) + EPSV);
#pragma unroll
        for (int i = 0; i < 4; ++i) {
            const int k = i * 256 + lane * 4;
            const f32x4 w = *(const f32x4*)(nw + k);
            const f32x4 sh = *(const f32x4*)(mv + k);
            const f32x4 scl = *(const f32x4*)(mv + 1024 + k);
            float h[4];
#pragma unroll
            for (int e = 0; e < 4; ++e) h[e] = (v[i][e] * rstd * w[e]) * (1.f + scl[e]) + sh[e];
            u32x2 o; o.x = cvt_pk_bf16(h[0], h[1]); o.y = cvt_pk_bf16(h[2], h[3]);
            *(u32x2*)(H + (size_t)row * D + k) = o;
        }
    }
}

struct EpiInL0 {
    bf16_t *U, *SZ;
    DEVI void operator()(const f32x16 (&acc)[2][2], int mbase, int nbase, int fr, int fh) const {
        const bool isz = nbase >= 1024;
        bf16_t* dst = isz ? SZ : U;
        const int nb0 = isz ? nbase - 1024 : nbase;
#pragma unroll
        for (int mb = 0; mb < 2; ++mb)
#pragma unroll
            for (int nb = 0; nb < 2; ++nb)
#pragma unroll
                for (int g = 0; g < 4; ++g) {
                    const int m = mbase + mb * 32 + fr, n = nb0 + nb * 32 + 8 * g + 4 * fh;
                    float v[4];
#pragma unroll
                    for (int e = 0; e < 4; ++e) { v[e] = acc[mb][nb][4 * g + e]; if (isz) v[e] = silu_f(v[e]); }
                    u32x2 o; o.x = cvt_pk_bf16(v[0], v[1]); o.y = cvt_pk_bf16(v[2], v[3]);
                    *(u32x2*)(dst + (size_t)m * D + n) = o;
                }
    }
};

struct EpiChanDft {
    bf16_t* VT; int g;
    DEVI void operator()(const f32x16 (&acc)[2][2], int mbase, int nbase, int fr, int fh) const {
        int S, bgi, s0; bf16_t* base;
        if (nbase < NCTX) { S = 256; bgi = (nbase >> 8) * 4 + g; s0 = nbase & 255; base = VT; }
        else { const int t = nbase - NCTX; S = 1024; bgi = (t >> 10) * 4 + g; s0 = t & 1023; base = VT + (size_t)64 * 256 * 512; }
#pragma unroll
        for (int mb = 0; mb < 2; ++mb)
#pragma unroll
            for (int nb = 0; nb < 2; ++nb)
#pragma unroll
                for (int gq = 0; gq < 4; ++gq) {
                    const int m = mbase + mb * 32 + fr, which = m >> 8, cp = m & 255;
                    const int s = s0 + nb * 32 + 8 * gq + 4 * fh;
                    u32x2 o; o.x = cvt_pk_bf16(acc[mb][nb][4 * gq], acc[mb][nb][4 * gq + 1]); o.y = cvt_pk_bf16(acc[mb][nb][4 * gq + 2], acc[mb][nb][4 * gq + 3]);
                    *(u32x2*)(base + ((size_t)bgi * 256 + cp) * (2 * S) + which * S + s) = o;
                }
    }
};

struct EpiSeqDft {
    const bf16_t* SZ; bf16_t* Y; int tok0, g;
    DEVI void operator()(const f32x16 (&acc)[2][2], int mbase, int nbase, int fr, int fh) const {
#pragma unroll
        for (int mb = 0; mb < 2; ++mb)
#pragma unroll
            for (int nb = 0; nb < 2; ++nb)
#pragma unroll
                for (int gq = 0; gq < 4; ++gq) {
                    const int tok = tok0 + mbase + mb * 32 + fr;
                    const int col = g * 256 + nbase + nb * 32 + 8 * gq + 4 * fh;
                    const u32x2 z = *(const u32x2*)(SZ + (size_t)tok * D + col);
                    const float z0 = __uint_as_float(z.x << 16), z1 = __uint_as_float(z.x & 0xffff0000u);
                    const float z2 = __uint_as_float(z.y << 16), z3 = __uint_as_float(z.y & 0xffff0000u);
                    u32x2 o; o.x = cvt_pk_bf16(acc[mb][nb][4 * gq] * z0, acc[mb][nb][4 * gq + 1] * z1);
                    o.y = cvt_pk_bf16(acc[mb][nb][4 * gq + 2] * z2, acc[mb][nb][4 * gq + 3] * z3);
                    *(u32x2*)(Y + (size_t)tok * D + col) = o;
                }
    }
};

struct EpiOut {
    const float* xa; const float* xb;
    const float* mod;
    float* out;
    DEVI void operator()(const f32x16 (&acc)[2][2], int mbase, int nbase, int fr, int fh) const {
        const float* gate = mod + cond_of(mbase) * 3072 + 2048;
#pragma unroll
        for (int mb = 0; mb < 2; ++mb)
#pragma unroll
            for (int nb = 0; nb < 2; ++nb)
#pragma unroll
                for (int g = 0; g < 4; ++g) {
                    const int m = mbase + mb * 32 + fr, n = nbase + nb * 32 + 8 * g + 4 * fh;
                    const float* xr = m < NCTX ? xa + (size_t)m * D : xb + (size_t)(m - NCTX) * D;
                    const f32x4 xv = *(const f32x4*)(xr + n);
                    const f32x4 gv = *(const f32x4*)(gate + n);
                    f32x4 o;
#pragma unroll
                    for (int e = 0; e < 4; ++e) o[e] = xv[e] + gv[e] * acc[mb][nb][4 * g + e];
                    *(f32x4*)(out + (size_t)m * D + n) = o;
                }
    }
};

struct EpiInL1 {
    const float *qnw, *knw, *ropec, *ropes;
    bf16_t *Q, *KB, *VTB, *SZ;
    float *outk, *outv;
    DEVI void operator()(const f32x16 (&acc)[2][2], int mbase, int nbase, int fr, int fh) const {
        const bool lat = mbase >= NCTX;
        if (nbase < 1280) {
            const bool isq = nbase < 1024;
            const float* nwp = isq ? qnw : knw;
#pragma unroll
            for (int mb = 0; mb < 2; ++mb) {
                const int m = mbase + mb * 32 + fr;
                float ss = 0.f;
#pragma unroll
                for (int nb = 0; nb < 2; ++nb)
#pragma unroll
                    for (int r = 0; r < 16; ++r) ss += acc[mb][nb][r] * acc[mb][nb][r];
                ss += __shfl_xor(ss, 32);
                const float rn = rsqrtf(ss * (1.f / 64.f) + EPSV);
                const int pos = lat ? ((m - NCTX) & 1023) : 0;
#pragma unroll
                for (int g = 0; g < 4; ++g) {
                    const int d0 = 8 * g + 4 * fh;
                    const f32x4 w1 = *(const f32x4*)(nwp + d0), w2 = *(const f32x4*)(nwp + 32 + d0);
                    float x1[4], x2[4];
#pragma unroll
                    for (int e = 0; e < 4; ++e) { x1[e] = acc[mb][0][4 * g + e] * rn * w1[e]; x2[e] = acc[mb][1][4 * g + e] * rn * w2[e]; }
                    if (lat) {
                        const f32x4 cv = *(const f32x4*)(ropec + pos * 32 + d0), sv = *(const f32x4*)(ropes + pos * 32 + d0);
#pragma unroll
                        for (int e = 0; e < 4; ++e) { const float a = x1[e], b = x2[e]; x1[e] = a * cv[e] - b * sv[e]; x2[e] = a * sv[e] + b * cv[e]; }
                    }
                    if (isq) {
                        const float qs = 0.125f * LOG2E;
                        u32x2 o1, o2;
                        o1.x = cvt_pk_bf16(x1[0] * qs, x1[1] * qs); o1.y = cvt_pk_bf16(x1[2] * qs, x1[3] * qs);
                        o2.x = cvt_pk_bf16(x2[0] * qs, x2[1] * qs); o2.y = cvt_pk_bf16(x2[2] * qs, x2[3] * qs);
                        *(u32x2*)(Q + (size_t)m * D + nbase + d0) = o1;
                        *(u32x2*)(Q + (size_t)m * D + nbase + 32 + d0) = o2;
                    } else {
                        const int kc = nbase - 1024;
                        u32x2 o1, o2;
                        o1.x = cvt_pk_bf16(x1[0], x1[1]); o1.y = cvt_pk_bf16(x1[2], x1[3]);
                        o2.x = cvt_pk_bf16(x2[0], x2[1]); o2.y = cvt_pk_bf16(x2[2], x2[3]);
                        *(u32x2*)(KB + (size_t)m * 256 + kc + d0) = o1;
                        *(u32x2*)(KB + (size_t)m * 256 + kc + 32 + d0) = o2;
                        if (!lat) {
                            f32x4 f1 = {x1[0], x1[1], x1[2], x1[3]}, f2 = {x2[0], x2[1], x2[2], x2[3]};
                            *(f32x4*)(outk + (size_t)m * 256 + kc + d0) = f1;
                            *(f32x4*)(outk + (size_t)m * 256 + kc + 32 + d0) = f2;
                        }
                    }
                }
            }
        } else if (nbase < 1536) {
            const int vc = nbase - 1280, kvh = vc >> 6;
#pragma unroll
            for (int mb = 0; mb < 2; ++mb) {
                const int m = mbase + mb * 32 + fr;
                bf16_t* vt; int S, s;
                if (!lat) { S = 256; s = m & 255; vt = VTB + ((size_t)((m >> 8) * 4 + kvh) * 64) * 256; }
                else { const int t = m - NCTX; S = 1024; s = t & 1023; vt = VTB + (size_t)16 * 4 * 64 * 256 + ((size_t)((t >> 10) * 4 + kvh) * 64) * 1024; }
                const int sp = swap23(s);
#pragma unroll
                for (int nb = 0; nb < 2; ++nb)
#pragma unroll
                    for (int g = 0; g < 4; ++g) {
                        const int d0 = nb * 32 + 8 * g + 4 * fh;
#pragma unroll
                        for (int e = 0; e < 4; ++e) vt[(size_t)(d0 + e) * S + sp] = f2bf(acc[mb][nb][4 * g + e]);
                        if (!lat) {
                            f32x4 f = {acc[mb][nb][4 * g], acc[mb][nb][4 * g + 1], acc[mb][nb][4 * g + 2], acc[mb][nb][4 * g + 3]};
                            *(f32x4*)(outv + (size_t)m * 256 + vc + d0) = f;
                        }
                    }
            }
        } else {
            const int zc = nbase - 1536;
#pragma unroll
            for (int mb = 0; mb < 2; ++mb)
#pragma unroll
                for (int nb = 0; nb < 2; ++nb)
#pragma unroll
                    for (int g = 0; g < 4; ++g) {
                        const int m = mbase + mb * 32 + fr, n = zc + nb * 32 + 8 * g + 4 * fh;
                        u32x2 o; o.x = cvt_pk_bf16(silu_f(acc[mb][nb][4 * g]), silu_f(acc[mb][nb][4 * g + 1]));
                        o.y = cvt_pk_bf16(silu_f(acc[mb][nb][4 * g + 2]), silu_f(acc[mb][nb][4 * g + 3]));
                        *(u32x2*)(SZ + (size_t)m * D + n) = o;
                    }
        }
    }
};

DEVI void attn_item(const Params& p, int item) {
    const int lane = threadIdx.x & 63, w = threadIdx.x >> 6, fr = lane & 31, fh = lane >> 5;
    const bf16_t* Q = (const bf16_t*)(p.ws + WS_Q);
    const bf16_t* KB = (const bf16_t*)(p.ws + WS_KB);
    const bf16_t* VTB = (const bf16_t*)(p.ws + WS_VTB);
    const bf16_t* KC = (const bf16_t*)(p.ws + WS_KC);
    const bf16_t* VCT = (const bf16_t*)(p.ws + WS_VCT);
    const bf16_t* SZ = (const bf16_t*)(p.ws + WS_SZ);
    bf16_t* Y = (bf16_t*)(p.ws + WS_Y);
    bool lat; int b, kvh, qb, tb;
    if (item < 256) { lat = true; b = item >> 7; kvh = (item >> 5) & 3; qb = item & 31; tb = NCTX + b * 1024; }
    else { const int it = item - 256; lat = false; b = it >> 5; kvh = (it >> 3) & 3; qb = it & 7; tb = b * 256; }
    const int head = kvh * 4 + w;
    const int qtok = tb + qb * 32 + fr;
    bf16x8 qf[4];
#pragma unroll
    for (int ks = 0; ks < 4; ++ks) qf[ks] = *(const bf16x8*)(Q + (size_t)qtok * D + head * 64 + ks * 16 + fh * 8);
    float m_run = p.sink[head] * LOG2E, l_run = 1.f;
    f32x16 O[2];
#pragma unroll
    for (int i = 0; i < 2; ++i)
#pragma unroll
        for (int r = 0; r < 16; ++r) O[i][r] = 0.f;

    auto block = [&](const bf16_t* kp, const bf16_t* vp, int ldv, int mode, int dpos  ) {
        f32x16 s;
#pragma unroll
        for (int r = 0; r < 16; ++r) s[r] = 0.f;
#pragma unroll
        for (int ks = 0; ks < 4; ++ks) {
            const bf16x8 kf = *(const bf16x8*)(kp + (size_t)fr * 256 + ks * 16 + fh * 8);
            s = __builtin_amdgcn_mfma_f32_32x32x16_bf16(kf, qf[ks], s, 0, 0, 0);
        }
        if (mode) {
#pragma unroll
            for (int r = 0; r < 16; ++r) {
                const int rel = dpos + (r & 3) + 8 * (r >> 2) + 4 * fh - fr;
                const bool ok = mode == 1 ? (rel >= -128) : (rel <= 128);
                if (!ok) s[r] = -1e30f;
            }
        }
        float mx = s[0];
#pragma unroll
        for (int r = 1; r < 16; ++r) mx = fmaxf(mx, s[r]);
        mx = fmaxf(mx, __shfl_xor(mx, 32));
        const float m_new = fmaxf(m_run, mx);
        const float alpha = exp2f(m_run - m_new);
        float rs = 0.f;
#pragma unroll
        for (int r = 0; r < 16; ++r) { s[r] = exp2f(s[r] - m_new); rs += s[r]; }
        rs += __shfl_xor(rs, 32);
        l_run = l_run * alpha + rs; m_run = m_new;
#pragma unroll
        for (int i = 0; i < 2; ++i)
#pragma unroll
            for (int r = 0; r < 16; ++r) O[i][r] *= alpha;
#pragma unroll
        for (int s2 = 0; s2 < 2; ++s2) {
            union { u32x4 u; bf16x8 v; } pf;
            pf.u.x = cvt_pk_bf16(s[8 * s2 + 0], s[8 * s2 + 1]); pf.u.y = cvt_pk_bf16(s[8 * s2 + 2], s[8 * s2 + 3]);
            pf.u.z = cvt_pk_bf16(s[8 * s2 + 4], s[8 * s2 + 5]); pf.u.w = cvt_pk_bf16(s[8 * s2 + 6], s[8 * s2 + 7]);
#pragma unroll
            for (int db = 0; db < 2; ++db) {
                const bf16x8 vf = *(const bf16x8*)(vp + (size_t)(db * 32 + fr) * ldv + s2 * 16 + fh * 8);
                O[db] = __builtin_amdgcn_mfma_f32_32x32x16_bf16(vf, pf.v, O[db], 0, 0, 0);
            }
        }
    };

    if (lat) {
        const bf16_t* vbase = VTB + (size_t)16 * 4 * 64 * 256 + ((size_t)(b * 4 + kvh) * 64) * 1024;
        const int k_lo = qb - 4 < 0 ? 0 : qb - 4, k_hi = qb + 4 > 31 ? 31 : qb + 4;
        for (int kb = k_lo; kb <= k_hi; ++kb) {
            const int mode = (kb == qb - 4) ? 1 : (kb == qb + 4) ? 2 : 0;
            block(KB + (size_t)(tb + kb * 32) * 256 + kvh * 64, vbase + kb * 32, 1024, mode, (kb - qb) * 32);
        }
        const bf16_t* vcb = VCT + ((size_t)(b * 4 + kvh) * 64) * 256;
        for (int kb = 0; kb < 8; ++kb)
            block(KC + (size_t)(b * 256 + kb * 32) * 256 + kvh * 64, vcb + kb * 32, 256, 0, 0);
    } else {
        const bf16_t* vbase = VTB + ((size_t)(b * 4 + kvh) * 64) * 256;
        for (int kb = 0; kb < 8; ++kb)
            block(KB + (size_t)(tb + kb * 32) * 256 + kvh * 64, vbase + kb * 32, 256, 0, 0);
    }
    const float il = 1.f / l_run;
#pragma unroll
    for (int db = 0; db < 2; ++db)
#pragma unroll
        for (int g = 0; g < 4; ++g) {
            const int col = head * 64 + db * 32 + 8 * g + 4 * fh;
            const u32x2 z = *(const u32x2*)(SZ + (size_t)qtok * D + col);
            const float z0 = __uint_as_float(z.x << 16), z1 = __uint_as_float(z.x & 0xffff0000u);
            const float z2 = __uint_as_float(z.y << 16), z3 = __uint_as_float(z.y & 0xffff0000u);
            u32x2 o; o.x = cvt_pk_bf16(O[db][4 * g] * il * z0, O[db][4 * g + 1] * il * z1);
            o.y = cvt_pk_bf16(O[db][4 * g + 2] * il * z2, O[db][4 * g + 3] * il * z3);
            *(u32x2*)(Y + (size_t)qtok * D + col) = o;
        }
}

DEVI void run_phase(const Params& p, int ph, unsigned char* lds) {
    const int G = gridDim.x;
    bf16_t* H = (bf16_t*)(p.ws + WS_H);
    bf16_t* U = (bf16_t*)(p.ws + WS_U);
    bf16_t* SZ = (bf16_t*)(p.ws + WS_SZ);
    bf16_t* VT = (bf16_t*)(p.ws + WS_VT);
    bf16_t* Y = (bf16_t*)(p.ws + WS_Y);
    float* X1 = (float*)(p.ws + WS_X1);
    const float* mod = (const float*)(p.ws + WS_MOD);
    switch (ph) {
    case 0: phase0(p, lds); break;
    case 1: phase_norm(p, 0); break;
    case 2: {
        EpiInL0 e{U, SZ};
        for (int t = blockIdx.x; t < 768; t += G) {
            const int tt = xcd_remap(t, 768);
            gemm_tile(H, D, (const bf16_t*)(p.ws + WS_WT0IN), D, 16, lds, e, (tt >> 4) * 128, (tt & 15) * 128);
        }
    } break;
    case 3: {
        for (int t = blockIdx.x; t < 768; t += G) {
            const int tt = xcd_remap(t, 768);
            const int mt = tt & 3, g = (tt >> 2) & 3, nt = tt >> 4;
            EpiChanDft e{VT, g};
            gemm_tile((const bf16_t*)(p.ws + WS_TW256), 256, U + g * 256, D, 4, lds, e, mt * 128, nt * 128);
        }
    } break;
    case 4: {
        for (int t = blockIdx.x; t < 384; t += G) {
            if (t < 128) {
                const int nt = t & 1, mt = (t >> 1) & 7, bg = t >> 4;
                EpiSeqDft e{SZ, Y, NCTX + (bg >> 2) * 1024, bg & 3};
                gemm_tile((const bf16_t*)(p.ws + WS_TS1024), 2048, VT + (size_t)64 * 256 * 512 + (size_t)bg * 256 * 2048, 2048, 32, lds, e, mt * 128, nt * 128);
            } else {
                const int u = t - 128, nt = u & 1, mt = (u >> 1) & 1, bg = u >> 2;
                EpiSeqDft e{SZ, Y, (bg >> 2) * 256, bg & 3};
                gemm_tile((const bf16_t*)(p.ws + WS_TS256), 512, VT + (size_t)bg * 256 * 512, 512, 8, lds, e, mt * 128, nt * 128);
            }
        }
    } break;
    case 5: {
        EpiOut e{p.x_prompt, p.x_sample, mod, X1};
        for (int t = blockIdx.x; t < 384; t += G) {
            const int tt = xcd_remap(t, 384);
            gemm_tile(Y, D, (const bf16_t*)(p.ws + WS_WT0OUT), D, 16, lds, e, (tt >> 3) * 128, (tt & 7) * 128);
        }
    } break;
    case 6: phase_norm(p, 1); break;
    case 7: {
        EpiInL1 e{p.qnw, p.knw, (const float*)(p.ws + WS_ROPEC), (const float*)(p.ws + WS_ROPES),
                  (bf16_t*)(p.ws + WS_Q), (bf16_t*)(p.ws + WS_KB), (bf16_t*)(p.ws + WS_VTB), SZ,
                  p.out + (size_t)NTOK * D, p.out + (size_t)NTOK * D + (size_t)NCTX * 256};
        for (int t = blockIdx.x; t < 960; t += G) {
            const int tt = xcd_remap(t, 960);
            gemm_tile(H, D, (const bf16_t*)(p.ws + WS_WT1IN), D, 16, lds, e, (tt / 20) * 128, (tt % 20) * 128);
        }
    } break;
    case 8: {
        for (int t = blockIdx.x; t < 768; t += G) attn_item(p, t);
    } break;
    case 9: {
        EpiOut e{X1, X1 + (size_t)NCTX * D, mod + 3 * 3072, p.out};
        for (int t = blockIdx.x; t < 384; t += G) {
            const int tt = xcd_remap(t, 384);
            gemm_tile(Y, D, (const bf16_t*)(p.ws + WS_WT1OUT), D, 16, lds, e, (tt >> 3) * 128, (tt & 7) * 128);
        }
    } break;
    }
}

__global__ void __launch_bounds__(256, 2) mega(Params p) {
    __shared__ __attribute__((aligned(16))) unsigned char lds[65536];
    cg::grid_group grid = cg::this_grid();
#if SINGLE_LAUNCH
#define PH(n) run_phase(p, n, lds);
#define SY() grid.sync();
#else
    const int lo = (int)p.ph_lo, hi = (int)p.ph_hi;
#define PH(n) if (lo <= n && n < hi) run_phase(p, n, lds);
#define SY()
#endif
    PH(0) SY() PH(1) SY() PH(2) SY() PH(3) SY() PH(4) SY() PH(5) SY() PH(6) SY() PH(7) SY() PH(8) SY() PH(9)
}

extern "C" void kernel_launch(void* const* d_in, const int* in_sizes, int n_in, void* d_out, int out_size, void* d_ws, size_t ws_size, hipStream_t stream) {
    static int grid_blocks = 0;
    if (!grid_blocks) {
        int dev = 0, cus = 0, per_cu = 0;
        hipGetDevice(&dev);
        hipDeviceGetAttribute(&cus, hipDeviceAttributeMultiprocessorCount, dev);
        hipOccupancyMaxActiveBlocksPerMultiprocessor(&per_cu, mega, 256, 0);
        if (per_cu > 2) per_cu = 2;
        if (per_cu < 1) per_cu = 1;
        grid_blocks = cus * per_cu;
    }
    Params p{};
    const float* const* in = (const float* const*)d_in;
    p.x_prompt = in[0]; p.x_sample = in[1]; p.cache_k = in[2]; p.cache_v = in[3]; p.c = in[4]; p.c_ctx = in[5];
    p.norm_w0 = in[6]; p.w_mod0 = in[7]; p.b_mod0 = in[8]; p.w_in0 = in[9]; p.w_out0 = in[10];
    p.norm_w1 = in[11]; p.w_mod1 = in[12]; p.b_mod1 = in[13]; p.w_in1 = in[14]; p.qnw = in[15]; p.knw = in[16]; p.sink = in[17]; p.w_out1 = in[18];
    p.out = (float*)d_out; p.ws = (unsigned char*)d_ws;
#if SINGLE_LAUNCH
    p.ph_lo = 0; p.ph_hi = 10;
    void* args[] = {&p};
    hipError_t e = hipLaunchCooperativeKernel((void*)mega, dim3(grid_blocks), dim3(256), args, 0, stream);
    if (e != hipSuccess) fprintf(stderr, "cooperative launch failed: %s (grid %d)\n", hipGetErrorString(e), grid_blocks);
#else
    for (int ph = 0; ph < 10; ++ph) {
        p.ph_lo = ph; p.ph_hi = ph + 1;
        hipLaunchKernelGGL(mega, dim3(grid_blocks), dim3(256), 0, stream, p);
    }
#endif
}
```

```cpp
#include <hip/hip_runtime.h>
#include <hip/hip_cooperative_groups.h>
#include <stdint.h>
#include <cstdio>
namespace cg = cooperative_groups;

#ifndef SINGLE_LAUNCH
#define SINGLE_LAUNCH 1
#endif

typedef unsigned short bf16_t;
typedef short bf16x8 __attribute__((ext_vector_type(8)));
typedef float f32x16 __attribute__((ext_vector_type(16)));
typedef float f32x4 __attribute__((ext_vector_type(4)));
typedef unsigned u32x4 __attribute__((ext_vector_type(4)));
typedef unsigned u32x2 __attribute__((ext_vector_type(2)));
#define DEVI __device__ __forceinline__

constexpr int NTOK = 6144, NCTX = 4096, D = 1024;
constexpr float EPSV = 1e-6f;
constexpr float LOG2E = 1.4426950408889634f;

constexpr size_t WS_MOD = 0;
constexpr size_t WS_WT0IN = 1 << 20;
constexpr size_t WS_WT0OUT = WS_WT0IN + (size_t)2048 * 1024 * 2;
constexpr size_t WS_WT1IN = WS_WT0OUT + (size_t)1024 * 1024 * 2;
constexpr size_t WS_WT1OUT = WS_WT1IN + (size_t)2560 * 1024 * 2;
constexpr size_t WS_TW256 = WS_WT1OUT + (size_t)1024 * 1024 * 2;
constexpr size_t WS_TS256 = WS_TW256 + (size_t)512 * 256 * 2;
constexpr size_t WS_TS1024 = WS_TS256 + (size_t)256 * 512 * 2;
constexpr size_t WS_ROPEC = WS_TS1024 + (size_t)1024 * 2048 * 2;
constexpr size_t WS_ROPES = WS_ROPEC + (size_t)1024 * 32 * 4;
constexpr size_t WS_KC = WS_ROPES + (size_t)1024 * 32 * 4;
constexpr size_t WS_VCT = WS_KC + (size_t)2 * 256 * 256 * 2;
constexpr size_t WS_H = WS_VCT + (size_t)2 * 256 * 256 * 2;
constexpr size_t WS_U = WS_H + (size_t)NTOK * D * 2;
constexpr size_t WS_SZ = WS_U + (size_t)NTOK * D * 2;
constexpr size_t WS_VT = WS_SZ + (size_t)NTOK * D * 2;
constexpr size_t WS_Y = WS_VT + (size_t)NTOK * 2048 * 2;
constexpr size_t WS_X1 = WS_Y + (size_t)NTOK * D * 2;
constexpr size_t WS_Q = WS_X1 + (size_t)NTOK * D * 4;
constexpr size_t WS_KB = WS_Q + (size_t)NTOK * D * 2;
constexpr size_t WS_VTB = WS_KB + (size_t)NTOK * 256 * 2;
constexpr size_t WS_END = WS_VTB + (size_t)NTOK * 256 * 2;

struct Params {
    const float *x_prompt, *x_sample, *cache_k, *cache_v, *c, *c_ctx;
    const float *norm_w0, *w_mod0, *b_mod0, *w_in0, *w_out0;
    const float *norm_w1, *w_mod1, *b_mod1, *w_in1, *qnw, *knw, *sink, *w_out1;
    float* out;
    unsigned char* ws;
    long long ph_lo, ph_hi;
};

DEVI unsigned cvt_pk_bf16(float lo, float hi) { unsigned r; asm("v_cvt_pk_bf16_f32 %0, %1, %2" : "=v"(r) : "v"(lo), "v"(hi)); return r; }
DEVI bf16_t f2bf(float f) { return (bf16_t)(cvt_pk_bf16(f, 0.f) & 0xffffu); }
DEVI float silu_f(float v) { return v / (1.f + __expf(-v)); }
DEVI int swap23(int x) { return (x & ~12) | ((x & 4) << 1) | ((x & 8) >> 1); }
DEVI int cond_of(int m) { return m < NCTX ? 0 : 1 + ((m - NCTX) >> 10); }

DEVI void glds16(const void* g, void* l) { __builtin_amdgcn_global_load_lds(g, l, 16, 0, 0); }

template <class Epi>
DEVI void gemm_tile(const bf16_t* __restrict__ A, int lda, const bf16_t* __restrict__ B, int ldb, int nk,
                    unsigned char* lds, const Epi& epi, int m0, int n0) {
    const int tid = threadIdx.x, lane = tid & 63, wid = tid >> 6, wr = wid >> 1, wc = wid & 1;
    const int srow = tid >> 3;
    const int slc = (tid & 7) ^ ((tid >> 4) & 7);
    const bf16_t* gA = A + (size_t)(m0 + srow) * lda + slc * 8;
    const bf16_t* gB = B + (size_t)(n0 + srow) * ldb + slc * 8;
    const int fr = lane & 31, fh = lane >> 5, sw = (lane >> 1) & 7;
    const unsigned aoff = (wr * 64 + fr) * 128, boff = 16384 + (wc * 64 + fr) * 128;
    f32x16 acc[2][2];
#pragma unroll
    for (int i = 0; i < 2; ++i)
#pragma unroll
        for (int j = 0; j < 2; ++j)
#pragma unroll
            for (int r = 0; r < 16; ++r) acc[i][j][r] = 0.f;
    {
        unsigned char* la = lds + tid * 16;
#pragma unroll
        for (int i = 0; i < 4; ++i) {
            glds16(gA + (size_t)i * 32 * lda, la + i * 4096);
            glds16(gB + (size_t)i * 32 * ldb, la + 16384 + i * 4096);
        }
    }
    for (int kt = 0; kt < nk; ++kt) {
        asm volatile("s_waitcnt vmcnt(0)" ::: "memory");
        __syncthreads();
        if (kt + 1 < nk) {
            unsigned char* la = lds + ((kt + 1) & 1) * 32768 + tid * 16;
            const int ko = (kt + 1) * 64;
#pragma unroll
            for (int i = 0; i < 4; ++i) {
                glds16(gA + (size_t)i * 32 * lda + ko, la + i * 4096);
                glds16(gB + (size_t)i * 32 * ldb + ko, la + 16384 + i * 4096);
            }
        }
        const unsigned char* base = lds + (kt & 1) * 32768;
#pragma unroll
        for (int ks = 0; ks < 4; ++ks) {
            const int ch = ((2 * ks + fh) ^ sw) * 16;
            const bf16x8 a0 = *(const bf16x8*)(base + aoff + ch);
            const bf16x8 a1 = *(const bf16x8*)(base + aoff + 4096 + ch);
            const bf16x8 b0 = *(const bf16x8*)(base + boff + ch);
            const bf16x8 b1 = *(const bf16x8*)(base + boff + 4096 + ch);
            acc[0][0] = __builtin_amdgcn_mfma_f32_32x32x16_bf16(b0, a0, acc[0][0], 0, 0, 0);
            acc[0][1] = __builtin_amdgcn_mfma_f32_32x32x16_bf16(b1, a0, acc[0][1], 0, 0, 0);
            acc[1][0] = __builtin_amdgcn_mfma_f32_32x32x16_bf16(b0, a1, acc[1][0], 0, 0, 0);
            acc[1][1] = __builtin_amdgcn_mfma_f32_32x32x16_bf16(b1, a1, acc[1][1], 0, 0, 0);
        }
    }
    epi(acc, m0 + wr * 64, n0 + wc * 64, fr, fh);
    __syncthreads();
}

DEVI int xcd_remap(int t, int T) { return (t & 7) * (T >> 3) + (t >> 3); }

DEVI void mod_item(const Params& p, int it, unsigned char* lds) {
    const int tid = threadIdx.x;
    const int l = it / 48, cc = it % 48;
    float* sc = (float*)lds;
    for (int i = tid; i < 3072; i += 256) {
        const int cv = i >> 10, k = i & 1023;
        const float cval = cv == 0 ? p.c_ctx[k] : p.c[(cv - 1) * 1024 + k];
        sc[i] = silu_f(cval);
    }
    __syncthreads();
    const float* W = l ? p.w_mod1 : p.w_mod0;
    const float* bm = l ? p.b_mod1 : p.b_mod0;
    const int cg4 = tid & 15, rg = tid >> 4, c0 = cc * 64 + cg4 * 4;
    f32x4 a0 = {0.f, 0.f, 0.f, 0.f}, a1 = a0, a2 = a0;
#pragma unroll 8
    for (int k = rg; k < 1024; k += 16) {
        const f32x4 w = *(const f32x4*)(W + (size_t)k * 3072 + c0);
        a0 += sc[k] * w; a1 += sc[1024 + k] * w; a2 += sc[2048 + k] * w;
    }
    float* red = (float*)(lds + 12288);
#pragma unroll
    for (int e = 0; e < 4; ++e) {
        red[(rg * 3 + 0) * 64 + cg4 * 4 + e] = a0[e];
        red[(rg * 3 + 1) * 64 + cg4 * 4 + e] = a1[e];
        red[(rg * 3 + 2) * 64 + cg4 * 4 + e] = a2[e];
    }
    __syncthreads();
    if (tid < 192) {
        const int cv = tid >> 6, j = tid & 63;
        float s = 0.f;
#pragma unroll
        for (int r = 0; r < 16; ++r) s += red[(r * 3 + cv) * 64 + j];
        float* mod = (float*)(p.ws + WS_MOD);
        mod[(l * 3 + cv) * 3072 + cc * 64 + j] = s + bm[cc * 64 + j];
    }
    __syncthreads();
}

DEVI void transpose_item(const Params& p, int idx, unsigned char* lds) {
    const int tid = threadIdx.x;
    const float* src; bf16_t* dst; int N;
    if (idx < 512) { src = p.w_in0; dst = (bf16_t*)(p.ws + WS_WT0IN); N = 2048; }
    else if (idx < 768) { idx -= 512; src = p.w_out0; dst = (bf16_t*)(p.ws + WS_WT0OUT); N = 1024; }
    else if (idx < 1408) { idx -= 768; src = p.w_in1; dst = (bf16_t*)(p.ws + WS_WT1IN); N = 2560; }
    else { idx -= 1408; src = p.w_out1; dst = (bf16_t*)(p.ws + WS_WT1OUT); N = 1024; }
    const int ntn = N >> 6;
    const int kt = idx / ntn, nt = idx % ntn;
    float* tl = (float*)lds;
#pragma unroll
    for (int pass = 0; pass < 4; ++pass) {
        const int r = pass * 16 + (tid >> 4), c4 = (tid & 15) * 4;
        const f32x4 v = *(const f32x4*)(src + (size_t)(kt * 64 + r) * N + nt * 64 + c4);
#pragma unroll
        for (int e = 0; e < 4; ++e) tl[r * 65 + c4 + e] = v[e];
    }
    __syncthreads();
#pragma unroll
    for (int pass = 0; pass < 2; ++pass) {
        const int n = pass * 32 + (tid >> 3), kc = tid & 7;
        float v[8];
#pragma unroll
        for (int j = 0; j < 8; ++j) v[j] = tl[(kc * 8 + j) * 65 + n];
        u32x4 w;
        w.x = cvt_pk_bf16(v[0], v[1]); w.y = cvt_pk_bf16(v[2], v[3]); w.z = cvt_pk_bf16(v[4], v[5]); w.w = cvt_pk_bf16(v[6], v[7]);
        *(u32x4*)(dst + (size_t)(nt * 64 + n) * 1024 + kt * 64 + kc * 8) = w;
    }
    __syncthreads();
}

DEVI void phase0(const Params& p, unsigned char* lds) {
    constexpr int NMOD = 96, NTR = 1664;
    for (int it = blockIdx.x; it < NMOD + NTR; it += gridDim.x) {
        if (it < NMOD) mod_item(p, it, lds); else transpose_item(p, it - NMOD, lds);
    }
    const int gt = blockIdx.x * 256 + threadIdx.x, gs = gridDim.x * 256;
    bf16_t* tw256 = (bf16_t*)(p.ws + WS_TW256);
    bf16_t* ts256 = (bf16_t*)(p.ws + WS_TS256);
    bf16_t* ts1024 = (bf16_t*)(p.ws + WS_TS1024);
    for (int i = gt; i < 512 * 256; i += gs) {
        const int m = i >> 8, j = i & 255, which = m >> 8, cp = m & 255;
        const int r = (cp * j) & 255;
        float s, c; sincospif((float)r * (1.f / 128.f), &s, &c);
        tw256[i] = f2bf(which ? s : c);
    }
    for (int i = gt; i < 256 * 512; i += gs) {
        const int sp = i >> 9, k2 = i & 511, which = k2 >> 8, s0 = k2 & 255;
        const int r = (sp * s0) & 255;
        float s, c; sincospif((float)r * (1.f / 128.f), &s, &c);
        ts256[i] = f2bf((which ? -s : c) * (1.f / 256.f));
    }
    for (int i = gt; i < 1024 * 2048; i += gs) {
        const int sp = i >> 11, k2 = i & 2047, which = k2 >> 10, s0 = k2 & 1023;
        const int r = (sp * s0) & 1023;
        float s, c; sincospif((float)r * (1.f / 512.f), &s, &c);
        ts1024[i] = f2bf((which ? -s : c) * (1.f / 512.f));
    }
    float* ropec = (float*)(p.ws + WS_ROPEC);
    float* ropes = (float*)(p.ws + WS_ROPES);
    for (int i = gt; i < 1024 * 32; i += gs) {
        const int pos = i >> 5, f = i & 31;
        const int row = pos >> 6, col = pos & 63;
        const float inv = powf(10000.f, -(float)(f & 15) * (1.f / 16.f));
        const float ang = (float)(f < 16 ? row : col) * inv;
        float s, c; sincosf(ang, &s, &c);
        ropec[i] = c; ropes[i] = s;
    }
    bf16_t* kc = (bf16_t*)(p.ws + WS_KC);
    bf16_t* vct = (bf16_t*)(p.ws + WS_VCT);
    for (int i = gt; i < 2 * 256 * 256; i += gs) {
        kc[i] = f2bf(p.cache_k[i]);
        const int b = i >> 16, kvh = (i >> 14) & 3, d = (i >> 8) & 63, pp = i & 255;
        const int key = swap23(pp);
        vct[i] = f2bf(p.cache_v[((b * 256 + key) * 4 + kvh) * 64 + d]);
    }
}

DEVI void phase_norm(const Params& p, int layer) {
    const int lane = threadIdx.x & 63, wid = threadIdx.x >> 6;
    const float* mod = (const float*)(p.ws + WS_MOD) + layer * 3 * 3072;
    const float* nw = layer ? p.norm_w1 : p.norm_w0;
    bf16_t* H = (bf16_t*)(p.ws + WS_H);
    for (int row = blockIdx.x * 4 + wid; row < NTOK; row += gridDim.x * 4) {
        const float* xr;
        if (layer == 0) xr = row < NCTX ? p.x_prompt + (size_t)row * D : p.x_sample + (size_t)(row - NCTX) * D;
        else xr = (const float*)(p.ws + WS_X1) + (size_t)row * D;
        const float* mv = mod + cond_of(row) * 3072;
        f32x4 v[4];
        float ss = 0.f;
#pragma unroll
        for (int i = 0; i < 4; ++i) {
            v[i] = *(const f32x4*)(xr + i * 256 + lane * 4);
            ss += v[i][0] * v[i][0] + v[i][1] * v[i][1] + v[i][2] * v[i][2] + v[i][3] * v[i][3];
        }
#pragma unroll
        for (int o = 32; o >= 1; o >>= 1) ss += __shfl_xor(ss, o);
        const float rstd = rsqrtf(ss * (1.f / 1024.f) + EPSV);
#pragma unroll
        for (int i = 0; i < 4; ++i) {
            const int k = i * 256 + lane * 4;
            const f32x4 w = *(const f32x4*)(nw + k);
            const f32x4 sh = *(const f32x4*)(mv + k);
            const f32x4 scl = *(const f32x4*)(mv + 1024 + k);
            float h[4];
#pragma unroll
            for (int e = 0; e < 4; ++e) h[e] = (v[i][e] * rstd * w[e]) * (1.f + scl[e]) + sh[e];
            u32x2 o; o.x = cvt_pk_bf16(h[0], h[1]); o.y = cvt_pk_bf16(h[2], h[3]);
            *(u32x2*)(H + (size_t)row * D + k) = o;
        }
    }
}

struct EpiInL0 {
    bf16_t *U, *SZ;
    DEVI void operator()(const f32x16 (&acc)[2][2], int mbase, int nbase, int fr, int fh) const {
        const bool isz = nbase >= 1024;
        bf16_t* dst = isz ? SZ : U;
        const int nb0 = isz ? nbase - 1024 : nbase;
#pragma unroll
        for (int mb = 0; mb < 2; ++mb)
#pragma unroll
            for (int nb = 0; nb < 2; ++nb)
#pragma unroll
                for (int g = 0; g < 4; ++g) {
                    const int m = mbase + mb * 32 + fr, n = nb0 + nb * 32 + 8 * g + 4 * fh;
                    float v[4];
#pragma unroll
                    for (int e = 0; e < 4; ++e) { v[e] = acc[mb][nb][4 * g + e]; if (isz) v[e] = silu_f(v[e]); }
                    u32x2 o; o.x = cvt_pk_bf16(v[0], v[1]); o.y = cvt_pk_bf16(v[2], v[3]);
                    *(u32x2*)(dst + (size_t)m * D + n) = o;
                }
    }
};

struct EpiChanDft {
    bf16_t* VT; int g;
    DEVI void operator()(const f32x16 (&acc)[2][2], int mbase, int nbase, int fr, int fh) const {
        int S, bgi, s0; bf16_t* base;
        if (nbase < NCTX) { S = 256; bgi = (nbase >> 8) * 4 + g; s0 = nbase & 255; base = VT; }
        else { const int t = nbase - NCTX; S = 1024; bgi = (t >> 10) * 4 + g; s0 = t & 1023; base = VT + (size_t)64 * 256 * 512; }
#pragma unroll
        for (int mb = 0; mb < 2; ++mb)
#pragma unroll
            for (int nb = 0; nb < 2; ++nb)
#pragma unroll
                for (int gq = 0; gq < 4; ++gq) {
                    const int m = mbase + mb * 32 + fr, which = m >> 8, cp = m & 255;
                    const int s = s0 + nb * 32 + 8 * gq + 4 * fh;
                    u32x2 o; o.x = cvt_pk_bf16(acc[mb][nb][4 * gq], acc[mb][nb][4 * gq + 1]); o.y = cvt_pk_bf16(acc[mb][nb][4 * gq + 2], acc[mb][nb][4 * gq + 3]);
                    *(u32x2*)(base + ((size_t)bgi * 256 + cp) * (2 * S) + which * S + s) = o;
                }
    }
};

struct EpiSeqDft {
    const bf16_t* SZ; bf16_t* Y; int tok0, g;
    DEVI void operator()(const f32x16 (&acc)[2][2], int mbase, int nbase, int fr, int fh) const {
#pragma unroll
        for (int mb = 0; mb < 2; ++mb)
#pragma unroll
            for (int nb = 0; nb < 2; ++nb)
#pragma unroll
                for (int gq = 0; gq < 4; ++gq) {
                    const int tok = tok0 + mbase + mb * 32 + fr;
                    const int col = g * 256 + nbase + nb * 32 + 8 * gq + 4 * fh;
                    const u32x2 z = *(const u32x2*)(SZ + (size_t)tok * D + col);
                    const float z0 = __uint_as_float(z.x << 16), z1 = __uint_as_float(z.x & 0xffff0000u);
                    const float z2 = __uint_as_float(z.y << 16), z3 = __uint_as_float(z.y & 0xffff0000u);
                    u32x2 o; o.x = cvt_pk_bf16(acc[mb][nb][4 * gq] * z0, acc[mb][nb][4 * gq + 1] * z1);
                    o.y = cvt_pk_bf16(acc[mb][nb][4 * gq + 2] * z2, acc[mb][nb][4 * gq + 3] * z3);
                    *(u32x2*)(Y + (size_t)tok * D + col) = o;
                }
    }
};

struct EpiOut {
    const float* xa; const float* xb;
    const float* mod;
    float* out;
    DEVI void operator()(const f32x16 (&acc)[2][2], int mbase, int nbase, int fr, int fh) const {
        const float* gate = mod + cond_of(mbase) * 3072 + 2048;
#pragma unroll
        for (int mb = 0; mb < 2; ++mb)
#pragma unroll
            for (int nb = 0; nb < 2; ++nb)
#pragma unroll
                for (int g = 0; g < 4; ++g) {
                    const int m = mbase + mb * 32 + fr, n = nbase + nb * 32 + 8 * g + 4 * fh;
                    const float* xr = m < NCTX ? xa + (size_t)m * D : xb + (size_t)(m - NCTX) * D;
                    const f32x4 xv = *(const f32x4*)(xr + n);
                    const f32x4 gv = *(const f32x4*)(gate + n);
                    f32x4 o;
#pragma unroll
                    for (int e = 0; e < 4; ++e) o[e] = xv[e] + gv[e] * acc[mb][nb][4 * g + e];
                    *(f32x4*)(out + (size_t)m * D + n) = o;
                }
    }
};

struct EpiInL1 {
    const float *qnw, *knw, *ropec, *ropes;
    bf16_t *Q, *KB, *VTB, *SZ;
    float *outk, *outv;
    DEVI void operator()(const f32x16 (&acc)[2][2], int mbase, int nbase, int fr, int fh) const {
        const bool lat = mbase >= NCTX;
        if (nbase < 1280) {
            const bool isq = nbase < 1024;
            const float* nwp = isq ? qnw : knw;
#pragma unroll
            for (int mb = 0; mb < 2; ++mb) {
                const int m = mbase + mb * 32 + fr;
                float ss = 0.f;
#pragma unroll
                for (int nb = 0; nb < 2; ++nb)
#pragma unroll
                    for (int r = 0; r < 16; ++r) ss += acc[mb][nb][r] * acc[mb][nb][r];
                ss += __shfl_xor(ss, 32);
                const float rn = rsqrtf(ss * (1.f / 64.f) + EPSV);
                const int pos = lat ? ((m - NCTX) & 1023) : 0;
#pragma unroll
                for (int g = 0; g < 4; ++g) {
                    const int d0 = 8 * g + 4 * fh;
                    const f32x4 w1 = *(const f32x4*)(nwp + d0), w2 = *(const f32x4*)(nwp + 32 + d0);
                    float x1[4], x2[4];
#pragma unroll
                    for (int e = 0; e < 4; ++e) { x1[e] = acc[mb][0][4 * g + e] * rn * w1[e]; x2[e] = acc[mb][1][4 * g + e] * rn * w2[e]; }
                    if (lat) {
                        const f32x4 cv = *(const f32x4*)(ropec + pos * 32 + d0), sv = *(const f32x4*)(ropes + pos * 32 + d0);
#pragma unroll
                        for (int e = 0; e < 4; ++e) { const float a = x1[e], b = x2[e]; x1[e] = a * cv[e] - b * sv[e]; x2[e] = a * sv[e] + b * cv[e]; }
                    }
                    if (isq) {
                        const float qs = 0.125f * LOG2E;
                        u32x2 o1, o2;
                        o1.x = cvt_pk_bf16(x1[0] * qs, x1[1] * qs); o1.y = cvt_pk_bf16(x1[2] * qs, x1[3] * qs);
                        o2.x = cvt_pk_bf16(x2[0] * qs, x2[1] * qs); o2.y = cvt_pk_bf16(x2[2] * qs, x2[3] * qs);
                        *(u32x2*)(Q + (size_t)m * D + nbase + d0) = o1;
                        *(u32x2*)(Q + (size_t)m * D + nbase + 32 + d0) = o2;
                    } else {
                        const int kc = nbase - 1024;
                        u32x2 o1, o2;
                        o1.x = cvt_pk_bf16(x1[0], x1[1]); o1.y = cvt_pk_bf16(x1[2], x1[3]);
                        o2.x = cvt_pk_bf16(x2[0], x2[1]); o2.y = cvt_pk_bf16(x2[2], x2[3]);
                        *(u32x2*)(KB + (size_t)m * 256 + kc + d0) = o1;
                        *(u32x2*)(KB + (size_t)m * 256 + kc + 32 + d0) = o2;
                        if (!lat) {
                            f32x4 f1 = {x1[0], x1[1], x1[2], x1[3]}, f2 = {x2[0], x2[1], x2[2], x2[3]};
                            *(f32x4*)(outk + (size_t)m * 256 + kc + d0) = f1;
                            *(f32x4*)(outk + (size_t)m * 256 + kc + 32 + d0) = f2;
                        }
                    }
                }
            }
        } else if (nbase < 1536) {
            const int vc = nbase - 1280, kvh = vc >> 6;
#pragma unroll
            for (int mb = 0; mb < 2; ++mb) {
                const int m = mbase + mb * 32 + fr;
                bf16_t* vt; int S, s;
                if (!lat) { S = 256; s = m & 255; vt = VTB + ((size_t)((m >> 8) * 4 + kvh) * 64) * 256; }
                else { const int t = m - NCTX; S = 1024; s = t & 1023; vt = VTB + (size_t)16 * 4 * 64 * 256 + ((size_t)((t >> 10) * 4 + kvh) * 64) * 1024; }
                const int sp = swap23(s);
#pragma unroll
                for (int nb = 0; nb < 2; ++nb)
#pragma unroll
                    for (int g = 0; g < 4; ++g) {
                        const int d0 = nb * 32 + 8 * g + 4 * fh;
#pragma unroll
                        for (int e = 0; e < 4; ++e) vt[(size_t)(d0 + e) * S + sp] = f2bf(acc[mb][nb][4 * g + e]);
                        if (!lat) {
                            f32x4 f = {acc[mb][nb][4 * g], acc[mb][nb][4 * g + 1], acc[mb][nb][4 * g + 2], acc[mb][nb][4 * g + 3]};
                            *(f32x4*)(outv + (size_t)m * 256 + vc + d0) = f;
                        }
                    }
            }
        } else {
            const int zc = nbase - 1536;
#pragma unroll
            for (int mb = 0; mb < 2; ++mb)
#pragma unroll
                for (int nb = 0; nb < 2; ++nb)
#pragma unroll
                    for (int g = 0; g < 4; ++g) {
                        const int m = mbase + mb * 32 + fr, n = zc + nb * 32 + 8 * g + 4 * fh;
                        u32x2 o; o.x = cvt_pk_bf16(silu_f(acc[mb][nb][4 * g]), silu_f(acc[mb][nb][4 * g + 1]));
                        o.y = cvt_pk_bf16(silu_f(acc[mb][nb][4 * g + 2]), silu_f(acc[mb][nb][4 * g + 3]));
                        *(u32x2*)(SZ + (size_t)m * D + n) = o;
                    }
        }
    }
};

DEVI void attn_item(const Params& p, int item) {
    const int lane = threadIdx.x & 63, w = threadIdx.x >> 6, fr = lane & 31, fh = lane >> 5;
    const bf16_t* Q = (const bf16_t*)(p.ws + WS_Q);
    const bf16_t* KB = (const bf16_t*)(p.ws + WS_KB);
    const bf16_t* VTB = (const bf16_t*)(p.ws + WS_VTB);
    const bf16_t* KC = (const bf16_t*)(p.ws + WS_KC);
    const bf16_t* VCT = (const bf16_t*)(p.ws + WS_VCT);
    const bf16_t* SZ = (const bf16_t*)(p.ws + WS_SZ);
    bf16_t* Y = (bf16_t*)(p.ws + WS_Y);
    bool lat; int b, kvh, qb, tb;
    if (item < 256) { lat = true; b = item >> 7; kvh = (item >> 5) & 3; qb = item & 31; tb = NCTX + b * 1024; }
    else { const int it = item - 256; lat = false; b = it >> 5; kvh = (it >> 3) & 3; qb = it & 7; tb = b * 256; }
    const int head = kvh * 4 + w;
    const int qtok = tb + qb * 32 + fr;
    bf16x8 qf[4];
#pragma unroll
    for (int ks = 0; ks < 4; ++ks) qf[ks] = *(const bf16x8*)(Q + (size_t)qtok * D + head * 64 + ks * 16 + fh * 8);
    float m_run = p.sink[head] * LOG2E, l_run = 1.f;
    f32x16 O[2];
#pragma unroll
    for (int i = 0; i < 2; ++i)
#pragma unroll
        for (int r = 0; r < 16; ++r) O[i][r] = 0.f;

    auto block = [&](const bf16_t* kp, const bf16_t* vp, int ldv, int mode, int dpos  ) {
        f32x16 s;
#pragma unroll
        for (int r = 0; r < 16; ++r) s[r] = 0.f;
#pragma unroll
        for (int ks = 0; ks < 4; ++ks) {
            const bf16x8 kf = *(const bf16x8*)(kp + (size_t)fr * 256 + ks * 16 + fh * 8);
            s = __builtin_amdgcn_mfma_f32_32x32x16_bf16(kf, qf[ks], s, 0, 0, 0);
        }
        if (mode) {
#pragma unroll
            for (int r = 0; r < 16; ++r) {
                const int rel = dpos + (r & 3) + 8 * (r >> 2) + 4 * fh - fr;
                const bool ok = mode == 1 ? (rel >= -128) : (rel <= 128);
                if (!ok) s[r] = -1e30f;
            }
        }
        float mx = s[0];
#pragma unroll
        for (int r = 1; r < 16; ++r) mx = fmaxf(mx, s[r]);
        mx = fmaxf(mx, __shfl_xor(mx, 32));
        const float m_new = fmaxf(m_run, mx);
        const float alpha = exp2f(m_run - m_new);
        float rs = 0.f;
#pragma unroll
        for (int r = 0; r < 16; ++r) { s[r] = exp2f(s[r] - m_new); rs += s[r]; }
        rs += __shfl_xor(rs, 32);
        l_run = l_run * alpha + rs; m_run = m_new;
#pragma unroll
        for (int i = 0; i < 2; ++i)
#pragma unroll
            for (int r = 0; r < 16; ++r) O[i][r] *= alpha;
#pragma unroll
        for (int s2 = 0; s2 < 2; ++s2) {
            union { u32x4 u; bf16x8 v; } pf;
            pf.u.x = cvt_pk_bf16(s[8 * s2 + 0], s[8 * s2 + 1]); pf.u.y = cvt_pk_bf16(s[8 * s2 + 2], s[8 * s2 + 3]);
            pf.u.z = cvt_pk_bf16(s[8 * s2 + 4], s[8 * s2 + 5]); pf.u.w = cvt_pk_bf16(s[8 * s2 + 6], s[8 * s2 + 7]);
#pragma unroll
            for (int db = 0; db < 2; ++db) {
                const bf16x8 vf = *(const bf16x8*)(vp + (size_t)(db * 32 + fr) * ldv + s2 * 16 + fh * 8);
                O[db] = __builtin_amdgcn_mfma_f32_32x32x16_bf16(vf, pf.v, O[db], 0, 0, 0);
            }
        }
    };

    if (lat) {
        const bf16_t* vbase = VTB + (size_t)16 * 4 * 64 * 256 + ((size_t)(b * 4 + kvh) * 64) * 1024;
        const int k_lo = qb - 4 < 0 ? 0 : qb - 4, k_hi = qb + 4 > 31 ? 31 : qb + 4;
        for (int kb = k_lo; kb <= k_hi; ++kb) {
            const int mode = (kb == qb - 4) ? 1 : (kb == qb + 4) ? 2 : 0;
            block(KB + (size_t)(tb + kb * 32) * 256 + kvh * 64, vbase + kb * 32, 1024, mode, (kb - qb) * 32);
        }
        const bf16_t* vcb = VCT + ((size_t)(b * 4 + kvh) * 64) * 256;
        for (int kb = 0; kb < 8; ++kb)
            block(KC + (size_t)(b * 256 + kb * 32) * 256 + kvh * 64, vcb + kb * 32, 256, 0, 0);
    } else {
        const bf16_t* vbase = VTB + ((size_t)(b * 4 + kvh) * 64) * 256;
        for (int kb = 0; kb < 8; ++kb)
            block(KB + (size_t)(tb + kb * 32) * 256 + kvh * 64, vbase + kb * 32, 256, 0, 0);
    }
    const float il = 1.f / l_run;
#pragma unroll
    for (int db = 0; db < 2; ++db)
#pragma unroll
        for (int g = 0; g < 4; ++g) {
            const int col = head * 64 + db * 32 + 8 * g + 4 * fh;
            const u32x2 z = *(const u32x2*)(SZ + (size_t)qtok * D + col);
            const float z0 = __uint_as_float(z.x << 16), z1 = __uint_as_float(z.x & 0xffff0000u);
            const float z2 = __uint_as_float(z.y << 16), z3 = __uint_as_float(z.y & 0xffff0000u);
            u32x2 o; o.x = cvt_pk_bf16(O[db][4 * g] * il * z0, O[db][4 * g + 1] * il * z1);
            o.y = cvt_pk_bf16(O[db][4 * g + 2] * il * z2, O[db][4 * g + 3] * il * z3);
            *(u32x2*)(Y + (size_t)qtok * D + col) = o;
        }
}

DEVI void run_phase(const Params& p, int ph, unsigned char* lds) {
    const int G = gridDim.x;
    bf16_t* H = (bf16_t*)(p.ws + WS_H);
    bf16_t* U = (bf16_t*)(p.ws + WS_U);
    bf16_t* SZ = (bf16_t*)(p.ws + WS_SZ);
    bf16_t* VT = (bf16_t*)(p.ws + WS_VT);
    bf16_t* Y = (bf16_t*)(p.ws + WS_Y);
    float* X1 = (float*)(p.ws + WS_X1);
    const float* mod = (const float*)(p.ws + WS_MOD);
    switch (ph) {
    case 0: phase0(p, lds); break;
    case 1: phase_norm(p, 0); break;
    case 2: {
        EpiInL0 e{U, SZ};
        for (int t = blockIdx.x; t < 768; t += G) {
            const int tt = xcd_remap(t, 768);
            gemm_tile(H, D, (const bf16_t*)(p.ws + WS_WT0IN), D, 16, lds, e, (tt >> 4) * 128, (tt & 15) * 128);
        }
    } break;
    case 3: {
        for (int t = blockIdx.x; t < 768; t += G) {
            const int tt = xcd_remap(t, 768);
            const int mt = tt & 3, g = (tt >> 2) & 3, nt = tt >> 4;
            EpiChanDft e{VT, g};
            gemm_tile((const bf16_t*)(p.ws + WS_TW256), 256, U + g * 256, D, 4, lds, e, mt * 128, nt * 128);
        }
    } break;
    case 4: {
        for (int t = blockIdx.x; t < 384; t += G) {
            if (t < 128) {
                const int nt = t & 1, mt = (t >> 1) & 7, bg = t >> 4;
                EpiSeqDft e{SZ, Y, NCTX + (bg >> 2) * 1024, bg & 3};
                gemm_tile((const bf16_t*)(p.ws + WS_TS1024), 2048, VT + (size_t)64 * 256 * 512 + (size_t)bg * 256 * 2048, 2048, 32, lds, e, mt * 128, nt * 128);
            } else {
                const int u = t - 128, nt = u & 1, mt = (u >> 1) & 1, bg = u >> 2;
                EpiSeqDft e{SZ, Y, (bg >> 2) * 256, bg & 3};
                gemm_tile((const bf16_t*)(p.ws + WS_TS256), 512, VT + (size_t)bg * 256 * 512, 512, 8, lds, e, mt * 128, nt * 128);
            }
        }
    } break;
    case 5: {
        EpiOut e{p.x_prompt, p.x_sample, mod, X1};
        for (int t = blockIdx.x; t < 384; t += G) {
            const int tt = xcd_remap(t, 384);
            gemm_tile(Y, D, (const bf16_t*)(p.ws + WS_WT0OUT), D, 16, lds, e, (tt >> 3) * 128, (tt & 7) * 128);
        }
    } break;
    case 6: phase_norm(p, 1); break;
    case 7: {
        EpiInL1 e{p.qnw, p.knw, (const float*)(p.ws + WS_ROPEC), (const float*)(p.ws + WS_ROPES),
                  (bf16_t*)(p.ws + WS_Q), (bf16_t*)(p.ws + WS_KB), (bf16_t*)(p.ws + WS_VTB), SZ,
                  p.out + (size_t)NTOK * D, p.out + (size_t)NTOK * D + (size_t)NCTX * 256};
        for (int t = blockIdx.x; t < 960; t += G) {
            const int tt = xcd_remap(t, 960);
            gemm_tile(H, D, (const bf16_t*)(p.ws + WS_WT1IN), D, 16, lds, e, (tt / 20) * 128, (tt % 20) * 128);
        }
    } break;
    case 8: {
        for (int t = blockIdx.x; t < 768; t += G) attn_item(p, t);
    } break;
    case 9: {
        EpiOut e{X1, X1 + (size_t)NCTX * D, mod + 3 * 3072, p.out};
        for (int t = blockIdx.x; t < 384; t += G) {
            const int tt = xcd_remap(t, 384);
            gemm_tile(Y, D, (const bf16_t*)(p.ws + WS_WT1OUT), D, 16, lds, e, (tt >> 3) * 128, (tt & 7) * 128);
        }
    } break;
    }
}

__global__ void __launch_bounds__(256, 2) mega(Params p) {
    __shared__ __attribute__((aligned(16))) unsigned char lds[65536];
    cg::grid_group grid = cg::this_grid();
#if SINGLE_LAUNCH
#define PH(n) run_phase(p, n, lds);
#define SY() grid.sync();
#else
    const int lo = (int)p.ph_lo, hi = (int)p.ph_hi;
#define PH(n) if (lo <= n && n < hi) run_phase(p, n, lds);
#define SY()
#endif
    PH(0) SY() PH(1) SY() PH(2) SY() PH(3) SY() PH(4) SY() PH(5) SY() PH(6) SY() PH(7) SY() PH(8) SY() PH(9)
}

extern "C" void kernel_launch(void* const* d_in, const int* in_sizes, int n_in, void* d_out, int out_size, void* d_ws, size_t ws_size, hipStream_t stream) {
    static int grid_blocks = 0;
    if (!grid_blocks) {
        int dev = 0, cus = 0, per_cu = 0;
        hipGetDevice(&dev);
        hipDeviceGetAttribute(&cus, hipDeviceAttributeMultiprocessorCount, dev);
        hipOccupancyMaxActiveBlocksPerMultiprocessor(&per_cu, mega, 256, 0);
        if (per_cu > 2) per_cu = 2;
        if (per_cu < 1) per_cu = 1;
        grid_blocks = cus * per_cu;
    }
    Params p{};
    const float* const* in = (const float* const*)d_in;
    p.x_prompt = in[0]; p.x_sample = in[1]; p.cache_k = in[2]; p.cache_v = in[3]; p.c = in[4]; p.c_ctx = in[5];
    p.norm_w0 = in[6]; p.w_mod0 = in[7]; p.b_mod0 = in[8]; p.w_in0 = in[9]; p.w_out0 = in[10];
    p.norm_w1 = in[11]; p.w_mod1 = in[12]; p.b_mod1 = in[13]; p.w_in1 = in[14]; p.qnw = in[15]; p.knw = in[16]; p.sink = in[17]; p.w_out1 = in[18];
    p.out = (float*)d_out; p.ws = (unsigned char*)d_ws;
#if SINGLE_LAUNCH
    p.ph_lo = 0; p.ph_hi = 10;
    void* args[] = {&p};
    hipError_t e = hipLaunchCooperativeKernel((void*)mega, dim3(grid_blocks), dim3(256), args, 0, stream);
    if (e != hipSuccess) fprintf(stderr, "cooperative launch failed: %s (grid %d)\n", hipGetErrorString(e), grid_blocks);
#else
    for (int ph = 0; ph < 10; ++ph) {
        p.ph_lo = ph; p.ph_hi = ph + 1;
        hipLaunchKernelGGL(mega, dim3(grid_blocks), dim3(256), 0, stream, p);
    }
#endif
}
```

```cpp
#include <hip/hip_runtime.h>
#include <hip/hip_cooperative_groups.h>
#include <stdint.h>
#include <cstdio>
namespace cg = cooperative_groups;

#ifndef SINGLE_LAUNCH
#define SINGLE_LAUNCH 1
#endif

typedef unsigned short bf16_t;
typedef short bf16x8 __attribute__((ext_vector_type(8)));
typedef float f32x16 __attribute__((ext_vector_type(16)));
typedef float f32x4 __attribute__((ext_vector_type(4)));
typedef unsigned u32x4 __attribute__((ext_vector_type(4)));
typedef unsigned u32x2 __attribute__((ext_vector_type(2)));
#define DEVI __device__ __forceinline__

constexpr int NTOK = 6144, NCTX = 4096, D = 1024;
constexpr float EPSV = 1e-6f;
constexpr float LOG2E = 1.4426950408889634f;

constexpr size_t WS_MOD = 0;
constexpr size_t WS_WT0IN = 1 << 20;
constexpr size_t WS_WT0OUT = WS_WT0IN + (size_t)2048 * 1024 * 2;
constexpr size_t WS_WT1IN = WS_WT0OUT + (size_t)1024 * 1024 * 2;
constexpr size_t WS_WT1OUT = WS_WT1IN + (size_t)2560 * 1024 * 2;
constexpr size_t WS_TW256 = WS_WT1OUT + (size_t)1024 * 1024 * 2;
constexpr size_t WS_TS256 = WS_TW256 + (size_t)512 * 256 * 2;
constexpr size_t WS_TS1024 = WS_TS256 + (size_t)256 * 512 * 2;
constexpr size_t WS_ROPEC = WS_TS1024 + (size_t)1024 * 2048 * 2;
constexpr size_t WS_ROPES = WS_ROPEC + (size_t)1024 * 32 * 4;
constexpr size_t WS_KC = WS_ROPES + (size_t)1024 * 32 * 4;
constexpr size_t WS_VCT = WS_KC + (size_t)2 * 256 * 256 * 2;
constexpr size_t WS_H = WS_VCT + (size_t)2 * 256 * 256 * 2;
constexpr size_t WS_U = WS_H + (size_t)NTOK * D * 2;
constexpr size_t WS_SZ = WS_U + (size_t)NTOK * D * 2;
constexpr size_t WS_VT = WS_SZ + (size_t)NTOK * D * 2;
constexpr size_t WS_Y = WS_VT + (size_t)NTOK * 2048 * 2;
constexpr size_t WS_X1 = WS_Y + (size_t)NTOK * D * 2;
constexpr size_t WS_Q = WS_X1 + (size_t)NTOK * D * 4;
constexpr size_t WS_KB = WS_Q + (size_t)NTOK * D * 2;
constexpr size_t WS_VTB = WS_KB + (size_t)NTOK * 256 * 2;
constexpr size_t WS_BAR = WS_VTB + (size_t)NTOK * 256 * 2;
constexpr size_t WS_END = WS_BAR + 16384;

struct Params {
    const float *x_prompt, *x_sample, *cache_k, *cache_v, *c, *c_ctx;
    const float *norm_w0, *w_mod0, *b_mod0, *w_in0, *w_out0;
    const float *norm_w1, *w_mod1, *b_mod1, *w_in1, *qnw, *knw, *sink, *w_out1;
    float* out;
    unsigned char* ws;
    long long ph_lo, ph_hi;
};

DEVI unsigned cvt_pk_bf16(float lo, float hi) { unsigned r; asm("v_cvt_pk_bf16_f32 %0, %1, %2" : "=v"(r) : "v"(lo), "v"(hi)); return r; }
DEVI bf16_t f2bf(float f) { return (bf16_t)(cvt_pk_bf16(f, 0.f) & 0xffffu); }
DEVI float silu_f(float v) { return v / (1.f + __expf(-v)); }
DEVI int swap23(int x) { return (x & ~12) | ((x & 4) << 1) | ((x & 8) >> 1); }
DEVI int cond_of(int m) { return m < NCTX ? 0 : 1 + ((m - NCTX) >> 10); }

DEVI void glds16(const void* g, void* l) { __builtin_amdgcn_global_load_lds(g, l, 16, 0, 0); }

template <class Epi>
DEVI void gemm_tile(const bf16_t* __restrict__ A, int lda, const bf16_t* __restrict__ B, int ldb, int nk,
                    unsigned char* lds, const Epi& epi, int m0, int n0) {
    const int tid = threadIdx.x, lane = tid & 63, wid = tid >> 6, wr = wid >> 1, wc = wid & 1;
    const int srow = tid >> 3;
    const int slc = (tid & 7) ^ ((tid >> 4) & 7);
    const bf16_t* gA = A + (size_t)(m0 + srow) * lda + slc * 8;
    const bf16_t* gB = B + (size_t)(n0 + srow) * ldb + slc * 8;
    const int fr = lane & 31, fh = lane >> 5, sw = (lane >> 1) & 7;
    const unsigned aoff = (wr * 64 + fr) * 128, boff = 16384 + (wc * 64 + fr) * 128;
    f32x16 acc[2][2];
#pragma unroll
    for (int i = 0; i < 2; ++i)
#pragma unroll
        for (int j = 0; j < 2; ++j)
#pragma unroll
            for (int r = 0; r < 16; ++r) acc[i][j][r] = 0.f;
    {
        unsigned char* la = lds + tid * 16;
#pragma unroll
        for (int i = 0; i < 4; ++i) {
            glds16(gA + (size_t)i * 32 * lda, la + i * 4096);
            glds16(gB + (size_t)i * 32 * ldb, la + 16384 + i * 4096);
        }
    }
    for (int kt = 0; kt < nk; ++kt) {
        asm volatile("s_waitcnt vmcnt(0)" ::: "memory");
        __syncthreads();
        if (kt + 1 < nk) {
            unsigned char* la = lds + ((kt + 1) & 1) * 32768 + tid * 16;
            const int ko = (kt + 1) * 64;
#pragma unroll
            for (int i = 0; i < 4; ++i) {
                glds16(gA + (size_t)i * 32 * lda + ko, la + i * 4096);
                glds16(gB + (size_t)i * 32 * ldb + ko, la + 16384 + i * 4096);
            }
        }
        const unsigned char* base = lds + (kt & 1) * 32768;
#pragma unroll
        for (int ks = 0; ks < 4; ++ks) {
            const int ch = ((2 * ks + fh) ^ sw) * 16;
            const bf16x8 a0 = *(const bf16x8*)(base + aoff + ch);
            const bf16x8 a1 = *(const bf16x8*)(base + aoff + 4096 + ch);
            const bf16x8 b0 = *(const bf16x8*)(base + boff + ch);
            const bf16x8 b1 = *(const bf16x8*)(base + boff + 4096 + ch);
            acc[0][0] = __builtin_amdgcn_mfma_f32_32x32x16_bf16(b0, a0, acc[0][0], 0, 0, 0);
            acc[0][1] = __builtin_amdgcn_mfma_f32_32x32x16_bf16(b1, a0, acc[0][1], 0, 0, 0);
            acc[1][0] = __builtin_amdgcn_mfma_f32_32x32x16_bf16(b0, a1, acc[1][0], 0, 0, 0);
            acc[1][1] = __builtin_amdgcn_mfma_f32_32x32x16_bf16(b1, a1, acc[1][1], 0, 0, 0);
        }
    }
    epi(acc, m0 + wr * 64, n0 + wc * 64, fr, fh);
    __syncthreads();
}

DEVI int xcd_remap(int t, int T) { return (t & 7) * (T >> 3) + (t >> 3); }

DEVI void mod_item(const Params& p, int it, unsigned char* lds) {
    const int tid = threadIdx.x;
    const int l = it / 48, cc = it % 48;
    float* sc = (float*)lds;
    for (int i = tid; i < 3072; i += 256) {
        const int cv = i >> 10, k = i & 1023;
        const float cval = cv == 0 ? p.c_ctx[k] : p.c[(cv - 1) * 1024 + k];
        sc[i] = silu_f(cval);
    }
    __syncthreads();
    const float* W = l ? p.w_mod1 : p.w_mod0;
    const float* bm = l ? p.b_mod1 : p.b_mod0;
    const int cg4 = tid & 15, rg = tid >> 4, c0 = cc * 64 + cg4 * 4;
    f32x4 a0 = {0.f, 0.f, 0.f, 0.f}, a1 = a0, a2 = a0;
#pragma unroll 8
    for (int k = rg; k < 1024; k += 16) {
        const f32x4 w = *(const f32x4*)(W + (size_t)k * 3072 + c0);
        a0 += sc[k] * w; a1 += sc[1024 + k] * w; a2 += sc[2048 + k] * w;
    }
    float* red = (float*)(lds + 12288);
#pragma unroll
    for (int e = 0; e < 4; ++e) {
        red[(rg * 3 + 0) * 64 + cg4 * 4 + e] = a0[e];
        red[(rg * 3 + 1) * 64 + cg4 * 4 + e] = a1[e];
        red[(rg * 3 + 2) * 64 + cg4 * 4 + e] = a2[e];
    }
    __syncthreads();
    if (tid < 192) {
        const int cv = tid >> 6, j = tid & 63;
        float s = 0.f;
#pragma unroll
        for (int r = 0; r < 16; ++r) s += red[(r * 3 + cv) * 64 + j];
        float* mod = (float*)(p.ws + WS_MOD);
        mod[(l * 3 + cv) * 3072 + cc * 64 + j] = s + bm[cc * 64 + j];
    }
    __syncthreads();
}

DEVI void transpose_item(const Params& p, int idx, unsigned char* lds) {
    const int tid = threadIdx.x;
    const float* src; bf16_t* dst; int N;
    if (idx < 512) { src = p.w_in0; dst = (bf16_t*)(p.ws + WS_WT0IN); N = 2048; }
    else if (idx < 768) { idx -= 512; src = p.w_out0; dst = (bf16_t*)(p.ws + WS_WT0OUT); N = 1024; }
    else if (idx < 1408) { idx -= 768; src = p.w_in1; dst = (bf16_t*)(p.ws + WS_WT1IN); N = 2560; }
    else { idx -= 1408; src = p.w_out1; dst = (bf16_t*)(p.ws + WS_WT1OUT); N = 1024; }
    const int ntn = N >> 6;
    const int kt = idx / ntn, nt = idx % ntn;
    float* tl = (float*)lds;
#pragma unroll
    for (int pass = 0; pass < 4; ++pass) {
        const int r = pass * 16 + (tid >> 4), c4 = (tid & 15) * 4;
        const f32x4 v = *(const f32x4*)(src + (size_t)(kt * 64 + r) * N + nt * 64 + c4);
#pragma unroll
        for (int e = 0; e < 4; ++e) tl[r * 65 + c4 + e] = v[e];
    }
    __syncthreads();
#pragma unroll
    for (int pass = 0; pass < 2; ++pass) {
        const int n = pass * 32 + (tid >> 3), kc = tid & 7;
        float v[8];
#pragma unroll
        for (int j = 0; j < 8; ++j) v[j] = tl[(kc * 8 + j) * 65 + n];
        u32x4 w;
        w.x = cvt_pk_bf16(v[0], v[1]); w.y = cvt_pk_bf16(v[2], v[3]); w.z = cvt_pk_bf16(v[4], v[5]); w.w = cvt_pk_bf16(v[6], v[7]);
        *(u32x4*)(dst + (size_t)(nt * 64 + n) * 1024 + kt * 64 + kc * 8) = w;
    }
    __syncthreads();
}

DEVI void phase0(const Params& p, unsigned char* lds) {
    constexpr int NMOD = 96, NTR = 1664;
    for (int it = blockIdx.x; it < NMOD + NTR; it += gridDim.x) {
        if (it < NMOD) mod_item(p, it, lds); else transpose_item(p, it - NMOD, lds);
    }
    const int gt = blockIdx.x * 256 + threadIdx.x, gs = gridDim.x * 256;
    bf16_t* tw256 = (bf16_t*)(p.ws + WS_TW256);
    bf16_t* ts256 = (bf16_t*)(p.ws + WS_TS256);
    bf16_t* ts1024 = (bf16_t*)(p.ws + WS_TS1024);
    for (int i = gt; i < 512 * 256; i += gs) {
        const int m = i >> 8, j = i & 255, which = m >> 8, cp = m & 255;
        const int r = (cp * j) & 255;
        float s, c; sincospif((float)r * (1.f / 128.f), &s, &c);
        tw256[i] = f2bf(which ? s : c);
    }
    for (int i = gt; i < 256 * 512; i += gs) {
        const int sp = i >> 9, k2 = i & 511, which = k2 >> 8, s0 = k2 & 255;
        const int r = (sp * s0) & 255;
        float s, c; sincospif((float)r * (1.f / 128.f), &s, &c);
        ts256[i] = f2bf((which ? -s : c) * (1.f / 256.f));
    }
    for (int i = gt; i < 1024 * 2048; i += gs) {
        const int sp = i >> 11, k2 = i & 2047, which = k2 >> 10, s0 = k2 & 1023;
        const int r = (sp * s0) & 1023;
        float s, c; sincospif((float)r * (1.f / 512.f), &s, &c);
        ts1024[i] = f2bf((which ? -s : c) * (1.f / 512.f));
    }
    float* ropec = (float*)(p.ws + WS_ROPEC);
    float* ropes = (float*)(p.ws + WS_ROPES);
    for (int i = gt; i < 1024 * 32; i += gs) {
        const int pos = i >> 5, f = i & 31;
        const int row = pos >> 6, col = pos & 63;
        const float inv = powf(10000.f, -(float)(f & 15) * (1.f / 16.f));
        const float ang = (float)(f < 16 ? row : col) * inv;
        float s, c; sincosf(ang, &s, &c);
        ropec[i] = c; ropes[i] = s;
    }
    bf16_t* kc = (bf16_t*)(p.ws + WS_KC);
    bf16_t* vct = (bf16_t*)(p.ws + WS_VCT);
    for (int i = gt; i < 2 * 256 * 256; i += gs) {
        kc[i] = f2bf(p.cache_k[i]);
        const int b = i >> 16, kvh = (i >> 14) & 3, d = (i >> 8) & 63, pp = i & 255;
        const int key = swap23(pp);
        vct[i] = f2bf(p.cache_v[((b * 256 + key) * 4 + kvh) * 64 + d]);
    }
}

DEVI void phase_norm(const Params& p, int layer) {
    const int lane = threadIdx.x & 63, wid = threadIdx.x >> 6;
    const float* mod = (const float*)(p.ws + WS_MOD) + layer * 3 * 3072;
    const float* nw = layer ? p.norm_w1 : p.norm_w0;
    bf16_t* H = (bf16_t*)(p.ws + WS_H);
    for (int row = blockIdx.x * 4 + wid; row < NTOK; row += gridDim.x * 4) {
        const float* xr;
        if (layer == 0) xr = row < NCTX ? p.x_prompt + (size_t)row * D : p.x_sample + (size_t)(row - NCTX) * D;
        else xr = (const float*)(p.ws + WS_X1) + (size_t)row * D;
        const float* mv = mod + cond_of(row) * 3072;
        f32x4 v[4];
        float ss = 0.f;
#pragma unroll
        for (int i = 0; i < 4; ++i) {
            v[i] = *(const f32x4*)(xr + i * 256 + lane * 4);
            ss += v[i][0] * v[i][0] + v[i][1] * v[i][1] + v[i][2] * v[i][2] + v[i][3] * v[i][3];
        }
#pragma unroll
        for (int o = 32; o >= 1; o >>= 1) ss += __shfl_xor(ss, o);
        const float rstd = rsqrtf(ss * (1.f / 1024.f) + EPSV);
#pragma unroll
        for (int i = 0; i < 4; ++i) {
            const int k = i * 256 + lane * 4;
            const f32x4 w = *(const f32x4*)(nw + k);
            const f32x4 sh = *(const f32x4*)(mv + k);
            const f32x4 scl = *(const f32x4*)(mv + 1024 + k);
            float h[4];
#pragma unroll
            for (int e = 0; e < 4; ++e) h[e] = (v[i][e] * rstd * w[e]) * (1.f + scl[e]) + sh[e];
            u32x2 o; o.x = cvt_pk_bf16(h[0], h[1]); o.y = cvt_pk_bf16(h[2], h[3]);
            *(u32x2*)(H + (size_t)row * D + k) = o;
        }
    }
}

struct EpiInL0 {
    bf16_t *U, *SZ;
    DEVI void operator()(const f32x16 (&acc)[2][2], int mbase, int nbase, int fr, int fh) const {
        const bool isz = nbase >= 1024;
        bf16_t* dst = isz ? SZ : U;
        const int nb0 = isz ? nbase - 1024 : nbase;
#pragma unroll
        for (int mb = 0; mb < 2; ++mb)
#pragma unroll
            for (int nb = 0; nb < 2; ++nb)
#pragma unroll
                for (int g = 0; g < 4; ++g) {
                    const int m = mbase + mb * 32 + fr, n = nb0 + nb * 32 + 8 * g + 4 * fh;
                    float v[4];
#pragma unroll
                    for (int e = 0; e < 4; ++e) { v[e] = acc[mb][nb][4 * g + e]; if (isz) v[e] = silu_f(v[e]); }
                    u32x2 o; o.x = cvt_pk_bf16(v[0], v[1]); o.y = cvt_pk_bf16(v[2], v[3]);
                    *(u32x2*)(dst + (size_t)m * D + n) = o;
                }
    }
};

struct EpiChanDft {
    bf16_t* VT; int g;
    DEVI void operator()(const f32x16 (&acc)[2][2], int mbase, int nbase, int fr, int fh) const {
        int S, bgi, s0; bf16_t* base;
        if (nbase < NCTX) { S = 256; bgi = (nbase >> 8) * 4 + g; s0 = nbase & 255; base = VT; }
        else { const int t = nbase - NCTX; S = 1024; bgi = (t >> 10) * 4 + g; s0 = t & 1023; base = VT + (size_t)64 * 256 * 512; }
#pragma unroll
        for (int mb = 0; mb < 2; ++mb)
#pragma unroll
            for (int nb = 0; nb < 2; ++nb)
#pragma unroll
                for (int gq = 0; gq < 4; ++gq) {
                    const int m = mbase + mb * 32 + fr, which = m >> 8, cp = m & 255;
                    const int s = s0 + nb * 32 + 8 * gq + 4 * fh;
                    u32x2 o; o.x = cvt_pk_bf16(acc[mb][nb][4 * gq], acc[mb][nb][4 * gq + 1]); o.y = cvt_pk_bf16(acc[mb][nb][4 * gq + 2], acc[mb][nb][4 * gq + 3]);
                    *(u32x2*)(base + ((size_t)bgi * 256 + cp) * (2 * S) + which * S + s) = o;
                }
    }
};

struct EpiSeqDft {
    const bf16_t* SZ; bf16_t* Y; int tok0, g;
    DEVI void operator()(const f32x16 (&acc)[2][2], int mbase, int nbase, int fr, int fh) const {
#pragma unroll
        for (int mb = 0; mb < 2; ++mb)
#pragma unroll
            for (int nb = 0; nb < 2; ++nb)
#pragma unroll
                for (int gq = 0; gq < 4; ++gq) {
                    const int tok = tok0 + mbase + mb * 32 + fr;
                    const int col = g * 256 + nbase + nb * 32 + 8 * gq + 4 * fh;
                    const u32x2 z = *(const u32x2*)(SZ + (size_t)tok * D + col);
                    const float z0 = __uint_as_float(z.x << 16), z1 = __uint_as_float(z.x & 0xffff0000u);
                    const float z2 = __uint_as_float(z.y << 16), z3 = __uint_as_float(z.y & 0xffff0000u);
                    u32x2 o; o.x = cvt_pk_bf16(acc[mb][nb][4 * gq] * z0, acc[mb][nb][4 * gq + 1] * z1);
                    o.y = cvt_pk_bf16(acc[mb][nb][4 * gq + 2] * z2, acc[mb][nb][4 * gq + 3] * z3);
                    *(u32x2*)(Y + (size_t)tok * D + col) = o;
                }
    }
};

struct EpiOut {
    const float* xa; const float* xb;
    const float* mod;
    float* out;
    DEVI void operator()(const f32x16 (&acc)[2][2], int mbase, int nbase, int fr, int fh) const {
        const float* gate = mod + cond_of(mbase) * 3072 + 2048;
#pragma unroll
        for (int mb = 0; mb < 2; ++mb)
#pragma unroll
            for (int nb = 0; nb < 2; ++nb)
#pragma unroll
                for (int g = 0; g < 4; ++g) {
                    const int m = mbase + mb * 32 + fr, n = nbase + nb * 32 + 8 * g + 4 * fh;
                    const float* xr = m < NCTX ? xa + (size_t)m * D : xb + (size_t)(m - NCTX) * D;
                    const f32x4 xv = *(const f32x4*)(xr + n);
                    const f32x4 gv = *(const f32x4*)(gate + n);
                    f32x4 o;
#pragma unroll
                    for (int e = 0; e < 4; ++e) o[e] = xv[e] + gv[e] * acc[mb][nb][4 * g + e];
                    *(f32x4*)(out + (size_t)m * D + n) = o;
                }
    }
};

struct EpiInL1 {
    const float *qnw, *knw, *ropec, *ropes;
    bf16_t *Q, *KB, *VTB, *SZ;
    float *outk, *outv;
    DEVI void operator()(const f32x16 (&acc)[2][2], int mbase, int nbase, int fr, int fh) const {
        const bool lat = mbase >= NCTX;
        if (nbase < 1280) {
            const bool isq = nbase < 1024;
            const float* nwp = isq ? qnw : knw;
#pragma unroll
            for (int mb = 0; mb < 2; ++mb) {
                const int m = mbase + mb * 32 + fr;
                float ss = 0.f;
#pragma unroll
                for (int nb = 0; nb < 2; ++nb)
#pragma unroll
                    for (int r = 0; r < 16; ++r) ss += acc[mb][nb][r] * acc[mb][nb][r];
                ss += __shfl_xor(ss, 32);
                const float rn = rsqrtf(ss * (1.f / 64.f) + EPSV);
                const int pos = lat ? ((m - NCTX) & 1023) : 0;
#pragma unroll
                for (int g = 0; g < 4; ++g) {
                    const int d0 = 8 * g + 4 * fh;
                    const f32x4 w1 = *(const f32x4*)(nwp + d0), w2 = *(const f32x4*)(nwp + 32 + d0);
                    float x1[4], x2[4];
#pragma unroll
                    for (int e = 0; e < 4; ++e) { x1[e] = acc[mb][0][4 * g + e] * rn * w1[e]; x2[e] = acc[mb][1][4 * g + e] * rn * w2[e]; }
                    if (lat) {
                        const f32x4 cv = *(const f32x4*)(ropec + pos * 32 + d0), sv = *(const f32x4*)(ropes + pos * 32 + d0);
#pragma unroll
                        for (int e = 0; e < 4; ++e) { const float a = x1[e], b = x2[e]; x1[e] = a * cv[e] - b * sv[e]; x2[e] = a * sv[e] + b * cv[e]; }
                    }
                    if (isq) {
                        const float qs = 0.125f * LOG2E;
                        u32x2 o1, o2;
                        o1.x = cvt_pk_bf16(x1[0] * qs, x1[1] * qs); o1.y = cvt_pk_bf16(x1[2] * qs, x1[3] * qs);
                        o2.x = cvt_pk_bf16(x2[0] * qs, x2[1] * qs); o2.y = cvt_pk_bf16(x2[2] * qs, x2[3] * qs);
                        *(u32x2*)(Q + (size_t)m * D + nbase + d0) = o1;
                        *(u32x2*)(Q + (size_t)m * D + nbase + 32 + d0) = o2;
                    } else {
                        const int kc = nbase - 1024;
                        u32x2 o1, o2;
                        o1.x = cvt_pk_bf16(x1[0], x1[1]); o1.y = cvt_pk_bf16(x1[2], x1[3]);
                        o2.x = cvt_pk_bf16(x2[0], x2[1]); o2.y = cvt_pk_bf16(x2[2], x2[3]);
                        *(u32x2*)(KB + (size_t)m * 256 + kc + d0) = o1;
                        *(u32x2*)(KB + (size_t)m * 256 + kc + 32 + d0) = o2;
                        if (!lat) {
                            f32x4 f1 = {x1[0], x1[1], x1[2], x1[3]}, f2 = {x2[0], x2[1], x2[2], x2[3]};
                            *(f32x4*)(outk + (size_t)m * 256 + kc + d0) = f1;
                            *(f32x4*)(outk + (size_t)m * 256 + kc + 32 + d0) = f2;
                        }
                    }
                }
            }
        } else if (nbase < 1536) {
            const int vc = nbase - 1280, kvh = vc >> 6;
#pragma unroll
            for (int mb = 0; mb < 2; ++mb) {
                const int m = mbase + mb * 32 + fr;
                bf16_t* vt; int S, s;
                if (!lat) { S = 256; s = m & 255; vt = VTB + ((size_t)((m >> 8) * 4 + kvh) * 64) * 256; }
                else { const int t = m - NCTX; S = 1024; s = t & 1023; vt = VTB + (size_t)16 * 4 * 64 * 256 + ((size_t)((t >> 10) * 4 + kvh) * 64) * 1024; }
                const int sp = swap23(s);
#pragma unroll
                for (int nb = 0; nb < 2; ++nb)
#pragma unroll
                    for (int g = 0; g < 4; ++g) {
                        const int d0 = nb * 32 + 8 * g + 4 * fh;
#pragma unroll
                        for (int e = 0; e < 4; ++e) vt[(size_t)(d0 + e) * S + sp] = f2bf(acc[mb][nb][4 * g + e]);
                        if (!lat) {
                            f32x4 f = {acc[mb][nb][4 * g], acc[mb][nb][4 * g + 1], acc[mb][nb][4 * g + 2], acc[mb][nb][4 * g + 3]};
                            *(f32x4*)(outv + (size_t)m * 256 + vc + d0) = f;
                        }
                    }
            }
        } else {
            const int zc = nbase - 1536;
#pragma unroll
            for (int mb = 0; mb < 2; ++mb)
#pragma unroll
                for (int nb = 0; nb < 2; ++nb)
#pragma unroll
                    for (int g = 0; g < 4; ++g) {
                        const int m = mbase + mb * 32 + fr, n = zc + nb * 32 + 8 * g + 4 * fh;
                        u32x2 o; o.x = cvt_pk_bf16(silu_f(acc[mb][nb][4 * g]), silu_f(acc[mb][nb][4 * g + 1]));
                        o.y = cvt_pk_bf16(silu_f(acc[mb][nb][4 * g + 2]), silu_f(acc[mb][nb][4 * g + 3]));
                        *(u32x2*)(SZ + (size_t)m * D + n) = o;
                    }
        }
    }
};

DEVI void attn_item(const Params& p, int item) {
    const int lane = threadIdx.x & 63, w = threadIdx.x >> 6, fr = lane & 31, fh = lane >> 5;
    const bf16_t* Q = (const bf16_t*)(p.ws + WS_Q);
    const bf16_t* KB = (const bf16_t*)(p.ws + WS_KB);
    const bf16_t* VTB = (const bf16_t*)(p.ws + WS_VTB);
    const bf16_t* KC = (const bf16_t*)(p.ws + WS_KC);
    const bf16_t* VCT = (const bf16_t*)(p.ws + WS_VCT);
    const bf16_t* SZ = (const bf16_t*)(p.ws + WS_SZ);
    bf16_t* Y = (bf16_t*)(p.ws + WS_Y);
    bool lat; int b, kvh, qb, tb;
    if (item < 256) { lat = true; b = item >> 7; kvh = (item >> 5) & 3; qb = item & 31; tb = NCTX + b * 1024; }
    else { const int it = item - 256; lat = false; b = it >> 5; kvh = (it >> 3) & 3; qb = it & 7; tb = b * 256; }
    const int head = kvh * 4 + w;
    const int qtok = tb + qb * 32 + fr;
    bf16x8 qf[4];
#pragma unroll
    for (int ks = 0; ks < 4; ++ks) qf[ks] = *(const bf16x8*)(Q + (size_t)qtok * D + head * 64 + ks * 16 + fh * 8);
    float m_run = p.sink[head] * LOG2E, l_run = 1.f;
    f32x16 O[2];
#pragma unroll
    for (int i = 0; i < 2; ++i)
#pragma unroll
        for (int r = 0; r < 16; ++r) O[i][r] = 0.f;

    auto block = [&](const bf16_t* kp, const bf16_t* vp, int ldv, int mode, int dpos  ) {
        f32x16 s;
#pragma unroll
        for (int r = 0; r < 16; ++r) s[r] = 0.f;
#pragma unroll
        for (int ks = 0; ks < 4; ++ks) {
            const bf16x8 kf = *(const bf16x8*)(kp + (size_t)fr * 256 + ks * 16 + fh * 8);
            s = __builtin_amdgcn_mfma_f32_32x32x16_bf16(kf, qf[ks], s, 0, 0, 0);
        }
        if (mode) {
#pragma unroll
            for (int r = 0; r < 16; ++r) {
                const int rel = dpos + (r & 3) + 8 * (r >> 2) + 4 * fh - fr;
                const bool ok = mode == 1 ? (rel >= -128) : (rel <= 128);
                if (!ok) s[r] = -1e30f;
            }
        }
        float mx = s[0];
#pragma unroll
        for (int r = 1; r < 16; ++r) mx = fmaxf(mx, s[r]);
        mx = fmaxf(mx, __shfl_xor(mx, 32));
        const float m_new = fmaxf(m_run, mx);
        const float alpha = exp2f(m_run - m_new);
        float rs = 0.f;
#pragma unroll
        for (int r = 0; r < 16; ++r) { s[r] = exp2f(s[r] - m_new); rs += s[r]; }
        rs += __shfl_xor(rs, 32);
        l_run = l_run * alpha + rs; m_run = m_new;
#pragma unroll
        for (int i = 0; i < 2; ++i)
#pragma unroll
            for (int r = 0; r < 16; ++r) O[i][r] *= alpha;
#pragma unroll
        for (int s2 = 0; s2 < 2; ++s2) {
            union { u32x4 u; bf16x8 v; } pf;
            pf.u.x = cvt_pk_bf16(s[8 * s2 + 0], s[8 * s2 + 1]); pf.u.y = cvt_pk_bf16(s[8 * s2 + 2], s[8 * s2 + 3]);
            pf.u.z = cvt_pk_bf16(s[8 * s2 + 4], s[8 * s2 + 5]); pf.u.w = cvt_pk_bf16(s[8 * s2 + 6], s[8 * s2 + 7]);
#pragma unroll
            for (int db = 0; db < 2; ++db) {
                const bf16x8 vf = *(const bf16x8*)(vp + (size_t)(db * 32 + fr) * ldv + s2 * 16 + fh * 8);
                O[db] = __builtin_amdgcn_mfma_f32_32x32x16_bf16(vf, pf.v, O[db], 0, 0, 0);
            }
        }
    };

    if (lat) {
        const bf16_t* vbase = VTB + (size_t)16 * 4 * 64 * 256 + ((size_t)(b * 4 + kvh) * 64) * 1024;
        const int k_lo = qb - 4 < 0 ? 0 : qb - 4, k_hi = qb + 4 > 31 ? 31 : qb + 4;
        for (int kb = k_lo; kb <= k_hi; ++kb) {
            const int mode = (kb == qb - 4) ? 1 : (kb == qb + 4) ? 2 : 0;
            block(KB + (size_t)(tb + kb * 32) * 256 + kvh * 64, vbase + kb * 32, 1024, mode, (kb - qb) * 32);
        }
        const bf16_t* vcb = VCT + ((size_t)(b * 4 + kvh) * 64) * 256;
        for (int kb = 0; kb < 8; ++kb)
            block(KC + (size_t)(b * 256 + kb * 32) * 256 + kvh * 64, vcb + kb * 32, 256, 0, 0);
    } else {
        const bf16_t* vbase = VTB + ((size_t)(b * 4 + kvh) * 64) * 256;
        for (int kb = 0; kb < 8; ++kb)
            block(KB + (size_t)(tb + kb * 32) * 256 + kvh * 64, vbase + kb * 32, 256, 0, 0);
    }
    const float il = 1.f / l_run;
#pragma unroll
    for (int db = 0; db < 2; ++db)
#pragma unroll
        for (int g = 0; g < 4; ++g) {
            const int col = head * 64 + db * 32 + 8 * g + 4 * fh;
            const u32x2 z = *(const u32x2*)(SZ + (size_t)qtok * D + col);
            const float z0 = __uint_as_float(z.x << 16), z1 = __uint_as_float(z.x & 0xffff0000u);
            const float z2 = __uint_as_float(z.y << 16), z3 = __uint_as_float(z.y & 0xffff0000u);
            u32x2 o; o.x = cvt_pk_bf16(O[db][4 * g] * il * z0, O[db][4 * g + 1] * il * z1);
            o.y = cvt_pk_bf16(O[db][4 * g + 2] * il * z2, O[db][4 * g + 3] * il * z3);
            *(u32x2*)(Y + (size_t)qtok * D + col) = o;
        }
}


#define XB_TMO      128
#define XB_XCNT(j)  (256  + 64 * (j))
#define XB_XSUB(j)  (1280 + 64 * (j))
#define XB_XGEN(j)  (2304 + 64 * (j))
#define XB_TOP      3328
#define XB_TOPGEN   3392
#define XCD_BAR_WORDS 3456
#define XB_SPIN_CAP (1u << 18)
#define LAS __attribute__((address_space(3)))
DEVI unsigned xb_ld(unsigned* p)              { return __hip_atomic_load(p, __ATOMIC_RELAXED, __HIP_MEMORY_SCOPE_AGENT); }
DEVI unsigned xb_add(unsigned* p, unsigned v) { return __hip_atomic_fetch_add(p, v, __ATOMIC_RELAXED, __HIP_MEMORY_SCOPE_AGENT); }
DEVI unsigned xb_xcc_id() { return (unsigned)__builtin_amdgcn_s_getreg((3 << 11) | 20) & 0xFu; }
#define XB_SPIN(cond, bar) do { unsigned _sp = 0; while (cond) { __builtin_amdgcn_s_sleep(1); \
    if ((++_sp & 255u) == 0u) { if (xb_ld(&(bar)[XB_TMO])) break; if (_sp > XB_SPIN_CAP) { atomicAdd(&(bar)[XB_TMO], 1u); break; } } } } while (0)
struct XcdBarrier { unsigned* bar; unsigned x; volatile LAS unsigned* st; };
DEVI XcdBarrier xcd_barrier_post(unsigned* bar, volatile LAS unsigned* st) {
    XcdBarrier b; b.bar = bar; b.x = xb_xcc_id(); b.st = st;
    if (threadIdx.x == 0) (void)xb_add(&bar[XB_XCNT(b.x)], 1u);
    return b;
}
DEVI void xcd_barrier_complete(unsigned* bar, unsigned x, unsigned& nloc, unsigned& nx) {
    const unsigned G = gridDim.x * gridDim.y * gridDim.z;
    unsigned sum, cnt, mine, sp = 0u;
    for (;;) {
        sum = 0u; cnt = 0u; mine = 0u;
#pragma unroll
        for (unsigned j = 0; j < 16; ++j) { const unsigned c = xb_ld(&bar[XB_XCNT(j)]); sum += c; cnt += (c > 0u) ? 1u : 0u; mine = (j == x) ? c : mine; }
        if (sum == G) break;
        __builtin_amdgcn_s_sleep(1);
        if ((++sp & 255u) == 0u) { if (xb_ld(&bar[XB_TMO])) break; if (sp > XB_SPIN_CAP) { atomicAdd(&bar[XB_TMO], 1u); break; } }
    }
    nloc = mine > 0u ? mine : 1u; nx = cnt > 0u ? cnt : 1u;
}
DEVI void xcd_barrier(const XcdBarrier& b) {
    asm volatile("s_waitcnt vmcnt(0)" ::: "memory");
    __syncthreads();
    if (threadIdx.x == 0) {
        unsigned* bar = b.bar;
        __builtin_amdgcn_s_waitcnt(0);
        unsigned nloc = b.st[0], nx = b.st[1];
        if (nloc == 0u) { xcd_barrier_complete(bar, b.x, nloc, nx); b.st[0] = nloc; b.st[1] = nx; }
        const unsigned old = xb_add(&bar[XB_XSUB(b.x)], 1u);
        const unsigned gen = old / nloc;
        if (old + 1u == (gen + 1u) * nloc) {
            __builtin_amdgcn_fence(__ATOMIC_RELEASE, "agent");
            asm volatile("s_waitcnt vmcnt(0)" ::: "memory");
            const unsigned og = xb_add(&bar[XB_TOP], 1u);
            const unsigned tg = og / nx;
            if (og + 1u == (tg + 1u) * nx) xb_add(&bar[XB_TOPGEN], 1u);
            else XB_SPIN(xb_ld(&bar[XB_TOPGEN]) == tg, bar);
            __builtin_amdgcn_fence(__ATOMIC_ACQUIRE, "agent");
            xb_add(&bar[XB_XGEN(b.x)], 1u);
            asm volatile("s_waitcnt vmcnt(0)" ::: "memory");
        } else {
            XB_SPIN(xb_ld(&bar[XB_XGEN(b.x)]) == gen, bar);
            __builtin_amdgcn_fence(__ATOMIC_ACQUIRE, "agent");
            asm volatile("s_waitcnt vmcnt(0)" ::: "memory");
        }
    }
    __syncthreads();
}

DEVI void run_phase(const Params& p, int ph, unsigned char* lds) {
    const int G = gridDim.x;
    bf16_t* H = (bf16_t*)(p.ws + WS_H);
    bf16_t* U = (bf16_t*)(p.ws + WS_U);
    bf16_t* SZ = (bf16_t*)(p.ws + WS_SZ);
    bf16_t* VT = (bf16_t*)(p.ws + WS_VT);
    bf16_t* Y = (bf16_t*)(p.ws + WS_Y);
    float* X1 = (float*)(p.ws + WS_X1);
    const float* mod = (const float*)(p.ws + WS_MOD);
    switch (ph) {
    case 0: phase0(p, lds); break;
    case 1: phase_norm(p, 0); break;
    case 2: {
        EpiInL0 e{U, SZ};
        for (int t = blockIdx.x; t < 768; t += G) {
            const int tt = xcd_remap(t, 768);
            gemm_tile(H, D, (const bf16_t*)(p.ws + WS_WT0IN), D, 16, lds, e, (tt >> 4) * 128, (tt & 15) * 128);
        }
    } break;
    case 3: {
        for (int t = blockIdx.x; t < 768; t += G) {
            const int tt = xcd_remap(t, 768);
            const int mt = tt & 3, g = (tt >> 2) & 3, nt = tt >> 4;
            EpiChanDft e{VT, g};
            gemm_tile((const bf16_t*)(p.ws + WS_TW256), 256, U + g * 256, D, 4, lds, e, mt * 128, nt * 128);
        }
    } break;
    case 4: {
        for (int t = blockIdx.x; t < 384; t += G) {
            if (t < 128) {
                const int nt = t & 1, mt = (t >> 1) & 7, bg = t >> 4;
                EpiSeqDft e{SZ, Y, NCTX + (bg >> 2) * 1024, bg & 3};
                gemm_tile((const bf16_t*)(p.ws + WS_TS1024), 2048, VT + (size_t)64 * 256 * 512 + (size_t)bg * 256 * 2048, 2048, 32, lds, e, mt * 128, nt * 128);
            } else {
                const int u = t - 128, nt = u & 1, mt = (u >> 1) & 1, bg = u >> 2;
                EpiSeqDft e{SZ, Y, (bg >> 2) * 256, bg & 3};
                gemm_tile((const bf16_t*)(p.ws + WS_TS256), 512, VT + (size_t)bg * 256 * 512, 512, 8, lds, e, mt * 128, nt * 128);
            }
        }
    } break;
    case 5: {
        EpiOut e{p.x_prompt, p.x_sample, mod, X1};
        for (int t = blockIdx.x; t < 384; t += G) {
            const int tt = xcd_remap(t, 384);
            gemm_tile(Y, D, (const bf16_t*)(p.ws + WS_WT0OUT), D, 16, lds, e, (tt >> 3) * 128, (tt & 7) * 128);
        }
    } break;
    case 6: phase_norm(p, 1); break;
    case 7: {
        EpiInL1 e{p.qnw, p.knw, (const float*)(p.ws + WS_ROPEC), (const float*)(p.ws + WS_ROPES),
                  (bf16_t*)(p.ws + WS_Q), (bf16_t*)(p.ws + WS_KB), (bf16_t*)(p.ws + WS_VTB), SZ,
                  p.out + (size_t)NTOK * D, p.out + (size_t)NTOK * D + (size_t)NCTX * 256};
        for (int t = blockIdx.x; t < 960; t += G) {
            const int tt = xcd_remap(t, 960);
            gemm_tile(H, D, (const bf16_t*)(p.ws + WS_WT1IN), D, 16, lds, e, (tt / 20) * 128, (tt % 20) * 128);
        }
    } break;
    case 8: {
        for (int t = blockIdx.x; t < 768; t += G) attn_item(p, t);
    } break;
    case 9: {
        EpiOut e{X1, X1 + (size_t)NCTX * D, mod + 3 * 3072, p.out};
        for (int t = blockIdx.x; t < 384; t += G) {
            const int tt = xcd_remap(t, 384);
            gemm_tile(Y, D, (const bf16_t*)(p.ws + WS_WT1OUT), D, 16, lds, e, (tt >> 3) * 128, (tt & 7) * 128);
        }
    } break;
    }
}

__global__ void __launch_bounds__(256, 2) mega(Params p) {
    __shared__ __attribute__((aligned(16))) unsigned char lds[65536 + 16];
    cg::grid_group grid = cg::this_grid();
#if SINGLE_LAUNCH
    volatile LAS unsigned* st = (volatile LAS unsigned*)(lds + 65536);
    if (threadIdx.x < 4) st[threadIdx.x] = 0u;
    __syncthreads();
    XcdBarrier bar = xcd_barrier_post((unsigned*)(p.ws + WS_BAR), st);
    if (p.ph_hi == 777) grid.sync();
#define PH(n) run_phase(p, n, lds);
#define SY() xcd_barrier(bar);
#else
    const int lo = (int)p.ph_lo, hi = (int)p.ph_hi;
#define PH(n) if (lo <= n && n < hi) run_phase(p, n, lds);
#define SY()
#endif
    PH(0) SY() PH(1) SY() PH(2) SY() PH(3) SY() PH(4) SY() PH(5) SY() PH(6) SY() PH(7) SY() PH(8) SY() PH(9)
}

extern "C" void kernel_launch(void* const* d_in, const int* in_sizes, int n_in, void* d_out, int out_size, void* d_ws, size_t ws_size, hipStream_t stream) {
    static int grid_blocks = 0;
    if (!grid_blocks) {
        int dev = 0, cus = 0, per_cu = 0;
        hipGetDevice(&dev);
        hipDeviceGetAttribute(&cus, hipDeviceAttributeMultiprocessorCount, dev);
        hipOccupancyMaxActiveBlocksPerMultiprocessor(&per_cu, mega, 256, 0);
        if (per_cu > 2) per_cu = 2;
        if (per_cu < 1) per_cu = 1;
        grid_blocks = cus * per_cu;
    }
    Params p{};
    const float* const* in = (const float* const*)d_in;
    p.x_prompt = in[0]; p.x_sample = in[1]; p.cache_k = in[2]; p.cache_v = in[3]; p.c = in[4]; p.c_ctx = in[5];
    p.norm_w0 = in[6]; p.w_mod0 = in[7]; p.b_mod0 = in[8]; p.w_in0 = in[9]; p.w_out0 = in[10];
    p.norm_w1 = in[11]; p.w_mod1 = in[12]; p.b_mod1 = in[13]; p.w_in1 = in[14]; p.qnw = in[15]; p.knw = in[16]; p.sink = in[17]; p.w_out1 = in[18];
    p.out = (float*)d_out; p.ws = (unsigned char*)d_ws;
#if SINGLE_LAUNCH
    p.ph_lo = 0; p.ph_hi = 10;
    hipMemsetAsync((unsigned char*)d_ws + WS_BAR, 0, XCD_BAR_WORDS * 4, stream);
    void* args[] = {&p};
    hipError_t e = hipLaunchCooperativeKernel((void*)mega, dim3(grid_blocks), dim3(256), args, 0, stream);
    if (e != hipSuccess) fprintf(stderr, "cooperative launch failed: %s (grid %d)\n", hipGetErrorString(e), grid_blocks);
#else
    for (int ph = 0; ph < 10; ++ph) {
        p.ph_lo = ph; p.ph_hi = ph + 1;
        hipLaunchKernelGGL(mega, dim3(grid_blocks), dim3(256), 0, stream, p);
    }
#endif
}
```

```cpp
#include <hip/hip_runtime.h>
#include <hip/hip_cooperative_groups.h>
#include <stdint.h>
#include <cstdio>
namespace cg = cooperative_groups;

#ifndef SINGLE_LAUNCH
#define SINGLE_LAUNCH 1
#endif

typedef unsigned short bf16_t;
typedef short bf16x8 __attribute__((ext_vector_type(8)));
typedef float f32x16 __attribute__((ext_vector_type(16)));
typedef float f32x4 __attribute__((ext_vector_type(4)));
typedef unsigned u32x4 __attribute__((ext_vector_type(4)));
typedef unsigned u32x2 __attribute__((ext_vector_type(2)));
#define DEVI __device__ __forceinline__

constexpr int NTOK = 6144, NCTX = 4096, D = 1024;
constexpr float EPSV = 1e-6f;
constexpr float LOG2E = 1.4426950408889634f;

constexpr size_t WS_MOD = 0;
constexpr size_t WS_WT0IN = 1 << 20;
constexpr size_t WS_WT0OUT = WS_WT0IN + (size_t)2048 * 1024 * 2;
constexpr size_t WS_WT1IN = WS_WT0OUT + (size_t)1024 * 1024 * 2;
constexpr size_t WS_WT1OUT = WS_WT1IN + (size_t)2560 * 1024 * 2;
constexpr size_t WS_TW256 = WS_WT1OUT + (size_t)1024 * 1024 * 2;
constexpr size_t WS_TS256 = WS_TW256 + (size_t)512 * 256 * 2;
constexpr size_t WS_TS1024 = WS_TS256 + (size_t)256 * 512 * 2;
constexpr size_t WS_ROPEC = WS_TS1024 + (size_t)1024 * 2048 * 2;
constexpr size_t WS_ROPES = WS_ROPEC + (size_t)1024 * 32 * 4;
constexpr size_t WS_KC = WS_ROPES + (size_t)1024 * 32 * 4;
constexpr size_t WS_VCT = WS_KC + (size_t)2 * 256 * 256 * 2;
constexpr size_t WS_H = WS_VCT + (size_t)2 * 256 * 256 * 2;
constexpr size_t WS_U = WS_H + (size_t)NTOK * D * 2;
constexpr size_t WS_SZ = WS_U + (size_t)NTOK * D * 2;
constexpr size_t WS_VT = WS_SZ + (size_t)NTOK * D * 2;
constexpr size_t WS_Y = WS_VT + (size_t)NTOK * 2048 * 2;
constexpr size_t WS_X1 = WS_Y + (size_t)NTOK * D * 2;
constexpr size_t WS_Q = WS_X1 + (size_t)NTOK * D * 4;
constexpr size_t WS_KB = WS_Q + (size_t)NTOK * D * 2;
constexpr size_t WS_VTB = WS_KB + (size_t)NTOK * 256 * 2;
constexpr size_t WS_BAR = WS_VTB + (size_t)NTOK * 256 * 2;
constexpr size_t WS_CNT = WS_BAR + 14336;
constexpr size_t WS_ROWSS = WS_BAR + 16384;
constexpr size_t WS_BIAS1 = WS_ROWSS + 6144 * 4;
constexpr size_t WS_END = WS_BIAS1 + 3 * 2560 * 4;

struct Params {
    const float *x_prompt, *x_sample, *cache_k, *cache_v, *c, *c_ctx;
    const float *norm_w0, *w_mod0, *b_mod0, *w_in0, *w_out0;
    const float *norm_w1, *w_mod1, *b_mod1, *w_in1, *qnw, *knw, *sink, *w_out1;
    float* out;
    unsigned char* ws;
    long long ph_lo, ph_hi;
};

DEVI unsigned cvt_pk_bf16(float lo, float hi) { unsigned r; asm("v_cvt_pk_bf16_f32 %0, %1, %2" : "=v"(r) : "v"(lo), "v"(hi)); return r; }
DEVI bf16_t f2bf(float f) { return (bf16_t)(cvt_pk_bf16(f, 0.f) & 0xffffu); }
DEVI float silu_f(float v) { return v / (1.f + __expf(-v)); }
DEVI int swap23(int x) { return (x & ~12) | ((x & 4) << 1) | ((x & 8) >> 1); }
DEVI int cond_of(int m) { return m < NCTX ? 0 : 1 + ((m - NCTX) >> 10); }

DEVI void glds16(const void* g, void* l) { __builtin_amdgcn_global_load_lds(g, l, 16, 0, 0); }

template <class Epi>
DEVI void gemm_tile(const bf16_t* __restrict__ A, int lda, const bf16_t* __restrict__ B, int ldb, int nk,
                    unsigned char* lds, const Epi& epi, int m0, int n0) {
    const int tid = threadIdx.x, lane = tid & 63, wid = tid >> 6, wr = wid >> 1, wc = wid & 1;
    const int srow = tid >> 3;
    const int slc = (tid & 7) ^ ((tid >> 4) & 7);
    const bf16_t* gA = A + (size_t)(m0 + srow) * lda + slc * 8;
    const bf16_t* gB = B + (size_t)(n0 + srow) * ldb + slc * 8;
    const int fr = lane & 31, fh = lane >> 5, sw = (lane >> 1) & 7;
    const unsigned aoff = (wr * 64 + fr) * 128, boff = 16384 + (wc * 64 + fr) * 128;
    f32x16 acc[2][2];
#pragma unroll
    for (int i = 0; i < 2; ++i)
#pragma unroll
        for (int j = 0; j < 2; ++j)
#pragma unroll
            for (int r = 0; r < 16; ++r) acc[i][j][r] = 0.f;
    {
        unsigned char* la = lds + tid * 16;
#pragma unroll
        for (int i = 0; i < 4; ++i) {
            glds16(gA + (size_t)i * 32 * lda, la + i * 4096);
            glds16(gB + (size_t)i * 32 * ldb, la + 16384 + i * 4096);
        }
    }
    for (int kt = 0; kt < nk; ++kt) {
        asm volatile("s_waitcnt vmcnt(0)" ::: "memory");
        __syncthreads();
        if (kt + 1 < nk) {
            unsigned char* la = lds + ((kt + 1) & 1) * 32768 + tid * 16;
            const int ko = (kt + 1) * 64;
#pragma unroll
            for (int i = 0; i < 4; ++i) {
                glds16(gA + (size_t)i * 32 * lda + ko, la + i * 4096);
                glds16(gB + (size_t)i * 32 * ldb + ko, la + 16384 + i * 4096);
            }
        }
        const unsigned char* base = lds + (kt & 1) * 32768;
        bf16x8 af[4][2], bfr[4][2];
#define LDFRAG(ks) { const int ch = ((2 * (ks) + fh) ^ sw) * 16; \
            af[ks][0] = *(const bf16x8*)(base + aoff + ch); bfr[ks][0] = *(const bf16x8*)(base + boff + ch); \
            bfr[ks][1] = *(const bf16x8*)(base + boff + 4096 + ch); af[ks][1] = *(const bf16x8*)(base + aoff + 4096 + ch); }
#define MFMA4(ks) { acc[0][0] = __builtin_amdgcn_mfma_f32_32x32x16_bf16(bfr[ks][0], af[ks][0], acc[0][0], 0, 0, 0); \
            acc[0][1] = __builtin_amdgcn_mfma_f32_32x32x16_bf16(bfr[ks][1], af[ks][0], acc[0][1], 0, 0, 0); \
            acc[1][0] = __builtin_amdgcn_mfma_f32_32x32x16_bf16(bfr[ks][0], af[ks][1], acc[1][0], 0, 0, 0); \
            acc[1][1] = __builtin_amdgcn_mfma_f32_32x32x16_bf16(bfr[ks][1], af[ks][1], acc[1][1], 0, 0, 0); }
        LDFRAG(0) LDFRAG(1)
        __builtin_amdgcn_sched_barrier(0);
        MFMA4(0) LDFRAG(2)
        __builtin_amdgcn_sched_barrier(0);
        MFMA4(1) LDFRAG(3)
        __builtin_amdgcn_sched_barrier(0);
        MFMA4(2)
        __builtin_amdgcn_sched_barrier(0);
        MFMA4(3)
#undef LDFRAG
#undef MFMA4
    }
    epi(acc, m0 + wr * 64, n0 + wc * 64, fr, fh);
    __syncthreads();
}

DEVI int xcd_remap(int t, int T) { return (t & 7) * (T >> 3) + (t >> 3); }

DEVI void mod_item(const Params& p, int it, unsigned char* lds) {
    const int tid = threadIdx.x;
    const int l = it / 48, cc = it % 48;
    float* sc = (float*)lds;
    for (int i = tid; i < 3072; i += 256) {
        const int cv = i >> 10, k = i & 1023;
        const float cval = cv == 0 ? p.c_ctx[k] : p.c[(cv - 1) * 1024 + k];
        sc[i] = silu_f(cval);
    }
    __syncthreads();
    const float* W = l ? p.w_mod1 : p.w_mod0;
    const float* bm = l ? p.b_mod1 : p.b_mod0;
    const int cg4 = tid & 15, rg = tid >> 4, c0 = cc * 64 + cg4 * 4;
    f32x4 a0 = {0.f, 0.f, 0.f, 0.f}, a1 = a0, a2 = a0;
#pragma unroll 8
    for (int k = rg; k < 1024; k += 16) {
        const f32x4 w = *(const f32x4*)(W + (size_t)k * 3072 + c0);
        a0 += sc[k] * w; a1 += sc[1024 + k] * w; a2 += sc[2048 + k] * w;
    }
    float* red = (float*)(lds + 12288);
#pragma unroll
    for (int e = 0; e < 4; ++e) {
        red[(rg * 3 + 0) * 64 + cg4 * 4 + e] = a0[e];
        red[(rg * 3 + 1) * 64 + cg4 * 4 + e] = a1[e];
        red[(rg * 3 + 2) * 64 + cg4 * 4 + e] = a2[e];
    }
    __syncthreads();
    if (tid < 192) {
        const int cv = tid >> 6, j = tid & 63;
        float s = 0.f;
#pragma unroll
        for (int r = 0; r < 16; ++r) s += red[(r * 3 + cv) * 64 + j];
        float* mod = (float*)(p.ws + WS_MOD);
        __hip_atomic_store(&mod[(l * 3 + cv) * 3072 + cc * 64 + j], s + bm[cc * 64 + j], __ATOMIC_RELAXED, __HIP_MEMORY_SCOPE_AGENT);
    }
    asm volatile("s_waitcnt vmcnt(0)" ::: "memory");
    __syncthreads();
    if (tid == 0) __hip_atomic_fetch_add((unsigned*)(p.ws + WS_CNT), 1u, __ATOMIC_RELAXED, __HIP_MEMORY_SCOPE_AGENT);
}

DEVI void transpose_item(const Params& p, int idx, unsigned char* lds) {
    const int tid = threadIdx.x;
    const float* src; bf16_t* dst; int N;
    if (idx < 512) { src = p.w_in0; dst = (bf16_t*)(p.ws + WS_WT0IN); N = 2048; }
    else if (idx < 768) { idx -= 512; src = p.w_out0; dst = (bf16_t*)(p.ws + WS_WT0OUT); N = 1024; }
    else if (idx < 1408) { idx -= 768; src = p.w_in1; dst = (bf16_t*)(p.ws + WS_WT1IN); N = 2560; }
    else { idx -= 1408; src = p.w_out1; dst = (bf16_t*)(p.ws + WS_WT1OUT); N = 1024; }
    const int ntn = N >> 6;
    const int kt = idx / ntn, nt = idx % ntn;
    float* tl = (float*)lds;
#pragma unroll
    for (int pass = 0; pass < 4; ++pass) {
        const int r = pass * 16 + (tid >> 4), c4 = (tid & 15) * 4;
        const f32x4 v = *(const f32x4*)(src + (size_t)(kt * 64 + r) * N + nt * 64 + c4);
#pragma unroll
        for (int e = 0; e < 4; ++e) tl[r * 65 + c4 + e] = v[e];
    }
    __syncthreads();
#pragma unroll
    for (int pass = 0; pass < 2; ++pass) {
        const int n = pass * 32 + (tid >> 3), kc = tid & 7;
        float v[8];
#pragma unroll
        for (int j = 0; j < 8; ++j) v[j] = tl[(kc * 8 + j) * 65 + n];
        u32x4 w;
        w.x = cvt_pk_bf16(v[0], v[1]); w.y = cvt_pk_bf16(v[2], v[3]); w.z = cvt_pk_bf16(v[4], v[5]); w.w = cvt_pk_bf16(v[6], v[7]);
        *(u32x4*)(dst + (size_t)(nt * 64 + n) * 1024 + kt * 64 + kc * 8) = w;
    }
    __syncthreads();
}

DEVI void phase0(const Params& p, unsigned char* lds) {
    constexpr int NMOD = 96, NTR = 1664;
    for (int it = blockIdx.x; it < NMOD + NTR; it += gridDim.x) {
        if (it < NMOD) mod_item(p, it, lds); else transpose_item(p, it - NMOD, lds);
    }
    const int gt = blockIdx.x * 256 + threadIdx.x, gs = gridDim.x * 256;
    bf16_t* tw256 = (bf16_t*)(p.ws + WS_TW256);
    bf16_t* ts256 = (bf16_t*)(p.ws + WS_TS256);
    bf16_t* ts1024 = (bf16_t*)(p.ws + WS_TS1024);
    for (int i = gt; i < 512 * 256; i += gs) {
        const int m = i >> 8, j = i & 255, which = m >> 8, cp = m & 255;
        const int r = (cp * j) & 255;
        float s, c; sincospif((float)r * (1.f / 128.f), &s, &c);
        tw256[i] = f2bf(which ? s : c);
    }
    for (int i = gt; i < 256 * 512; i += gs) {
        const int sp = i >> 9, k2 = i & 511, which = k2 >> 8, s0 = k2 & 255;
        const int r = (sp * s0) & 255;
        float s, c; sincospif((float)r * (1.f / 128.f), &s, &c);
        ts256[i] = f2bf((which ? -s : c) * (1.f / 256.f));
    }
    for (int i = gt; i < 1024 * 2048; i += gs) {
        const int sp = i >> 11, k2 = i & 2047, which = k2 >> 10, s0 = k2 & 1023;
        const int r = (sp * s0) & 1023;
        float s, c; sincospif((float)r * (1.f / 512.f), &s, &c);
        ts1024[i] = f2bf((which ? -s : c) * (1.f / 512.f));
    }
    float* ropec = (float*)(p.ws + WS_ROPEC);
    float* ropes = (float*)(p.ws + WS_ROPES);
    for (int i = gt; i < 1024 * 32; i += gs) {
        const int pos = i >> 5, f = i & 31;
        const int row = pos >> 6, col = pos & 63;
        const float inv = powf(10000.f, -(float)(f & 15) * (1.f / 16.f));
        const float ang = (float)(f < 16 ? row : col) * inv;
        float s, c; sincosf(ang, &s, &c);
        ropec[i] = c; ropes[i] = s;
    }
    for (int i = gt; i < NTOK; i += gs) ((float*)(p.ws + WS_ROWSS))[i] = 0.f;
    bf16_t* kc = (bf16_t*)(p.ws + WS_KC);
    bf16_t* vct = (bf16_t*)(p.ws + WS_VCT);
    for (int i = gt; i < 2 * 256 * 256; i += gs) {
        kc[i] = f2bf(p.cache_k[i]);
        const int b = i >> 16, kvh = (i >> 14) & 3, d = (i >> 8) & 63, pp = i & 255;
        const int key = swap23(pp);
        vct[i] = f2bf(p.cache_v[((b * 256 + key) * 4 + kvh) * 64 + d]);
    }
}

DEVI void phase_norm(const Params& p, int layer, const float* lmod  ) {
    const int lane = threadIdx.x & 63, wid = threadIdx.x >> 6;
    const float* nw = layer ? p.norm_w1 : p.norm_w0;
    bf16_t* H = (bf16_t*)(p.ws + WS_H);
    for (int row = blockIdx.x * 4 + wid; row < NTOK; row += gridDim.x * 4) {
        const float* xr;
        if (layer == 0) xr = row < NCTX ? p.x_prompt + (size_t)row * D : p.x_sample + (size_t)(row - NCTX) * D;
        else xr = (const float*)(p.ws + WS_X1) + (size_t)row * D;
        const float* mv = lmod + cond_of(row) * 2048;
        f32x4 v[4];
        float ss = 0.f;
#pragma unroll
        for (int i = 0; i < 4; ++i) {
            v[i] = *(const f32x4*)(xr + i * 256 + lane * 4);
            ss += v[i][0] * v[i][0] + v[i][1] * v[i][1] + v[i][2] * v[i][2] + v[i][3] * v[i][3];
        }
#pragma unroll
        for (int o = 32; o >= 1; o >>= 1) ss += __shfl_xor(ss, o);
        const float rstd = rsqrtf(ss * (1.f / 1024.f) + EPSV);
#pragma unroll
        for (int i = 0; i < 4; ++i) {
            const int k = i * 256 + lane * 4;
            const f32x4 w = *(const f32x4*)(nw + k);
            const f32x4 sh = *(const f32x4*)(mv + k);
            const f32x4 scl = *(const f32x4*)(mv + 1024 + k);
            float h[4];
#pragma unroll
            for (int e = 0; e < 4; ++e) h[e] = (v[i][e] * rstd * w[e]) * (1.f + scl[e]) + sh[e];
            u32x2 o; o.x = cvt_pk_bf16(h[0], h[1]); o.y = cvt_pk_bf16(h[2], h[3]);
            *(u32x2*)(H + (size_t)row * D + k) = o;
        }
    }
}

DEVI void bias1_items(const Params& p) {
    const int lane = threadIdx.x & 63, gw = blockIdx.x * 4 + (threadIdx.x >> 6), nw = gridDim.x * 4;
    const float* mod1 = (const float*)(p.ws + WS_MOD) + 3 * 3072;
    const bf16_t* WT = (const bf16_t*)(p.ws + WS_WT1IN);
    float* bias1 = (float*)(p.ws + WS_BIAS1);
    for (int n = gw; n < 2560; n += nw) {
        float w[16];
        const u32x4 r0 = *(const u32x4*)(WT + (size_t)n * 1024 + lane * 16), r1 = *(const u32x4*)(WT + (size_t)n * 1024 + lane * 16 + 8);
        const unsigned rr[8] = {r0.x, r0.y, r0.z, r0.w, r1.x, r1.y, r1.z, r1.w};
#pragma unroll
        for (int i = 0; i < 8; ++i) { w[2 * i] = __uint_as_float(rr[i] << 16); w[2 * i + 1] = __uint_as_float(rr[i] & 0xffff0000u); }
        float s[3];
#pragma unroll
        for (int cv = 0; cv < 3; ++cv) {
            float a = 0.f;
#pragma unroll
            for (int q = 0; q < 4; ++q) {
                const f32x4 sh = *(const f32x4*)(mod1 + cv * 3072 + lane * 16 + q * 4);
#pragma unroll
                for (int e = 0; e < 4; ++e) a += sh[e] * w[q * 4 + e];
            }
#pragma unroll
            for (int o = 32; o >= 1; o >>= 1) a += __shfl_xor(a, o);
            s[cv] = a;
        }
        if (lane == 0) { bias1[n] = s[0]; bias1[2560 + n] = s[1]; bias1[5120 + n] = s[2]; }
    }
}

struct EpiInL0 {
    bf16_t *U, *SZ;
    DEVI void operator()(const f32x16 (&acc)[2][2], int mbase, int nbase, int fr, int fh) const {
        const bool isz = nbase >= 1024;
        bf16_t* dst = isz ? SZ : U;
        const int nb0 = isz ? nbase - 1024 : nbase;
#pragma unroll
        for (int mb = 0; mb < 2; ++mb)
#pragma unroll
            for (int nb = 0; nb < 2; ++nb)
#pragma unroll
                for (int g = 0; g < 4; ++g) {
                    const int m = mbase + mb * 32 + fr, n = nb0 + nb * 32 + 8 * g + 4 * fh;
                    float v[4];
#pragma unroll
                    for (int e = 0; e < 4; ++e) { v[e] = acc[mb][nb][4 * g + e]; if (isz) v[e] = silu_f(v[e]); }
                    u32x2 o; o.x = cvt_pk_bf16(v[0], v[1]); o.y = cvt_pk_bf16(v[2], v[3]);
                    *(u32x2*)(dst + (size_t)m * D + n) = o;
                }
    }
};

struct EpiChanDft {
    bf16_t* VT; int g;
    DEVI void operator()(const f32x16 (&acc)[2][2], int mbase, int nbase, int fr, int fh) const {
        int S, bgi, s0; bf16_t* base;
        if (nbase < NCTX) { S = 256; bgi = (nbase >> 8) * 4 + g; s0 = nbase & 255; base = VT; }
        else { const int t = nbase - NCTX; S = 1024; bgi = (t >> 10) * 4 + g; s0 = t & 1023; base = VT + (size_t)64 * 256 * 512; }
#pragma unroll
        for (int mb = 0; mb < 2; ++mb)
#pragma unroll
            for (int nb = 0; nb < 2; ++nb)
#pragma unroll
                for (int gq = 0; gq < 4; ++gq) {
                    const int m = mbase + mb * 32 + fr, which = m >> 8, cp = m & 255;
                    const int s = s0 + nb * 32 + 8 * gq + 4 * fh;
                    u32x2 o; o.x = cvt_pk_bf16(acc[mb][nb][4 * gq], acc[mb][nb][4 * gq + 1]); o.y = cvt_pk_bf16(acc[mb][nb][4 * gq + 2], acc[mb][nb][4 * gq + 3]);
                    *(u32x2*)(base + ((size_t)bgi * 256 + cp) * (2 * S) + which * S + s) = o;
                }
    }
};

struct EpiSeqDft {
    const bf16_t* SZ; bf16_t* Y; int tok0, g;
    DEVI void operator()(const f32x16 (&acc)[2][2], int mbase, int nbase, int fr, int fh) const {
#pragma unroll
        for (int mb = 0; mb < 2; ++mb)
#pragma unroll
            for (int nb = 0; nb < 2; ++nb)
#pragma unroll
                for (int gq = 0; gq < 4; ++gq) {
                    const int tok = tok0 + mbase + mb * 32 + fr;
                    const int col = g * 256 + nbase + nb * 32 + 8 * gq + 4 * fh;
                    const u32x2 z = *(const u32x2*)(SZ + (size_t)tok * D + col);
                    const float z0 = __uint_as_float(z.x << 16), z1 = __uint_as_float(z.x & 0xffff0000u);
                    const float z2 = __uint_as_float(z.y << 16), z3 = __uint_as_float(z.y & 0xffff0000u);
                    u32x2 o; o.x = cvt_pk_bf16(acc[mb][nb][4 * gq] * z0, acc[mb][nb][4 * gq + 1] * z1);
                    o.y = cvt_pk_bf16(acc[mb][nb][4 * gq + 2] * z2, acc[mb][nb][4 * gq + 3] * z3);
                    *(u32x2*)(Y + (size_t)tok * D + col) = o;
                }
    }
};

template <bool NEXT> struct EpiOut {
    const float* xa; const float* xb;
    const float* mod;
    float* out;
    const float* nw1; const float* mod1; bf16_t* Hn; float* rowss;
    DEVI void operator()(const f32x16 (&acc)[2][2], int mbase, int nbase, int fr, int fh) const {
        const int cv = cond_of(mbase);
        const float* gate = mod + cv * 3072 + 2048;
#pragma unroll
        for (int mb = 0; mb < 2; ++mb) {
            const int m = mbase + mb * 32 + fr;
            const float* xr = m < NCTX ? xa + (size_t)m * D : xb + (size_t)(m - NCTX) * D;
            float ss = 0.f;
#pragma unroll
            for (int nb = 0; nb < 2; ++nb)
#pragma unroll
                for (int g = 0; g < 4; ++g) {
                    const int n = nbase + nb * 32 + 8 * g + 4 * fh;
                    const f32x4 xv = *(const f32x4*)(xr + n);
                    const f32x4 gv = *(const f32x4*)(gate + n);
                    f32x4 o;
#pragma unroll
                    for (int e = 0; e < 4; ++e) o[e] = xv[e] + gv[e] * acc[mb][nb][4 * g + e];
                    *(f32x4*)(out + (size_t)m * D + n) = o;
                    if (NEXT) {
                        const f32x4 w = *(const f32x4*)(nw1 + n);
                        const f32x4 sc = *(const f32x4*)(mod1 + cv * 3072 + 1024 + n);
                        float h[4];
#pragma unroll
                        for (int e = 0; e < 4; ++e) { ss += o[e] * o[e]; h[e] = o[e] * w[e] * (1.f + sc[e]); }
                        u32x2 hb; hb.x = cvt_pk_bf16(h[0], h[1]); hb.y = cvt_pk_bf16(h[2], h[3]);
                        *(u32x2*)(Hn + (size_t)m * D + n) = hb;
                    }
                }
            if (NEXT) {
                ss += __shfl_xor(ss, 32);
                if (fh == 0) atomicAdd(rowss + m, ss);
            }
        }
    }
};

struct EpiInL1 {
    const float *qnw, *knw, *ropec, *ropes;
    bf16_t *Q, *KB, *VTB, *SZ;
    float *outk, *outv;
    const float* rowss; const float* bias1;
    DEVI void operator()(const f32x16 (&acc_in)[2][2], int mbase, int nbase, int fr, int fh) const {
        const bool lat = mbase >= NCTX;
        f32x16 acc[2][2];
        {
            const float* bp = bias1 + cond_of(mbase) * 2560 + nbase;
#pragma unroll
            for (int mb = 0; mb < 2; ++mb) {
                const float rstd = rsqrtf(rowss[mbase + mb * 32 + fr] * (1.f / 1024.f) + EPSV);
#pragma unroll
                for (int nb = 0; nb < 2; ++nb)
#pragma unroll
                    for (int g = 0; g < 4; ++g) {
                        const f32x4 bv = *(const f32x4*)(bp + nb * 32 + 8 * g + 4 * fh);
#pragma unroll
                        for (int e = 0; e < 4; ++e) acc[mb][nb][4 * g + e] = acc_in[mb][nb][4 * g + e] * rstd + bv[e];
                    }
            }
        }
        if (nbase < 1280) {
            const bool isq = nbase < 1024;
            const float* nwp = isq ? qnw : knw;
#pragma unroll
            for (int mb = 0; mb < 2; ++mb) {
                const int m = mbase + mb * 32 + fr;
                float ss = 0.f;
#pragma unroll
                for (int nb = 0; nb < 2; ++nb)
#pragma unroll
                    for (int r = 0; r < 16; ++r) ss += acc[mb][nb][r] * acc[mb][nb][r];
                ss += __shfl_xor(ss, 32);
                const float rn = rsqrtf(ss * (1.f / 64.f) + EPSV);
                const int pos = lat ? ((m - NCTX) & 1023) : 0;
#pragma unroll
                for (int g = 0; g < 4; ++g) {
                    const int d0 = 8 * g + 4 * fh;
                    const f32x4 w1 = *(const f32x4*)(nwp + d0), w2 = *(const f32x4*)(nwp + 32 + d0);
                    float x1[4], x2[4];
#pragma unroll
                    for (int e = 0; e < 4; ++e) { x1[e] = acc[mb][0][4 * g + e] * rn * w1[e]; x2[e] = acc[mb][1][4 * g + e] * rn * w2[e]; }
                    if (lat) {
                        const f32x4 cv = *(const f32x4*)(ropec + pos * 32 + d0), sv = *(const f32x4*)(ropes + pos * 32 + d0);
#pragma unroll
                        for (int e = 0; e < 4; ++e) { const float a = x1[e], b = x2[e]; x1[e] = a * cv[e] - b * sv[e]; x2[e] = a * sv[e] + b * cv[e]; }
                    }
                    if (isq) {
                        const float qs = 0.125f * LOG2E;
                        u32x2 o1, o2;
                        o1.x = cvt_pk_bf16(x1[0] * qs, x1[1] * qs); o1.y = cvt_pk_bf16(x1[2] * qs, x1[3] * qs);
                        o2.x = cvt_pk_bf16(x2[0] * qs, x2[1] * qs); o2.y = cvt_pk_bf16(x2[2] * qs, x2[3] * qs);
                        *(u32x2*)(Q + (size_t)m * D + nbase + d0) = o1;
                        *(u32x2*)(Q + (size_t)m * D + nbase + 32 + d0) = o2;
                    } else {
                        const int kc = nbase - 1024;
                        u32x2 o1, o2;
                        o1.x = cvt_pk_bf16(x1[0], x1[1]); o1.y = cvt_pk_bf16(x1[2], x1[3]);
                        o2.x = cvt_pk_bf16(x2[0], x2[1]); o2.y = cvt_pk_bf16(x2[2], x2[3]);
                        *(u32x2*)(KB + (size_t)m * 256 + kc + d0) = o1;
                        *(u32x2*)(KB + (size_t)m * 256 + kc + 32 + d0) = o2;
                        if (!lat) {
                            f32x4 f1 = {x1[0], x1[1], x1[2], x1[3]}, f2 = {x2[0], x2[1], x2[2], x2[3]};
                            *(f32x4*)(outk + (size_t)m * 256 + kc + d0) = f1;
                            *(f32x4*)(outk + (size_t)m * 256 + kc + 32 + d0) = f2;
                        }
                    }
                }
            }
        } else if (nbase < 1536) {
            const int vc = nbase - 1280, kvh = vc >> 6;
#pragma unroll
            for (int mb = 0; mb < 2; ++mb) {
                const int m = mbase + mb * 32 + fr;
                bf16_t* vt; int S, s;
                if (!lat) { S = 256; s = m & 255; vt = VTB + ((size_t)((m >> 8) * 4 + kvh) * 64) * 256; }
                else { const int t = m - NCTX; S = 1024; s = t & 1023; vt = VTB + (size_t)16 * 4 * 64 * 256 + ((size_t)((t >> 10) * 4 + kvh) * 64) * 1024; }
                const int sp = swap23(s);
#pragma unroll
                for (int nb = 0; nb < 2; ++nb)
#pragma unroll
                    for (int g = 0; g < 4; ++g) {
                        const int d0 = nb * 32 + 8 * g + 4 * fh;
#pragma unroll
                        for (int e = 0; e < 4; ++e) vt[(size_t)(d0 + e) * S + sp] = f2bf(acc[mb][nb][4 * g + e]);
                        if (!lat) {
                            f32x4 f = {acc[mb][nb][4 * g], acc[mb][nb][4 * g + 1], acc[mb][nb][4 * g + 2], acc[mb][nb][4 * g + 3]};
                            *(f32x4*)(outv + (size_t)m * 256 + vc + d0) = f;
                        }
                    }
            }
        } else {
            const int zc = nbase - 1536;
#pragma unroll
            for (int mb = 0; mb < 2; ++mb)
#pragma unroll
                for (int nb = 0; nb < 2; ++nb)
#pragma unroll
                    for (int g = 0; g < 4; ++g) {
                        const int m = mbase + mb * 32 + fr, n = zc + nb * 32 + 8 * g + 4 * fh;
                        u32x2 o; o.x = cvt_pk_bf16(silu_f(acc[mb][nb][4 * g]), silu_f(acc[mb][nb][4 * g + 1]));
                        o.y = cvt_pk_bf16(silu_f(acc[mb][nb][4 * g + 2]), silu_f(acc[mb][nb][4 * g + 3]));
                        *(u32x2*)(SZ + (size_t)m * D + n) = o;
                    }
        }
    }
};

DEVI void attn_item(const Params& p, int item, unsigned char* lds) {
    const int lane = threadIdx.x & 63, w = threadIdx.x >> 6, fr = lane & 31, fh = lane >> 5;
    const bf16_t* Q = (const bf16_t*)(p.ws + WS_Q);
    const bf16_t* KB = (const bf16_t*)(p.ws + WS_KB);
    const bf16_t* VTB = (const bf16_t*)(p.ws + WS_VTB);
    const bf16_t* KC = (const bf16_t*)(p.ws + WS_KC);
    const bf16_t* VCT = (const bf16_t*)(p.ws + WS_VCT);
    const bf16_t* SZ = (const bf16_t*)(p.ws + WS_SZ);
    bf16_t* Y = (bf16_t*)(p.ws + WS_Y);
    bool lat; int b, kvh, qb, tb;
    if (item < 256) { lat = true; b = item >> 7; kvh = (item >> 5) & 3; qb = item & 31; tb = NCTX + b * 1024; }
    else { const int it = item - 256; lat = false; b = it >> 5; kvh = (it >> 3) & 3; qb = it & 7; tb = b * 256; }
    const int head = kvh * 4 + w;
    const int qtok = tb + qb * 32 + fr;
    bf16x8 qf[4];
#pragma unroll
    for (int ks = 0; ks < 4; ++ks) qf[ks] = *(const bf16x8*)(Q + (size_t)qtok * D + head * 64 + ks * 16 + fh * 8);
    float m_run = p.sink[head] * LOG2E, l_run = 1.f;
    f32x16 O[2];
#pragma unroll
    for (int i = 0; i < 2; ++i)
#pragma unroll
        for (int r = 0; r < 16; ++r) O[i][r] = 0.f;

    int nloc, k_lo = 0; const bf16_t *kloc, *vloc; int ldloc;
    if (lat) {
        k_lo = qb - 4 < 0 ? 0 : qb - 4; const int k_hi = qb + 4 > 31 ? 31 : qb + 4; nloc = k_hi - k_lo + 1;
        kloc = KB + (size_t)(tb + k_lo * 32) * 256 + kvh * 64;
        vloc = VTB + (size_t)16 * 4 * 64 * 256 + ((size_t)(b * 4 + kvh) * 64) * 1024 + k_lo * 32; ldloc = 1024;
    } else {
        nloc = 8; kloc = KB + (size_t)tb * 256 + kvh * 64; vloc = VTB + ((size_t)(b * 4 + kvh) * 64) * 256; ldloc = 256;
    }
    const int nblk = lat ? nloc + 8 : 8;
    const bf16_t* kcb = KC + (size_t)(b * 256) * 256 + kvh * 64;
    const bf16_t* vcb = VCT + ((size_t)(b * 4 + kvh) * 64) * 256;
    const int tid = threadIdx.x;
    const int kkey = tid >> 3, kch = tid & 7, vd = tid >> 2, vch = tid & 3;
    const unsigned kst = kkey * 128 + ((kch ^ ((kkey >> 1) & 7)) << 4), vst = 4096 + vd * 64 + ((vch ^ ((vd >> 2) & 3)) << 4);
    const unsigned ksw = (fr >> 1) & 7, vsw = (fr >> 2) & 3;
    u32x4 kreg, vreg;
    auto loadkv = [&](int j) {
        const bf16_t *kp, *vp; int ldv;
        if (j < nloc) { kp = kloc + (size_t)j * 32 * 256; vp = vloc + j * 32; ldv = ldloc; }
        else { const int c = j - nloc; kp = kcb + (size_t)c * 32 * 256; vp = vcb + c * 32; ldv = 256; }
        kreg = *(const u32x4*)(kp + (size_t)kkey * 256 + kch * 8);
        vreg = *(const u32x4*)(vp + (size_t)vd * ldv + vch * 8);
    };
    loadkv(0);
    *(u32x4*)(lds + kst) = kreg; *(u32x4*)(lds + vst) = vreg;
    if (nblk > 1) loadkv(1);
    __syncthreads();
    for (int j = 0; j < nblk; ++j) {
        const unsigned char* lb = lds + (j & 1) * 8192;
        bf16x8 kf[4], vf[4];
#pragma unroll
        for (int ks = 0; ks < 4; ++ks) kf[ks] = *(const bf16x8*)(lb + fr * 128 + (((2 * ks + fh) ^ ksw) << 4));
#pragma unroll
        for (int s2 = 0; s2 < 2; ++s2)
#pragma unroll
            for (int db = 0; db < 2; ++db) vf[s2 * 2 + db] = *(const bf16x8*)(lb + 4096 + (db * 32 + fr) * 64 + (((2 * s2 + fh) ^ vsw) << 4));
        f32x16 s;
#pragma unroll
        for (int r = 0; r < 16; ++r) s[r] = 0.f;
#pragma unroll
        for (int ks = 0; ks < 4; ++ks) s = __builtin_amdgcn_mfma_f32_32x32x16_bf16(kf[ks], qf[ks], s, 0, 0, 0);
        if (lat && j < nloc) {
            const int kb = k_lo + j;
            const int mode = (kb == qb - 4) ? 1 : (kb == qb + 4) ? 2 : 0;
            if (mode) {
                const int dpos = (kb - qb) * 32;
#pragma unroll
                for (int r = 0; r < 16; ++r) {
                    const int rel = dpos + (r & 3) + 8 * (r >> 2) + 4 * fh - fr;
                    const bool ok = mode == 1 ? (rel >= -128) : (rel <= 128);
                    if (!ok) s[r] = -1e30f;
                }
            }
        }
        float mx = s[0];
#pragma unroll
        for (int r = 1; r < 16; ++r) mx = fmaxf(mx, s[r]);
        mx = fmaxf(mx, __shfl_xor(mx, 32));
        const float m_new = fmaxf(m_run, mx);
        const float alpha = __builtin_amdgcn_exp2f(m_run - m_new);
        float rs = 0.f;
#pragma unroll
        for (int r = 0; r < 16; ++r) { s[r] = __builtin_amdgcn_exp2f(s[r] - m_new); rs += s[r]; }
        rs += __shfl_xor(rs, 32);
        l_run = l_run * alpha + rs; m_run = m_new;
#pragma unroll
        for (int i = 0; i < 2; ++i)
#pragma unroll
            for (int r = 0; r < 16; ++r) O[i][r] *= alpha;
#pragma unroll
        for (int s2 = 0; s2 < 2; ++s2) {
            union { u32x4 u; bf16x8 v; } pf;
            pf.u.x = cvt_pk_bf16(s[8 * s2 + 0], s[8 * s2 + 1]); pf.u.y = cvt_pk_bf16(s[8 * s2 + 2], s[8 * s2 + 3]);
            pf.u.z = cvt_pk_bf16(s[8 * s2 + 4], s[8 * s2 + 5]); pf.u.w = cvt_pk_bf16(s[8 * s2 + 6], s[8 * s2 + 7]);
#pragma unroll
            for (int db = 0; db < 2; ++db) O[db] = __builtin_amdgcn_mfma_f32_32x32x16_bf16(vf[s2 * 2 + db], pf.v, O[db], 0, 0, 0);
        }
        if (j + 1 < nblk) {
            unsigned char* nb = lds + ((j + 1) & 1) * 8192;
            *(u32x4*)(nb + kst) = kreg; *(u32x4*)(nb + vst) = vreg;
            if (j + 2 < nblk) loadkv(j + 2);
        }
        __syncthreads();
    }
    const float il = 1.f / l_run;
#pragma unroll
    for (int db = 0; db < 2; ++db)
#pragma unroll
        for (int g = 0; g < 4; ++g) {
            const int col = head * 64 + db * 32 + 8 * g + 4 * fh;
            const u32x2 z = *(const u32x2*)(SZ + (size_t)qtok * D + col);
            const float z0 = __uint_as_float(z.x << 16), z1 = __uint_as_float(z.x & 0xffff0000u);
            const float z2 = __uint_as_float(z.y << 16), z3 = __uint_as_float(z.y & 0xffff0000u);
            u32x2 o; o.x = cvt_pk_bf16(O[db][4 * g] * il * z0, O[db][4 * g + 1] * il * z1);
            o.y = cvt_pk_bf16(O[db][4 * g + 2] * il * z2, O[db][4 * g + 3] * il * z3);
            *(u32x2*)(Y + (size_t)qtok * D + col) = o;
        }
}


#define XB_TMO      128
#define XB_XCNT(j)  (256  + 64 * (j))
#define XB_XSUB(j)  (1280 + 64 * (j))
#define XB_XGEN(j)  (2304 + 64 * (j))
#define XB_TOP      3328
#define XB_TOPGEN   3392
#define XCD_BAR_WORDS 3456
#define XB_SPIN_CAP (1u << 18)
#define LAS __attribute__((address_space(3)))
DEVI unsigned xb_ld(unsigned* p)              { return __hip_atomic_load(p, __ATOMIC_RELAXED, __HIP_MEMORY_SCOPE_AGENT); }
DEVI unsigned xb_add(unsigned* p, unsigned v) { return __hip_atomic_fetch_add(p, v, __ATOMIC_RELAXED, __HIP_MEMORY_SCOPE_AGENT); }
DEVI unsigned xb_xcc_id() { return (unsigned)__builtin_amdgcn_s_getreg((3 << 11) | 20) & 0xFu; }
#define XB_SPIN(cond, bar) do { unsigned _sp = 0; while (cond) { __builtin_amdgcn_s_sleep(1); \
    if ((++_sp & 255u) == 0u) { if (xb_ld(&(bar)[XB_TMO])) break; if (_sp > XB_SPIN_CAP) { atomicAdd(&(bar)[XB_TMO], 1u); break; } } } } while (0)
struct XcdBarrier { unsigned* bar; unsigned x; volatile LAS unsigned* st; };
DEVI XcdBarrier xcd_barrier_post(unsigned* bar, volatile LAS unsigned* st) {
    XcdBarrier b; b.bar = bar; b.x = xb_xcc_id(); b.st = st;
    if (threadIdx.x == 0) (void)xb_add(&bar[XB_XCNT(b.x)], 1u);
    return b;
}
DEVI void xcd_barrier_complete(unsigned* bar, unsigned x, unsigned& nloc, unsigned& nx) {
    const unsigned G = gridDim.x * gridDim.y * gridDim.z;
    unsigned sum, cnt, mine, sp = 0u;
    for (;;) {
        sum = 0u; cnt = 0u; mine = 0u;
#pragma unroll
        for (unsigned j = 0; j < 16; ++j) { const unsigned c = xb_ld(&bar[XB_XCNT(j)]); sum += c; cnt += (c > 0u) ? 1u : 0u; mine = (j == x) ? c : mine; }
        if (sum == G) break;
        __builtin_amdgcn_s_sleep(1);
        if ((++sp & 255u) == 0u) { if (xb_ld(&bar[XB_TMO])) break; if (sp > XB_SPIN_CAP) { atomicAdd(&bar[XB_TMO], 1u); break; } }
    }
    nloc = mine > 0u ? mine : 1u; nx = cnt > 0u ? cnt : 1u;
}
DEVI void xcd_barrier(const XcdBarrier& b) {
    asm volatile("s_waitcnt vmcnt(0)" ::: "memory");
    __syncthreads();
    if (threadIdx.x == 0) {
        unsigned* bar = b.bar;
        __builtin_amdgcn_s_waitcnt(0);
        unsigned nloc = b.st[0], nx = b.st[1];
        if (nloc == 0u) { xcd_barrier_complete(bar, b.x, nloc, nx); b.st[0] = nloc; b.st[1] = nx; }
        const unsigned old = xb_add(&bar[XB_XSUB(b.x)], 1u);
        const unsigned gen = old / nloc;
        if (old + 1u == (gen + 1u) * nloc) {
            __builtin_amdgcn_fence(__ATOMIC_RELEASE, "agent");
            asm volatile("s_waitcnt vmcnt(0)" ::: "memory");
            const unsigned og = xb_add(&bar[XB_TOP], 1u);
            const unsigned tg = og / nx;
            if (og + 1u == (tg + 1u) * nx) xb_add(&bar[XB_TOPGEN], 1u);
            else XB_SPIN(xb_ld(&bar[XB_TOPGEN]) == tg, bar);
            __builtin_amdgcn_fence(__ATOMIC_ACQUIRE, "agent");
            xb_add(&bar[XB_XGEN(b.x)], 1u);
            asm volatile("s_waitcnt vmcnt(0)" ::: "memory");
        } else {
            XB_SPIN(xb_ld(&bar[XB_XGEN(b.x)]) == gen, bar);
            __builtin_amdgcn_fence(__ATOMIC_ACQUIRE, "agent");
            asm volatile("s_waitcnt vmcnt(0)" ::: "memory");
        }
    }
    __syncthreads();
}

DEVI void run_phase(const Params& p, int ph, unsigned char* lds) {
    const int G = gridDim.x;
    bf16_t* H = (bf16_t*)(p.ws + WS_H);
    bf16_t* U = (bf16_t*)(p.ws + WS_U);
    bf16_t* SZ = (bf16_t*)(p.ws + WS_SZ);
    bf16_t* VT = (bf16_t*)(p.ws + WS_VT);
    bf16_t* Y = (bf16_t*)(p.ws + WS_Y);
    float* X1 = (float*)(p.ws + WS_X1);
    const float* mod = (const float*)(p.ws + WS_MOD);
    switch (ph) {
    case 0: {
        phase0(p, lds);
        if (threadIdx.x == 0) {
            unsigned* cnt = (unsigned*)(p.ws + WS_CNT); unsigned sp = 0;
            while (__hip_atomic_load(cnt, __ATOMIC_RELAXED, __HIP_MEMORY_SCOPE_AGENT) < 96u) { __builtin_amdgcn_s_sleep(2); if (++sp > (1u << 22)) break; }
        }
        __syncthreads();
        float* lmod = (float*)lds;
        for (int i = threadIdx.x; i < 3 * 2048; i += 256)
            lmod[i] = __hip_atomic_load((float*)(p.ws + WS_MOD) + (i >> 11) * 3072 + (i & 2047), __ATOMIC_RELAXED, __HIP_MEMORY_SCOPE_AGENT);
        __syncthreads();
        phase_norm(p, 0, lmod);
    } break;
    case 2: {
        EpiInL0 e{U, SZ};
        for (int t = blockIdx.x; t < 768; t += G) {
            const int tt = xcd_remap(t, 768);
            gemm_tile(H, D, (const bf16_t*)(p.ws + WS_WT0IN), D, 16, lds, e, (tt >> 4) * 128, (tt & 15) * 128);
        }
    } break;
    case 3: {
        bias1_items(p);
        for (int t = blockIdx.x; t < 768; t += G) {
            const int tt = xcd_remap(t, 768);
            const int mt = tt & 3, g = (tt >> 2) & 3, nt = tt >> 4;
            EpiChanDft e{VT, g};
            gemm_tile((const bf16_t*)(p.ws + WS_TW256), 256, U + g * 256, D, 4, lds, e, mt * 128, nt * 128);
        }
    } break;
    case 4: {
        for (int t = blockIdx.x; t < 384; t += G) {
            if (t < 128) {
                const int nt = t & 1, mt = (t >> 1) & 7, bg = t >> 4;
                EpiSeqDft e{SZ, Y, NCTX + (bg >> 2) * 1024, bg & 3};
                gemm_tile((const bf16_t*)(p.ws + WS_TS1024), 2048, VT + (size_t)64 * 256 * 512 + (size_t)bg * 256 * 2048, 2048, 32, lds, e, mt * 128, nt * 128);
            } else {
                const int u = t - 128, nt = u & 1, mt = (u >> 1) & 1, bg = u >> 2;
                EpiSeqDft e{SZ, Y, (bg >> 2) * 256, bg & 3};
                gemm_tile((const bf16_t*)(p.ws + WS_TS256), 512, VT + (size_t)bg * 256 * 512, 512, 8, lds, e, mt * 128, nt * 128);
            }
        }
    } break;
    case 5: {
        EpiOut<true> e{p.x_prompt, p.x_sample, mod, X1, p.norm_w1, mod + 3 * 3072, H, (float*)(p.ws + WS_ROWSS)};
        for (int t = blockIdx.x; t < 384; t += G) {
            const int tt = xcd_remap(t, 384);
            gemm_tile(Y, D, (const bf16_t*)(p.ws + WS_WT0OUT), D, 16, lds, e, (tt >> 3) * 128, (tt & 7) * 128);
        }
    } break;
    case 7: {
        EpiInL1 e{p.qnw, p.knw, (const float*)(p.ws + WS_ROPEC), (const float*)(p.ws + WS_ROPES),
                  (bf16_t*)(p.ws + WS_Q), (bf16_t*)(p.ws + WS_KB), (bf16_t*)(p.ws + WS_VTB), SZ,
                  p.out + (size_t)NTOK * D, p.out + (size_t)NTOK * D + (size_t)NCTX * 256,
                  (const float*)(p.ws + WS_ROWSS), (const float*)(p.ws + WS_BIAS1)};
        for (int t = blockIdx.x; t < 960; t += G) {
            const int tt = xcd_remap(t, 960);
            gemm_tile(H, D, (const bf16_t*)(p.ws + WS_WT1IN), D, 16, lds, e, (tt / 20) * 128, (tt % 20) * 128);
        }
    } break;
    case 8: {
        for (int t = blockIdx.x; t < 768; t += G) attn_item(p, t, lds);
    } break;
    case 9: {
        EpiOut<false> e{X1, X1 + (size_t)NCTX * D, mod + 3 * 3072, p.out, nullptr, nullptr, nullptr, nullptr};
        for (int t = blockIdx.x; t < 384; t += G) {
            const int tt = xcd_remap(t, 384);
            gemm_tile(Y, D, (const bf16_t*)(p.ws + WS_WT1OUT), D, 16, lds, e, (tt >> 3) * 128, (tt & 7) * 128);
        }
    } break;
    }
}

__global__ void __launch_bounds__(256, 2) mega(Params p) {
    __shared__ __attribute__((aligned(16))) unsigned char lds[65536 + 16];
    cg::grid_group grid = cg::this_grid();
#if SINGLE_LAUNCH
    volatile LAS unsigned* st = (volatile LAS unsigned*)(lds + 65536);
    if (threadIdx.x < 4) st[threadIdx.x] = 0u;
    __syncthreads();
    XcdBarrier bar = xcd_barrier_post((unsigned*)(p.ws + WS_BAR), st);
    if (p.ph_hi == 777) grid.sync();
#ifndef REP_PH
#define REP_PH -1
#endif
#ifndef REP_SY
#define REP_SY 0
#endif
#define PH(n) run_phase(p, n, lds); if (REP_PH == n) run_phase(p, n, lds);
#define SY() xcd_barrier(bar); if (REP_SY) xcd_barrier(bar);
#else
    const int lo = (int)p.ph_lo, hi = (int)p.ph_hi;
#define PH(n) if (lo <= n && n < hi) run_phase(p, n, lds);
#define SY()
#endif
    PH(0) SY() PH(2) SY() PH(3) SY() PH(4) SY() PH(5) SY() PH(7) SY() PH(8) SY() PH(9)
}

extern "C" void kernel_launch(void* const* d_in, const int* in_sizes, int n_in, void* d_out, int out_size, void* d_ws, size_t ws_size, hipStream_t stream) {
    static int grid_blocks = 0;
    if (!grid_blocks) {
        int dev = 0, cus = 0, per_cu = 0;
        hipGetDevice(&dev);
        hipDeviceGetAttribute(&cus, hipDeviceAttributeMultiprocessorCount, dev);
        hipOccupancyMaxActiveBlocksPerMultiprocessor(&per_cu, mega, 256, 0);
        if (per_cu > 2) per_cu = 2;
        if (per_cu < 1) per_cu = 1;
        grid_blocks = cus * per_cu;
    }
    Params p{};
    const float* const* in = (const float* const*)d_in;
    p.x_prompt = in[0]; p.x_sample = in[1]; p.cache_k = in[2]; p.cache_v = in[3]; p.c = in[4]; p.c_ctx = in[5];
    p.norm_w0 = in[6]; p.w_mod0 = in[7]; p.b_mod0 = in[8]; p.w_in0 = in[9]; p.w_out0 = in[10];
    p.norm_w1 = in[11]; p.w_mod1 = in[12]; p.b_mod1 = in[13]; p.w_in1 = in[14]; p.qnw = in[15]; p.knw = in[16]; p.sink = in[17]; p.w_out1 = in[18];
    p.out = (float*)d_out; p.ws = (unsigned char*)d_ws;
#if SINGLE_LAUNCH
    p.ph_lo = 0; p.ph_hi = 10;
    hipMemsetAsync((unsigned char*)d_ws + WS_BAR, 0, 16384, stream);
    void* args[] = {&p};
    hipError_t e = hipLaunchCooperativeKernel((void*)mega, dim3(grid_blocks), dim3(256), args, 0, stream);
    if (e != hipSuccess) fprintf(stderr, "cooperative launch failed: %s (grid %d)\n", hipGetErrorString(e), grid_blocks);
#else
    for (int ph = 0; ph < 10; ++ph) {
        p.ph_lo = ph; p.ph_hi = ph + 1;
        hipLaunchKernelGGL(mega, dim3(grid_blocks), dim3(256), 0, stream, p);
    }
#endif
}
```

```cpp
#include <hip/hip_runtime.h>
#include <hip/hip_cooperative_groups.h>
#include <stdint.h>
#include <cstdio>
namespace cg = cooperative_groups;

#ifndef SINGLE_LAUNCH
#define SINGLE_LAUNCH 1
#endif

typedef unsigned short bf16_t;
typedef short bf16x8 __attribute__((ext_vector_type(8)));
typedef float f32x16 __attribute__((ext_vector_type(16)));
typedef float f32x4 __attribute__((ext_vector_type(4)));
typedef unsigned u32x4 __attribute__((ext_vector_type(4)));
typedef unsigned u32x2 __attribute__((ext_vector_type(2)));
#define DEVI __device__ __forceinline__

constexpr int NTOK = 6144, NCTX = 4096, D = 1024;
constexpr float EPSV = 1e-6f;
constexpr float LOG2E = 1.4426950408889634f;

constexpr size_t WS_MOD = 0;
constexpr size_t WS_WT0IN = 1 << 20;
constexpr size_t WS_WT0OUT = WS_WT0IN + (size_t)2048 * 1024 * 2;
constexpr size_t WS_WT1IN = WS_WT0OUT + (size_t)1024 * 1024 * 2;
constexpr size_t WS_WT1OUT = WS_WT1IN + (size_t)2560 * 1024 * 2;
constexpr size_t WS_TW256 = WS_WT1OUT + (size_t)1024 * 1024 * 2;
constexpr size_t WS_TS256 = WS_TW256 + (size_t)512 * 256 * 2;
constexpr size_t WS_TS1024 = WS_TS256 + (size_t)256 * 512 * 2;
constexpr size_t WS_ROPEC = WS_TS1024 + (size_t)1024 * 2048 * 2;
constexpr size_t WS_ROPES = WS_ROPEC + (size_t)1024 * 32 * 4;
constexpr size_t WS_KC = WS_ROPES + (size_t)1024 * 32 * 4;
constexpr size_t WS_VCT = WS_KC + (size_t)2 * 256 * 256 * 2;
constexpr size_t WS_H = WS_VCT + (size_t)2 * 256 * 256 * 2;
constexpr size_t WS_U = WS_H + (size_t)NTOK * D * 2;
constexpr size_t WS_SZ = WS_U + (size_t)NTOK * D * 2;
constexpr size_t WS_VT = WS_SZ + (size_t)NTOK * D * 2;
constexpr size_t WS_Y = WS_VT + (size_t)NTOK * 2048 * 2;
constexpr size_t WS_X1 = WS_Y + (size_t)NTOK * D * 2;
constexpr size_t WS_Q = WS_X1 + (size_t)NTOK * D * 4;
constexpr size_t WS_KB = WS_Q + (size_t)NTOK * D * 2;
constexpr size_t WS_VTB = WS_KB + (size_t)NTOK * 256 * 2;
constexpr size_t WS_BAR = WS_VTB + (size_t)NTOK * 256 * 2;
constexpr size_t WS_CNT = WS_BAR + 14336;
constexpr size_t WS_ROWSS = WS_BAR + 16384;
constexpr size_t WS_BIAS1 = WS_ROWSS + 6144 * 4;
constexpr size_t WS_MODP = WS_BIAS1 + 3 * 2560 * 4;
constexpr size_t WS_END = WS_MODP + (size_t)4 * 18432 * 4;

struct Params {
    const float *x_prompt, *x_sample, *cache_k, *cache_v, *c, *c_ctx;
    const float *norm_w0, *w_mod0, *b_mod0, *w_in0, *w_out0;
    const float *norm_w1, *w_mod1, *b_mod1, *w_in1, *qnw, *knw, *sink, *w_out1;
    float* out;
    unsigned char* ws;
    long long ph_lo, ph_hi;
};

DEVI unsigned cvt_pk_bf16(float lo, float hi) { unsigned r; asm("v_cvt_pk_bf16_f32 %0, %1, %2" : "=v"(r) : "v"(lo), "v"(hi)); return r; }
DEVI bf16_t f2bf(float f) { return (bf16_t)(cvt_pk_bf16(f, 0.f) & 0xffffu); }
DEVI float silu_f(float v) { return v / (1.f + __expf(-v)); }
DEVI int swap23(int x) { return (x & ~12) | ((x & 4) << 1) | ((x & 8) >> 1); }
DEVI int cond_of(int m) { return m < NCTX ? 0 : 1 + ((m - NCTX) >> 10); }

DEVI void glds16(const void* g, void* l) { __builtin_amdgcn_global_load_lds(g, l, 16, 0, 0); }

template <class Epi>
DEVI void gemm_tile(const bf16_t* __restrict__ A, int lda, const bf16_t* __restrict__ B, int ldb, int nk,
                    unsigned char* lds, const Epi& epi, int m0, int n0) {
    const int tid = threadIdx.x, lane = tid & 63, wid = tid >> 6, wr = wid >> 1, wc = wid & 1;
    const int srow = tid >> 3;
    const int slc = (tid & 7) ^ ((tid >> 4) & 7);
    const bf16_t* gA = A + (size_t)(m0 + srow) * lda + slc * 8;
    const bf16_t* gB = B + (size_t)(n0 + srow) * ldb + slc * 8;
    const int fr = lane & 31, fh = lane >> 5, sw = (lane >> 1) & 7;
    const unsigned aoff = (wr * 64 + fr) * 128, boff = 16384 + (wc * 64 + fr) * 128;
    f32x16 acc[2][2];
#pragma unroll
    for (int i = 0; i < 2; ++i)
#pragma unroll
        for (int j = 0; j < 2; ++j)
#pragma unroll
            for (int r = 0; r < 16; ++r) acc[i][j][r] = 0.f;
    {
        unsigned char* la = lds + tid * 16;
#pragma unroll
        for (int i = 0; i < 4; ++i) {
            glds16(gA + (size_t)i * 32 * lda, la + i * 4096);
            glds16(gB + (size_t)i * 32 * ldb, la + 16384 + i * 4096);
        }
    }
    for (int kt = 0; kt < nk; ++kt) {
        asm volatile("s_waitcnt vmcnt(0)" ::: "memory");
        __syncthreads();
        if (kt + 1 < nk) {
            unsigned char* la = lds + ((kt + 1) & 1) * 32768 + tid * 16;
            const int ko = (kt + 1) * 64;
#pragma unroll
            for (int i = 0; i < 4; ++i) {
                glds16(gA + (size_t)i * 32 * lda + ko, la + i * 4096);
                glds16(gB + (size_t)i * 32 * ldb + ko, la + 16384 + i * 4096);
            }
        }
        const unsigned char* base = lds + (kt & 1) * 32768;
        bf16x8 af[4][2], bfr[4][2];
#define LDFRAG(ks) { const int ch = ((2 * (ks) + fh) ^ sw) * 16; \
            af[ks][0] = *(const bf16x8*)(base + aoff + ch); bfr[ks][0] = *(const bf16x8*)(base + boff + ch); \
            bfr[ks][1] = *(const bf16x8*)(base + boff + 4096 + ch); af[ks][1] = *(const bf16x8*)(base + aoff + 4096 + ch); }
#define MFMA4(ks) { acc[0][0] = __builtin_amdgcn_mfma_f32_32x32x16_bf16(bfr[ks][0], af[ks][0], acc[0][0], 0, 0, 0); \
            acc[0][1] = __builtin_amdgcn_mfma_f32_32x32x16_bf16(bfr[ks][1], af[ks][0], acc[0][1], 0, 0, 0); \
            acc[1][0] = __builtin_amdgcn_mfma_f32_32x32x16_bf16(bfr[ks][0], af[ks][1], acc[1][0], 0, 0, 0); \
            acc[1][1] = __builtin_amdgcn_mfma_f32_32x32x16_bf16(bfr[ks][1], af[ks][1], acc[1][1], 0, 0, 0); }
        LDFRAG(0) LDFRAG(1)
        __builtin_amdgcn_sched_barrier(0);
        MFMA4(0) LDFRAG(2)
        __builtin_amdgcn_sched_barrier(0);
        MFMA4(1) LDFRAG(3)
        __builtin_amdgcn_sched_barrier(0);
        MFMA4(2)
        __builtin_amdgcn_sched_barrier(0);
        MFMA4(3)
#undef LDFRAG
#undef MFMA4
    }
    epi(acc, m0 + wr * 64, n0 + wc * 64, fr, fh);
    __syncthreads();
}

DEVI int xcd_remap(int t, int T) { return (t & 7) * (T >> 3) + (t >> 3); }

DEVI void mod_item(const Params& p, int it, unsigned char* lds) {
    const int tid = threadIdx.x;
    const int ks = it & 3, lc = it >> 2, l = lc / 48, cc = lc % 48;
    float* sc = (float*)lds;
    for (int i = tid; i < 768; i += 256) {
        const int cv = i >> 8, k = ks * 256 + (i & 255);
        const float cval = cv == 0 ? p.c_ctx[k] : p.c[(cv - 1) * 1024 + k];
        sc[i] = silu_f(cval);
    }
    __syncthreads();
    const float* W = (l ? p.w_mod1 : p.w_mod0) + (size_t)ks * 256 * 3072;
    const int cg4 = tid & 15, rg = tid >> 4, c0 = cc * 64 + cg4 * 4;
    f32x4 w[16];
#pragma unroll
    for (int i = 0; i < 16; ++i) w[i] = *(const f32x4*)(W + (size_t)(rg + 16 * i) * 3072 + c0);
    f32x4 a0 = {0.f, 0.f, 0.f, 0.f}, a1 = a0, a2 = a0;
#pragma unroll
    for (int i = 0; i < 16; ++i) { const int k = rg + 16 * i; a0 += sc[k] * w[i]; a1 += sc[256 + k] * w[i]; a2 += sc[512 + k] * w[i]; }
    float* red = (float*)(lds + 12288);
#pragma unroll
    for (int e = 0; e < 4; ++e) {
        red[(rg * 3 + 0) * 64 + cg4 * 4 + e] = a0[e];
        red[(rg * 3 + 1) * 64 + cg4 * 4 + e] = a1[e];
        red[(rg * 3 + 2) * 64 + cg4 * 4 + e] = a2[e];
    }
    __syncthreads();
    if (tid < 192) {
        const int cv = tid >> 6, j = tid & 63;
        float s = 0.f;
#pragma unroll
        for (int r = 0; r < 16; ++r) s += red[(r * 3 + cv) * 64 + j];
        float* modp = (float*)(p.ws + WS_MODP) + (size_t)ks * 18432;
        __hip_atomic_store(&modp[(l * 3 + cv) * 3072 + cc * 64 + j], s, __ATOMIC_RELAXED, __HIP_MEMORY_SCOPE_AGENT);
    }
    asm volatile("s_waitcnt vmcnt(0)" ::: "memory");
    __syncthreads();
    if (tid == 0) __hip_atomic_fetch_add((unsigned*)(p.ws + WS_CNT), 1u, __ATOMIC_RELAXED, __HIP_MEMORY_SCOPE_AGENT);
}

DEVI void transpose_item(const Params& p, int idx, unsigned char* lds) {
    const int tid = threadIdx.x;
    const float* src; bf16_t* dst; int N;
    if (idx < 512) { src = p.w_in0; dst = (bf16_t*)(p.ws + WS_WT0IN); N = 2048; }
    else if (idx < 768) { idx -= 512; src = p.w_out0; dst = (bf16_t*)(p.ws + WS_WT0OUT); N = 1024; }
    else if (idx < 1408) { idx -= 768; src = p.w_in1; dst = (bf16_t*)(p.ws + WS_WT1IN); N = 2560; }
    else { idx -= 1408; src = p.w_out1; dst = (bf16_t*)(p.ws + WS_WT1OUT); N = 1024; }
    const int ntn = N >> 6;
    const int kt = idx / ntn, nt = idx % ntn;
    float* tl = (float*)lds;
#pragma unroll
    for (int pass = 0; pass < 4; ++pass) {
        const int r = pass * 16 + (tid >> 4), c4 = (tid & 15) * 4;
        const f32x4 v = *(const f32x4*)(src + (size_t)(kt * 64 + r) * N + nt * 64 + c4);
#pragma unroll
        for (int e = 0; e < 4; ++e) tl[r * 65 + c4 + e] = v[e];
    }
    __syncthreads();
#pragma unroll
    for (int pass = 0; pass < 2; ++pass) {
        const int n = pass * 32 + (tid >> 3), kc = tid & 7;
        float v[8];
#pragma unroll
        for (int j = 0; j < 8; ++j) v[j] = tl[(kc * 8 + j) * 65 + n];
        u32x4 w;
        w.x = cvt_pk_bf16(v[0], v[1]); w.y = cvt_pk_bf16(v[2], v[3]); w.z = cvt_pk_bf16(v[4], v[5]); w.w = cvt_pk_bf16(v[6], v[7]);
        *(u32x4*)(dst + (size_t)(nt * 64 + n) * 1024 + kt * 64 + kc * 8) = w;
    }
    __syncthreads();
}

DEVI void phase0(const Params& p, unsigned char* lds) {
    constexpr int NMOD = 384, NTR = 1664;
    for (int it = blockIdx.x; it < NMOD + NTR; it += gridDim.x) {
        if (it < NMOD) mod_item(p, it, lds); else transpose_item(p, it - NMOD, lds);
    }
    const int gt = blockIdx.x * 256 + threadIdx.x, gs = gridDim.x * 256;
    bf16_t* tw256 = (bf16_t*)(p.ws + WS_TW256);
    bf16_t* ts256 = (bf16_t*)(p.ws + WS_TS256);
    bf16_t* ts1024 = (bf16_t*)(p.ws + WS_TS1024);
    for (int i = gt; i < 512 * 256; i += gs) {
        const int m = i >> 8, j = i & 255, which = m >> 8, cp = m & 255;
        const int r = (cp * j) & 255;
        float s, c; sincospif((float)r * (1.f / 128.f), &s, &c);
        tw256[i] = f2bf(which ? s : c);
    }
    for (int i = gt; i < 256 * 512; i += gs) {
        const int sp = i >> 9, k2 = i & 511, which = k2 >> 8, s0 = k2 & 255;
        const int r = (sp * s0) & 255;
        float s, c; sincospif((float)r * (1.f / 128.f), &s, &c);
        ts256[i] = f2bf((which ? -s : c) * (1.f / 256.f));
    }
    for (int i = gt; i < 1024 * 2048; i += gs) {
        const int sp = i >> 11, k2 = i & 2047, which = k2 >> 10, s0 = k2 & 1023;
        const int r = (sp * s0) & 1023;
        float s, c; sincospif((float)r * (1.f / 512.f), &s, &c);
        ts1024[i] = f2bf((which ? -s : c) * (1.f / 512.f));
    }
    float* ropec = (float*)(p.ws + WS_ROPEC);
    float* ropes = (float*)(p.ws + WS_ROPES);
    for (int i = gt; i < 1024 * 32; i += gs) {
        const int pos = i >> 5, f = i & 31;
        const int row = pos >> 6, col = pos & 63;
        const float inv = powf(10000.f, -(float)(f & 15) * (1.f / 16.f));
        const float ang = (float)(f < 16 ? row : col) * inv;
        float s, c; sincosf(ang, &s, &c);
        ropec[i] = c; ropes[i] = s;
    }
    for (int i = gt; i < NTOK; i += gs) ((float*)(p.ws + WS_ROWSS))[i] = 0.f;
    bf16_t* kc = (bf16_t*)(p.ws + WS_KC);
    bf16_t* vct = (bf16_t*)(p.ws + WS_VCT);
    for (int i = gt; i < 2 * 256 * 256; i += gs) {
        kc[i] = f2bf(p.cache_k[i]);
        const int b = i >> 16, kvh = (i >> 14) & 3, d = (i >> 8) & 63, pp = i & 255;
        const int key = swap23(pp);
        vct[i] = f2bf(p.cache_v[((b * 256 + key) * 4 + kvh) * 64 + d]);
    }
}

DEVI void phase_norm(const Params& p, int layer, const float* lmod  ) {
    const int lane = threadIdx.x & 63, wid = threadIdx.x >> 6;
    const float* nw = layer ? p.norm_w1 : p.norm_w0;
    bf16_t* H = (bf16_t*)(p.ws + WS_H);
    for (int row = blockIdx.x * 4 + wid; row < NTOK; row += gridDim.x * 4) {
        const float* xr;
        if (layer == 0) xr = row < NCTX ? p.x_prompt + (size_t)row * D : p.x_sample + (size_t)(row - NCTX) * D;
        else xr = (const float*)(p.ws + WS_X1) + (size_t)row * D;
        const float* mv = lmod + cond_of(row) * 2048;
        f32x4 v[4];
        float ss = 0.f;
#pragma unroll
        for (int i = 0; i < 4; ++i) {
            v[i] = *(const f32x4*)(xr + i * 256 + lane * 4);
            ss += v[i][0] * v[i][0] + v[i][1] * v[i][1] + v[i][2] * v[i][2] + v[i][3] * v[i][3];
        }
#pragma unroll
        for (int o = 32; o >= 1; o >>= 1) ss += __shfl_xor(ss, o);
        const float rstd = rsqrtf(ss * (1.f / 1024.f) + EPSV);
#pragma unroll
        for (int i = 0; i < 4; ++i) {
            const int k = i * 256 + lane * 4;
            const f32x4 w = *(const f32x4*)(nw + k);
            const f32x4 sh = *(const f32x4*)(mv + k);
            const f32x4 scl = *(const f32x4*)(mv + 1024 + k);
            float h[4];
#pragma unroll
            for (int e = 0; e < 4; ++e) h[e] = (v[i][e] * rstd * w[e]) * (1.f + scl[e]) + sh[e];
            u32x2 o; o.x = cvt_pk_bf16(h[0], h[1]); o.y = cvt_pk_bf16(h[2], h[3]);
            *(u32x2*)(H + (size_t)row * D + k) = o;
        }
    }
}

DEVI void bias1_items(const Params& p) {
    const int lane = threadIdx.x & 63, gw = blockIdx.x * 4 + (threadIdx.x >> 6), nw = gridDim.x * 4;
    const float* mod1 = (const float*)(p.ws + WS_MOD) + 3 * 3072;
    const bf16_t* WT = (const bf16_t*)(p.ws + WS_WT1IN);
    float* bias1 = (float*)(p.ws + WS_BIAS1);
    for (int n = gw; n < 2560; n += nw) {
        float w[16];
        const u32x4 r0 = *(const u32x4*)(WT + (size_t)n * 1024 + lane * 16), r1 = *(const u32x4*)(WT + (size_t)n * 1024 + lane * 16 + 8);
        const unsigned rr[8] = {r0.x, r0.y, r0.z, r0.w, r1.x, r1.y, r1.z, r1.w};
#pragma unroll
        for (int i = 0; i < 8; ++i) { w[2 * i] = __uint_as_float(rr[i] << 16); w[2 * i + 1] = __uint_as_float(rr[i] & 0xffff0000u); }
        float s[3];
#pragma unroll
        for (int cv = 0; cv < 3; ++cv) {
            float a = 0.f;
#pragma unroll
            for (int q = 0; q < 4; ++q) {
                const f32x4 sh = *(const f32x4*)(mod1 + cv * 3072 + lane * 16 + q * 4);
#pragma unroll
                for (int e = 0; e < 4; ++e) a += sh[e] * w[q * 4 + e];
            }
#pragma unroll
            for (int o = 32; o >= 1; o >>= 1) a += __shfl_xor(a, o);
            s[cv] = a;
        }
        if (lane == 0) { bias1[n] = s[0]; bias1[2560 + n] = s[1]; bias1[5120 + n] = s[2]; }
    }
}

struct EpiInL0 {
    bf16_t *U, *SZ;
    DEVI void operator()(const f32x16 (&acc)[2][2], int mbase, int nbase, int fr, int fh) const {
        const bool isz = nbase >= 1024;
        bf16_t* dst = isz ? SZ : U;
        const int nb0 = isz ? nbase - 1024 : nbase;
#pragma unroll
        for (int mb = 0; mb < 2; ++mb)
#pragma unroll
            for (int nb = 0; nb < 2; ++nb)
#pragma unroll
                for (int g = 0; g < 4; ++g) {
                    const int m = mbase + mb * 32 + fr, n = nb0 + nb * 32 + 8 * g + 4 * fh;
                    float v[4];
#pragma unroll
                    for (int e = 0; e < 4; ++e) { v[e] = acc[mb][nb][4 * g + e]; if (isz) v[e] = silu_f(v[e]); }
                    u32x2 o; o.x = cvt_pk_bf16(v[0], v[1]); o.y = cvt_pk_bf16(v[2], v[3]);
                    *(u32x2*)(dst + (size_t)m * D + n) = o;
                }
    }
};

struct EpiChanDft {
    bf16_t* VT; int g;
    DEVI void operator()(const f32x16 (&acc)[2][2], int mbase, int nbase, int fr, int fh) const {
        int S, bgi, s0; bf16_t* base;
        if (nbase < NCTX) { S = 256; bgi = (nbase >> 8) * 4 + g; s0 = nbase & 255; base = VT; }
        else { const int t = nbase - NCTX; S = 1024; bgi = (t >> 10) * 4 + g; s0 = t & 1023; base = VT + (size_t)64 * 256 * 512; }
#pragma unroll
        for (int mb = 0; mb < 2; ++mb)
#pragma unroll
            for (int nb = 0; nb < 2; ++nb)
#pragma unroll
                for (int gq = 0; gq < 4; ++gq) {
                    const int m = mbase + mb * 32 + fr, which = m >> 8, cp = m & 255;
                    const int s = s0 + nb * 32 + 8 * gq + 4 * fh;
                    u32x2 o; o.x = cvt_pk_bf16(acc[mb][nb][4 * gq], acc[mb][nb][4 * gq + 1]); o.y = cvt_pk_bf16(acc[mb][nb][4 * gq + 2], acc[mb][nb][4 * gq + 3]);
                    *(u32x2*)(base + ((size_t)bgi * 256 + cp) * (2 * S) + which * S + s) = o;
                }
    }
};

struct EpiSeqDft {
    const bf16_t* SZ; bf16_t* Y; int tok0, g;
    DEVI void operator()(const f32x16 (&acc)[2][2], int mbase, int nbase, int fr, int fh) const {
#pragma unroll
        for (int mb = 0; mb < 2; ++mb)
#pragma unroll
            for (int nb = 0; nb < 2; ++nb)
#pragma unroll
                for (int gq = 0; gq < 4; ++gq) {
                    const int tok = tok0 + mbase + mb * 32 + fr;
                    const int col = g * 256 + nbase + nb * 32 + 8 * gq + 4 * fh;
                    const u32x2 z = *(const u32x2*)(SZ + (size_t)tok * D + col);
                    const float z0 = __uint_as_float(z.x << 16), z1 = __uint_as_float(z.x & 0xffff0000u);
                    const float z2 = __uint_as_float(z.y << 16), z3 = __uint_as_float(z.y & 0xffff0000u);
                    u32x2 o; o.x = cvt_pk_bf16(acc[mb][nb][4 * gq] * z0, acc[mb][nb][4 * gq + 1] * z1);
                    o.y = cvt_pk_bf16(acc[mb][nb][4 * gq + 2] * z2, acc[mb][nb][4 * gq + 3] * z3);
                    *(u32x2*)(Y + (size_t)tok * D + col) = o;
                }
    }
};

template <bool NEXT> struct EpiOut {
    const float* xa; const float* xb;
    const float* mod;
    float* out;
    const float* nw1; const float* mod1; bf16_t* Hn; float* rowss;
    DEVI void operator()(const f32x16 (&acc)[2][2], int mbase, int nbase, int fr, int fh) const {
        const int cv = cond_of(mbase);
        const float* gate = mod + cv * 3072 + 2048;
#pragma unroll
        for (int mb = 0; mb < 2; ++mb) {
            const int m = mbase + mb * 32 + fr;
            const float* xr = m < NCTX ? xa + (size_t)m * D : xb + (size_t)(m - NCTX) * D;
            float ss = 0.f;
#pragma unroll
            for (int nb = 0; nb < 2; ++nb)
#pragma unroll
                for (int g = 0; g < 4; ++g) {
                    const int n = nbase + nb * 32 + 8 * g + 4 * fh;
                    const f32x4 xv = *(const f32x4*)(xr + n);
                    const f32x4 gv = *(const f32x4*)(gate + n);
                    f32x4 o;
#pragma unroll
                    for (int e = 0; e < 4; ++e) o[e] = xv[e] + gv[e] * acc[mb][nb][4 * g + e];
                    *(f32x4*)(out + (size_t)m * D + n) = o;
                    if (NEXT) {
                        const f32x4 w = *(const f32x4*)(nw1 + n);
                        const f32x4 sc = *(const f32x4*)(mod1 + cv * 3072 + 1024 + n);
                        float h[4];
#pragma unroll
                        for (int e = 0; e < 4; ++e) { ss += o[e] * o[e]; h[e] = o[e] * w[e] * (1.f + sc[e]); }
                        u32x2 hb; hb.x = cvt_pk_bf16(h[0], h[1]); hb.y = cvt_pk_bf16(h[2], h[3]);
                        *(u32x2*)(Hn + (size_t)m * D + n) = hb;
                    }
                }
            if (NEXT) {
                ss += __shfl_xor(ss, 32);
                if (fh == 0) atomicAdd(rowss + m, ss);
            }
        }
    }
};

struct EpiInL1 {
    const float *qnw, *knw, *ropec, *ropes;
    bf16_t *Q, *KB, *VTB, *SZ;
    float *outk, *outv;
    const float* rowss; const float* bias1;
    DEVI void operator()(const f32x16 (&acc_in)[2][2], int mbase, int nbase, int fr, int fh) const {
        const bool lat = mbase >= NCTX;
        f32x16 acc[2][2];
        {
            const float* bp = bias1 + cond_of(mbase) * 2560 + nbase;
#pragma unroll
            for (int mb = 0; mb < 2; ++mb) {
                const float rstd = rsqrtf(rowss[mbase + mb * 32 + fr] * (1.f / 1024.f) + EPSV);
#pragma unroll
                for (int nb = 0; nb < 2; ++nb)
#pragma unroll
                    for (int g = 0; g < 4; ++g) {
                        const f32x4 bv = *(const f32x4*)(bp + nb * 32 + 8 * g + 4 * fh);
#pragma unroll
                        for (int e = 0; e < 4; ++e) acc[mb][nb][4 * g + e] = acc_in[mb][nb][4 * g + e] * rstd + bv[e];
                    }
            }
        }
        if (nbase < 1280) {
            const bool isq = nbase < 1024;
            const float* nwp = isq ? qnw : knw;
#pragma unroll
            for (int mb = 0; mb < 2; ++mb) {
                const int m = mbase + mb * 32 + fr;
                float ss = 0.f;
#pragma unroll
                for (int nb = 0; nb < 2; ++nb)
#pragma unroll
                    for (int r = 0; r < 16; ++r) ss += acc[mb][nb][r] * acc[mb][nb][r];
                ss += __shfl_xor(ss, 32);
                const float rn = rsqrtf(ss * (1.f / 64.f) + EPSV);
                const int pos = lat ? ((m - NCTX) & 1023) : 0;
#pragma unroll
                for (int g = 0; g < 4; ++g) {
                    const int d0 = 8 * g + 4 * fh;
                    const f32x4 w1 = *(const f32x4*)(nwp + d0), w2 = *(const f32x4*)(nwp + 32 + d0);
                    float x1[4], x2[4];
#pragma unroll
                    for (int e = 0; e < 4; ++e) { x1[e] = acc[mb][0][4 * g + e] * rn * w1[e]; x2[e] = acc[mb][1][4 * g + e] * rn * w2[e]; }
                    if (lat) {
                        const f32x4 cv = *(const f32x4*)(ropec + pos * 32 + d0), sv = *(const f32x4*)(ropes + pos * 32 + d0);
#pragma unroll
                        for (int e = 0; e < 4; ++e) { const float a = x1[e], b = x2[e]; x1[e] = a * cv[e] - b * sv[e]; x2[e] = a * sv[e] + b * cv[e]; }
                    }
                    if (isq) {
                        const float qs = 0.125f * LOG2E;
                        u32x2 o1, o2;
                        o1.x = cvt_pk_bf16(x1[0] * qs, x1[1] * qs); o1.y = cvt_pk_bf16(x1[2] * qs, x1[3] * qs);
                        o2.x = cvt_pk_bf16(x2[0] * qs, x2[1] * qs); o2.y = cvt_pk_bf16(x2[2] * qs, x2[3] * qs);
                        *(u32x2*)(Q + (size_t)m * D + nbase + d0) = o1;
                        *(u32x2*)(Q + (size_t)m * D + nbase + 32 + d0) = o2;
                    } else {
                        const int kc = nbase - 1024;
                        u32x2 o1, o2;
                        o1.x = cvt_pk_bf16(x1[0], x1[1]); o1.y = cvt_pk_bf16(x1[2], x1[3]);
                        o2.x = cvt_pk_bf16(x2[0], x2[1]); o2.y = cvt_pk_bf16(x2[2], x2[3]);
                        *(u32x2*)(KB + (size_t)m * 256 + kc + d0) = o1;
                        *(u32x2*)(KB + (size_t)m * 256 + kc + 32 + d0) = o2;
                        if (!lat) {
                            f32x4 f1 = {x1[0], x1[1], x1[2], x1[3]}, f2 = {x2[0], x2[1], x2[2], x2[3]};
                            *(f32x4*)(outk + (size_t)m * 256 + kc + d0) = f1;
                            *(f32x4*)(outk + (size_t)m * 256 + kc + 32 + d0) = f2;
                        }
                    }
                }
            }
        } else if (nbase < 1536) {
            const int vc = nbase - 1280, kvh = vc >> 6;
#pragma unroll
            for (int mb = 0; mb < 2; ++mb) {
                const int m = mbase + mb * 32 + fr;
                bf16_t* vt; int S, s;
                if (!lat) { S = 256; s = m & 255; vt = VTB + ((size_t)((m >> 8) * 4 + kvh) * 64) * 256; }
                else { const int t = m - NCTX; S = 1024; s = t & 1023; vt = VTB + (size_t)16 * 4 * 64 * 256 + ((size_t)((t >> 10) * 4 + kvh) * 64) * 1024; }
                const int sp = swap23(s);
#pragma unroll
                for (int nb = 0; nb < 2; ++nb)
#pragma unroll
                    for (int g = 0; g < 4; ++g) {
                        const int d0 = nb * 32 + 8 * g + 4 * fh;
#pragma unroll
                        for (int e = 0; e < 4; ++e) vt[(size_t)(d0 + e) * S + sp] = f2bf(acc[mb][nb][4 * g + e]);
                        if (!lat) {
                            f32x4 f = {acc[mb][nb][4 * g], acc[mb][nb][4 * g + 1], acc[mb][nb][4 * g + 2], acc[mb][nb][4 * g + 3]};
                            *(f32x4*)(outv + (size_t)m * 256 + vc + d0) = f;
                        }
                    }
            }
        } else {
            const int zc = nbase - 1536;
#pragma unroll
            for (int mb = 0; mb < 2; ++mb)
#pragma unroll
                for (int nb = 0; nb < 2; ++nb)
#pragma unroll
                    for (int g = 0; g < 4; ++g) {
                        const int m = mbase + mb * 32 + fr, n = zc + nb * 32 + 8 * g + 4 * fh;
                        u32x2 o; o.x = cvt_pk_bf16(silu_f(acc[mb][nb][4 * g]), silu_f(acc[mb][nb][4 * g + 1]));
                        o.y = cvt_pk_bf16(silu_f(acc[mb][nb][4 * g + 2]), silu_f(acc[mb][nb][4 * g + 3]));
                        *(u32x2*)(SZ + (size_t)m * D + n) = o;
                    }
        }
    }
};

DEVI void attn_item(const Params& p, int item, unsigned char* lds) {
    const int lane = threadIdx.x & 63, w = threadIdx.x >> 6, fr = lane & 31, fh = lane >> 5;
    const bf16_t* Q = (const bf16_t*)(p.ws + WS_Q);
    const bf16_t* KB = (const bf16_t*)(p.ws + WS_KB);
    const bf16_t* VTB = (const bf16_t*)(p.ws + WS_VTB);
    const bf16_t* KC = (const bf16_t*)(p.ws + WS_KC);
    const bf16_t* VCT = (const bf16_t*)(p.ws + WS_VCT);
    const bf16_t* SZ = (const bf16_t*)(p.ws + WS_SZ);
    bf16_t* Y = (bf16_t*)(p.ws + WS_Y);
    bool lat; int b, kvh, qb, tb;
    if (item < 256) { lat = true; b = item >> 7; kvh = (item >> 5) & 3; qb = item & 31; tb = NCTX + b * 1024; }
    else { const int it = item - 256; lat = false; b = it >> 5; kvh = (it >> 3) & 3; qb = it & 7; tb = b * 256; }
    const int head = kvh * 4 + w;
    const int qtok = tb + qb * 32 + fr;
    bf16x8 qf[4];
#pragma unroll
    for (int ks = 0; ks < 4; ++ks) qf[ks] = *(const bf16x8*)(Q + (size_t)qtok * D + head * 64 + ks * 16 + fh * 8);
    float m_run = p.sink[head] * LOG2E, l_run = 1.f;
    f32x16 O[2];
#pragma unroll
    for (int i = 0; i < 2; ++i)
#pragma unroll
        for (int r = 0; r < 16; ++r) O[i][r] = 0.f;

    int nloc, k_lo = 0; const bf16_t *kloc, *vloc; int ldloc;
    if (lat) {
        k_lo = qb - 4 < 0 ? 0 : qb - 4; const int k_hi = qb + 4 > 31 ? 31 : qb + 4; nloc = k_hi - k_lo + 1;
        kloc = KB + (size_t)(tb + k_lo * 32) * 256 + kvh * 64;
        vloc = VTB + (size_t)16 * 4 * 64 * 256 + ((size_t)(b * 4 + kvh) * 64) * 1024 + k_lo * 32; ldloc = 1024;
    } else {
        nloc = 8; kloc = KB + (size_t)tb * 256 + kvh * 64; vloc = VTB + ((size_t)(b * 4 + kvh) * 64) * 256; ldloc = 256;
    }
    const int nblk = lat ? nloc + 8 : 8;
    const bf16_t* kcb = KC + (size_t)(b * 256) * 256 + kvh * 64;
    const bf16_t* vcb = VCT + ((size_t)(b * 4 + kvh) * 64) * 256;
    const int tid = threadIdx.x;
    const int kkey = tid >> 3, kch = tid & 7, vd = tid >> 2, vch = tid & 3;
    const unsigned kst = kkey * 128 + ((kch ^ ((kkey >> 1) & 7)) << 4), vst = 4096 + vd * 64 + ((vch ^ ((vd >> 2) & 3)) << 4);
    const unsigned ksw = (fr >> 1) & 7, vsw = (fr >> 2) & 3;
    u32x4 kreg, vreg;
    auto loadkv = [&](int j) {
        const bf16_t *kp, *vp; int ldv;
        if (j < nloc) { kp = kloc + (size_t)j * 32 * 256; vp = vloc + j * 32; ldv = ldloc; }
        else { const int c = j - nloc; kp = kcb + (size_t)c * 32 * 256; vp = vcb + c * 32; ldv = 256; }
        kreg = *(const u32x4*)(kp + (size_t)kkey * 256 + kch * 8);
        vreg = *(const u32x4*)(vp + (size_t)vd * ldv + vch * 8);
    };
    loadkv(0);
    *(u32x4*)(lds + kst) = kreg; *(u32x4*)(lds + vst) = vreg;
    if (nblk > 1) loadkv(1);
    __syncthreads();
    for (int j = 0; j < nblk; ++j) {
        const unsigned char* lb = lds + (j & 1) * 8192;
        bf16x8 kf[4], vf[4];
#pragma unroll
        for (int ks = 0; ks < 4; ++ks) kf[ks] = *(const bf16x8*)(lb + fr * 128 + (((2 * ks + fh) ^ ksw) << 4));
#pragma unroll
        for (int s2 = 0; s2 < 2; ++s2)
#pragma unroll
            for (int db = 0; db < 2; ++db) vf[s2 * 2 + db] = *(const bf16x8*)(lb + 4096 + (db * 32 + fr) * 64 + (((2 * s2 + fh) ^ vsw) << 4));
        f32x16 s;
#pragma unroll
        for (int r = 0; r < 16; ++r) s[r] = 0.f;
#pragma unroll
        for (int ks = 0; ks < 4; ++ks) s = __builtin_amdgcn_mfma_f32_32x32x16_bf16(kf[ks], qf[ks], s, 0, 0, 0);
        if (lat && j < nloc) {
            const int kb = k_lo + j;
            const int mode = (kb == qb - 4) ? 1 : (kb == qb + 4) ? 2 : 0;
            if (mode) {
                const int dpos = (kb - qb) * 32;
#pragma unroll
                for (int r = 0; r < 16; ++r) {
                    const int rel = dpos + (r & 3) + 8 * (r >> 2) + 4 * fh - fr;
                    const bool ok = mode == 1 ? (rel >= -128) : (rel <= 128);
                    if (!ok) s[r] = -1e30f;
                }
            }
        }
        float mx = s[0];
#pragma unroll
        for (int r = 1; r < 16; ++r) mx = fmaxf(mx, s[r]);
        mx = fmaxf(mx, __shfl_xor(mx, 32));
        const float m_new = fmaxf(m_run, mx);
        const float alpha = __builtin_amdgcn_exp2f(m_run - m_new);
        float rs = 0.f;
#pragma unroll
        for (int r = 0; r < 16; ++r) { s[r] = __builtin_amdgcn_exp2f(s[r] - m_new); rs += s[r]; }
        rs += __shfl_xor(rs, 32);
        l_run = l_run * alpha + rs; m_run = m_new;
#pragma unroll
        for (int i = 0; i < 2; ++i)
#pragma unroll
            for (int r = 0; r < 16; ++r) O[i][r] *= alpha;
#pragma unroll
        for (int s2 = 0; s2 < 2; ++s2) {
            union { u32x4 u; bf16x8 v; } pf;
            pf.u.x = cvt_pk_bf16(s[8 * s2 + 0], s[8 * s2 + 1]); pf.u.y = cvt_pk_bf16(s[8 * s2 + 2], s[8 * s2 + 3]);
            pf.u.z = cvt_pk_bf16(s[8 * s2 + 4], s[8 * s2 + 5]); pf.u.w = cvt_pk_bf16(s[8 * s2 + 6], s[8 * s2 + 7]);
#pragma unroll
            for (int db = 0; db < 2; ++db) O[db] = __builtin_amdgcn_mfma_f32_32x32x16_bf16(vf[s2 * 2 + db], pf.v, O[db], 0, 0, 0);
        }
        if (j + 1 < nblk) {
            unsigned char* nb = lds + ((j + 1) & 1) * 8192;
            *(u32x4*)(nb + kst) = kreg; *(u32x4*)(nb + vst) = vreg;
            if (j + 2 < nblk) loadkv(j + 2);
        }
        __syncthreads();
    }
    const float il = 1.f / l_run;
#pragma unroll
    for (int db = 0; db < 2; ++db)
#pragma unroll
        for (int g = 0; g < 4; ++g) {
            const int col = head * 64 + db * 32 + 8 * g + 4 * fh;
            const u32x2 z = *(const u32x2*)(SZ + (size_t)qtok * D + col);
            const float z0 = __uint_as_float(z.x << 16), z1 = __uint_as_float(z.x & 0xffff0000u);
            const float z2 = __uint_as_float(z.y << 16), z3 = __uint_as_float(z.y & 0xffff0000u);
            u32x2 o; o.x = cvt_pk_bf16(O[db][4 * g] * il * z0, O[db][4 * g + 1] * il * z1);
            o.y = cvt_pk_bf16(O[db][4 * g + 2] * il * z2, O[db][4 * g + 3] * il * z3);
            *(u32x2*)(Y + (size_t)qtok * D + col) = o;
        }
}


#define XB_TMO      128
#define XB_XCNT(j)  (256  + 64 * (j))
#define XB_XSUB(j)  (1280 + 64 * (j))
#define XB_XGEN(j)  (2304 + 64 * (j))
#define XB_TOP      3328
#define XB_TOPGEN   3392
#define XCD_BAR_WORDS 3456
#define XB_SPIN_CAP (1u << 18)
#define LAS __attribute__((address_space(3)))
DEVI unsigned xb_ld(unsigned* p)              { return __hip_atomic_load(p, __ATOMIC_RELAXED, __HIP_MEMORY_SCOPE_AGENT); }
DEVI unsigned xb_add(unsigned* p, unsigned v) { return __hip_atomic_fetch_add(p, v, __ATOMIC_RELAXED, __HIP_MEMORY_SCOPE_AGENT); }
DEVI unsigned xb_xcc_id() { return (unsigned)__builtin_amdgcn_s_getreg((3 << 11) | 20) & 0xFu; }
#define XB_SPIN(cond, bar) do { unsigned _sp = 0; while (cond) { __builtin_amdgcn_s_sleep(1); \
    if ((++_sp & 255u) == 0u) { if (xb_ld(&(bar)[XB_TMO])) break; if (_sp > XB_SPIN_CAP) { atomicAdd(&(bar)[XB_TMO], 1u); break; } } } } while (0)
struct XcdBarrier { unsigned* bar; unsigned x; volatile LAS unsigned* st; };
DEVI XcdBarrier xcd_barrier_post(unsigned* bar, volatile LAS unsigned* st) {
    XcdBarrier b; b.bar = bar; b.x = xb_xcc_id(); b.st = st;
    if (threadIdx.x == 0) (void)xb_add(&bar[XB_XCNT(b.x)], 1u);
    return b;
}
DEVI void xcd_barrier_complete(unsigned* bar, unsigned x, unsigned& nloc, unsigned& nx) {
    const unsigned G = gridDim.x * gridDim.y * gridDim.z;
    unsigned sum, cnt, mine, sp = 0u;
    for (;;) {
        sum = 0u; cnt = 0u; mine = 0u;
#pragma unroll
        for (unsigned j = 0; j < 16; ++j) { const unsigned c = xb_ld(&bar[XB_XCNT(j)]); sum += c; cnt += (c > 0u) ? 1u : 0u; mine = (j == x) ? c : mine; }
        if (sum == G) break;
        __builtin_amdgcn_s_sleep(1);
        if ((++sp & 255u) == 0u) { if (xb_ld(&bar[XB_TMO])) break; if (sp > XB_SPIN_CAP) { atomicAdd(&bar[XB_TMO], 1u); break; } }
    }
    nloc = mine > 0u ? mine : 1u; nx = cnt > 0u ? cnt : 1u;
}
DEVI void xcd_barrier(const XcdBarrier& b) {
    asm volatile("s_waitcnt vmcnt(0)" ::: "memory");
    __syncthreads();
    if (threadIdx.x == 0) {
        unsigned* bar = b.bar;
        __builtin_amdgcn_s_waitcnt(0);
        unsigned nloc = b.st[0], nx = b.st[1];
        if (nloc == 0u) { xcd_barrier_complete(bar, b.x, nloc, nx); b.st[0] = nloc; b.st[1] = nx; }
        const unsigned old = xb_add(&bar[XB_XSUB(b.x)], 1u);
        const unsigned gen = old / nloc;
        if (old + 1u == (gen + 1u) * nloc) {
            __builtin_amdgcn_fence(__ATOMIC_RELEASE, "agent");
            asm volatile("s_waitcnt vmcnt(0)" ::: "memory");
            const unsigned og = xb_add(&bar[XB_TOP], 1u);
            const unsigned tg = og / nx;
            if (og + 1u == (tg + 1u) * nx) xb_add(&bar[XB_TOPGEN], 1u);
            else XB_SPIN(xb_ld(&bar[XB_TOPGEN]) == tg, bar);
            __builtin_amdgcn_fence(__ATOMIC_ACQUIRE, "agent");
            xb_add(&bar[XB_XGEN(b.x)], 1u);
            asm volatile("s_waitcnt vmcnt(0)" ::: "memory");
        } else {
            XB_SPIN(xb_ld(&bar[XB_XGEN(b.x)]) == gen, bar);
            __builtin_amdgcn_fence(__ATOMIC_ACQUIRE, "agent");
            asm volatile("s_waitcnt vmcnt(0)" ::: "memory");
        }
    }
    __syncthreads();
}

DEVI void run_phase(const Params& p, int ph, unsigned char* lds) {
    const int G = gridDim.x;
    bf16_t* H = (bf16_t*)(p.ws + WS_H);
    bf16_t* U = (bf16_t*)(p.ws + WS_U);
    bf16_t* SZ = (bf16_t*)(p.ws + WS_SZ);
    bf16_t* VT = (bf16_t*)(p.ws + WS_VT);
    bf16_t* Y = (bf16_t*)(p.ws + WS_Y);
    float* X1 = (float*)(p.ws + WS_X1);
    const float* mod = (const float*)(p.ws + WS_MOD);
    switch (ph) {
    case 0: {
        phase0(p, lds);
        if (threadIdx.x == 0) {
            unsigned* cnt = (unsigned*)(p.ws + WS_CNT); unsigned sp = 0;
            while (__hip_atomic_load(cnt, __ATOMIC_RELAXED, __HIP_MEMORY_SCOPE_AGENT) < 384u) { __builtin_amdgcn_s_sleep(4); if (++sp > (1u << 22)) break; }
        }
        __syncthreads();
        const float* modp = (const float*)(p.ws + WS_MODP);
        if (blockIdx.x < 72) {
            const int i = blockIdx.x * 256 + threadIdx.x, l = i / 9216, j = i % 3072;
            float s = (l ? p.b_mod1 : p.b_mod0)[j];
#pragma unroll
            for (int ks = 0; ks < 4; ++ks) s += __hip_atomic_load(modp + ks * 18432 + i, __ATOMIC_RELAXED, __HIP_MEMORY_SCOPE_AGENT);
            ((float*)(p.ws + WS_MOD))[i] = s;
        }
        float* lmod = (float*)lds;
        {
            float tmp[24];
#pragma unroll
            for (int q = 0; q < 24; ++q) {
                const int i = threadIdx.x + 256 * q, src_i = (i >> 11) * 3072 + (i & 2047);
                float s = p.b_mod0[i & 2047];
#pragma unroll
                for (int ks = 0; ks < 4; ++ks) s += __hip_atomic_load(modp + ks * 18432 + src_i, __ATOMIC_RELAXED, __HIP_MEMORY_SCOPE_AGENT);
                tmp[q] = s;
            }
#pragma unroll
            for (int q = 0; q < 24; ++q) lmod[threadIdx.x + 256 * q] = tmp[q];
        }
        __syncthreads();
        phase_norm(p, 0, lmod);
    } break;
    case 2: {
        EpiInL0 e{U, SZ};
        for (int t = blockIdx.x; t < 768; t += G) {
            const int tt = xcd_remap(t, 768);
            gemm_tile(H, D, (const bf16_t*)(p.ws + WS_WT0IN), D, 16, lds, e, (tt >> 4) * 128, (tt & 15) * 128);
        }
    } break;
    case 3: {
        bias1_items(p);
        for (int t = blockIdx.x; t < 768; t += G) {
            const int tt = xcd_remap(t, 768);
            const int mt = tt & 3, g = (tt >> 2) & 3, nt = tt >> 4;
            EpiChanDft e{VT, g};
            gemm_tile((const bf16_t*)(p.ws + WS_TW256), 256, U + g * 256, D, 4, lds, e, mt * 128, nt * 128);
        }
    } break;
    case 4: {
        for (int t = blockIdx.x; t < 384; t += G) {
            if (t < 128) {
                const int nt = t & 1, mt = (t >> 1) & 7, bg = t >> 4;
                EpiSeqDft e{SZ, Y, NCTX + (bg >> 2) * 1024, bg & 3};
                gemm_tile((const bf16_t*)(p.ws + WS_TS1024), 2048, VT + (size_t)64 * 256 * 512 + (size_t)bg * 256 * 2048, 2048, 32, lds, e, mt * 128, nt * 128);
            } else {
                const int u = t - 128, nt = u & 1, mt = (u >> 1) & 1, bg = u >> 2;
                EpiSeqDft e{SZ, Y, (bg >> 2) * 256, bg & 3};
                gemm_tile((const bf16_t*)(p.ws + WS_TS256), 512, VT + (size_t)bg * 256 * 512, 512, 8, lds, e, mt * 128, nt * 128);
            }
        }
    } break;
    case 5: {
        EpiOut<true> e{p.x_prompt, p.x_sample, mod, X1, p.norm_w1, mod + 3 * 3072, H, (float*)(p.ws + WS_ROWSS)};
        for (int t = blockIdx.x; t < 384; t += G) {
            const int tt = xcd_remap(t, 384);
            gemm_tile(Y, D, (const bf16_t*)(p.ws + WS_WT0OUT), D, 16, lds, e, (tt >> 3) * 128, (tt & 7) * 128);
        }
    } break;
    case 7: {
        EpiInL1 e{p.qnw, p.knw, (const float*)(p.ws + WS_ROPEC), (const float*)(p.ws + WS_ROPES),
                  (bf16_t*)(p.ws + WS_Q), (bf16_t*)(p.ws + WS_KB), (bf16_t*)(p.ws + WS_VTB), SZ,
                  p.out + (size_t)NTOK * D, p.out + (size_t)NTOK * D + (size_t)NCTX * 256,
                  (const float*)(p.ws + WS_ROWSS), (const float*)(p.ws + WS_BIAS1)};
        for (int t = blockIdx.x; t < 960; t += G) {
            const int tt = xcd_remap(t, 960);
            gemm_tile(H, D, (const bf16_t*)(p.ws + WS_WT1IN), D, 16, lds, e, (tt / 20) * 128, (tt % 20) * 128);
        }
    } break;
    case 8: {
        for (int t = blockIdx.x; t < 768; t += G) attn_item(p, t, lds);
    } break;
    case 9: {
        EpiOut<false> e{X1, X1 + (size_t)NCTX * D, mod + 3 * 3072, p.out, nullptr, nullptr, nullptr, nullptr};
        for (int t = blockIdx.x; t < 384; t += G) {
            const int tt = xcd_remap(t, 384);
            gemm_tile(Y, D, (const bf16_t*)(p.ws + WS_WT1OUT), D, 16, lds, e, (tt >> 3) * 128, (tt & 7) * 128);
        }
    } break;
    }
}

__global__ void __launch_bounds__(256, 2) mega(Params p) {
    __shared__ __attribute__((aligned(16))) unsigned char lds[65536 + 16];
    cg::grid_group grid = cg::this_grid();
#if SINGLE_LAUNCH
    volatile LAS unsigned* st = (volatile LAS unsigned*)(lds + 65536);
    if (threadIdx.x < 4) st[threadIdx.x] = 0u;
    __syncthreads();
    XcdBarrier bar = xcd_barrier_post((unsigned*)(p.ws + WS_BAR), st);
    if (p.ph_hi == 777) grid.sync();
#ifndef REP_PH
#define REP_PH -1
#endif
#ifndef REP_SY
#define REP_SY 0
#endif
#define PH(n) run_phase(p, n, lds); if (REP_PH == n) run_phase(p, n, lds);
#define SY() xcd_barrier(bar); if (REP_SY) xcd_barrier(bar);
#else
    const int lo = (int)p.ph_lo, hi = (int)p.ph_hi;
#define PH(n) if (lo <= n && n < hi) run_phase(p, n, lds);
#define SY()
#endif
    PH(0) SY() PH(2) SY() PH(3) SY() PH(4) SY() PH(5) SY() PH(7) SY() PH(8) SY() PH(9)
}

extern "C" void kernel_launch(void* const* d_in, const int* in_sizes, int n_in, void* d_out, int out_size, void* d_ws, size_t ws_size, hipStream_t stream) {
    static int grid_blocks = 0;
    if (!grid_blocks) {
        int dev = 0, cus = 0, per_cu = 0;
        hipGetDevice(&dev);
        hipDeviceGetAttribute(&cus, hipDeviceAttributeMultiprocessorCount, dev);
        hipOccupancyMaxActiveBlocksPerMultiprocessor(&per_cu, mega, 256, 0);
        if (per_cu > 2) per_cu = 2;
        if (per_cu < 1) per_cu = 1;
        grid_blocks = cus * per_cu;
    }
    Params p{};
    const float* const* in = (const float* const*)d_in;
    p.x_prompt = in[0]; p.x_sample = in[1]; p.cache_k = in[2]; p.cache_v = in[3]; p.c = in[4]; p.c_ctx = in[5];
    p.norm_w0 = in[6]; p.w_mod0 = in[7]; p.b_mod0 = in[8]; p.w_in0 = in[9]; p.w_out0 = in[10];
    p.norm_w1 = in[11]; p.w_mod1 = in[12]; p.b_mod1 = in[13]; p.w_in1 = in[14]; p.qnw = in[15]; p.knw = in[16]; p.sink = in[17]; p.w_out1 = in[18];
    p.out = (float*)d_out; p.ws = (unsigned char*)d_ws;
#if SINGLE_LAUNCH
    p.ph_lo = 0; p.ph_hi = 10;
    hipMemsetAsync((unsigned char*)d_ws + WS_BAR, 0, 16384, stream);
    void* args[] = {&p};
    hipError_t e = hipLaunchCooperativeKernel((void*)mega, dim3(grid_blocks), dim3(256), args, 0, stream);
    if (e != hipSuccess) fprintf(stderr, "cooperative launch failed: %s (grid %d)\n", hipGetErrorString(e), grid_blocks);
#else
    for (int ph = 0; ph < 10; ++ph) {
        p.ph_lo = ph; p.ph_hi = ph + 1;
        hipLaunchKernelGGL(mega, dim3(grid_blocks), dim3(256), 0, stream, p);
    }
#endif
}
```

```cpp
#include <hip/hip_runtime.h>
#include <hip/hip_cooperative_groups.h>
#include <stdint.h>
#include <cstdio>
namespace cg = cooperative_groups;

#ifndef SINGLE_LAUNCH
#define SINGLE_LAUNCH 1
#endif

typedef unsigned short bf16_t;
typedef short bf16x8 __attribute__((ext_vector_type(8)));
typedef float f32x16 __attribute__((ext_vector_type(16)));
typedef float f32x4 __attribute__((ext_vector_type(4)));
typedef unsigned u32x4 __attribute__((ext_vector_type(4)));
typedef unsigned u32x2 __attribute__((ext_vector_type(2)));
#define DEVI __device__ __forceinline__

constexpr int NTOK = 6144, NCTX = 4096, D = 1024;
constexpr float EPSV = 1e-6f;
constexpr float LOG2E = 1.4426950408889634f;

constexpr size_t WS_MOD = 0;
constexpr size_t WS_WT0IN = 1 << 20;
constexpr size_t WS_WT0OUT = WS_WT0IN + (size_t)2048 * 1024 * 2;
constexpr size_t WS_WT1IN = WS_WT0OUT + (size_t)1024 * 1024 * 2;
constexpr size_t WS_WT1OUT = WS_WT1IN + (size_t)2560 * 1024 * 2;
constexpr size_t WS_TW256 = WS_WT1OUT + (size_t)1024 * 1024 * 2;
constexpr size_t WS_TS256 = WS_TW256 + (size_t)512 * 256 * 2;
constexpr size_t WS_TS1024 = WS_TS256 + (size_t)256 * 512 * 2;
constexpr size_t WS_ROPEC = WS_TS1024 + (size_t)1024 * 2048 * 2;
constexpr size_t WS_ROPES = WS_ROPEC + (size_t)1024 * 32 * 4;
constexpr size_t WS_KC = WS_ROPES + (size_t)1024 * 32 * 4;
constexpr size_t WS_VCT = WS_KC + (size_t)2 * 256 * 256 * 2;
constexpr size_t WS_H = WS_VCT + (size_t)2 * 256 * 256 * 2;
constexpr size_t WS_U = WS_H + (size_t)NTOK * D * 2;
constexpr size_t WS_SZ = WS_U + (size_t)NTOK * D * 2;
constexpr size_t WS_VT = WS_SZ + (size_t)NTOK * D * 2;
constexpr size_t WS_Y = WS_VT + (size_t)NTOK * 2048 * 2;
constexpr size_t WS_X1 = WS_Y + (size_t)NTOK * D * 2;
constexpr size_t WS_Q = WS_X1 + (size_t)NTOK * D * 4;
constexpr size_t WS_KB = WS_Q + (size_t)NTOK * D * 2;
constexpr size_t WS_VTB = WS_KB + (size_t)NTOK * 256 * 2;
constexpr size_t WS_BAR = WS_VTB + (size_t)NTOK * 256 * 2;
constexpr size_t WS_CNT = WS_BAR + 14336;
constexpr size_t WS_ROWSS = WS_BAR + 16384;
constexpr size_t WS_BIAS1 = WS_ROWSS + 6144 * 4;
constexpr size_t WS_MODP = WS_BIAS1 + 3 * 2560 * 4;
constexpr size_t WS_END = WS_MODP + (size_t)4 * 18432 * 4;

struct Params {
    const float *x_prompt, *x_sample, *cache_k, *cache_v, *c, *c_ctx;
    const float *norm_w0, *w_mod0, *b_mod0, *w_in0, *w_out0;
    const float *norm_w1, *w_mod1, *b_mod1, *w_in1, *qnw, *knw, *sink, *w_out1;
    float* out;
    unsigned char* ws;
    long long ph_lo, ph_hi;
};

DEVI unsigned cvt_pk_bf16(float lo, float hi) { unsigned r; asm("v_cvt_pk_bf16_f32 %0, %1, %2" : "=v"(r) : "v"(lo), "v"(hi)); return r; }
DEVI bf16_t f2bf(float f) { return (bf16_t)(cvt_pk_bf16(f, 0.f) & 0xffffu); }
DEVI float silu_f(float v) { return v * __builtin_amdgcn_rcpf(1.f + __expf(-v)); }
DEVI int swap23(int x) { return (x & ~12) | ((x & 4) << 1) | ((x & 8) >> 1); }
DEVI int cond_of(int m) { return m < NCTX ? 0 : 1 + ((m - NCTX) >> 10); }

DEVI void glds16(const void* g, void* l) { __builtin_amdgcn_global_load_lds(g, l, 16, 0, 0); }

template <int MB = 2, class Epi>
DEVI void gemm_tile(const bf16_t* __restrict__ A, int lda, const bf16_t* __restrict__ B, int ldb, int nk,
                    unsigned char* lds, const Epi& epi, int m0, int n0) {
    const int tid = threadIdx.x, lane = tid & 63, wid = tid >> 6, wr = wid >> 1, wc = wid & 1;
    const int srow = tid >> 3;
    const int slc = (tid & 7) ^ ((tid >> 4) & 7);
    const bf16_t* gA = A + (size_t)(m0 + srow) * lda + slc * 8;
    const bf16_t* gB = B + (size_t)(n0 + srow) * ldb + slc * 8;
    const int fr = lane & 31, fh = lane >> 5, sw = (lane >> 1) & 7;
    const unsigned aoff = (wr * 32 * MB + fr) * 128, boff = 16384 + (wc * 64 + fr) * 128;
    f32x16 acc[MB][2];
#pragma unroll
    for (int i = 0; i < MB; ++i)
#pragma unroll
        for (int j = 0; j < 2; ++j)
#pragma unroll
            for (int r = 0; r < 16; ++r) acc[i][j][r] = 0.f;
    {
        unsigned char* la = lds + tid * 16;
#pragma unroll
        for (int i = 0; i < 4; ++i) {
            if (i < 2 * MB) glds16(gA + (size_t)i * 32 * lda, la + i * 4096);
            glds16(gB + (size_t)i * 32 * ldb, la + 16384 + i * 4096);
        }
    }
    for (int kt = 0; kt < nk; ++kt) {
        asm volatile("s_waitcnt vmcnt(0)" ::: "memory");
        __syncthreads();
        if (kt + 1 < nk) {
            unsigned char* la = lds + ((kt + 1) & 1) * 32768 + tid * 16;
            const int ko = (kt + 1) * 64;
#pragma unroll
            for (int i = 0; i < 4; ++i) {
                if (i < 2 * MB) glds16(gA + (size_t)i * 32 * lda + ko, la + i * 4096);
                glds16(gB + (size_t)i * 32 * ldb + ko, la + 16384 + i * 4096);
            }
        }
        const unsigned char* base = lds + (kt & 1) * 32768;
        bf16x8 af[4][2], bfr[4][2];
#define LDFRAG(ks) { const int ch = ((2 * (ks) + fh) ^ sw) * 16; \
            af[ks][0] = *(const bf16x8*)(base + aoff + ch); bfr[ks][0] = *(const bf16x8*)(base + boff + ch); \
            bfr[ks][1] = *(const bf16x8*)(base + boff + 4096 + ch); if (MB == 2) af[ks][1] = *(const bf16x8*)(base + aoff + 4096 + ch); }
#define MFMA4(ks) { acc[0][0] = __builtin_amdgcn_mfma_f32_32x32x16_bf16(bfr[ks][0], af[ks][0], acc[0][0], 0, 0, 0); \
            acc[0][1] = __builtin_amdgcn_mfma_f32_32x32x16_bf16(bfr[ks][1], af[ks][0], acc[0][1], 0, 0, 0); \
            if (MB == 2) { acc[MB - 1][0] = __builtin_amdgcn_mfma_f32_32x32x16_bf16(bfr[ks][0], af[ks][1], acc[MB - 1][0], 0, 0, 0); \
            acc[MB - 1][1] = __builtin_amdgcn_mfma_f32_32x32x16_bf16(bfr[ks][1], af[ks][1], acc[MB - 1][1], 0, 0, 0); } }
        LDFRAG(0) LDFRAG(1)
        __builtin_amdgcn_sched_barrier(0);
        MFMA4(0) LDFRAG(2)
        __builtin_amdgcn_sched_barrier(0);
        MFMA4(1) LDFRAG(3)
        __builtin_amdgcn_sched_barrier(0);
        MFMA4(2)
        __builtin_amdgcn_sched_barrier(0);
        MFMA4(3)
#undef LDFRAG
#undef MFMA4
    }
    epi(acc, m0 + wr * 32 * MB, n0 + wc * 64, fr, fh);
    __syncthreads();
}

DEVI int xcd_remap(int t, int T) { return (t & 7) * (T >> 3) + (t >> 3); }

DEVI void mod_item(const Params& p, int it, unsigned char* lds) {
    const int tid = threadIdx.x;
    const int ks = it & 3, lc = it >> 2, l = lc / 48, cc = lc % 48;
    float* sc = (float*)lds;
    for (int i = tid; i < 768; i += 256) {
        const int cv = i >> 8, k = ks * 256 + (i & 255);
        const float cval = cv == 0 ? p.c_ctx[k] : p.c[(cv - 1) * 1024 + k];
        sc[i] = silu_f(cval);
    }
    __syncthreads();
    const float* W = (l ? p.w_mod1 : p.w_mod0) + (size_t)ks * 256 * 3072;
    const int cg4 = tid & 15, rg = tid >> 4, c0 = cc * 64 + cg4 * 4;
    f32x4 w[16];
#pragma unroll
    for (int i = 0; i < 16; ++i) w[i] = *(const f32x4*)(W + (size_t)(rg + 16 * i) * 3072 + c0);
    f32x4 a0 = {0.f, 0.f, 0.f, 0.f}, a1 = a0, a2 = a0;
#pragma unroll
    for (int i = 0; i < 16; ++i) { const int k = rg + 16 * i; a0 += sc[k] * w[i]; a1 += sc[256 + k] * w[i]; a2 += sc[512 + k] * w[i]; }
    float* red = (float*)(lds + 12288);
#pragma unroll
    for (int e = 0; e < 4; ++e) {
        red[(rg * 3 + 0) * 64 + cg4 * 4 + e] = a0[e];
        red[(rg * 3 + 1) * 64 + cg4 * 4 + e] = a1[e];
        red[(rg * 3 + 2) * 64 + cg4 * 4 + e] = a2[e];
    }
    __syncthreads();
    if (tid < 192) {
        const int cv = tid >> 6, j = tid & 63;
        float s = 0.f;
#pragma unroll
        for (int r = 0; r < 16; ++r) s += red[(r * 3 + cv) * 64 + j];
        float* modp = (float*)(p.ws + WS_MODP) + (size_t)ks * 18432;
        __hip_atomic_store(&modp[(l * 3 + cv) * 3072 + cc * 64 + j], s, __ATOMIC_RELAXED, __HIP_MEMORY_SCOPE_AGENT);
    }
    asm volatile("s_waitcnt vmcnt(0)" ::: "memory");
    __syncthreads();
    if (tid == 0) __hip_atomic_fetch_add((unsigned*)(p.ws + WS_CNT), 1u, __ATOMIC_RELAXED, __HIP_MEMORY_SCOPE_AGENT);
}

struct TrDesc { const float* src; bf16_t* dst; int N, kt, nt; };
DEVI TrDesc tr_desc(const Params& p, int idx) {
    TrDesc d;
    if (idx < 512) { d.src = p.w_in0; d.dst = (bf16_t*)(p.ws + WS_WT0IN); d.N = 2048; }
    else if (idx < 768) { idx -= 512; d.src = p.w_out0; d.dst = (bf16_t*)(p.ws + WS_WT0OUT); d.N = 1024; }
    else if (idx < 1408) { idx -= 768; d.src = p.w_in1; d.dst = (bf16_t*)(p.ws + WS_WT1IN); d.N = 2560; }
    else { idx -= 1408; d.src = p.w_out1; d.dst = (bf16_t*)(p.ws + WS_WT1OUT); d.N = 1024; }
    const int ntn = d.N >> 6;
    d.kt = idx / ntn; d.nt = idx % ntn;
    return d;
}
DEVI void transpose_items(const Params& p, int first, int end, int stride, unsigned char* lds) {
    const int tid = threadIdx.x;
    float* tl = (float*)lds;
    if (first >= end) return;
    f32x4 v[4];
    TrDesc d = tr_desc(p, first);
#pragma unroll
    for (int pass = 0; pass < 4; ++pass) v[pass] = *(const f32x4*)(d.src + (size_t)(d.kt * 64 + pass * 16 + (tid >> 4)) * d.N + d.nt * 64 + (tid & 15) * 4);
    for (int idx = first; idx < end; idx += stride) {
#pragma unroll
        for (int pass = 0; pass < 4; ++pass) {
            const int r = pass * 16 + (tid >> 4), c4 = (tid & 15) * 4;
#pragma unroll
            for (int e = 0; e < 4; ++e) tl[r * 65 + c4 + e] = v[pass][e];
        }
        const TrDesc cur = d;
        if (idx + stride < end) {
            d = tr_desc(p, idx + stride);
#pragma unroll
            for (int pass = 0; pass < 4; ++pass) v[pass] = *(const f32x4*)(d.src + (size_t)(d.kt * 64 + pass * 16 + (tid >> 4)) * d.N + d.nt * 64 + (tid & 15) * 4);
        }
        __syncthreads();
#pragma unroll
        for (int pass = 0; pass < 2; ++pass) {
            const int n = pass * 32 + (tid >> 3), kc = tid & 7;
            float x[8];
#pragma unroll
            for (int j = 0; j < 8; ++j) x[j] = tl[(kc * 8 + j) * 65 + n];
            u32x4 w;
            w.x = cvt_pk_bf16(x[0], x[1]); w.y = cvt_pk_bf16(x[2], x[3]); w.z = cvt_pk_bf16(x[4], x[5]); w.w = cvt_pk_bf16(x[6], x[7]);
            *(u32x4*)(cur.dst + (size_t)(cur.nt * 64 + n) * 1024 + cur.kt * 64 + kc * 8) = w;
        }
        __syncthreads();
    }
}

DEVI void phase0(const Params& p, unsigned char* lds) {
    for (int it = blockIdx.x; it < 384; it += gridDim.x) mod_item(p, it, lds);
    transpose_items(p, (blockIdx.x + 128) % gridDim.x, 1664, gridDim.x, lds);
    const int gt = blockIdx.x * 256 + threadIdx.x, gs = gridDim.x * 256;
    bf16_t* tw256 = (bf16_t*)(p.ws + WS_TW256);
    bf16_t* ts256 = (bf16_t*)(p.ws + WS_TS256);
    bf16_t* ts1024 = (bf16_t*)(p.ws + WS_TS1024);
    float* lut = (float*)(lds + 32768);
    __syncthreads();
    for (int r = threadIdx.x; r < 1024; r += 256) lut[r] = cospif((float)r * (1.f / 512.f));
    __syncthreads();
    for (int i = gt; i < 512 * 256; i += gs) {
        const int m = i >> 8, j = i & 255, which = m >> 8, cp = m & 255;
        const int r = ((cp * j) & 255) << 2;
        tw256[i] = f2bf(which ? lut[(r - 256) & 1023] : lut[r]);
    }
    for (int i = gt; i < 256 * 512; i += gs) {
        const int sp = i >> 9, k2 = i & 511, which = k2 >> 8, s0 = k2 & 255;
        const int r = ((sp * s0) & 255) << 2;
        ts256[i] = f2bf((which ? -lut[(r - 256) & 1023] : lut[r]) * (1.f / 256.f));
    }
    for (int i = gt; i < 1024 * 2048; i += gs) {
        const int sp = i >> 11, k2 = i & 2047, which = k2 >> 10, s0 = k2 & 1023;
        const int r = (sp * s0) & 1023;
        ts1024[i] = f2bf((which ? -lut[(r - 256) & 1023] : lut[r]) * (1.f / 512.f));
    }
    float* ropec = (float*)(p.ws + WS_ROPEC);
    float* ropes = (float*)(p.ws + WS_ROPES);
    for (int i = gt; i < 1024 * 32; i += gs) {
        const int pos = i >> 5, f = i & 31;
        const int row = pos >> 6, col = pos & 63;
        const float inv = powf(10000.f, -(float)(f & 15) * (1.f / 16.f));
        const float ang = (float)(f < 16 ? row : col) * inv;
        float s, c; sincosf(ang, &s, &c);
        ropec[i] = c; ropes[i] = s;
    }
    for (int i = gt; i < NTOK; i += gs) ((float*)(p.ws + WS_ROWSS))[i] = 0.f;
    bf16_t* kc = (bf16_t*)(p.ws + WS_KC);
    bf16_t* vct = (bf16_t*)(p.ws + WS_VCT);
    for (int i = gt; i < 2 * 256 * 256; i += gs) {
        kc[i] = f2bf(p.cache_k[i]);
        const int b = i >> 16, kvh = (i >> 14) & 3, d = (i >> 8) & 63, pp = i & 255;
        const int key = swap23(pp);
        vct[i] = f2bf(p.cache_v[((b * 256 + key) * 4 + kvh) * 64 + d]);
    }
}

DEVI void phase_norm(const Params& p, int layer, const float* lmod  ) {
    const int lane = threadIdx.x & 63, wid = threadIdx.x >> 6;
    const float* nw = layer ? p.norm_w1 : p.norm_w0;
    bf16_t* H = (bf16_t*)(p.ws + WS_H);
    for (int row = blockIdx.x * 4 + wid; row < NTOK; row += gridDim.x * 4) {
        const float* xr;
        if (layer == 0) xr = row < NCTX ? p.x_prompt + (size_t)row * D : p.x_sample + (size_t)(row - NCTX) * D;
        else xr = (const float*)(p.ws + WS_X1) + (size_t)row * D;
        const float* mv = lmod + cond_of(row) * 2048;
        f32x4 v[4];
        float ss = 0.f;
#pragma unroll
        for (int i = 0; i < 4; ++i) {
            v[i] = *(const f32x4*)(xr + i * 256 + lane * 4);
            ss += v[i][0] * v[i][0] + v[i][1] * v[i][1] + v[i][2] * v[i][2] + v[i][3] * v[i][3];
        }
#pragma unroll
        for (int o = 32; o >= 1; o >>= 1) ss += __shfl_xor(ss, o);
        const float rstd = rsqrtf(ss * (1.f / 1024.f) + EPSV);
#pragma unroll
        for (int i = 0; i < 4; ++i) {
            const int k = i * 256 + lane * 4;
            const f32x4 w = *(const f32x4*)(nw + k);
            const f32x4 sh = *(const f32x4*)(mv + k);
            const f32x4 scl = *(const f32x4*)(mv + 1024 + k);
            float h[4];
#pragma unroll
            for (int e = 0; e < 4; ++e) h[e] = (v[i][e] * rstd * w[e]) * (1.f + scl[e]) + sh[e];
            u32x2 o; o.x = cvt_pk_bf16(h[0], h[1]); o.y = cvt_pk_bf16(h[2], h[3]);
            *(u32x2*)(H + (size_t)row * D + k) = o;
        }
    }
}

DEVI void bias1_items(const Params& p) {
    const int lane = threadIdx.x & 63, gw = blockIdx.x * 4 + (threadIdx.x >> 6), nw = gridDim.x * 4;
    const float* mod1 = (const float*)(p.ws + WS_MOD) + 3 * 3072;
    const bf16_t* WT = (const bf16_t*)(p.ws + WS_WT1IN);
    float* bias1 = (float*)(p.ws + WS_BIAS1);
    for (int n = gw; n < 2560; n += nw) {
        float w[16];
        const u32x4 r0 = *(const u32x4*)(WT + (size_t)n * 1024 + lane * 16), r1 = *(const u32x4*)(WT + (size_t)n * 1024 + lane * 16 + 8);
        const unsigned rr[8] = {r0.x, r0.y, r0.z, r0.w, r1.x, r1.y, r1.z, r1.w};
#pragma unroll
        for (int i = 0; i < 8; ++i) { w[2 * i] = __uint_as_float(rr[i] << 16); w[2 * i + 1] = __uint_as_float(rr[i] & 0xffff0000u); }
        float s[3];
#pragma unroll
        for (int cv = 0; cv < 3; ++cv) {
            float a = 0.f;
#pragma unroll
            for (int q = 0; q < 4; ++q) {
                const f32x4 sh = *(const f32x4*)(mod1 + cv * 3072 + lane * 16 + q * 4);
#pragma unroll
                for (int e = 0; e < 4; ++e) a += sh[e] * w[q * 4 + e];
            }
#pragma unroll
            for (int o = 32; o >= 1; o >>= 1) a += __shfl_xor(a, o);
            s[cv] = a;
        }
        if (lane == 0) { bias1[n] = s[0]; bias1[2560 + n] = s[1]; bias1[5120 + n] = s[2]; }
    }
}

struct EpiInL0 {
    bf16_t *U, *SZ;
    DEVI void operator()(const f32x16 (&acc)[2][2], int mbase, int nbase, int fr, int fh) const {
        const bool isz = nbase >= 1024;
        bf16_t* dst = isz ? SZ : U;
        const int nb0 = isz ? nbase - 1024 : nbase;
#pragma unroll
        for (int mb = 0; mb < 2; ++mb)
#pragma unroll
            for (int nb = 0; nb < 2; ++nb)
#pragma unroll
                for (int g = 0; g < 4; ++g) {
                    const int m = mbase + mb * 32 + fr, n = nb0 + nb * 32 + 8 * g + 4 * fh;
                    float v[4];
#pragma unroll
                    for (int e = 0; e < 4; ++e) { v[e] = acc[mb][nb][4 * g + e]; if (isz) v[e] = silu_f(v[e]); }
                    u32x2 o; o.x = cvt_pk_bf16(v[0], v[1]); o.y = cvt_pk_bf16(v[2], v[3]);
                    *(u32x2*)(dst + (size_t)m * D + n) = o;
                }
    }
};

struct EpiChanDft {
    bf16_t* VT; int g;
    DEVI void operator()(const f32x16 (&acc)[2][2], int mbase, int nbase, int fr, int fh) const {
        int S, bgi, s0; bf16_t* base;
        if (nbase < NCTX) { S = 256; bgi = (nbase >> 8) * 4 + g; s0 = nbase & 255; base = VT; }
        else { const int t = nbase - NCTX; S = 1024; bgi = (t >> 10) * 4 + g; s0 = t & 1023; base = VT + (size_t)64 * 256 * 512; }
#pragma unroll
        for (int mb = 0; mb < 2; ++mb)
#pragma unroll
            for (int nb = 0; nb < 2; ++nb)
#pragma unroll
                for (int gq = 0; gq < 4; ++gq) {
                    const int m = mbase + mb * 32 + fr, which = m >> 8, cp = m & 255;
                    const int s = s0 + nb * 32 + 8 * gq + 4 * fh;
                    u32x2 o; o.x = cvt_pk_bf16(acc[mb][nb][4 * gq], acc[mb][nb][4 * gq + 1]); o.y = cvt_pk_bf16(acc[mb][nb][4 * gq + 2], acc[mb][nb][4 * gq + 3]);
                    *(u32x2*)(base + ((size_t)bgi * 256 + cp) * (2 * S) + which * S + s) = o;
                }
    }
};

template <int MB> struct EpiSeqDft {
    const bf16_t* SZ; bf16_t* Y; int tok0, g;
    DEVI void operator()(const f32x16 (&acc)[MB][2], int mbase, int nbase, int fr, int fh) const {
#pragma unroll
        for (int mb = 0; mb < MB; ++mb)
#pragma unroll
            for (int nb = 0; nb < 2; ++nb)
#pragma unroll
                for (int gq = 0; gq < 4; ++gq) {
                    const int tok = tok0 + mbase + mb * 32 + fr;
                    const int col = g * 256 + nbase + nb * 32 + 8 * gq + 4 * fh;
                    const u32x2 z = *(const u32x2*)(SZ + (size_t)tok * D + col);
                    const float z0 = __uint_as_float(z.x << 16), z1 = __uint_as_float(z.x & 0xffff0000u);
                    const float z2 = __uint_as_float(z.y << 16), z3 = __uint_as_float(z.y & 0xffff0000u);
                    u32x2 o; o.x = cvt_pk_bf16(acc[mb][nb][4 * gq] * z0, acc[mb][nb][4 * gq + 1] * z1);
                    o.y = cvt_pk_bf16(acc[mb][nb][4 * gq + 2] * z2, acc[mb][nb][4 * gq + 3] * z3);
                    *(u32x2*)(Y + (size_t)tok * D + col) = o;
                }
    }
};

template <bool NEXT, int MB> struct EpiOut {
    const float* xa; const float* xb;
    const float* mod;
    float* out;
    const float* nw1; const float* mod1; bf16_t* Hn; float* rowss;
    DEVI void operator()(const f32x16 (&acc)[MB][2], int mbase, int nbase, int fr, int fh) const {
        const int cv = cond_of(mbase);
        const float* gate = mod + cv * 3072 + 2048;
#pragma unroll
        for (int mb = 0; mb < MB; ++mb) {
            const int m = mbase + mb * 32 + fr;
            const float* xr = m < NCTX ? xa + (size_t)m * D : xb + (size_t)(m - NCTX) * D;
            float ss = 0.f;
#pragma unroll
            for (int nb = 0; nb < 2; ++nb)
#pragma unroll
                for (int g = 0; g < 4; ++g) {
                    const int n = nbase + nb * 32 + 8 * g + 4 * fh;
                    const f32x4 xv = *(const f32x4*)(xr + n);
                    const f32x4 gv = *(const f32x4*)(gate + n);
                    f32x4 o;
#pragma unroll
                    for (int e = 0; e < 4; ++e) o[e] = xv[e] + gv[e] * acc[mb][nb][4 * g + e];
                    *(f32x4*)(out + (size_t)m * D + n) = o;
                    if (NEXT) {
                        const f32x4 w = *(const f32x4*)(nw1 + n);
                        const f32x4 sc = *(const f32x4*)(mod1 + cv * 3072 + 1024 + n);
                        float h[4];
#pragma unroll
                        for (int e = 0; e < 4; ++e) { ss += o[e] * o[e]; h[e] = o[e] * w[e] * (1.f + sc[e]); }
                        u32x2 hb; hb.x = cvt_pk_bf16(h[0], h[1]); hb.y = cvt_pk_bf16(h[2], h[3]);
                        *(u32x2*)(Hn + (size_t)m * D + n) = hb;
                    }
                }
            if (NEXT) {
                ss += __shfl_xor(ss, 32);
                if (fh == 0) atomicAdd(rowss + m, ss);
            }
        }
    }
};

struct EpiInL1 {
    const float *qnw, *knw, *ropec, *ropes;
    bf16_t *Q, *KB, *VTB, *SZ;
    float *outk, *outv;
    const float* rowss; const float* bias1;
    DEVI void operator()(const f32x16 (&acc_in)[2][2], int mbase, int nbase, int fr, int fh) const {
        const bool lat = mbase >= NCTX;
        f32x16 acc[2][2];
        {
            const float* bp = bias1 + cond_of(mbase) * 2560 + nbase;
#pragma unroll
            for (int mb = 0; mb < 2; ++mb) {
                const float rstd = rsqrtf(rowss[mbase + mb * 32 + fr] * (1.f / 1024.f) + EPSV);
#pragma unroll
                for (int nb = 0; nb < 2; ++nb)
#pragma unroll
                    for (int g = 0; g < 4; ++g) {
                        const f32x4 bv = *(const f32x4*)(bp + nb * 32 + 8 * g + 4 * fh);
#pragma unroll
                        for (int e = 0; e < 4; ++e) acc[mb][nb][4 * g + e] = acc_in[mb][nb][4 * g + e] * rstd + bv[e];
                    }
            }
        }
        if (nbase < 1280) {
            const bool isq = nbase < 1024;
            const float* nwp = isq ? qnw : knw;
#pragma unroll
            for (int mb = 0; mb < 2; ++mb) {
                const int m = mbase + mb * 32 + fr;
                float ss = 0.f;
#pragma unroll
                for (int nb = 0; nb < 2; ++nb)
#pragma unroll
                    for (int r = 0; r < 16; ++r) ss += acc[mb][nb][r] * acc[mb][nb][r];
                ss += __shfl_xor(ss, 32);
                const float rn = rsqrtf(ss * (1.f / 64.f) + EPSV);
                const int pos = lat ? ((m - NCTX) & 1023) : 0;
#pragma unroll
                for (int g = 0; g < 4; ++g) {
                    const int d0 = 8 * g + 4 * fh;
                    const f32x4 w1 = *(const f32x4*)(nwp + d0), w2 = *(const f32x4*)(nwp + 32 + d0);
                    float x1[4], x2[4];
#pragma unroll
                    for (int e = 0; e < 4; ++e) { x1[e] = acc[mb][0][4 * g + e] * rn * w1[e]; x2[e] = acc[mb][1][4 * g + e] * rn * w2[e]; }
                    if (lat) {
                        const f32x4 cv = *(const f32x4*)(ropec + pos * 32 + d0), sv = *(const f32x4*)(ropes + pos * 32 + d0);
#pragma unroll
                        for (int e = 0; e < 4; ++e) { const float a = x1[e], b = x2[e]; x1[e] = a * cv[e] - b * sv[e]; x2[e] = a * sv[e] + b * cv[e]; }
                    }
                    if (isq) {
                        const float qs = 0.125f * LOG2E;
                        u32x2 o1, o2;
                        o1.x = cvt_pk_bf16(x1[0] * qs, x1[1] * qs); o1.y = cvt_pk_bf16(x1[2] * qs, x1[3] * qs);
                        o2.x = cvt_pk_bf16(x2[0] * qs, x2[1] * qs); o2.y = cvt_pk_bf16(x2[2] * qs, x2[3] * qs);
                        *(u32x2*)(Q + (size_t)m * D + nbase + d0) = o1;
                        *(u32x2*)(Q + (size_t)m * D + nbase + 32 + d0) = o2;
                    } else {
                        const int kc = nbase - 1024;
                        u32x2 o1, o2;
                        o1.x = cvt_pk_bf16(x1[0], x1[1]); o1.y = cvt_pk_bf16(x1[2], x1[3]);
                        o2.x = cvt_pk_bf16(x2[0], x2[1]); o2.y = cvt_pk_bf16(x2[2], x2[3]);
                        *(u32x2*)(KB + (size_t)m * 256 + kc + d0) = o1;
                        *(u32x2*)(KB + (size_t)m * 256 + kc + 32 + d0) = o2;
                        if (!lat) {
                            f32x4 f1 = {x1[0], x1[1], x1[2], x1[3]}, f2 = {x2[0], x2[1], x2[2], x2[3]};
                            *(f32x4*)(outk + (size_t)m * 256 + kc + d0) = f1;
                            *(f32x4*)(outk + (size_t)m * 256 + kc + 32 + d0) = f2;
                        }
                    }
                }
            }
        } else if (nbase < 1536) {
            const int vc = nbase - 1280, kvh = vc >> 6;
#pragma unroll
            for (int mb = 0; mb < 2; ++mb) {
                const int m = mbase + mb * 32 + fr;
                bf16_t* vt; int S, s;
                if (!lat) { S = 256; s = m & 255; vt = VTB + ((size_t)((m >> 8) * 4 + kvh) * 64) * 256; }
                else { const int t = m - NCTX; S = 1024; s = t & 1023; vt = VTB + (size_t)16 * 4 * 64 * 256 + ((size_t)((t >> 10) * 4 + kvh) * 64) * 1024; }
                const int sp = swap23(s);
#pragma unroll
                for (int nb = 0; nb < 2; ++nb)
#pragma unroll
                    for (int g = 0; g < 4; ++g) {
                        const int d0 = nb * 32 + 8 * g + 4 * fh;
#pragma unroll
                        for (int e = 0; e < 4; ++e) vt[(size_t)(d0 + e) * S + sp] = f2bf(acc[mb][nb][4 * g + e]);
                        if (!lat) {
                            f32x4 f = {acc[mb][nb][4 * g], acc[mb][nb][4 * g + 1], acc[mb][nb][4 * g + 2], acc[mb][nb][4 * g + 3]};
                            *(f32x4*)(outv + (size_t)m * 256 + vc + d0) = f;
                        }
                    }
            }
        } else {
            const int zc = nbase - 1536;
#pragma unroll
            for (int mb = 0; mb < 2; ++mb)
#pragma unroll
                for (int nb = 0; nb < 2; ++nb)
#pragma unroll
                    for (int g = 0; g < 4; ++g) {
                        const int m = mbase + mb * 32 + fr, n = zc + nb * 32 + 8 * g + 4 * fh;
                        u32x2 o; o.x = cvt_pk_bf16(silu_f(acc[mb][nb][4 * g]), silu_f(acc[mb][nb][4 * g + 1]));
                        o.y = cvt_pk_bf16(silu_f(acc[mb][nb][4 * g + 2]), silu_f(acc[mb][nb][4 * g + 3]));
                        *(u32x2*)(SZ + (size_t)m * D + n) = o;
                    }
        }
    }
};

DEVI void attn_item(const Params& p, int item, unsigned char* lds) {
    const int lane = threadIdx.x & 63, w = threadIdx.x >> 6, fr = lane & 31, fh = lane >> 5;
    const bf16_t* Q = (const bf16_t*)(p.ws + WS_Q);
    const bf16_t* KB = (const bf16_t*)(p.ws + WS_KB);
    const bf16_t* VTB = (const bf16_t*)(p.ws + WS_VTB);
    const bf16_t* KC = (const bf16_t*)(p.ws + WS_KC);
    const bf16_t* VCT = (const bf16_t*)(p.ws + WS_VCT);
    const bf16_t* SZ = (const bf16_t*)(p.ws + WS_SZ);
    bf16_t* Y = (bf16_t*)(p.ws + WS_Y);
    bool lat; int b, kvh, qb, tb;
    if (item < 256) { lat = true; b = item >> 7; kvh = (item >> 5) & 3; qb = item & 31; tb = NCTX + b * 1024; }
    else { const int it = item - 256; lat = false; b = it >> 5; kvh = (it >> 3) & 3; qb = it & 7; tb = b * 256; }
    const int head = kvh * 4 + w;
    const int qtok = tb + qb * 32 + fr;
    bf16x8 qf[4];
#pragma unroll
    for (int ks = 0; ks < 4; ++ks) qf[ks] = *(const bf16x8*)(Q + (size_t)qtok * D + head * 64 + ks * 16 + fh * 8);
    float m_run = p.sink[head] * LOG2E, l_run = 1.f;
    f32x16 O[2];
#pragma unroll
    for (int i = 0; i < 2; ++i)
#pragma unroll
        for (int r = 0; r < 16; ++r) O[i][r] = 0.f;

    int nloc, k_lo = 0; const bf16_t *kloc, *vloc; int ldloc;
    if (lat) {
        k_lo = qb - 4 < 0 ? 0 : qb - 4; const int k_hi = qb + 4 > 31 ? 31 : qb + 4; nloc = k_hi - k_lo + 1;
        kloc = KB + (size_t)(tb + k_lo * 32) * 256 + kvh * 64;
        vloc = VTB + (size_t)16 * 4 * 64 * 256 + ((size_t)(b * 4 + kvh) * 64) * 1024 + k_lo * 32; ldloc = 1024;
    } else {
        nloc = 8; kloc = KB + (size_t)tb * 256 + kvh * 64; vloc = VTB + ((size_t)(b * 4 + kvh) * 64) * 256; ldloc = 256;
    }
    const int nblk = lat ? nloc + 8 : 8;
    const bf16_t* kcb = KC + (size_t)(b * 256) * 256 + kvh * 64;
    const bf16_t* vcb = VCT + ((size_t)(b * 4 + kvh) * 64) * 256;
    const int tid = threadIdx.x;
    const int kkey = tid >> 3, kch = tid & 7, vd = tid >> 2, vch = tid & 3;
    const unsigned kst = kkey * 128 + ((kch ^ ((kkey >> 1) & 7)) << 4), vst = 4096 + vd * 64 + ((vch ^ ((vd >> 2) & 3)) << 4);
    const unsigned ksw = (fr >> 1) & 7, vsw = (fr >> 2) & 3;
    u32x4 kreg, vreg;
    auto loadkv = [&](int j) {
        const bf16_t *kp, *vp; int ldv;
        if (j < nloc) { kp = kloc + (size_t)j * 32 * 256; vp = vloc + j * 32; ldv = ldloc; }
        else { const int c = j - nloc; kp = kcb + (size_t)c * 32 * 256; vp = vcb + c * 32; ldv = 256; }
        kreg = *(const u32x4*)(kp + (size_t)kkey * 256 + kch * 8);
        vreg = *(const u32x4*)(vp + (size_t)vd * ldv + vch * 8);
    };
    loadkv(0);
    *(u32x4*)(lds + kst) = kreg; *(u32x4*)(lds + vst) = vreg;
    if (nblk > 1) loadkv(1);
    __syncthreads();
    for (int j = 0; j < nblk; ++j) {
        const unsigned char* lb = lds + (j & 1) * 8192;
        bf16x8 kf[4], vf[4];
#pragma unroll
        for (int ks = 0; ks < 4; ++ks) kf[ks] = *(const bf16x8*)(lb + fr * 128 + (((2 * ks + fh) ^ ksw) << 4));
#pragma unroll
        for (int s2 = 0; s2 < 2; ++s2)
#pragma unroll
            for (int db = 0; db < 2; ++db) vf[s2 * 2 + db] = *(const bf16x8*)(lb + 4096 + (db * 32 + fr) * 64 + (((2 * s2 + fh) ^ vsw) << 4));
        f32x16 s;
#pragma unroll
        for (int r = 0; r < 16; ++r) s[r] = 0.f;
#pragma unroll
        for (int ks = 0; ks < 4; ++ks) s = __builtin_amdgcn_mfma_f32_32x32x16_bf16(kf[ks], qf[ks], s, 0, 0, 0);
        if (lat && j < nloc) {
            const int kb = k_lo + j;
            const int mode = (kb == qb - 4) ? 1 : (kb == qb + 4) ? 2 : 0;
            if (mode) {
                const int dpos = (kb - qb) * 32;
#pragma unroll
                for (int r = 0; r < 16; ++r) {
                    const int rel = dpos + (r & 3) + 8 * (r >> 2) + 4 * fh - fr;
                    const bool ok = mode == 1 ? (rel >= -128) : (rel <= 128);
                    if (!ok) s[r] = -1e30f;
                }
            }
        }
        float mx = s[0];
#pragma unroll
        for (int r = 1; r < 16; ++r) mx = fmaxf(mx, s[r]);
        mx = fmaxf(mx, __shfl_xor(mx, 32));
        const float m_new = fmaxf(m_run, mx);
        const float alpha = __builtin_amdgcn_exp2f(m_run - m_new);
        float rs = 0.f;
#pragma unroll
        for (int r = 0; r < 16; ++r) { s[r] = __builtin_amdgcn_exp2f(s[r] - m_new); rs += s[r]; }
        rs += __shfl_xor(rs, 32);
        l_run = l_run * alpha + rs; m_run = m_new;
#pragma unroll
        for (int i = 0; i < 2; ++i)
#pragma unroll
            for (int r = 0; r < 16; ++r) O[i][r] *= alpha;
#pragma unroll
        for (int s2 = 0; s2 < 2; ++s2) {
            union { u32x4 u; bf16x8 v; } pf;
            pf.u.x = cvt_pk_bf16(s[8 * s2 + 0], s[8 * s2 + 1]); pf.u.y = cvt_pk_bf16(s[8 * s2 + 2], s[8 * s2 + 3]);
            pf.u.z = cvt_pk_bf16(s[8 * s2 + 4], s[8 * s2 + 5]); pf.u.w = cvt_pk_bf16(s[8 * s2 + 6], s[8 * s2 + 7]);
#pragma unroll
            for (int db = 0; db < 2; ++db) O[db] = __builtin_amdgcn_mfma_f32_32x32x16_bf16(vf[s2 * 2 + db], pf.v, O[db], 0, 0, 0);
        }
        if (j + 1 < nblk) {
            unsigned char* nb = lds + ((j + 1) & 1) * 8192;
            *(u32x4*)(nb + kst) = kreg; *(u32x4*)(nb + vst) = vreg;
            if (j + 2 < nblk) loadkv(j + 2);
        }
        __syncthreads();
    }
    const float il = 1.f / l_run;
#pragma unroll
    for (int db = 0; db < 2; ++db)
#pragma unroll
        for (int g = 0; g < 4; ++g) {
            const int col = head * 64 + db * 32 + 8 * g + 4 * fh;
            const u32x2 z = *(const u32x2*)(SZ + (size_t)qtok * D + col);
            const float z0 = __uint_as_float(z.x << 16), z1 = __uint_as_float(z.x & 0xffff0000u);
            const float z2 = __uint_as_float(z.y << 16), z3 = __uint_as_float(z.y & 0xffff0000u);
            u32x2 o; o.x = cvt_pk_bf16(O[db][4 * g] * il * z0, O[db][4 * g + 1] * il * z1);
            o.y = cvt_pk_bf16(O[db][4 * g + 2] * il * z2, O[db][4 * g + 3] * il * z3);
            *(u32x2*)(Y + (size_t)qtok * D + col) = o;
        }
}


#define XB_TMO      128
#define XB_XCNT(j)  (256  + 64 * (j))
#define XB_XSUB(j)  (1280 + 64 * (j))
#define XB_XGEN(j)  (2304 + 64 * (j))
#define XB_TOP      3328
#define XB_TOPGEN   3392
#define XCD_BAR_WORDS 3456
#define XB_SPIN_CAP (1u << 18)
#define LAS __attribute__((address_space(3)))
DEVI unsigned xb_ld(unsigned* p)              { return __hip_atomic_load(p, __ATOMIC_RELAXED, __HIP_MEMORY_SCOPE_AGENT); }
DEVI unsigned xb_add(unsigned* p, unsigned v) { return __hip_atomic_fetch_add(p, v, __ATOMIC_RELAXED, __HIP_MEMORY_SCOPE_AGENT); }
DEVI unsigned xb_xcc_id() { return (unsigned)__builtin_amdgcn_s_getreg((3 << 11) | 20) & 0xFu; }
#define XB_SPIN(cond, bar) do { unsigned _sp = 0; while (cond) { __builtin_amdgcn_s_sleep(1); \
    if ((++_sp & 255u) == 0u) { if (xb_ld(&(bar)[XB_TMO])) break; if (_sp > XB_SPIN_CAP) { atomicAdd(&(bar)[XB_TMO], 1u); break; } } } } while (0)
struct XcdBarrier { unsigned* bar; unsigned x; volatile LAS unsigned* st; };
DEVI XcdBarrier xcd_barrier_post(unsigned* bar, volatile LAS unsigned* st) {
    XcdBarrier b; b.bar = bar; b.x = xb_xcc_id(); b.st = st;
    if (threadIdx.x == 0) (void)xb_add(&bar[XB_XCNT(b.x)], 1u);
    return b;
}
DEVI void xcd_barrier_complete(unsigned* bar, unsigned x, unsigned& nloc, unsigned& nx) {
    const unsigned G = gridDim.x * gridDim.y * gridDim.z;
    unsigned sum, cnt, mine, sp = 0u;
    for (;;) {
        sum = 0u; cnt = 0u; mine = 0u;
#pragma unroll
        for (unsigned j = 0; j < 16; ++j) { const unsigned c = xb_ld(&bar[XB_XCNT(j)]); sum += c; cnt += (c > 0u) ? 1u : 0u; mine = (j == x) ? c : mine; }
        if (sum == G) break;
        __builtin_amdgcn_s_sleep(1);
        if ((++sp & 255u) == 0u) { if (xb_ld(&bar[XB_TMO])) break; if (sp > XB_SPIN_CAP) { atomicAdd(&bar[XB_TMO], 1u); break; } }
    }
    nloc = mine > 0u ? mine : 1u; nx = cnt > 0u ? cnt : 1u;
}
DEVI void xcd_barrier(const XcdBarrier& b) {
    asm volatile("s_waitcnt vmcnt(0)" ::: "memory");
    __syncthreads();
    if (threadIdx.x == 0) {
        unsigned* bar = b.bar;
        __builtin_amdgcn_s_waitcnt(0);
        unsigned nloc = b.st[0], nx = b.st[1];
        if (nloc == 0u) { xcd_barrier_complete(bar, b.x, nloc, nx); b.st[0] = nloc; b.st[1] = nx; }
        const unsigned old = xb_add(&bar[XB_XSUB(b.x)], 1u);
        const unsigned gen = old / nloc;
        if (old + 1u == (gen + 1u) * nloc) {
            __builtin_amdgcn_fence(__ATOMIC_RELEASE, "agent");
            asm volatile("s_waitcnt vmcnt(0)" ::: "memory");
            const unsigned og = xb_add(&bar[XB_TOP], 1u);
            const unsigned tg = og / nx;
            if (og + 1u == (tg + 1u) * nx) xb_add(&bar[XB_TOPGEN], 1u);
            else XB_SPIN(xb_ld(&bar[XB_TOPGEN]) == tg, bar);
            __builtin_amdgcn_fence(__ATOMIC_ACQUIRE, "agent");
            xb_add(&bar[XB_XGEN(b.x)], 1u);
            asm volatile("s_waitcnt vmcnt(0)" ::: "memory");
        } else {
            XB_SPIN(xb_ld(&bar[XB_XGEN(b.x)]) == gen, bar);
            __builtin_amdgcn_fence(__ATOMIC_ACQUIRE, "agent");
            asm volatile("s_waitcnt vmcnt(0)" ::: "memory");
        }
    }
    __syncthreads();
}

DEVI void run_phase(const Params& p, int ph, unsigned char* lds) {
    const int G = gridDim.x;
    bf16_t* H = (bf16_t*)(p.ws + WS_H);
    bf16_t* U = (bf16_t*)(p.ws + WS_U);
    bf16_t* SZ = (bf16_t*)(p.ws + WS_SZ);
    bf16_t* VT = (bf16_t*)(p.ws + WS_VT);
    bf16_t* Y = (bf16_t*)(p.ws + WS_Y);
    float* X1 = (float*)(p.ws + WS_X1);
    const float* mod = (const float*)(p.ws + WS_MOD);
    switch (ph) {
    case 0: {
        phase0(p, lds);
        if (threadIdx.x == 0) {
            unsigned* cnt = (unsigned*)(p.ws + WS_CNT); unsigned sp = 0;
            while (__hip_atomic_load(cnt, __ATOMIC_RELAXED, __HIP_MEMORY_SCOPE_AGENT) < 384u) { __builtin_amdgcn_s_sleep(4); if (++sp > (1u << 22)) break; }
        }
        __syncthreads();
        const float* modp = (const float*)(p.ws + WS_MODP);
        if (blockIdx.x < 72) {
            const int i = blockIdx.x * 256 + threadIdx.x, l = i / 9216, j = i % 3072;
            float s = (l ? p.b_mod1 : p.b_mod0)[j];
#pragma unroll
            for (int ks = 0; ks < 4; ++ks) s += __hip_atomic_load(modp + ks * 18432 + i, __ATOMIC_RELAXED, __HIP_MEMORY_SCOPE_AGENT);
            ((float*)(p.ws + WS_MOD))[i] = s;
        }
        float* lmod = (float*)lds;
        {
            float tmp[24];
#pragma unroll
            for (int q = 0; q < 24; ++q) {
                const int i = threadIdx.x + 256 * q, src_i = (i >> 11) * 3072 + (i & 2047);
                float s = p.b_mod0[i & 2047];
#pragma unroll
                for (int ks = 0; ks < 4; ++ks) s += __hip_atomic_load(modp + ks * 18432 + src_i, __ATOMIC_RELAXED, __HIP_MEMORY_SCOPE_AGENT);
                tmp[q] = s;
            }
#pragma unroll
            for (int q = 0; q < 24; ++q) lmod[threadIdx.x + 256 * q] = tmp[q];
        }
        __syncthreads();
        phase_norm(p, 0, lmod);
    } break;
    case 2: {
        EpiInL0 e{U, SZ};
        for (int t = blockIdx.x; t < 768; t += G) {
            const int tt = xcd_remap(t, 768);
            gemm_tile(H, D, (const bf16_t*)(p.ws + WS_WT0IN), D, 16, lds, e, (tt >> 4) * 128, (tt & 15) * 128);
        }
    } break;
    case 3: {
        bias1_items(p);
        for (int t = blockIdx.x; t < 768; t += G) {
            const int tt = xcd_remap(t, 768);
            const int mt = tt & 3, g = (tt >> 2) & 3, nt = tt >> 4;
            EpiChanDft e{VT, g};
            gemm_tile((const bf16_t*)(p.ws + WS_TW256), 256, U + g * 256, D, 4, lds, e, mt * 128, nt * 128);
        }
    } break;
    case 4: {
        for (int t = blockIdx.x; t < 512; t += G) {
            if (t < 256) {
                const int nt = t & 1, mt = (t >> 1) & 15, bg = t >> 5;
                EpiSeqDft<1> e{SZ, Y, NCTX + (bg >> 2) * 1024, bg & 3};
                gemm_tile<1>((const bf16_t*)(p.ws + WS_TS1024), 2048, VT + (size_t)64 * 256 * 512 + (size_t)bg * 256 * 2048, 2048, 32, lds, e, mt * 64, nt * 128);
            } else {
                const int u = t - 256, nt = u & 1, mt = (u >> 1) & 1, bg = u >> 2;
                EpiSeqDft<2> e{SZ, Y, (bg >> 2) * 256, bg & 3};
                gemm_tile<2>((const bf16_t*)(p.ws + WS_TS256), 512, VT + (size_t)bg * 256 * 512, 512, 8, lds, e, mt * 128, nt * 128);
            }
        }
    } break;
    case 5: {
        EpiOut<true, 2> e{p.x_prompt, p.x_sample, mod, X1, p.norm_w1, mod + 3 * 3072, H, (float*)(p.ws + WS_ROWSS)};
        EpiOut<true, 1> e1{p.x_prompt, p.x_sample, mod, X1, p.norm_w1, mod + 3 * 3072, H, (float*)(p.ws + WS_ROWSS)};
        if (G == 512) {
            if (blockIdx.x < 256) { const int tt = xcd_remap(blockIdx.x, 256); gemm_tile<2>(Y, D, (const bf16_t*)(p.ws + WS_WT0OUT), D, 16, lds, e, (tt >> 3) * 128, (tt & 7) * 128); }
            else { const int tt = xcd_remap(blockIdx.x - 256, 256); gemm_tile<1>(Y, D, (const bf16_t*)(p.ws + WS_WT0OUT), D, 16, lds, e1, 4096 + (tt >> 3) * 64, (tt & 7) * 128); }
        } else
        for (int t = blockIdx.x; t < 384; t += G) {
            const int tt = xcd_remap(t, 384);
            gemm_tile(Y, D, (const bf16_t*)(p.ws + WS_WT0OUT), D, 16, lds, e, (tt >> 3) * 128, (tt & 7) * 128);
        }
    } break;
    case 7: {
        EpiInL1 e{p.qnw, p.knw, (const float*)(p.ws + WS_ROPEC), (const float*)(p.ws + WS_ROPES),
                  (bf16_t*)(p.ws + WS_Q), (bf16_t*)(p.ws + WS_KB), (bf16_t*)(p.ws + WS_VTB), SZ,
                  p.out + (size_t)NTOK * D, p.out + (size_t)NTOK * D + (size_t)NCTX * 256,
                  (const float*)(p.ws + WS_ROWSS), (const float*)(p.ws + WS_BIAS1)};
        for (int t = blockIdx.x; t < 960; t += G) {
            const int tt = xcd_remap(t, 960);
            gemm_tile(H, D, (const bf16_t*)(p.ws + WS_WT1IN), D, 16, lds, e, (tt / 20) * 128, (tt % 20) * 128);
        }
    } break;
    case 8: {
        if (G == 512) {
            if (blockIdx.x < 256) attn_item(p, blockIdx.x, lds);
            else { attn_item(p, 256 + 2 * (blockIdx.x - 256), lds); attn_item(p, 257 + 2 * (blockIdx.x - 256), lds); }
        } else
            for (int t = blockIdx.x; t < 768; t += G) attn_item(p, t, lds);
    } break;
    case 9: {
        EpiOut<false, 2> e{X1, X1 + (size_t)NCTX * D, mod + 3 * 3072, p.out, nullptr, nullptr, nullptr, nullptr};
        EpiOut<false, 1> e1{X1, X1 + (size_t)NCTX * D, mod + 3 * 3072, p.out, nullptr, nullptr, nullptr, nullptr};
        if (G == 512) {
            if (blockIdx.x < 256) { const int tt = xcd_remap(blockIdx.x, 256); gemm_tile<2>(Y, D, (const bf16_t*)(p.ws + WS_WT1OUT), D, 16, lds, e, (tt >> 3) * 128, (tt & 7) * 128); }
            else { const int tt = xcd_remap(blockIdx.x - 256, 256); gemm_tile<1>(Y, D, (const bf16_t*)(p.ws + WS_WT1OUT), D, 16, lds, e1, 4096 + (tt >> 3) * 64, (tt & 7) * 128); }
        } else
        for (int t = blockIdx.x; t < 384; t += G) {
            const int tt = xcd_remap(t, 384);
            gemm_tile(Y, D, (const bf16_t*)(p.ws + WS_WT1OUT), D, 16, lds, e, (tt >> 3) * 128, (tt & 7) * 128);
        }
    } break;
    }
}

__global__ void __launch_bounds__(256, 2) mega(Params p) {
    __shared__ __attribute__((aligned(16))) unsigned char lds[65536 + 16];
    cg::grid_group grid = cg::this_grid();
#if SINGLE_LAUNCH
    volatile LAS unsigned* st = (volatile LAS unsigned*)(lds + 65536);
    if (threadIdx.x < 4) st[threadIdx.x] = 0u;
    __syncthreads();
    XcdBarrier bar = xcd_barrier_post((unsigned*)(p.ws + WS_BAR), st);
    if (p.ph_hi == 777) grid.sync();
#ifndef REP_PH
#define REP_PH -1
#endif
#ifndef REP_SY
#define REP_SY 0
#endif
#define PH(n) run_phase(p, n, lds); if (REP_PH == n) run_phase(p, n, lds);
#define SY() xcd_barrier(bar); if (REP_SY) xcd_barrier(bar);
#else
    const int lo = (int)p.ph_lo, hi = (int)p.ph_hi;
#define PH(n) if (lo <= n && n < hi) run_phase(p, n, lds);
#define SY()
#endif
    PH(0) SY() PH(2) SY() PH(3) SY() PH(4) SY() PH(5) SY() PH(7) SY() PH(8) SY() PH(9)
}

extern "C" void kernel_launch(void* const* d_in, const int* in_sizes, int n_in, void* d_out, int out_size, void* d_ws, size_t ws_size, hipStream_t stream) {
    static int grid_blocks = 0;
    if (!grid_blocks) {
        int dev = 0, cus = 0, per_cu = 0;
        hipGetDevice(&dev);
        hipDeviceGetAttribute(&cus, hipDeviceAttributeMultiprocessorCount, dev);
        hipOccupancyMaxActiveBlocksPerMultiprocessor(&per_cu, mega, 256, 0);
        if (per_cu > 2) per_cu = 2;
        if (per_cu < 1) per_cu = 1;
        grid_blocks = cus * per_cu;
    }
    Params p{};
    const float* const* in = (const float* const*)d_in;
    p.x_prompt = in[0]; p.x_sample = in[1]; p.cache_k = in[2]; p.cache_v = in[3]; p.c = in[4]; p.c_ctx = in[5];
    p.norm_w0 = in[6]; p.w_mod0 = in[7]; p.b_mod0 = in[8]; p.w_in0 = in[9]; p.w_out0 = in[10];
    p.norm_w1 = in[11]; p.w_mod1 = in[12]; p.b_mod1 = in[13]; p.w_in1 = in[14]; p.qnw = in[15]; p.knw = in[16]; p.sink = in[17]; p.w_out1 = in[18];
    p.out = (float*)d_out; p.ws = (unsigned char*)d_ws;
#if SINGLE_LAUNCH
    p.ph_lo = 0; p.ph_hi = 10;
    hipMemsetAsync((unsigned char*)d_ws + WS_BAR, 0, 16384, stream);
    void* args[] = {&p};
    hipError_t e = hipLaunchCooperativeKernel((void*)mega, dim3(grid_blocks), dim3(256), args, 0, stream);
    if (e != hipSuccess) fprintf(stderr, "cooperative launch failed: %s (grid %d)\n", hipGetErrorString(e), grid_blocks);
#else
    for (int ph = 0; ph < 10; ++ph) {
        p.ph_lo = ph; p.ph_hi = ph + 1;
        hipLaunchKernelGGL(mega, dim3(grid_blocks), dim3(256), 0, stream, p);
    }
#endif
}
```

```cpp
#include <hip/hip_runtime.h>
#include <hip/hip_cooperative_groups.h>
#include <stdint.h>
#include <cstdio>
namespace cg = cooperative_groups;

#ifndef SINGLE_LAUNCH
#define SINGLE_LAUNCH 1
#endif

typedef unsigned short bf16_t;
typedef short bf16x8 __attribute__((ext_vector_type(8)));
typedef float f32x16 __attribute__((ext_vector_type(16)));
typedef float f32x4 __attribute__((ext_vector_type(4)));
typedef unsigned u32x4 __attribute__((ext_vector_type(4)));
typedef unsigned u32x2 __attribute__((ext_vector_type(2)));
#define DEVI __device__ __forceinline__

constexpr int NTOK = 6144, NCTX = 4096, D = 1024;
constexpr float EPSV = 1e-6f;
constexpr float LOG2E = 1.4426950408889634f;

constexpr size_t WS_MOD = 0;
constexpr size_t WS_WT0IN = 1 << 20;
constexpr size_t WS_WT0OUT = WS_WT0IN + (size_t)2048 * 1024 * 2;
constexpr size_t WS_WT1IN = WS_WT0OUT + (size_t)1024 * 1024 * 2;
constexpr size_t WS_WT1OUT = WS_WT1IN + (size_t)2560 * 1024 * 2;
constexpr size_t WS_TW256 = WS_WT1OUT + (size_t)1024 * 1024 * 2;
constexpr size_t WS_TS256 = WS_TW256 + (size_t)512 * 256 * 2;
constexpr size_t WS_TS1024 = WS_TS256 + (size_t)256 * 512 * 2;
constexpr size_t WS_ROPEC = WS_TS1024 + (size_t)1024 * 2048 * 2;
constexpr size_t WS_ROPES = WS_ROPEC + (size_t)1024 * 32 * 4;
constexpr size_t WS_KC = WS_ROPES + (size_t)1024 * 32 * 4;
constexpr size_t WS_VCT = WS_KC + (size_t)2 * 256 * 256 * 2;
constexpr size_t WS_H = WS_VCT + (size_t)2 * 256 * 256 * 2;
constexpr size_t WS_U = WS_H + (size_t)NTOK * D * 2;
constexpr size_t WS_SZ = WS_U + (size_t)NTOK * D * 2;
constexpr size_t WS_VT = WS_SZ + (size_t)NTOK * D * 2;
constexpr size_t WS_Y = WS_VT + (size_t)NTOK * 2048 * 2;
constexpr size_t WS_X1 = WS_Y + (size_t)NTOK * D * 2;
constexpr size_t WS_Q = WS_X1 + (size_t)NTOK * D * 4;
constexpr size_t WS_KB = WS_Q + (size_t)NTOK * D * 2;
constexpr size_t WS_VTB = WS_KB + (size_t)NTOK * 256 * 2;
constexpr size_t WS_BAR = WS_VTB + (size_t)NTOK * 256 * 2;
constexpr size_t WS_CNT = WS_BAR + 14336;
constexpr size_t WS_ROWSS = WS_BAR + 16384;
constexpr size_t WS_BIAS1 = WS_ROWSS + 6144 * 4;
constexpr size_t WS_MODP = WS_BIAS1 + 3 * 2560 * 4;
constexpr size_t WS_END = WS_MODP + (size_t)4 * 18432 * 4;

struct Params {
    const float *x_prompt, *x_sample, *cache_k, *cache_v, *c, *c_ctx;
    const float *norm_w0, *w_mod0, *b_mod0, *w_in0, *w_out0;
    const float *norm_w1, *w_mod1, *b_mod1, *w_in1, *qnw, *knw, *sink, *w_out1;
    float* out;
    unsigned char* ws;
    long long ph_lo, ph_hi;
};

DEVI unsigned cvt_pk_bf16(float lo, float hi) { unsigned r; asm("v_cvt_pk_bf16_f32 %0, %1, %2" : "=v"(r) : "v"(lo), "v"(hi)); return r; }
DEVI bf16_t f2bf(float f) { return (bf16_t)(cvt_pk_bf16(f, 0.f) & 0xffffu); }
DEVI float silu_f(float v) { return v * __builtin_amdgcn_rcpf(1.f + __expf(-v)); }
DEVI int swap23(int x) { return (x & ~12) | ((x & 4) << 1) | ((x & 8) >> 1); }
DEVI int cond_of(int m) { return m < NCTX ? 0 : 1 + ((m - NCTX) >> 10); }

DEVI void st8(bf16_t* p, u32x2 a, u32x2 b) {
    const auto r0 = __builtin_amdgcn_permlane32_swap(a.x, b.x, false, false);
    const auto r1 = __builtin_amdgcn_permlane32_swap(a.y, b.y, false, false);
    u32x4 w; w.x = r0[0]; w.y = r1[0]; w.z = r0[1]; w.w = r1[1];
    *(u32x4*)p = w;
}
DEVI float xhalf_sum(float x) { const auto r = __builtin_amdgcn_permlane32_swap(__float_as_uint(x), __float_as_uint(x), false, false); return __uint_as_float(r[0]) + __uint_as_float(r[1]); }
DEVI float xhalf_max(float x) { const auto r = __builtin_amdgcn_permlane32_swap(__float_as_uint(x), __float_as_uint(x), false, false); return fmaxf(__uint_as_float(r[0]), __uint_as_float(r[1])); }

DEVI void glds16(const void* g, void* l) { __builtin_amdgcn_global_load_lds(g, l, 16, 0, 0); }

template <int MB = 2, class Epi>
DEVI void gemm_tile(const bf16_t* __restrict__ A, int lda, const bf16_t* __restrict__ B, int ldb, int nk,
                    unsigned char* lds, const Epi& epi, int m0, int n0) {
    const int tid = threadIdx.x, lane = tid & 63, wid = tid >> 6, wr = wid >> 1, wc = wid & 1;
    const int srow = tid >> 3;
    const int slc = (tid & 7) ^ ((tid >> 4) & 7);
    const bf16_t* gA = A + (size_t)(m0 + srow) * lda + slc * 8;
    const bf16_t* gB = B + (size_t)(n0 + srow) * ldb + slc * 8;
    const int fr = lane & 31, fh = lane >> 5, sw = (lane >> 1) & 7;
    const unsigned aoff = (wr * 32 * MB + fr) * 128, boff = 16384 + (wc * 64 + fr) * 128;
    f32x16 acc[MB][2];
#pragma unroll
    for (int i = 0; i < MB; ++i)
#pragma unroll
        for (int j = 0; j < 2; ++j)
#pragma unroll
            for (int r = 0; r < 16; ++r) acc[i][j][r] = 0.f;
    {
        unsigned char* la = lds + tid * 16;
#pragma unroll
        for (int i = 0; i < 4; ++i) {
            if (i < 2 * MB) glds16(gA + (size_t)i * 32 * lda, la + i * 4096);
            glds16(gB + (size_t)i * 32 * ldb, la + 16384 + i * 4096);
        }
    }
    for (int kt = 0; kt < nk; ++kt) {
        asm volatile("s_waitcnt vmcnt(0)" ::: "memory");
        __syncthreads();
        if (kt + 1 < nk) {
            unsigned char* la = lds + ((kt + 1) & 1) * 32768 + tid * 16;
            const int ko = (kt + 1) * 64;
#pragma unroll
            for (int i = 0; i < 4; ++i) {
                if (i < 2 * MB) glds16(gA + (size_t)i * 32 * lda + ko, la + i * 4096);
                glds16(gB + (size_t)i * 32 * ldb + ko, la + 16384 + i * 4096);
            }
        }
        const unsigned char* base = lds + (kt & 1) * 32768;
        bf16x8 af[4][2], bfr[4][2];
#define LDFRAG(ks) { const int ch = ((2 * (ks) + fh) ^ sw) * 16; \
            af[ks][0] = *(const bf16x8*)(base + aoff + ch); bfr[ks][0] = *(const bf16x8*)(base + boff + ch); \
            bfr[ks][1] = *(const bf16x8*)(base + boff + 4096 + ch); if (MB == 2) af[ks][1] = *(const bf16x8*)(base + aoff + 4096 + ch); }
#define MFMA4(ks) { acc[0][0] = __builtin_amdgcn_mfma_f32_32x32x16_bf16(bfr[ks][0], af[ks][0], acc[0][0], 0, 0, 0); \
            acc[0][1] = __builtin_amdgcn_mfma_f32_32x32x16_bf16(bfr[ks][1], af[ks][0], acc[0][1], 0, 0, 0); \
            if (MB == 2) { acc[MB - 1][0] = __builtin_amdgcn_mfma_f32_32x32x16_bf16(bfr[ks][0], af[ks][1], acc[MB - 1][0], 0, 0, 0); \
            acc[MB - 1][1] = __builtin_amdgcn_mfma_f32_32x32x16_bf16(bfr[ks][1], af[ks][1], acc[MB - 1][1], 0, 0, 0); } }
        LDFRAG(0) LDFRAG(1)
        __builtin_amdgcn_sched_barrier(0);
        MFMA4(0) LDFRAG(2)
        __builtin_amdgcn_sched_barrier(0);
        MFMA4(1) LDFRAG(3)
        __builtin_amdgcn_sched_barrier(0);
        MFMA4(2)
        __builtin_amdgcn_sched_barrier(0);
        MFMA4(3)
#undef LDFRAG
#undef MFMA4
    }
    epi(acc, m0 + wr * 32 * MB, n0 + wc * 64, fr, fh);
    __syncthreads();
}

DEVI int xcd_remap(int t, int T) { return (t & 7) * (T >> 3) + (t >> 3); }

DEVI void mod_item(const Params& p, int it, unsigned char* lds) {
    const int tid = threadIdx.x;
    const int ks = it & 3, lc = it >> 2, l = lc / 48, cc = lc % 48;
    float* sc = (float*)lds;
    for (int i = tid; i < 768; i += 256) {
        const int cv = i >> 8, k = ks * 256 + (i & 255);
        const float cval = cv == 0 ? p.c_ctx[k] : p.c[(cv - 1) * 1024 + k];
        sc[i] = silu_f(cval);
    }
    __syncthreads();
    const float* W = (l ? p.w_mod1 : p.w_mod0) + (size_t)ks * 256 * 3072;
    const int cg4 = tid & 15, rg = tid >> 4, c0 = cc * 64 + cg4 * 4;
    f32x4 w[16];
#pragma unroll
    for (int i = 0; i < 16; ++i) w[i] = *(const f32x4*)(W + (size_t)(rg + 16 * i) * 3072 + c0);
    f32x4 a0 = {0.f, 0.f, 0.f, 0.f}, a1 = a0, a2 = a0;
#pragma unroll
    for (int i = 0; i < 16; ++i) { const int k = rg + 16 * i; a0 += sc[k] * w[i]; a1 += sc[256 + k] * w[i]; a2 += sc[512 + k] * w[i]; }
    float* red = (float*)(lds + 12288);
#pragma unroll
    for (int e = 0; e < 4; ++e) {
        red[(rg * 3 + 0) * 64 + cg4 * 4 + e] = a0[e];
        red[(rg * 3 + 1) * 64 + cg4 * 4 + e] = a1[e];
        red[(rg * 3 + 2) * 64 + cg4 * 4 + e] = a2[e];
    }
    __syncthreads();
    if (tid < 192) {
        const int cv = tid >> 6, j = tid & 63;
        float s = 0.f;
#pragma unroll
        for (int r = 0; r < 16; ++r) s += red[(r * 3 + cv) * 64 + j];
        float* modp = (float*)(p.ws + WS_MODP) + (size_t)ks * 18432;
        __hip_atomic_store(&modp[(l * 3 + cv) * 3072 + cc * 64 + j], s, __ATOMIC_RELAXED, __HIP_MEMORY_SCOPE_AGENT);
    }
    asm volatile("s_waitcnt vmcnt(0)" ::: "memory");
    __syncthreads();
    if (tid == 0) __hip_atomic_fetch_add((unsigned*)(p.ws + WS_CNT), 1u, __ATOMIC_RELAXED, __HIP_MEMORY_SCOPE_AGENT);
}

struct TrDesc { const float* src; bf16_t* dst; int N, kt, nt; };
DEVI TrDesc tr_desc(const Params& p, int idx) {
    TrDesc d;
    if (idx < 512) { d.src = p.w_in0; d.dst = (bf16_t*)(p.ws + WS_WT0IN); d.N = 2048; }
    else if (idx < 768) { idx -= 512; d.src = p.w_out0; d.dst = (bf16_t*)(p.ws + WS_WT0OUT); d.N = 1024; }
    else if (idx < 1408) { idx -= 768; d.src = p.w_in1; d.dst = (bf16_t*)(p.ws + WS_WT1IN); d.N = 2560; }
    else { idx -= 1408; d.src = p.w_out1; d.dst = (bf16_t*)(p.ws + WS_WT1OUT); d.N = 1024; }
    const int ntn = d.N >> 6;
    d.kt = idx / ntn; d.nt = idx % ntn;
    return d;
}
DEVI void transpose_items(const Params& p, int first, int end, int stride, unsigned char* lds) {
    const int tid = threadIdx.x;
    float* tl = (float*)lds;
    if (first >= end) return;
    f32x4 v[4];
    TrDesc d = tr_desc(p, first);
#pragma unroll
    for (int pass = 0; pass < 4; ++pass) v[pass] = *(const f32x4*)(d.src + (size_t)(d.kt * 64 + pass * 16 + (tid >> 4)) * d.N + d.nt * 64 + (tid & 15) * 4);
    for (int idx = first; idx < end; idx += stride) {
#pragma unroll
        for (int pass = 0; pass < 4; ++pass) {
            const int r = pass * 16 + (tid >> 4), c4 = (tid & 15) * 4;
#pragma unroll
            for (int e = 0; e < 4; ++e) tl[r * 65 + c4 + e] = v[pass][e];
        }
        const TrDesc cur = d;
        if (idx + stride < end) {
            d = tr_desc(p, idx + stride);
#pragma unroll
            for (int pass = 0; pass < 4; ++pass) v[pass] = *(const f32x4*)(d.src + (size_t)(d.kt * 64 + pass * 16 + (tid >> 4)) * d.N + d.nt * 64 + (tid & 15) * 4);
        }
        __syncthreads();
#pragma unroll
        for (int pass = 0; pass < 2; ++pass) {
            const int n = pass * 32 + (tid >> 3), kc = tid & 7;
            float x[8];
#pragma unroll
            for (int j = 0; j < 8; ++j) x[j] = tl[(kc * 8 + j) * 65 + n];
            u32x4 w;
            w.x = cvt_pk_bf16(x[0], x[1]); w.y = cvt_pk_bf16(x[2], x[3]); w.z = cvt_pk_bf16(x[4], x[5]); w.w = cvt_pk_bf16(x[6], x[7]);
            *(u32x4*)(cur.dst + (size_t)(cur.nt * 64 + n) * 1024 + cur.kt * 64 + kc * 8) = w;
        }
        __syncthreads();
    }
}

DEVI void phase0(const Params& p, unsigned char* lds) {
    for (int it = blockIdx.x; it < 384; it += gridDim.x) mod_item(p, it, lds);
    transpose_items(p, (blockIdx.x + 128) % gridDim.x, 1664, gridDim.x, lds);
    const int gt = blockIdx.x * 256 + threadIdx.x, gs = gridDim.x * 256;
    bf16_t* tw256 = (bf16_t*)(p.ws + WS_TW256);
    bf16_t* ts256 = (bf16_t*)(p.ws + WS_TS256);
    bf16_t* ts1024 = (bf16_t*)(p.ws + WS_TS1024);
    float* lut = (float*)(lds + 32768);
    __syncthreads();
    for (int r = threadIdx.x; r < 1024; r += 256) lut[r] = cospif((float)r * (1.f / 512.f));
    __syncthreads();
    for (int i = gt; i < 512 * 256; i += gs) {
        const int m = i >> 8, j = i & 255, which = m >> 8, cp = m & 255;
        const int r = ((cp * j) & 255) << 2;
        tw256[i] = f2bf(which ? lut[(r - 256) & 1023] : lut[r]);
    }
    for (int i = gt; i < 256 * 512; i += gs) {
        const int sp = i >> 9, k2 = i & 511, which = k2 >> 8, s0 = k2 & 255;
        const int r = ((sp * s0) & 255) << 2;
        ts256[i] = f2bf((which ? -lut[(r - 256) & 1023] : lut[r]) * (1.f / 256.f));
    }
    for (int i = gt; i < 1024 * 2048; i += gs) {
        const int sp = i >> 11, k2 = i & 2047, which = k2 >> 10, s0 = k2 & 1023;
        const int r = (sp * s0) & 1023;
        ts1024[i] = f2bf((which ? -lut[(r - 256) & 1023] : lut[r]) * (1.f / 512.f));
    }
    float* ropec = (float*)(p.ws + WS_ROPEC);
    float* ropes = (float*)(p.ws + WS_ROPES);
    for (int i = gt; i < 1024 * 32; i += gs) {
        const int pos = i >> 5, f = i & 31;
        const int row = pos >> 6, col = pos & 63;
        const float inv = powf(10000.f, -(float)(f & 15) * (1.f / 16.f));
        const float ang = (float)(f < 16 ? row : col) * inv;
        float s, c; sincosf(ang, &s, &c);
        ropec[i] = c; ropes[i] = s;
    }
    for (int i = gt; i < NTOK; i += gs) ((float*)(p.ws + WS_ROWSS))[i] = 0.f;
    bf16_t* kc = (bf16_t*)(p.ws + WS_KC);
    bf16_t* vct = (bf16_t*)(p.ws + WS_VCT);
    for (int i = gt; i < 2 * 256 * 256; i += gs) {
        kc[i] = f2bf(p.cache_k[i]);
        const int b = i >> 16, kvh = (i >> 14) & 3, d = (i >> 8) & 63, pp = i & 255;
        const int key = swap23(pp);
        vct[i] = f2bf(p.cache_v[((b * 256 + key) * 4 + kvh) * 64 + d]);
    }
}

DEVI void phase_norm(const Params& p, int layer, const float* lmod  ) {
    const int lane = threadIdx.x & 63, wid = threadIdx.x >> 6;
    const float* nw = layer ? p.norm_w1 : p.norm_w0;
    bf16_t* H = (bf16_t*)(p.ws + WS_H);
    for (int row = blockIdx.x * 4 + wid; row < NTOK; row += gridDim.x * 4) {
        const float* xr;
        if (layer == 0) xr = row < NCTX ? p.x_prompt + (size_t)row * D : p.x_sample + (size_t)(row - NCTX) * D;
        else xr = (const float*)(p.ws + WS_X1) + (size_t)row * D;
        const float* mv = lmod + cond_of(row) * 2048;
        f32x4 v[4];
        float ss = 0.f;
#pragma unroll
        for (int i = 0; i < 4; ++i) {
            v[i] = *(const f32x4*)(xr + i * 256 + lane * 4);
            ss += v[i][0] * v[i][0] + v[i][1] * v[i][1] + v[i][2] * v[i][2] + v[i][3] * v[i][3];
        }
#pragma unroll
        for (int o = 32; o >= 1; o >>= 1) ss += __shfl_xor(ss, o);
        const float rstd = rsqrtf(ss * (1.f / 1024.f) + EPSV);
#pragma unroll
        for (int i = 0; i < 4; ++i) {
            const int k = i * 256 + lane * 4;
            const f32x4 w = *(const f32x4*)(nw + k);
            const f32x4 sh = *(const f32x4*)(mv + k);
            const f32x4 scl = *(const f32x4*)(mv + 1024 + k);
            float h[4];
#pragma unroll
            for (int e = 0; e < 4; ++e) h[e] = (v[i][e] * rstd * w[e]) * (1.f + scl[e]) + sh[e];
            u32x2 o; o.x = cvt_pk_bf16(h[0], h[1]); o.y = cvt_pk_bf16(h[2], h[3]);
            *(u32x2*)(H + (size_t)row * D + k) = o;
        }
    }
}

DEVI void bias1_items(const Params& p) {
    const int lane = threadIdx.x & 63, gw = blockIdx.x * 4 + (threadIdx.x >> 6), nw = gridDim.x * 4;
    const float* mod1 = (const float*)(p.ws + WS_MOD) + 3 * 3072;
    const bf16_t* WT = (const bf16_t*)(p.ws + WS_WT1IN);
    float* bias1 = (float*)(p.ws + WS_BIAS1);
    for (int n = gw; n < 2560; n += nw) {
        float w[16];
        const u32x4 r0 = *(const u32x4*)(WT + (size_t)n * 1024 + lane * 16), r1 = *(const u32x4*)(WT + (size_t)n * 1024 + lane * 16 + 8);
        const unsigned rr[8] = {r0.x, r0.y, r0.z, r0.w, r1.x, r1.y, r1.z, r1.w};
#pragma unroll
        for (int i = 0; i < 8; ++i) { w[2 * i] = __uint_as_float(rr[i] << 16); w[2 * i + 1] = __uint_as_float(rr[i] & 0xffff0000u); }
        float s[3];
#pragma unroll
        for (int cv = 0; cv < 3; ++cv) {
            float a = 0.f;
#pragma unroll
            for (int q = 0; q < 4; ++q) {
                const f32x4 sh = *(const f32x4*)(mod1 + cv * 3072 + lane * 16 + q * 4);
#pragma unroll
                for (int e = 0; e < 4; ++e) a += sh[e] * w[q * 4 + e];
            }
#pragma unroll
            for (int o = 32; o >= 1; o >>= 1) a += __shfl_xor(a, o);
            s[cv] = a;
        }
        if (lane == 0) { bias1[n] = s[0]; bias1[2560 + n] = s[1]; bias1[5120 + n] = s[2]; }
    }
}

struct EpiInL0 {
    bf16_t *U, *SZ;
    DEVI void operator()(const f32x16 (&acc)[2][2], int mbase, int nbase, int fr, int fh) const {
        const bool isz = nbase >= 1024;
        bf16_t* dst = isz ? SZ : U;
        const int nb0 = isz ? nbase - 1024 : nbase;
        u32x2 keep = {0u, 0u};
#pragma unroll
        for (int mb = 0; mb < 2; ++mb)
#pragma unroll
            for (int nb = 0; nb < 2; ++nb)
#pragma unroll
                for (int g = 0; g < 4; ++g) {
                    const int m = mbase + mb * 32 + fr, n = nb0 + nb * 32 + 8 * g + 4 * fh;
                    float v[4];
#pragma unroll
                    for (int e = 0; e < 4; ++e) { v[e] = acc[mb][nb][4 * g + e]; if (isz) v[e] = silu_f(v[e]); }
                    u32x2 o; o.x = cvt_pk_bf16(v[0], v[1]); o.y = cvt_pk_bf16(v[2], v[3]);
                    if ((g & 1) == 0) keep = o; else st8(dst + (size_t)m * D + n - 8 + 4 * fh, keep, o);
                }
    }
};

struct EpiChanDft {
    bf16_t* VT; int g;
    DEVI void operator()(const f32x16 (&acc)[2][2], int mbase, int nbase, int fr, int fh) const {
        int S, bgi, s0; bf16_t* base;
        if (nbase < NCTX) { S = 256; bgi = (nbase >> 8) * 4 + g; s0 = nbase & 255; base = VT; }
        else { const int t = nbase - NCTX; S = 1024; bgi = (t >> 10) * 4 + g; s0 = t & 1023; base = VT + (size_t)64 * 256 * 512; }
        u32x2 keep = {0u, 0u};
#pragma unroll
        for (int mb = 0; mb < 2; ++mb)
#pragma unroll
            for (int nb = 0; nb < 2; ++nb)
#pragma unroll
                for (int gq = 0; gq < 4; ++gq) {
                    const int m = mbase + mb * 32 + fr, which = m >> 8, cp = m & 255;
                    const int s = s0 + nb * 32 + 8 * gq + 4 * fh;
                    u32x2 o; o.x = cvt_pk_bf16(acc[mb][nb][4 * gq], acc[mb][nb][4 * gq + 1]); o.y = cvt_pk_bf16(acc[mb][nb][4 * gq + 2], acc[mb][nb][4 * gq + 3]);
                    if ((gq & 1) == 0) keep = o; else st8(base + ((size_t)bgi * 256 + cp) * (2 * S) + which * S + s - 8 + 4 * fh, keep, o);
                }
    }
};

template <int MB> struct EpiSeqDft {
    const bf16_t* SZ; bf16_t* Y; int tok0, g;
    DEVI void operator()(const f32x16 (&acc)[MB][2], int mbase, int nbase, int fr, int fh) const {
        u32x2 keep = {0u, 0u};
#pragma unroll
        for (int mb = 0; mb < MB; ++mb)
#pragma unroll
            for (int nb = 0; nb < 2; ++nb)
#pragma unroll
                for (int gq = 0; gq < 4; ++gq) {
                    const int tok = tok0 + mbase + mb * 32 + fr;
                    const int col = g * 256 + nbase + nb * 32 + 8 * gq + 4 * fh;
                    const u32x2 z = *(const u32x2*)(SZ + (size_t)tok * D + col);
                    const float z0 = __uint_as_float(z.x << 16), z1 = __uint_as_float(z.x & 0xffff0000u);
                    const float z2 = __uint_as_float(z.y << 16), z3 = __uint_as_float(z.y & 0xffff0000u);
                    u32x2 o; o.x = cvt_pk_bf16(acc[mb][nb][4 * gq] * z0, acc[mb][nb][4 * gq + 1] * z1);
                    o.y = cvt_pk_bf16(acc[mb][nb][4 * gq + 2] * z2, acc[mb][nb][4 * gq + 3] * z3);
                    if ((gq & 1) == 0) keep = o; else st8(Y + (size_t)tok * D + col - 8 + 4 * fh, keep, o);
                }
    }
};

template <bool NEXT, int MB> struct EpiOut {
    const float* xa; const float* xb;
    const float* mod;
    float* out;
    const float* nw1; const float* mod1; bf16_t* Hn; float* rowss;
    DEVI void operator()(const f32x16 (&acc)[MB][2], int mbase, int nbase, int fr, int fh) const {
        const int cv = cond_of(mbase);
        const float* gate = mod + cv * 3072 + 2048;
        u32x2 keep = {0u, 0u};
#pragma unroll
        for (int mb = 0; mb < MB; ++mb) {
            const int m = mbase + mb * 32 + fr;
            const float* xr = m < NCTX ? xa + (size_t)m * D : xb + (size_t)(m - NCTX) * D;
            float ss = 0.f;
#pragma unroll
            for (int nb = 0; nb < 2; ++nb)
#pragma unroll
                for (int g = 0; g < 4; ++g) {
                    const int n = nbase + nb * 32 + 8 * g + 4 * fh;
                    const f32x4 xv = *(const f32x4*)(xr + n);
                    const f32x4 gv = *(const f32x4*)(gate + n);
                    f32x4 o;
#pragma unroll
                    for (int e = 0; e < 4; ++e) o[e] = xv[e] + gv[e] * acc[mb][nb][4 * g + e];
                    *(f32x4*)(out + (size_t)m * D + n) = o;
                    if (NEXT) {
                        const f32x4 w = *(const f32x4*)(nw1 + n);
                        const f32x4 sc = *(const f32x4*)(mod1 + cv * 3072 + 1024 + n);
                        float h[4];
#pragma unroll
                        for (int e = 0; e < 4; ++e) { ss += o[e] * o[e]; h[e] = o[e] * w[e] * (1.f + sc[e]); }
                        u32x2 hb; hb.x = cvt_pk_bf16(h[0], h[1]); hb.y = cvt_pk_bf16(h[2], h[3]);
                        if ((g & 1) == 0) keep = hb; else st8(Hn + (size_t)m * D + n - 8 + 4 * fh, keep, hb);
                    }
                }
            if (NEXT) {
                ss = xhalf_sum(ss);
                if (fh == 0) atomicAdd(rowss + m, ss);
            }
        }
    }
};

struct EpiInL1 {
    const float *qnw, *knw, *ropec, *ropes;
    bf16_t *Q, *KB, *VTB, *SZ;
    float *outk, *outv;
    const float* rowss; const float* bias1;
    DEVI void operator()(const f32x16 (&acc_in)[2][2], int mbase, int nbase, int fr, int fh) const {
        const bool lat = mbase >= NCTX;
        u32x2 keep1 = {0u, 0u}, keep2 = {0u, 0u};
        f32x16 acc[2][2];
        {
            const float* bp = bias1 + cond_of(mbase) * 2560 + nbase;
#pragma unroll
            for (int mb = 0; mb < 2; ++mb) {
                const float rstd = rsqrtf(rowss[mbase + mb * 32 + fr] * (1.f / 1024.f) + EPSV);
#pragma unroll
                for (int nb = 0; nb < 2; ++nb)
#pragma unroll
                    for (int g = 0; g < 4; ++g) {
                        const f32x4 bv = *(const f32x4*)(bp + nb * 32 + 8 * g + 4 * fh);
#pragma unroll
                        for (int e = 0; e < 4; ++e) acc[mb][nb][4 * g + e] = acc_in[mb][nb][4 * g + e] * rstd + bv[e];
                    }
            }
        }
        if (nbase < 1280) {
            const bool isq = nbase < 1024;
            const float* nwp = isq ? qnw : knw;
#pragma unroll
            for (int mb = 0; mb < 2; ++mb) {
                const int m = mbase + mb * 32 + fr;
                float ss = 0.f;
#pragma unroll
                for (int nb = 0; nb < 2; ++nb)
#pragma unroll
                    for (int r = 0; r < 16; ++r) ss += acc[mb][nb][r] * acc[mb][nb][r];
                ss = xhalf_sum(ss);
                const float rn = rsqrtf(ss * (1.f / 64.f) + EPSV);
                const int pos = lat ? ((m - NCTX) & 1023) : 0;
#pragma unroll
                for (int g = 0; g < 4; ++g) {
                    const int d0 = 8 * g + 4 * fh;
                    const f32x4 w1 = *(const f32x4*)(nwp + d0), w2 = *(const f32x4*)(nwp + 32 + d0);
                    float x1[4], x2[4];
#pragma unroll
                    for (int e = 0; e < 4; ++e) { x1[e] = acc[mb][0][4 * g + e] * rn * w1[e]; x2[e] = acc[mb][1][4 * g + e] * rn * w2[e]; }
                    if (lat) {
                        const f32x4 cv = *(const f32x4*)(ropec + pos * 32 + d0), sv = *(const f32x4*)(ropes + pos * 32 + d0);
#pragma unroll
                        for (int e = 0; e < 4; ++e) { const float a = x1[e], b = x2[e]; x1[e] = a * cv[e] - b * sv[e]; x2[e] = a * sv[e] + b * cv[e]; }
                    }
                    if (isq) {
                        const float qs = 0.125f * LOG2E;
                        u32x2 o1, o2;
                        o1.x = cvt_pk_bf16(x1[0] * qs, x1[1] * qs); o1.y = cvt_pk_bf16(x1[2] * qs, x1[3] * qs);
                        o2.x = cvt_pk_bf16(x2[0] * qs, x2[1] * qs); o2.y = cvt_pk_bf16(x2[2] * qs, x2[3] * qs);
                        if ((g & 1) == 0) { keep1 = o1; keep2 = o2; }
                        else { st8(Q + (size_t)m * D + nbase + d0 - 8 + 4 * fh, keep1, o1); st8(Q + (size_t)m * D + nbase + 32 + d0 - 8 + 4 * fh, keep2, o2); }
                    } else {
                        const int kc = nbase - 1024;
                        u32x2 o1, o2;
                        o1.x = cvt_pk_bf16(x1[0], x1[1]); o1.y = cvt_pk_bf16(x1[2], x1[3]);
                        o2.x = cvt_pk_bf16(x2[0], x2[1]); o2.y = cvt_pk_bf16(x2[2], x2[3]);
                        if ((g & 1) == 0) { keep1 = o1; keep2 = o2; }
                        else { st8(KB + (size_t)m * 256 + kc + d0 - 8 + 4 * fh, keep1, o1); st8(KB + (size_t)m * 256 + kc + 32 + d0 - 8 + 4 * fh, keep2, o2); }
                        if (!lat) {
                            f32x4 f1 = {x1[0], x1[1], x1[2], x1[3]}, f2 = {x2[0], x2[1], x2[2], x2[3]};
                            *(f32x4*)(outk + (size_t)m * 256 + kc + d0) = f1;
                            *(f32x4*)(outk + (size_t)m * 256 + kc + 32 + d0) = f2;
                        }
                    }
                }
            }
        } else if (nbase < 1536) {
            const int vc = nbase - 1280, kvh = vc >> 6;
#pragma unroll
            for (int mb = 0; mb < 2; ++mb) {
                const int m = mbase + mb * 32 + fr;
                bf16_t* vt; int S, s;
                if (!lat) { S = 256; s = m & 255; vt = VTB + ((size_t)((m >> 8) * 4 + kvh) * 64) * 256; }
                else { const int t = m - NCTX; S = 1024; s = t & 1023; vt = VTB + (size_t)16 * 4 * 64 * 256 + ((size_t)((t >> 10) * 4 + kvh) * 64) * 1024; }
                const int sp = swap23(s);
#pragma unroll
                for (int nb = 0; nb < 2; ++nb)
#pragma unroll
                    for (int g = 0; g < 4; ++g) {
                        const int d0 = nb * 32 + 8 * g + 4 * fh;
#pragma unroll
                        for (int e = 0; e < 4; ++e) vt[(size_t)(d0 + e) * S + sp] = f2bf(acc[mb][nb][4 * g + e]);
                        if (!lat) {
                            f32x4 f = {acc[mb][nb][4 * g], acc[mb][nb][4 * g + 1], acc[mb][nb][4 * g + 2], acc[mb][nb][4 * g + 3]};
                            *(f32x4*)(outv + (size_t)m * 256 + vc + d0) = f;
                        }
                    }
            }
        } else {
            const int zc = nbase - 1536;
#pragma unroll
            for (int mb = 0; mb < 2; ++mb)
#pragma unroll
                for (int nb = 0; nb < 2; ++nb)
#pragma unroll
                    for (int g = 0; g < 4; ++g) {
                        const int m = mbase + mb * 32 + fr, n = zc + nb * 32 + 8 * g + 4 * fh;
                        u32x2 o; o.x = cvt_pk_bf16(silu_f(acc[mb][nb][4 * g]), silu_f(acc[mb][nb][4 * g + 1]));
                        o.y = cvt_pk_bf16(silu_f(acc[mb][nb][4 * g + 2]), silu_f(acc[mb][nb][4 * g + 3]));
                        if ((g & 1) == 0) keep1 = o; else st8(SZ + (size_t)m * D + n - 8 + 4 * fh, keep1, o);
                    }
        }
    }
};

DEVI void attn_item(const Params& p, int item, unsigned char* lds) {
    const int lane = threadIdx.x & 63, w = threadIdx.x >> 6, fr = lane & 31, fh = lane >> 5;
    const bf16_t* Q = (const bf16_t*)(p.ws + WS_Q);
    const bf16_t* KB = (const bf16_t*)(p.ws + WS_KB);
    const bf16_t* VTB = (const bf16_t*)(p.ws + WS_VTB);
    const bf16_t* KC = (const bf16_t*)(p.ws + WS_KC);
    const bf16_t* VCT = (const bf16_t*)(p.ws + WS_VCT);
    const bf16_t* SZ = (const bf16_t*)(p.ws + WS_SZ);
    bf16_t* Y = (bf16_t*)(p.ws + WS_Y);
    bool lat; int b, kvh, qb, tb;
    if (item < 256) { lat = true; b = item >> 7; kvh = (item >> 5) & 3; qb = item & 31; tb = NCTX + b * 1024; }
    else { const int it = item - 256; lat = false; b = it >> 5; kvh = (it >> 3) & 3; qb = it & 7; tb = b * 256; }
    const int head = kvh * 4 + w;
    const int qtok = tb + qb * 32 + fr;
    bf16x8 qf[4];
#pragma unroll
    for (int ks = 0; ks < 4; ++ks) qf[ks] = *(const bf16x8*)(Q + (size_t)qtok * D + head * 64 + ks * 16 + fh * 8);
    float m_run = p.sink[head] * LOG2E, l_run = 1.f;
    f32x16 O[2];
#pragma unroll
    for (int i = 0; i < 2; ++i)
#pragma unroll
        for (int r = 0; r < 16; ++r) O[i][r] = 0.f;

    int nloc, k_lo = 0; const bf16_t *kloc, *vloc; int ldloc;
    if (lat) {
        k_lo = qb - 4 < 0 ? 0 : qb - 4; const int k_hi = qb + 4 > 31 ? 31 : qb + 4; nloc = k_hi - k_lo + 1;
        kloc = KB + (size_t)(tb + k_lo * 32) * 256 + kvh * 64;
        vloc = VTB + (size_t)16 * 4 * 64 * 256 + ((size_t)(b * 4 + kvh) * 64) * 1024 + k_lo * 32; ldloc = 1024;
    } else {
        nloc = 8; kloc = KB + (size_t)tb * 256 + kvh * 64; vloc = VTB + ((size_t)(b * 4 + kvh) * 64) * 256; ldloc = 256;
    }
    const int nblk = lat ? nloc + 8 : 8;
    const bf16_t* kcb = KC + (size_t)(b * 256) * 256 + kvh * 64;
    const bf16_t* vcb = VCT + ((size_t)(b * 4 + kvh) * 64) * 256;
    const int tid = threadIdx.x;
    const int kkey = tid >> 3, kch = tid & 7, vd = tid >> 2, vch = tid & 3;
    const unsigned kst = kkey * 128 + ((kch ^ ((kkey >> 1) & 7)) << 4), vst = 4096 + vd * 64 + ((vch ^ ((vd >> 2) & 3)) << 4);
    const unsigned ksw = (fr >> 1) & 7, vsw = (fr >> 2) & 3;
    u32x4 kreg, vreg;
    auto loadkv = [&](int j) {
        const bf16_t *kp, *vp; int ldv;
        if (j < nloc) { kp = kloc + (size_t)j * 32 * 256; vp = vloc + j * 32; ldv = ldloc; }
        else { const int c = j - nloc; kp = kcb + (size_t)c * 32 * 256; vp = vcb + c * 32; ldv = 256; }
        kreg = *(const u32x4*)(kp + (size_t)kkey * 256 + kch * 8);
        vreg = *(const u32x4*)(vp + (size_t)vd * ldv + vch * 8);
    };
    loadkv(0);
    *(u32x4*)(lds + kst) = kreg; *(u32x4*)(lds + vst) = vreg;
    if (nblk > 1) loadkv(1);
    __syncthreads();
    for (int j = 0; j < nblk; ++j) {
        const unsigned char* lb = lds + (j & 1) * 8192;
        bf16x8 kf[4], vf[4];
#pragma unroll
        for (int ks = 0; ks < 4; ++ks) kf[ks] = *(const bf16x8*)(lb + fr * 128 + (((2 * ks + fh) ^ ksw) << 4));
#pragma unroll
        for (int s2 = 0; s2 < 2; ++s2)
#pragma unroll
            for (int db = 0; db < 2; ++db) vf[s2 * 2 + db] = *(const bf16x8*)(lb + 4096 + (db * 32 + fr) * 64 + (((2 * s2 + fh) ^ vsw) << 4));
        f32x16 s;
#pragma unroll
        for (int r = 0; r < 16; ++r) s[r] = 0.f;
#pragma unroll
        for (int ks = 0; ks < 4; ++ks) s = __builtin_amdgcn_mfma_f32_32x32x16_bf16(kf[ks], qf[ks], s, 0, 0, 0);
        if (lat && j < nloc) {
            const int kb = k_lo + j;
            const int mode = (kb == qb - 4) ? 1 : (kb == qb + 4) ? 2 : 0;
            if (mode) {
                const int dpos = (kb - qb) * 32;
#pragma unroll
                for (int r = 0; r < 16; ++r) {
                    const int rel = dpos + (r & 3) + 8 * (r >> 2) + 4 * fh - fr;
                    const bool ok = mode == 1 ? (rel >= -128) : (rel <= 128);
                    if (!ok) s[r] = -1e30f;
                }
            }
        }
        float mx = s[0];
#pragma unroll
        for (int r = 1; r < 16; ++r) mx = fmaxf(mx, s[r]);
        mx = xhalf_max(mx);
        const float m_new = fmaxf(m_run, mx);
        const float alpha = __builtin_amdgcn_exp2f(m_run - m_new);
        float rs = 0.f;
#pragma unroll
        for (int r = 0; r < 16; ++r) { s[r] = __builtin_amdgcn_exp2f(s[r] - m_new); rs += s[r]; }
        rs = xhalf_sum(rs);
        l_run = l_run * alpha + rs; m_run = m_new;
#pragma unroll
        for (int i = 0; i < 2; ++i)
#pragma unroll
            for (int r = 0; r < 16; ++r) O[i][r] *= alpha;
#pragma unroll
        for (int s2 = 0; s2 < 2; ++s2) {
            union { u32x4 u; bf16x8 v; } pf;
            pf.u.x = cvt_pk_bf16(s[8 * s2 + 0], s[8 * s2 + 1]); pf.u.y = cvt_pk_bf16(s[8 * s2 + 2], s[8 * s2 + 3]);
            pf.u.z = cvt_pk_bf16(s[8 * s2 + 4], s[8 * s2 + 5]); pf.u.w = cvt_pk_bf16(s[8 * s2 + 6], s[8 * s2 + 7]);
#pragma unroll
            for (int db = 0; db < 2; ++db) O[db] = __builtin_amdgcn_mfma_f32_32x32x16_bf16(vf[s2 * 2 + db], pf.v, O[db], 0, 0, 0);
        }
        if (j + 1 < nblk) {
            unsigned char* nb = lds + ((j + 1) & 1) * 8192;
            *(u32x4*)(nb + kst) = kreg; *(u32x4*)(nb + vst) = vreg;
            if (j + 2 < nblk) loadkv(j + 2);
        }
        __syncthreads();
    }
    const float il = 1.f / l_run;
    u32x2 keepy = {0u, 0u};
#pragma unroll
    for (int db = 0; db < 2; ++db)
#pragma unroll
        for (int g = 0; g < 4; ++g) {
            const int col = head * 64 + db * 32 + 8 * g + 4 * fh;
            const u32x2 z = *(const u32x2*)(SZ + (size_t)qtok * D + col);
            const float z0 = __uint_as_float(z.x << 16), z1 = __uint_as_float(z.x & 0xffff0000u);
            const float z2 = __uint_as_float(z.y << 16), z3 = __uint_as_float(z.y & 0xffff0000u);
            u32x2 o; o.x = cvt_pk_bf16(O[db][4 * g] * il * z0, O[db][4 * g + 1] * il * z1);
            o.y = cvt_pk_bf16(O[db][4 * g + 2] * il * z2, O[db][4 * g + 3] * il * z3);
            if ((g & 1) == 0) keepy = o; else st8(Y + (size_t)qtok * D + col - 8 + 4 * fh, keepy, o);
        }
}


#define XB_TMO      128
#define XB_XCNT(j)  (256  + 64 * (j))
#define XB_XSUB(j)  (1280 + 64 * (j))
#define XB_XGEN(j)  (2304 + 64 * (j))
#define XB_TOP      3328
#define XB_TOPGEN   3392
#define XCD_BAR_WORDS 3456
#define XB_SPIN_CAP (1u << 18)
#define LAS __attribute__((address_space(3)))
DEVI unsigned xb_ld(unsigned* p)              { return __hip_atomic_load(p, __ATOMIC_RELAXED, __HIP_MEMORY_SCOPE_AGENT); }
DEVI unsigned xb_add(unsigned* p, unsigned v) { return __hip_atomic_fetch_add(p, v, __ATOMIC_RELAXED, __HIP_MEMORY_SCOPE_AGENT); }
DEVI unsigned xb_xcc_id() { return (unsigned)__builtin_amdgcn_s_getreg((3 << 11) | 20) & 0xFu; }
#define XB_SPIN(cond, bar) do { unsigned _sp = 0; while (cond) { __builtin_amdgcn_s_sleep(1); \
    if ((++_sp & 255u) == 0u) { if (xb_ld(&(bar)[XB_TMO])) break; if (_sp > XB_SPIN_CAP) { atomicAdd(&(bar)[XB_TMO], 1u); break; } } } } while (0)
struct XcdBarrier { unsigned* bar; unsigned x; volatile LAS unsigned* st; };
DEVI XcdBarrier xcd_barrier_post(unsigned* bar, volatile LAS unsigned* st) {
    XcdBarrier b; b.bar = bar; b.x = xb_xcc_id(); b.st = st;
    if (threadIdx.x == 0) (void)xb_add(&bar[XB_XCNT(b.x)], 1u);
    return b;
}
DEVI void xcd_barrier_complete(unsigned* bar, unsigned x, unsigned& nloc, unsigned& nx) {
    const unsigned G = gridDim.x * gridDim.y * gridDim.z;
    unsigned sum, cnt, mine, sp = 0u;
    for (;;) {
        sum = 0u; cnt = 0u; mine = 0u;
#pragma unroll
        for (unsigned j = 0; j < 16; ++j) { const unsigned c = xb_ld(&bar[XB_XCNT(j)]); sum += c; cnt += (c > 0u) ? 1u : 0u; mine = (j == x) ? c : mine; }
        if (sum == G) break;
        __builtin_amdgcn_s_sleep(1);
        if ((++sp & 255u) == 0u) { if (xb_ld(&bar[XB_TMO])) break; if (sp > XB_SPIN_CAP) { atomicAdd(&bar[XB_TMO], 1u); break; } }
    }
    nloc = mine > 0u ? mine : 1u; nx = cnt > 0u ? cnt : 1u;
}
DEVI void xcd_barrier(const XcdBarrier& b) {
    asm volatile("s_waitcnt vmcnt(0)" ::: "memory");
    __syncthreads();
    if (threadIdx.x == 0) {
        unsigned* bar = b.bar;
        __builtin_amdgcn_s_waitcnt(0);
        unsigned nloc = b.st[0], nx = b.st[1];
        if (nloc == 0u) { xcd_barrier_complete(bar, b.x, nloc, nx); b.st[0] = nloc; b.st[1] = nx; }
        const unsigned old = xb_add(&bar[XB_XSUB(b.x)], 1u);
        const unsigned gen = old / nloc;
        if (old + 1u == (gen + 1u) * nloc) {
            __builtin_amdgcn_fence(__ATOMIC_RELEASE, "agent");
            asm volatile("s_waitcnt vmcnt(0)" ::: "memory");
            const unsigned og = xb_add(&bar[XB_TOP], 1u);
            const unsigned tg = og / nx;
            if (og + 1u == (tg + 1u) * nx) xb_add(&bar[XB_TOPGEN], 1u);
            else XB_SPIN(xb_ld(&bar[XB_TOPGEN]) == tg, bar);
            __builtin_amdgcn_fence(__ATOMIC_ACQUIRE, "agent");
            xb_add(&bar[XB_XGEN(b.x)], 1u);
            asm volatile("s_waitcnt vmcnt(0)" ::: "memory");
        } else {
            XB_SPIN(xb_ld(&bar[XB_XGEN(b.x)]) == gen, bar);
            __builtin_amdgcn_fence(__ATOMIC_ACQUIRE, "agent");
            asm volatile("s_waitcnt vmcnt(0)" ::: "memory");
        }
    }
    __syncthreads();
}

DEVI void run_phase(const Params& p, int ph, unsigned char* lds) {
    const int G = gridDim.x;
    bf16_t* H = (bf16_t*)(p.ws + WS_H);
    bf16_t* U = (bf16_t*)(p.ws + WS_U);
    bf16_t* SZ = (bf16_t*)(p.ws + WS_SZ);
    bf16_t* VT = (bf16_t*)(p.ws + WS_VT);
    bf16_t* Y = (bf16_t*)(p.ws + WS_Y);
    float* X1 = (float*)(p.ws + WS_X1);
    const float* mod = (const float*)(p.ws + WS_MOD);
    switch (ph) {
    case 0: {
        phase0(p, lds);
        if (threadIdx.x == 0) {
            unsigned* cnt = (unsigned*)(p.ws + WS_CNT); unsigned sp = 0;
            while (__hip_atomic_load(cnt, __ATOMIC_RELAXED, __HIP_MEMORY_SCOPE_AGENT) < 384u) { __builtin_amdgcn_s_sleep(4); if (++sp > (1u << 22)) break; }
        }
        __syncthreads();
        const float* modp = (const float*)(p.ws + WS_MODP);
        if (blockIdx.x < 72) {
            const int i = blockIdx.x * 256 + threadIdx.x, l = i / 9216, j = i % 3072;
            float s = (l ? p.b_mod1 : p.b_mod0)[j];
#pragma unroll
            for (int ks = 0; ks < 4; ++ks) s += __hip_atomic_load(modp + ks * 18432 + i, __ATOMIC_RELAXED, __HIP_MEMORY_SCOPE_AGENT);
            ((float*)(p.ws + WS_MOD))[i] = s;
        }
        float* lmod = (float*)lds;
        {
            float tmp[24];
#pragma unroll
            for (int q = 0; q < 24; ++q) {
                const int i = threadIdx.x + 256 * q, src_i = (i >> 11) * 3072 + (i & 2047);
                float s = p.b_mod0[i & 2047];
#pragma unroll
                for (int ks = 0; ks < 4; ++ks) s += __hip_atomic_load(modp + ks * 18432 + src_i, __ATOMIC_RELAXED, __HIP_MEMORY_SCOPE_AGENT);
                tmp[q] = s;
            }
#pragma unroll
            for (int q = 0; q < 24; ++q) lmod[threadIdx.x + 256 * q] = tmp[q];
        }
        __syncthreads();
        phase_norm(p, 0, lmod);
    } break;
    case 2: {
        EpiInL0 e{U, SZ};
        for (int t = blockIdx.x; t < 768; t += G) {
            const int tt = xcd_remap(t, 768);
            gemm_tile(H, D, (const bf16_t*)(p.ws + WS_WT0IN), D, 16, lds, e, (tt >> 4) * 128, (tt & 15) * 128);
        }
    } break;
    case 3: {
        bias1_items(p);
        for (int t = blockIdx.x; t < 768; t += G) {
            const int tt = xcd_remap(t, 768);
            const int mt = tt & 3, g = (tt >> 2) & 3, nt = tt >> 4;
            EpiChanDft e{VT, g};
            gemm_tile((const bf16_t*)(p.ws + WS_TW256), 256, U + g * 256, D, 4, lds, e, mt * 128, nt * 128);
        }
    } break;
    case 4: {
        for (int t = blockIdx.x; t < 512; t += G) {
            if (t < 256) {
                const int nt = t & 1, mt = (t >> 1) & 15, bg = t >> 5;
                EpiSeqDft<1> e{SZ, Y, NCTX + (bg >> 2) * 1024, bg & 3};
                gemm_tile<1>((const bf16_t*)(p.ws + WS_TS1024), 2048, VT + (size_t)64 * 256 * 512 + (size_t)bg * 256 * 2048, 2048, 32, lds, e, mt * 64, nt * 128);
            } else {
                const int u = t - 256, nt = u & 1, mt = (u >> 1) & 1, bg = u >> 2;
                EpiSeqDft<2> e{SZ, Y, (bg >> 2) * 256, bg & 3};
                gemm_tile<2>((const bf16_t*)(p.ws + WS_TS256), 512, VT + (size_t)bg * 256 * 512, 512, 8, lds, e, mt * 128, nt * 128);
            }
        }
    } break;
    case 5: {
        EpiOut<true, 2> e{p.x_prompt, p.x_sample, mod, X1, p.norm_w1, mod + 3 * 3072, H, (float*)(p.ws + WS_ROWSS)};
        EpiOut<true, 1> e1{p.x_prompt, p.x_sample, mod, X1, p.norm_w1, mod + 3 * 3072, H, (float*)(p.ws + WS_ROWSS)};
        if (G == 512) {
            if (blockIdx.x < 256) { const int tt = xcd_remap(blockIdx.x, 256); gemm_tile<2>(Y, D, (const bf16_t*)(p.ws + WS_WT0OUT), D, 16, lds, e, (tt >> 3) * 128, (tt & 7) * 128); }
            else { const int tt = xcd_remap(blockIdx.x - 256, 256); gemm_tile<1>(Y, D, (const bf16_t*)(p.ws + WS_WT0OUT), D, 16, lds, e1, 4096 + (tt >> 3) * 64, (tt & 7) * 128); }
        } else
        for (int t = blockIdx.x; t < 384; t += G) {
            const int tt = xcd_remap(t, 384);
            gemm_tile(Y, D, (const bf16_t*)(p.ws + WS_WT0OUT), D, 16, lds, e, (tt >> 3) * 128, (tt & 7) * 128);
        }
    } break;
    case 7: {
        EpiInL1 e{p.qnw, p.knw, (const float*)(p.ws + WS_ROPEC), (const float*)(p.ws + WS_ROPES),
                  (bf16_t*)(p.ws + WS_Q), (bf16_t*)(p.ws + WS_KB), (bf16_t*)(p.ws + WS_VTB), SZ,
                  p.out + (size_t)NTOK * D, p.out + (size_t)NTOK * D + (size_t)NCTX * 256,
                  (const float*)(p.ws + WS_ROWSS), (const float*)(p.ws + WS_BIAS1)};
        for (int t = blockIdx.x; t < 960; t += G) {
            const int tt = xcd_remap(t, 960);
            gemm_tile(H, D, (const bf16_t*)(p.ws + WS_WT1IN), D, 16, lds, e, (tt / 20) * 128, (tt % 20) * 128);
        }
    } break;
    case 8: {
        if (G == 512) {
            if (blockIdx.x < 256) attn_item(p, blockIdx.x, lds);
            else { attn_item(p, 256 + 2 * (blockIdx.x - 256), lds); attn_item(p, 257 + 2 * (blockIdx.x - 256), lds); }
        } else
            for (int t = blockIdx.x; t < 768; t += G) attn_item(p, t, lds);
    } break;
    case 9: {
        EpiOut<false, 2> e{X1, X1 + (size_t)NCTX * D, mod + 3 * 3072, p.out, nullptr, nullptr, nullptr, nullptr};
        EpiOut<false, 1> e1{X1, X1 + (size_t)NCTX * D, mod + 3 * 3072, p.out, nullptr, nullptr, nullptr, nullptr};
        if (G == 512) {
            if (blockIdx.x < 256) { const int tt = xcd_remap(blockIdx.x, 256); gemm_tile<2>(Y, D, (const bf16_t*)(p.ws + WS_WT1OUT), D, 16, lds, e, (tt >> 3) * 128, (tt & 7) * 128); }
            else { const int tt = xcd_remap(blockIdx.x - 256, 256); gemm_tile<1>(Y, D, (const bf16_t*)(p.ws + WS_WT1OUT), D, 16, lds, e1, 4096 + (tt >> 3) * 64, (tt & 7) * 128); }
        } else
        for (int t = blockIdx.x; t < 384; t += G) {
            const int tt = xcd_remap(t, 384);
            gemm_tile(Y, D, (const bf16_t*)(p.ws + WS_WT1OUT), D, 16, lds, e, (tt >> 3) * 128, (tt & 7) * 128);
        }
    } break;
    }
}

__global__ void __launch_bounds__(256, 2) mega(Params p) {
    __shared__ __attribute__((aligned(16))) unsigned char lds[65536 + 16];
    cg::grid_group grid = cg::this_grid();
#if SINGLE_LAUNCH
    volatile LAS unsigned* st = (volatile LAS unsigned*)(lds + 65536);
    if (threadIdx.x < 4) st[threadIdx.x] = 0u;
    __syncthreads();
    XcdBarrier bar = xcd_barrier_post((unsigned*)(p.ws + WS_BAR), st);
    if (p.ph_hi == 777) grid.sync();
#ifndef REP_PH
#define REP_PH -1
#endif
#ifndef REP_SY
#define REP_SY 0
#endif
#define PH(n) run_phase(p, n, lds); if (REP_PH == n) run_phase(p, n, lds);
#define SY() xcd_barrier(bar); if (REP_SY) xcd_barrier(bar);
#else
    const int lo = (int)p.ph_lo, hi = (int)p.ph_hi;
#define PH(n) if (lo <= n && n < hi) run_phase(p, n, lds);
#define SY()
#endif
    PH(0) SY() PH(2) SY() PH(3) SY() PH(4) SY() PH(5) SY() PH(7) SY() PH(8) SY() PH(9)
}

extern "C" void kernel_launch(void* const* d_in, const int* in_sizes, int n_in, void* d_out, int out_size, void* d_ws, size_t ws_size, hipStream_t stream) {
    static int grid_blocks = 0;
    if (!grid_blocks) {
        int dev = 0, cus = 0, per_cu = 0;
        hipGetDevice(&dev);
        hipDeviceGetAttribute(&cus, hipDeviceAttributeMultiprocessorCount, dev);
        hipOccupancyMaxActiveBlocksPerMultiprocessor(&per_cu, mega, 256, 0);
        if (per_cu > 2) per_cu = 2;
        if (per_cu < 1) per_cu = 1;
        grid_blocks = cus * per_cu;
    }
    Params p{};
    const float* const* in = (const float* const*)d_in;
    p.x_prompt = in[0]; p.x_sample = in[1]; p.cache_k = in[2]; p.cache_v = in[3]; p.c = in[4]; p.c_ctx = in[5];
    p.norm_w0 = in[6]; p.w_mod0 = in[7]; p.b_mod0 = in[8]; p.w_in0 = in[9]; p.w_out0 = in[10];
    p.norm_w1 = in[11]; p.w_mod1 = in[12]; p.b_mod1 = in[13]; p.w_in1 = in[14]; p.qnw = in[15]; p.knw = in[16]; p.sink = in[17]; p.w_out1 = in[18];
    p.out = (float*)d_out; p.ws = (unsigned char*)d_ws;
#if SINGLE_LAUNCH
    p.ph_lo = 0; p.ph_hi = 10;
    hipMemsetAsync((unsigned char*)d_ws + WS_BAR, 0, 16384, stream);
    void* args[] = {&p};
    hipError_t e = hipLaunchCooperativeKernel((void*)mega, dim3(grid_blocks), dim3(256), args, 0, stream);
    if (e != hipSuccess) fprintf(stderr, "cooperative launch failed: %s (grid %d)\n", hipGetErrorString(e), grid_blocks);
#else
    for (int ph = 0; ph < 10; ++ph) {
        p.ph_lo = ph; p.ph_hi = ph + 1;
        hipLaunchKernelGGL(mega, dim3(grid_blocks), dim3(256), 0, stream, p);
    }
#endif
}
```

```cpp
#include <hip/hip_runtime.h>
#include <hip/hip_cooperative_groups.h>
#include <stdint.h>
#include <cstdio>
namespace cg = cooperative_groups;

#ifndef SINGLE_LAUNCH
#define SINGLE_LAUNCH 1
#endif

typedef unsigned short bf16_t;
typedef short bf16x8 __attribute__((ext_vector_type(8)));
typedef float f32x16 __attribute__((ext_vector_type(16)));
typedef float f32x4 __attribute__((ext_vector_type(4)));
typedef unsigned u32x4 __attribute__((ext_vector_type(4)));
typedef unsigned u32x2 __attribute__((ext_vector_type(2)));
#define DEVI __device__ __forceinline__

constexpr int NTOK = 6144, NCTX = 4096, D = 1024;
constexpr float EPSV = 1e-6f;
constexpr float LOG2E = 1.4426950408889634f;

constexpr size_t WS_MOD = 0;
constexpr size_t WS_WT0IN = 1 << 20;
constexpr size_t WS_WT0OUT = WS_WT0IN + (size_t)2048 * 1024 * 2;
constexpr size_t WS_WT1IN = WS_WT0OUT + (size_t)1024 * 1024 * 2;
constexpr size_t WS_WT1OUT = WS_WT1IN + (size_t)2560 * 1024 * 2;
constexpr size_t WS_TW256 = WS_WT1OUT + (size_t)1024 * 1024 * 2;
constexpr size_t WS_TS256 = WS_TW256 + (size_t)512 * 256 * 2;
constexpr size_t WS_TS1024 = WS_TS256 + (size_t)256 * 512 * 2;
constexpr size_t WS_ROPEC = WS_TS1024 + (size_t)1024 * 2048 * 2;
constexpr size_t WS_ROPES = WS_ROPEC + (size_t)1024 * 32 * 4;
constexpr size_t WS_KC = WS_ROPES + (size_t)1024 * 32 * 4;
constexpr size_t WS_VCT = WS_KC + (size_t)2 * 256 * 256 * 2;
constexpr size_t WS_H = WS_VCT + (size_t)2 * 256 * 256 * 2;
constexpr size_t WS_U = WS_H + (size_t)NTOK * D * 2;
constexpr size_t WS_SZ = WS_U + (size_t)NTOK * D * 2;
constexpr size_t WS_VT = WS_SZ + (size_t)NTOK * D * 2;
constexpr size_t WS_Y = WS_VT + (size_t)NTOK * 2048 * 2;
constexpr size_t WS_X1 = WS_Y + (size_t)NTOK * D * 2;
constexpr size_t WS_Q = WS_X1 + (size_t)NTOK * D * 4;
constexpr size_t WS_KB = WS_Q + (size_t)NTOK * D * 2;
constexpr size_t WS_VTB = WS_KB + (size_t)NTOK * 256 * 2;
constexpr size_t WS_BAR = WS_VTB + (size_t)NTOK * 256 * 2;
constexpr size_t WS_CNT = WS_BAR + 14336;
constexpr size_t WS_ROWSS = WS_BAR + 16384;
constexpr size_t WS_BIAS1 = WS_ROWSS + 6144 * 4;
constexpr size_t WS_MODP = WS_BIAS1 + 3 * 2560 * 4;
constexpr size_t WS_END = WS_MODP + (size_t)4 * 18432 * 4;

struct Params {
    const float *x_prompt, *x_sample, *cache_k, *cache_v, *c, *c_ctx;
    const float *norm_w0, *w_mod0, *b_mod0, *w_in0, *w_out0;
    const float *norm_w1, *w_mod1, *b_mod1, *w_in1, *qnw, *knw, *sink, *w_out1;
    float* out;
    unsigned char* ws;
    long long ph_lo, ph_hi;
};

DEVI unsigned cvt_pk_bf16(float lo, float hi) { unsigned r; asm("v_cvt_pk_bf16_f32 %0, %1, %2" : "=v"(r) : "v"(lo), "v"(hi)); return r; }
DEVI bf16_t f2bf(float f) { return (bf16_t)(cvt_pk_bf16(f, 0.f) & 0xffffu); }
DEVI float silu_f(float v) { return v * __builtin_amdgcn_rcpf(1.f + __expf(-v)); }
DEVI int swap23(int x) { return (x & ~12) | ((x & 4) << 1) | ((x & 8) >> 1); }
DEVI int cond_of(int m) { return m < NCTX ? 0 : 1 + ((m - NCTX) >> 10); }

DEVI void st8(bf16_t* p, u32x2 a, u32x2 b) {
    const auto r0 = __builtin_amdgcn_permlane32_swap(a.x, b.x, false, false);
    const auto r1 = __builtin_amdgcn_permlane32_swap(a.y, b.y, false, false);
    u32x4 w; w.x = r0[0]; w.y = r1[0]; w.z = r0[1]; w.w = r1[1];
    *(u32x4*)p = w;
}
DEVI void put8(unsigned char* wl, int r, int c, u32x2 a, u32x2 b) {
    const auto r0 = __builtin_amdgcn_permlane32_swap(a.x, b.x, false, false);
    const auto r1 = __builtin_amdgcn_permlane32_swap(a.y, b.y, false, false);
    u32x4 w; w.x = r0[0]; w.y = r1[0]; w.z = r0[1]; w.w = r1[1];
    *(u32x4*)(wl + r * 128 + ((c ^ (r & 7)) << 4)) = w;
}
template <int ROWS, class RowPtr>
DEVI void flush8(const unsigned char* wl, int lane, const RowPtr& rowptr) {
#pragma unroll
    for (int i = 0; i < ROWS / 8; ++i) {
        const int r = i * 8 + (lane >> 3), c = lane & 7;
        const u32x4 w = *(const u32x4*)(wl + r * 128 + ((c ^ (r & 7)) << 4));
        *(u32x4*)(rowptr(r) + c * 8) = w;
    }
}
DEVI float xhalf_sum(float x) { const auto r = __builtin_amdgcn_permlane32_swap(__float_as_uint(x), __float_as_uint(x), false, false); return __uint_as_float(r[0]) + __uint_as_float(r[1]); }
DEVI float xhalf_max(float x) { const auto r = __builtin_amdgcn_permlane32_swap(__float_as_uint(x), __float_as_uint(x), false, false); return fmaxf(__uint_as_float(r[0]), __uint_as_float(r[1])); }

DEVI void glds16(const void* g, void* l) { __builtin_amdgcn_global_load_lds(g, l, 16, 0, 0); }

template <int MB = 2, class Epi>
DEVI void gemm_tile(const bf16_t* __restrict__ A, int lda, const bf16_t* __restrict__ B, int ldb, int nk,
                    unsigned char* lds, const Epi& epi, int m0, int n0) {
    const int tid = threadIdx.x, lane = tid & 63, wid = tid >> 6, wr = wid >> 1, wc = wid & 1;
    const int srow = tid >> 3;
    const int slc = (tid & 7) ^ ((tid >> 4) & 7);
    const bf16_t* gA = A + (size_t)(m0 + srow) * lda + slc * 8;
    const bf16_t* gB = B + (size_t)(n0 + srow) * ldb + slc * 8;
    const int fr = lane & 31, fh = lane >> 5, sw = (lane >> 1) & 7;
    const unsigned aoff = (wr * 32 * MB + fr) * 128, boff = 16384 + (wc * 64 + fr) * 128;
    f32x16 acc[MB][2];
#pragma unroll
    for (int i = 0; i < MB; ++i)
#pragma unroll
        for (int j = 0; j < 2; ++j)
#pragma unroll
            for (int r = 0; r < 16; ++r) acc[i][j][r] = 0.f;
    {
        unsigned char* la = lds + tid * 16;
#pragma unroll
        for (int i = 0; i < 4; ++i) {
            if (i < 2 * MB) glds16(gA + (size_t)i * 32 * lda, la + i * 4096);
            glds16(gB + (size_t)i * 32 * ldb, la + 16384 + i * 4096);
        }
    }
    for (int kt = 0; kt < nk; ++kt) {
        asm volatile("s_waitcnt vmcnt(0)" ::: "memory");
        __syncthreads();
        if (kt + 1 < nk) {
            unsigned char* la = lds + ((kt + 1) & 1) * 32768 + tid * 16;
            const int ko = (kt + 1) * 64;
#pragma unroll
            for (int i = 0; i < 4; ++i) {
                if (i < 2 * MB) glds16(gA + (size_t)i * 32 * lda + ko, la + i * 4096);
                glds16(gB + (size_t)i * 32 * ldb + ko, la + 16384 + i * 4096);
            }
        }
        const unsigned char* base = lds + (kt & 1) * 32768;
        bf16x8 af[4][2], bfr[4][2];
#define LDFRAG(ks) { const int ch = ((2 * (ks) + fh) ^ sw) * 16; \
            af[ks][0] = *(const bf16x8*)(base + aoff + ch); bfr[ks][0] = *(const bf16x8*)(base + boff + ch); \
            bfr[ks][1] = *(const bf16x8*)(base + boff + 4096 + ch); if (MB == 2) af[ks][1] = *(const bf16x8*)(base + aoff + 4096 + ch); }
#define MFMA4(ks) { acc[0][0] = __builtin_amdgcn_mfma_f32_32x32x16_bf16(bfr[ks][0], af[ks][0], acc[0][0], 0, 0, 0); \
            acc[0][1] = __builtin_amdgcn_mfma_f32_32x32x16_bf16(bfr[ks][1], af[ks][0], acc[0][1], 0, 0, 0); \
            if (MB == 2) { acc[MB - 1][0] = __builtin_amdgcn_mfma_f32_32x32x16_bf16(bfr[ks][0], af[ks][1], acc[MB - 1][0], 0, 0, 0); \
            acc[MB - 1][1] = __builtin_amdgcn_mfma_f32_32x32x16_bf16(bfr[ks][1], af[ks][1], acc[MB - 1][1], 0, 0, 0); } }
        LDFRAG(0) LDFRAG(1)
        __builtin_amdgcn_sched_barrier(0);
        MFMA4(0) LDFRAG(2)
        __builtin_amdgcn_sched_barrier(0);
        MFMA4(1) LDFRAG(3)
        __builtin_amdgcn_sched_barrier(0);
        MFMA4(2)
        __builtin_amdgcn_sched_barrier(0);
        MFMA4(3)
#undef LDFRAG
#undef MFMA4
    }
    epi(acc, m0 + wr * 32 * MB, n0 + wc * 64, fr, fh, lds + wid * 8192);
    __syncthreads();
}

DEVI int xcd_remap(int t, int T) { return (t & 7) * (T >> 3) + (t >> 3); }

DEVI void mod_item(const Params& p, int it, unsigned char* lds) {
    const int tid = threadIdx.x;
    const int ks = it & 3, lc = it >> 2, l = lc / 48, cc = lc % 48;
    float* sc = (float*)lds;
    for (int i = tid; i < 768; i += 256) {
        const int cv = i >> 8, k = ks * 256 + (i & 255);
        const float cval = cv == 0 ? p.c_ctx[k] : p.c[(cv - 1) * 1024 + k];
        sc[i] = silu_f(cval);
    }
    __syncthreads();
    const float* W = (l ? p.w_mod1 : p.w_mod0) + (size_t)ks * 256 * 3072;
    const int cg4 = tid & 15, rg = tid >> 4, c0 = cc * 64 + cg4 * 4;
    f32x4 w[16];
#pragma unroll
    for (int i = 0; i < 16; ++i) w[i] = *(const f32x4*)(W + (size_t)(rg + 16 * i) * 3072 + c0);
    f32x4 a0 = {0.f, 0.f, 0.f, 0.f}, a1 = a0, a2 = a0;
#pragma unroll
    for (int i = 0; i < 16; ++i) { const int k = rg + 16 * i; a0 += sc[k] * w[i]; a1 += sc[256 + k] * w[i]; a2 += sc[512 + k] * w[i]; }
    float* red = (float*)(lds + 12288);
#pragma unroll
    for (int e = 0; e < 4; ++e) {
        red[(rg * 3 + 0) * 64 + cg4 * 4 + e] = a0[e];
        red[(rg * 3 + 1) * 64 + cg4 * 4 + e] = a1[e];
        red[(rg * 3 + 2) * 64 + cg4 * 4 + e] = a2[e];
    }
    __syncthreads();
    if (tid < 192) {
        const int cv = tid >> 6, j = tid & 63;
        float s = 0.f;
#pragma unroll
        for (int r = 0; r < 16; ++r) s += red[(r * 3 + cv) * 64 + j];
        float* modp = (float*)(p.ws + WS_MODP) + (size_t)ks * 18432;
        __hip_atomic_store(&modp[(l * 3 + cv) * 3072 + cc * 64 + j], s, __ATOMIC_RELAXED, __HIP_MEMORY_SCOPE_AGENT);
    }
    asm volatile("s_waitcnt vmcnt(0)" ::: "memory");
    __syncthreads();
    if (tid == 0) __hip_atomic_fetch_add((unsigned*)(p.ws + WS_CNT), 1u, __ATOMIC_RELAXED, __HIP_MEMORY_SCOPE_AGENT);
}

struct TrDesc { const float* src; bf16_t* dst; int N, kt, nt; };
DEVI TrDesc tr_desc(const Params& p, int idx) {
    TrDesc d;
    if (idx < 512) { d.src = p.w_in0; d.dst = (bf16_t*)(p.ws + WS_WT0IN); d.N = 2048; }
    else if (idx < 768) { idx -= 512; d.src = p.w_out0; d.dst = (bf16_t*)(p.ws + WS_WT0OUT); d.N = 1024; }
    else if (idx < 1408) { idx -= 768; d.src = p.w_in1; d.dst = (bf16_t*)(p.ws + WS_WT1IN); d.N = 2560; }
    else { idx -= 1408; d.src = p.w_out1; d.dst = (bf16_t*)(p.ws + WS_WT1OUT); d.N = 1024; }
    const int ntn = d.N >> 6;
    d.kt = idx / ntn; d.nt = idx % ntn;
    return d;
}
DEVI void transpose_items(const Params& p, int first, int end, int stride, unsigned char* lds) {
    const int tid = threadIdx.x;
    float* tl = (float*)lds;
    if (first >= end) return;
    f32x4 v[4];
    TrDesc d = tr_desc(p, first);
#pragma unroll
    for (int pass = 0; pass < 4; ++pass) v[pass] = *(const f32x4*)(d.src + (size_t)(d.kt * 64 + pass * 16 + (tid >> 4)) * d.N + d.nt * 64 + (tid & 15) * 4);
    for (int idx = first; idx < end; idx += stride) {
#pragma unroll
        for (int pass = 0; pass < 4; ++pass) {
            const int r = pass * 16 + (tid >> 4), c4 = (tid & 15) * 4;
#pragma unroll
            for (int e = 0; e < 4; ++e) tl[r * 65 + c4 + e] = v[pass][e];
        }
        const TrDesc cur = d;
        if (idx + stride < end) {
            d = tr_desc(p, idx + stride);
#pragma unroll
            for (int pass = 0; pass < 4; ++pass) v[pass] = *(const f32x4*)(d.src + (size_t)(d.kt * 64 + pass * 16 + (tid >> 4)) * d.N + d.nt * 64 + (tid & 15) * 4);
        }
        __syncthreads();
#pragma unroll
        for (int pass = 0; pass < 2; ++pass) {
            const int n = pass * 32 + (tid >> 3), kc = tid & 7;
            float x[8];
#pragma unroll
            for (int j = 0; j < 8; ++j) x[j] = tl[(kc * 8 + j) * 65 + n];
            u32x4 w;
            w.x = cvt_pk_bf16(x[0], x[1]); w.y = cvt_pk_bf16(x[2], x[3]); w.z = cvt_pk_bf16(x[4], x[5]); w.w = cvt_pk_bf16(x[6], x[7]);
            *(u32x4*)(cur.dst + (size_t)(cur.nt * 64 + n) * 1024 + cur.kt * 64 + kc * 8) = w;
        }
        __syncthreads();
    }
}

DEVI void phase0(const Params& p, unsigned char* lds) {
    for (int it = blockIdx.x; it < 384; it += gridDim.x) mod_item(p, it, lds);
    transpose_items(p, (blockIdx.x + 128) % gridDim.x, 1664, gridDim.x, lds);
    const int gt = blockIdx.x * 256 + threadIdx.x, gs = gridDim.x * 256;
    bf16_t* tw256 = (bf16_t*)(p.ws + WS_TW256);
    bf16_t* ts256 = (bf16_t*)(p.ws + WS_TS256);
    bf16_t* ts1024 = (bf16_t*)(p.ws + WS_TS1024);
    float* lut = (float*)(lds + 32768);
    __syncthreads();
    for (int r = threadIdx.x; r < 1024; r += 256) lut[r] = cospif((float)r * (1.f / 512.f));
    __syncthreads();
    for (int i = gt; i < 512 * 256; i += gs) {
        const int m = i >> 8, j = i & 255, which = m >> 8, cp = m & 255;
        const int r = ((cp * j) & 255) << 2;
        tw256[i] = f2bf(which ? lut[(r - 256) & 1023] : lut[r]);
    }
    for (int i = gt; i < 256 * 512; i += gs) {
        const int sp = i >> 9, k2 = i & 511, which = k2 >> 8, s0 = k2 & 255;
        const int r = ((sp * s0) & 255) << 2;
        ts256[i] = f2bf((which ? -lut[(r - 256) & 1023] : lut[r]) * (1.f / 256.f));
    }
    for (int i = gt; i < 1024 * 2048; i += gs) {
        const int sp = i >> 11, k2 = i & 2047, which = k2 >> 10, s0 = k2 & 1023;
        const int r = (sp * s0) & 1023;
        ts1024[i] = f2bf((which ? -lut[(r - 256) & 1023] : lut[r]) * (1.f / 512.f));
    }
    float* ropec = (float*)(p.ws + WS_ROPEC);
    float* ropes = (float*)(p.ws + WS_ROPES);
    for (int i = gt; i < 1024 * 32; i += gs) {
        const int pos = i >> 5, f = i & 31;
        const int row = pos >> 6, col = pos & 63;
        const float inv = powf(10000.f, -(float)(f & 15) * (1.f / 16.f));
        const float ang = (float)(f < 16 ? row : col) * inv;
        float s, c; sincosf(ang, &s, &c);
        ropec[i] = c; ropes[i] = s;
    }
    for (int i = gt; i < NTOK; i += gs) ((float*)(p.ws + WS_ROWSS))[i] = 0.f;
    bf16_t* kc = (bf16_t*)(p.ws + WS_KC);
    bf16_t* vct = (bf16_t*)(p.ws + WS_VCT);
    for (int i = gt; i < 2 * 256 * 256; i += gs) {
        kc[i] = f2bf(p.cache_k[i]);
        const int b = i >> 16, kvh = (i >> 14) & 3, d = (i >> 8) & 63, pp = i & 255;
        const int key = swap23(pp);
        vct[i] = f2bf(p.cache_v[((b * 256 + key) * 4 + kvh) * 64 + d]);
    }
}

DEVI void phase_norm(const Params& p, int layer, const float* lmod  ) {
    const int lane = threadIdx.x & 63, wid = threadIdx.x >> 6;
    const float* nw = layer ? p.norm_w1 : p.norm_w0;
    bf16_t* H = (bf16_t*)(p.ws + WS_H);
    for (int row = blockIdx.x * 4 + wid; row < NTOK; row += gridDim.x * 4) {
        const float* xr;
        if (layer == 0) xr = row < NCTX ? p.x_prompt + (size_t)row * D : p.x_sample + (size_t)(row - NCTX) * D;
        else xr = (const float*)(p.ws + WS_X1) + (size_t)row * D;
        const float* mv = lmod + cond_of(row) * 2048;
        f32x4 v[4];
        float ss = 0.f;
#pragma unroll
        for (int i = 0; i < 4; ++i) {
            v[i] = *(const f32x4*)(xr + i * 256 + lane * 4);
            ss += v[i][0] * v[i][0] + v[i][1] * v[i][1] + v[i][2] * v[i][2] + v[i][3] * v[i][3];
        }
#pragma unroll
        for (int o = 32; o >= 1; o >>= 1) ss += __shfl_xor(ss, o);
        const float rstd = rsqrtf(ss * (1.f / 1024.f) + EPSV);
#pragma unroll
        for (int i = 0; i < 4; ++i) {
            const int k = i * 256 + lane * 4;
            const f32x4 w = *(const f32x4*)(nw + k);
            const f32x4 sh = *(const f32x4*)(mv + k);
            const f32x4 scl = *(const f32x4*)(mv + 1024 + k);
            float h[4];
#pragma unroll
            for (int e = 0; e < 4; ++e) h[e] = (v[i][e] * rstd * w[e]) * (1.f + scl[e]) + sh[e];
            u32x2 o; o.x = cvt_pk_bf16(h[0], h[1]); o.y = cvt_pk_bf16(h[2], h[3]);
            *(u32x2*)(H + (size_t)row * D + k) = o;
        }
    }
}

DEVI void bias1_items(const Params& p) {
    const int lane = threadIdx.x & 63, gw = blockIdx.x * 4 + (threadIdx.x >> 6), nw = gridDim.x * 4;
    const float* mod1 = (const float*)(p.ws + WS_MOD) + 3 * 3072;
    const bf16_t* WT = (const bf16_t*)(p.ws + WS_WT1IN);
    float* bias1 = (float*)(p.ws + WS_BIAS1);
    for (int n = gw; n < 2560; n += nw) {
        float w[16];
        const u32x4 r0 = *(const u32x4*)(WT + (size_t)n * 1024 + lane * 16), r1 = *(const u32x4*)(WT + (size_t)n * 1024 + lane * 16 + 8);
        const unsigned rr[8] = {r0.x, r0.y, r0.z, r0.w, r1.x, r1.y, r1.z, r1.w};
#pragma unroll
        for (int i = 0; i < 8; ++i) { w[2 * i] = __uint_as_float(rr[i] << 16); w[2 * i + 1] = __uint_as_float(rr[i] & 0xffff0000u); }
        float s[3];
#pragma unroll
        for (int cv = 0; cv < 3; ++cv) {
            float a = 0.f;
#pragma unroll
            for (int q = 0; q < 4; ++q) {
                const f32x4 sh = *(const f32x4*)(mod1 + cv * 3072 + lane * 16 + q * 4);
#pragma unroll
                for (int e = 0; e < 4; ++e) a += sh[e] * w[q * 4 + e];
            }
#pragma unroll
            for (int o = 32; o >= 1; o >>= 1) a += __shfl_xor(a, o);
            s[cv] = a;
        }
        if (lane == 0) { bias1[n] = s[0]; bias1[2560 + n] = s[1]; bias1[5120 + n] = s[2]; }
    }
}

struct EpiInL0 {
    bf16_t *U, *SZ;
    DEVI void operator()(const f32x16 (&acc)[2][2], int mbase, int nbase, int fr, int fh, unsigned char* wl) const {
        const bool isz = nbase >= 1024;
        bf16_t* dst = isz ? SZ : U;
        const int nb0 = isz ? nbase - 1024 : nbase;
        u32x2 keep = {0u, 0u};
#pragma unroll
        for (int mb = 0; mb < 2; ++mb)
#pragma unroll
            for (int nb = 0; nb < 2; ++nb)
#pragma unroll
                for (int g = 0; g < 4; ++g) {
                    const int m = mbase + mb * 32 + fr, n = nb0 + nb * 32 + 8 * g + 4 * fh;
                    float v[4];
#pragma unroll
                    for (int e = 0; e < 4; ++e) { v[e] = acc[mb][nb][4 * g + e]; if (isz) v[e] = silu_f(v[e]); }
                    u32x2 o; o.x = cvt_pk_bf16(v[0], v[1]); o.y = cvt_pk_bf16(v[2], v[3]);
                    if ((g & 1) == 0) keep = o; else put8(wl, mb * 32 + fr, nb * 4 + (g - 1) + fh, keep, o);
                }
        flush8<64>(wl, fh * 32 + fr, [&](int r) { return dst + (size_t)(mbase + r) * D + nb0; });
    }
};

struct EpiChanDft {
    bf16_t* VT; int g;
    DEVI void operator()(const f32x16 (&acc)[2][2], int mbase, int nbase, int fr, int fh, unsigned char* wl) const {
        int S, bgi, s0; bf16_t* base;
        if (nbase < NCTX) { S = 256; bgi = (nbase >> 8) * 4 + g; s0 = nbase & 255; base = VT; }
        else { const int t = nbase - NCTX; S = 1024; bgi = (t >> 10) * 4 + g; s0 = t & 1023; base = VT + (size_t)64 * 256 * 512; }
        u32x2 keep = {0u, 0u};
#pragma unroll
        for (int mb = 0; mb < 2; ++mb)
#pragma unroll
            for (int nb = 0; nb < 2; ++nb)
#pragma unroll
                for (int gq = 0; gq < 4; ++gq) {
                    const int m = mbase + mb * 32 + fr, which = m >> 8, cp = m & 255;
                    const int s = s0 + nb * 32 + 8 * gq + 4 * fh;
                    u32x2 o; o.x = cvt_pk_bf16(acc[mb][nb][4 * gq], acc[mb][nb][4 * gq + 1]); o.y = cvt_pk_bf16(acc[mb][nb][4 * gq + 2], acc[mb][nb][4 * gq + 3]);
                    if ((gq & 1) == 0) keep = o; else put8(wl, mb * 32 + fr, nb * 4 + (gq - 1) + fh, keep, o);
                }
        flush8<64>(wl, fh * 32 + fr, [&](int r) { const int m = mbase + r; return base + ((size_t)bgi * 256 + (m & 255)) * (2 * S) + (m >> 8) * S + s0; });
    }
};

template <int MB> struct EpiSeqDft {
    const bf16_t* SZ; bf16_t* Y; int tok0, g;
    DEVI void operator()(const f32x16 (&acc)[MB][2], int mbase, int nbase, int fr, int fh, unsigned char* wl) const {
        u32x2 keep = {0u, 0u};
#pragma unroll
        for (int mb = 0; mb < MB; ++mb)
#pragma unroll
            for (int nb = 0; nb < 2; ++nb)
#pragma unroll
                for (int gq = 0; gq < 4; ++gq) {
                    const int tok = tok0 + mbase + mb * 32 + fr;
                    const int col = g * 256 + nbase + nb * 32 + 8 * gq + 4 * fh;
                    const u32x2 z = *(const u32x2*)(SZ + (size_t)tok * D + col);
                    const float z0 = __uint_as_float(z.x << 16), z1 = __uint_as_float(z.x & 0xffff0000u);
                    const float z2 = __uint_as_float(z.y << 16), z3 = __uint_as_float(z.y & 0xffff0000u);
                    u32x2 o; o.x = cvt_pk_bf16(acc[mb][nb][4 * gq] * z0, acc[mb][nb][4 * gq + 1] * z1);
                    o.y = cvt_pk_bf16(acc[mb][nb][4 * gq + 2] * z2, acc[mb][nb][4 * gq + 3] * z3);
                    if ((gq & 1) == 0) keep = o; else put8(wl, mb * 32 + fr, nb * 4 + (gq - 1) + fh, keep, o);
                }
        flush8<32 * MB>(wl, fh * 32 + fr, [&](int r) { return Y + (size_t)(tok0 + mbase + r) * D + g * 256 + nbase; });
    }
};

template <bool NEXT, int MB> struct EpiOut {
    const float* xa; const float* xb;
    const float* mod;
    float* out;
    const float* nw1; const float* mod1; bf16_t* Hn; float* rowss;
    DEVI void operator()(const f32x16 (&acc)[MB][2], int mbase, int nbase, int fr, int fh, unsigned char* wl) const {
        const int cv = cond_of(mbase);
        const float* gate = mod + cv * 3072 + 2048;
        u32x2 keep = {0u, 0u};
#pragma unroll
        for (int mb = 0; mb < MB; ++mb) {
            const int m = mbase + mb * 32 + fr;
            const float* xr = m < NCTX ? xa + (size_t)m * D : xb + (size_t)(m - NCTX) * D;
            float ss = 0.f;
#pragma unroll
            for (int nb = 0; nb < 2; ++nb)
#pragma unroll
                for (int g = 0; g < 4; ++g) {
                    const int n = nbase + nb * 32 + 8 * g + 4 * fh;
                    const f32x4 xv = *(const f32x4*)(xr + n);
                    const f32x4 gv = *(const f32x4*)(gate + n);
                    f32x4 o;
#pragma unroll
                    for (int e = 0; e < 4; ++e) o[e] = xv[e] + gv[e] * acc[mb][nb][4 * g + e];
                    *(f32x4*)(out + (size_t)m * D + n) = o;
                    if (NEXT) {
                        const f32x4 w = *(const f32x4*)(nw1 + n);
                        const f32x4 sc = *(const f32x4*)(mod1 + cv * 3072 + 1024 + n);
                        float h[4];
#pragma unroll
                        for (int e = 0; e < 4; ++e) { ss += o[e] * o[e]; h[e] = o[e] * w[e] * (1.f + sc[e]); }
                        u32x2 hb; hb.x = cvt_pk_bf16(h[0], h[1]); hb.y = cvt_pk_bf16(h[2], h[3]);
                        if ((g & 1) == 0) keep = hb; else put8(wl, mb * 32 + fr, nb * 4 + (g - 1) + fh, keep, hb);
                    }
                }
            if (NEXT) {
                ss = xhalf_sum(ss);
                if (fh == 0) atomicAdd(rowss + m, ss);
            }
        }
        if (NEXT) flush8<32 * MB>(wl, fh * 32 + fr, [&](int r) { return Hn + (size_t)(mbase + r) * D + nbase; });
    }
};

struct EpiInL1 {
    const float *qnw, *knw, *ropec, *ropes;
    bf16_t *Q, *KB, *VTB, *SZ;
    float *outk, *outv;
    const float* rowss; const float* bias1;
    DEVI void operator()(const f32x16 (&acc_in)[2][2], int mbase, int nbase, int fr, int fh, unsigned char* wl) const {
        const bool lat = mbase >= NCTX;
        u32x2 keep1 = {0u, 0u}, keep2 = {0u, 0u};
        f32x16 acc[2][2];
        {
            const float* bp = bias1 + cond_of(mbase) * 2560 + nbase;
#pragma unroll
            for (int mb = 0; mb < 2; ++mb) {
                const float rstd = rsqrtf(rowss[mbase + mb * 32 + fr] * (1.f / 1024.f) + EPSV);
#pragma unroll
                for (int nb = 0; nb < 2; ++nb)
#pragma unroll
                    for (int g = 0; g < 4; ++g) {
                        const f32x4 bv = *(const f32x4*)(bp + nb * 32 + 8 * g + 4 * fh);
#pragma unroll
                        for (int e = 0; e < 4; ++e) acc[mb][nb][4 * g + e] = acc_in[mb][nb][4 * g + e] * rstd + bv[e];
                    }
            }
        }
        if (nbase < 1280) {
            const bool isq = nbase < 1024;
            const float* nwp = isq ? qnw : knw;
#pragma unroll
            for (int mb = 0; mb < 2; ++mb) {
                const int m = mbase + mb * 32 + fr;
                float ss = 0.f;
#pragma unroll
                for (int nb = 0; nb < 2; ++nb)
#pragma unroll
                    for (int r = 0; r < 16; ++r) ss += acc[mb][nb][r] * acc[mb][nb][r];
                ss = xhalf_sum(ss);
                const float rn = rsqrtf(ss * (1.f / 64.f) + EPSV);
                const int pos = lat ? ((m - NCTX) & 1023) : 0;
#pragma unroll
                for (int g = 0; g < 4; ++g) {
                    const int d0 = 8 * g + 4 * fh;
                    const f32x4 w1 = *(const f32x4*)(nwp + d0), w2 = *(const f32x4*)(nwp + 32 + d0);
                    float x1[4], x2[4];
#pragma unroll
                    for (int e = 0; e < 4; ++e) { x1[e] = acc[mb][0][4 * g + e] * rn * w1[e]; x2[e] = acc[mb][1][4 * g + e] * rn * w2[e]; }
                    if (lat) {
                        const f32x4 cv = *(const f32x4*)(ropec + pos * 32 + d0), sv = *(const f32x4*)(ropes + pos * 32 + d0);
#pragma unroll
                        for (int e = 0; e < 4; ++e) { const float a = x1[e], b = x2[e]; x1[e] = a * cv[e] - b * sv[e]; x2[e] = a * sv[e] + b * cv[e]; }
                    }
                    if (isq) {
                        const float qs = 0.125f * LOG2E;
                        u32x2 o1, o2;
                        o1.x = cvt_pk_bf16(x1[0] * qs, x1[1] * qs); o1.y = cvt_pk_bf16(x1[2] * qs, x1[3] * qs);
                        o2.x = cvt_pk_bf16(x2[0] * qs, x2[1] * qs); o2.y = cvt_pk_bf16(x2[2] * qs, x2[3] * qs);
                        if ((g & 1) == 0) { keep1 = o1; keep2 = o2; }
                        else { put8(wl, mb * 32 + fr, (g - 1) + fh, keep1, o1); put8(wl, mb * 32 + fr, 4 + (g - 1) + fh, keep2, o2); }
                    } else {
                        const int kc = nbase - 1024;
                        u32x2 o1, o2;
                        o1.x = cvt_pk_bf16(x1[0], x1[1]); o1.y = cvt_pk_bf16(x1[2], x1[3]);
                        o2.x = cvt_pk_bf16(x2[0], x2[1]); o2.y = cvt_pk_bf16(x2[2], x2[3]);
                        if ((g & 1) == 0) { keep1 = o1; keep2 = o2; }
                        else { put8(wl, mb * 32 + fr, (g - 1) + fh, keep1, o1); put8(wl, mb * 32 + fr, 4 + (g - 1) + fh, keep2, o2); }
                        if (!lat) {
                            f32x4 f1 = {x1[0], x1[1], x1[2], x1[3]}, f2 = {x2[0], x2[1], x2[2], x2[3]};
                            *(f32x4*)(outk + (size_t)m * 256 + kc + d0) = f1;
                            *(f32x4*)(outk + (size_t)m * 256 + kc + 32 + d0) = f2;
                        }
                    }
                }
            }
            if (isq) flush8<64>(wl, fh * 32 + fr, [&](int r) { return Q + (size_t)(mbase + r) * D + nbase; });
            else flush8<64>(wl, fh * 32 + fr, [&](int r) { return KB + (size_t)(mbase + r) * 256 + (nbase - 1024); });
        } else if (nbase < 1536) {
            const int vc = nbase - 1280, kvh = vc >> 6;
#pragma unroll
            for (int mb = 0; mb < 2; ++mb) {
                const int m = mbase + mb * 32 + fr;
                bf16_t* vt; int S, s;
                if (!lat) { S = 256; s = m & 255; vt = VTB + ((size_t)((m >> 8) * 4 + kvh) * 64) * 256; }
                else { const int t = m - NCTX; S = 1024; s = t & 1023; vt = VTB + (size_t)16 * 4 * 64 * 256 + ((size_t)((t >> 10) * 4 + kvh) * 64) * 1024; }
                const int sp = swap23(s);
#pragma unroll
                for (int nb = 0; nb < 2; ++nb)
#pragma unroll
                    for (int g = 0; g < 4; ++g) {
                        const int d0 = nb * 32 + 8 * g + 4 * fh;
#pragma unroll
                        for (int e = 0; e < 4; ++e) vt[(size_t)(d0 + e) * S + sp] = f2bf(acc[mb][nb][4 * g + e]);
                        if (!lat) {
                            f32x4 f = {acc[mb][nb][4 * g], acc[mb][nb][4 * g + 1], acc[mb][nb][4 * g + 2], acc[mb][nb][4 * g + 3]};
                            *(f32x4*)(outv + (size_t)m * 256 + vc + d0) = f;
                        }
                    }
            }
        } else {
            const int zc = nbase - 1536;
#pragma unroll
            for (int mb = 0; mb < 2; ++mb)
#pragma unroll
                for (int nb = 0; nb < 2; ++nb)
#pragma unroll
                    for (int g = 0; g < 4; ++g) {
                        const int m = mbase + mb * 32 + fr, n = zc + nb * 32 + 8 * g + 4 * fh;
                        u32x2 o; o.x = cvt_pk_bf16(silu_f(acc[mb][nb][4 * g]), silu_f(acc[mb][nb][4 * g + 1]));
                        o.y = cvt_pk_bf16(silu_f(acc[mb][nb][4 * g + 2]), silu_f(acc[mb][nb][4 * g + 3]));
                        if ((g & 1) == 0) keep1 = o; else put8(wl, mb * 32 + fr, nb * 4 + (g - 1) + fh, keep1, o);
                    }
            flush8<64>(wl, fh * 32 + fr, [&](int r) { return SZ + (size_t)(mbase + r) * D + zc; });
        }
    }
};

DEVI void attn_item(const Params& p, int item, unsigned char* lds) {
    const int lane = threadIdx.x & 63, w = threadIdx.x >> 6, fr = lane & 31, fh = lane >> 5;
    const bf16_t* Q = (const bf16_t*)(p.ws + WS_Q);
    const bf16_t* KB = (const bf16_t*)(p.ws + WS_KB);
    const bf16_t* VTB = (const bf16_t*)(p.ws + WS_VTB);
    const bf16_t* KC = (const bf16_t*)(p.ws + WS_KC);
    const bf16_t* VCT = (const bf16_t*)(p.ws + WS_VCT);
    const bf16_t* SZ = (const bf16_t*)(p.ws + WS_SZ);
    bf16_t* Y = (bf16_t*)(p.ws + WS_Y);
    bool lat; int b, kvh, qb, tb;
    if (item < 256) { lat = true; b = item >> 7; kvh = (item >> 5) & 3; qb = item & 31; tb = NCTX + b * 1024; }
    else { const int it = item - 256; lat = false; b = it >> 5; kvh = (it >> 3) & 3; qb = it & 7; tb = b * 256; }
    const int head = kvh * 4 + w;
    const int qtok = tb + qb * 32 + fr;
    bf16x8 qf[4];
#pragma unroll
    for (int ks = 0; ks < 4; ++ks) qf[ks] = *(const bf16x8*)(Q + (size_t)qtok * D + head * 64 + ks * 16 + fh * 8);
    float m_run = p.sink[head] * LOG2E, l_run = 1.f;
    f32x16 O[2];
#pragma unroll
    for (int i = 0; i < 2; ++i)
#pragma unroll
        for (int r = 0; r < 16; ++r) O[i][r] = 0.f;

    int nloc, k_lo = 0; const bf16_t *kloc, *vloc; int ldloc;
    if (lat) {
        k_lo = qb - 4 < 0 ? 0 : qb - 4; const int k_hi = qb + 4 > 31 ? 31 : qb + 4; nloc = k_hi - k_lo + 1;
        kloc = KB + (size_t)(tb + k_lo * 32) * 256 + kvh * 64;
        vloc = VTB + (size_t)16 * 4 * 64 * 256 + ((size_t)(b * 4 + kvh) * 64) * 1024 + k_lo * 32; ldloc = 1024;
    } else {
        nloc = 8; kloc = KB + (size_t)tb * 256 + kvh * 64; vloc = VTB + ((size_t)(b * 4 + kvh) * 64) * 256; ldloc = 256;
    }
    const int nblk = lat ? nloc + 8 : 8;
    const bf16_t* kcb = KC + (size_t)(b * 256) * 256 + kvh * 64;
    const bf16_t* vcb = VCT + ((size_t)(b * 4 + kvh) * 64) * 256;
    const int tid = threadIdx.x;
    const int kkey = tid >> 3, kch = tid & 7, vd = tid >> 2, vch = tid & 3;
    const unsigned kst = kkey * 128 + ((kch ^ ((kkey >> 1) & 7)) << 4), vst = 4096 + vd * 64 + ((vch ^ ((vd >> 2) & 3)) << 4);
    const unsigned ksw = (fr >> 1) & 7, vsw = (fr >> 2) & 3;
    u32x4 kreg, vreg;
    auto loadkv = [&](int j) {
        const bf16_t *kp, *vp; int ldv;
        if (j < nloc) { kp = kloc + (size_t)j * 32 * 256; vp = vloc + j * 32; ldv = ldloc; }
        else { const int c = j - nloc; kp = kcb + (size_t)c * 32 * 256; vp = vcb + c * 32; ldv = 256; }
        kreg = *(const u32x4*)(kp + (size_t)kkey * 256 + kch * 8);
        vreg = *(const u32x4*)(vp + (size_t)vd * ldv + vch * 8);
    };
    loadkv(0);
    *(u32x4*)(lds + kst) = kreg; *(u32x4*)(lds + vst) = vreg;
    if (nblk > 1) loadkv(1);
    __syncthreads();
    for (int j = 0; j < nblk; ++j) {
        const unsigned char* lb = lds + (j & 1) * 8192;
        bf16x8 kf[4], vf[4];
#pragma unroll
        for (int ks = 0; ks < 4; ++ks) kf[ks] = *(const bf16x8*)(lb + fr * 128 + (((2 * ks + fh) ^ ksw) << 4));
#pragma unroll
        for (int s2 = 0; s2 < 2; ++s2)
#pragma unroll
            for (int db = 0; db < 2; ++db) vf[s2 * 2 + db] = *(const bf16x8*)(lb + 4096 + (db * 32 + fr) * 64 + (((2 * s2 + fh) ^ vsw) << 4));
        f32x16 s;
#pragma unroll
        for (int r = 0; r < 16; ++r) s[r] = 0.f;
#pragma unroll
        for (int ks = 0; ks < 4; ++ks) s = __builtin_amdgcn_mfma_f32_32x32x16_bf16(kf[ks], qf[ks], s, 0, 0, 0);
        if (lat && j < nloc) {
            const int kb = k_lo + j;
            const int mode = (kb == qb - 4) ? 1 : (kb == qb + 4) ? 2 : 0;
            if (mode) {
                const int dpos = (kb - qb) * 32;
#pragma unroll
                for (int r = 0; r < 16; ++r) {
                    const int rel = dpos + (r & 3) + 8 * (r >> 2) + 4 * fh - fr;
                    const bool ok = mode == 1 ? (rel >= -128) : (rel <= 128);
                    if (!ok) s[r] = -1e30f;
                }
            }
        }
        float mx = s[0];
#pragma unroll
        for (int r = 1; r < 16; ++r) mx = fmaxf(mx, s[r]);
        mx = xhalf_max(mx);
        const float m_new = fmaxf(m_run, mx);
        const float alpha = __builtin_amdgcn_exp2f(m_run - m_new);
        float rs = 0.f;
#pragma unroll
        for (int r = 0; r < 16; ++r) { s[r] = __builtin_amdgcn_exp2f(s[r] - m_new); rs += s[r]; }
        rs = xhalf_sum(rs);
        l_run = l_run * alpha + rs; m_run = m_new;
#pragma unroll
        for (int i = 0; i < 2; ++i)
#pragma unroll
            for (int r = 0; r < 16; ++r) O[i][r] *= alpha;
#pragma unroll
        for (int s2 = 0; s2 < 2; ++s2) {
            union { u32x4 u; bf16x8 v; } pf;
            pf.u.x = cvt_pk_bf16(s[8 * s2 + 0], s[8 * s2 + 1]); pf.u.y = cvt_pk_bf16(s[8 * s2 + 2], s[8 * s2 + 3]);
            pf.u.z = cvt_pk_bf16(s[8 * s2 + 4], s[8 * s2 + 5]); pf.u.w = cvt_pk_bf16(s[8 * s2 + 6], s[8 * s2 + 7]);
#pragma unroll
            for (int db = 0; db < 2; ++db) O[db] = __builtin_amdgcn_mfma_f32_32x32x16_bf16(vf[s2 * 2 + db], pf.v, O[db], 0, 0, 0);
        }
        if (j + 1 < nblk) {
            unsigned char* nb = lds + ((j + 1) & 1) * 8192;
            *(u32x4*)(nb + kst) = kreg; *(u32x4*)(nb + vst) = vreg;
            if (j + 2 < nblk) loadkv(j + 2);
        }
        __syncthreads();
    }
    const float il = 1.f / l_run;
    u32x2 keepy = {0u, 0u};
#pragma unroll
    for (int db = 0; db < 2; ++db)
#pragma unroll
        for (int g = 0; g < 4; ++g) {
            const int col = head * 64 + db * 32 + 8 * g + 4 * fh;
            const u32x2 z = *(const u32x2*)(SZ + (size_t)qtok * D + col);
            const float z0 = __uint_as_float(z.x << 16), z1 = __uint_as_float(z.x & 0xffff0000u);
            const float z2 = __uint_as_float(z.y << 16), z3 = __uint_as_float(z.y & 0xffff0000u);
            u32x2 o; o.x = cvt_pk_bf16(O[db][4 * g] * il * z0, O[db][4 * g + 1] * il * z1);
            o.y = cvt_pk_bf16(O[db][4 * g + 2] * il * z2, O[db][4 * g + 3] * il * z3);
            if ((g & 1) == 0) keepy = o; else put8(lds + w * 8192, fr, db * 4 + (g - 1) + fh, keepy, o);
        }
    flush8<32>(lds + w * 8192, lane, [&](int r) { return Y + (size_t)(tb + qb * 32 + r) * D + head * 64; });
    __syncthreads();
}


#define XB_TMO      128
#define XB_XCNT(j)  (256  + 64 * (j))
#define XB_XSUB(j)  (1280 + 64 * (j))
#define XB_XGEN(j)  (2304 + 64 * (j))
#define XB_TOP      3328
#define XB_TOPGEN   3392
#define XCD_BAR_WORDS 3456
#define XB_SPIN_CAP (1u << 18)
#define LAS __attribute__((address_space(3)))
DEVI unsigned xb_ld(unsigned* p)              { return __hip_atomic_load(p, __ATOMIC_RELAXED, __HIP_MEMORY_SCOPE_AGENT); }
DEVI unsigned xb_add(unsigned* p, unsigned v) { return __hip_atomic_fetch_add(p, v, __ATOMIC_RELAXED, __HIP_MEMORY_SCOPE_AGENT); }
DEVI unsigned xb_xcc_id() { return (unsigned)__builtin_amdgcn_s_getreg((3 << 11) | 20) & 0xFu; }
#define XB_SPIN(cond, bar) do { unsigned _sp = 0; while (cond) { __builtin_amdgcn_s_sleep(1); \
    if ((++_sp & 255u) == 0u) { if (xb_ld(&(bar)[XB_TMO])) break; if (_sp > XB_SPIN_CAP) { atomicAdd(&(bar)[XB_TMO], 1u); break; } } } } while (0)
struct XcdBarrier { unsigned* bar; unsigned x; volatile LAS unsigned* st; };
DEVI XcdBarrier xcd_barrier_post(unsigned* bar, volatile LAS unsigned* st) {
    XcdBarrier b; b.bar = bar; b.x = xb_xcc_id(); b.st = st;
    if (threadIdx.x == 0) (void)xb_add(&bar[XB_XCNT(b.x)], 1u);
    return b;
}
DEVI void xcd_barrier_complete(unsigned* bar, unsigned x, unsigned& nloc, unsigned& nx) {
    const unsigned G = gridDim.x * gridDim.y * gridDim.z;
    unsigned sum, cnt, mine, sp = 0u;
    for (;;) {
        sum = 0u; cnt = 0u; mine = 0u;
#pragma unroll
        for (unsigned j = 0; j < 16; ++j) { const unsigned c = xb_ld(&bar[XB_XCNT(j)]); sum += c; cnt += (c > 0u) ? 1u : 0u; mine = (j == x) ? c : mine; }
        if (sum == G) break;
        __builtin_amdgcn_s_sleep(1);
        if ((++sp & 255u) == 0u) { if (xb_ld(&bar[XB_TMO])) break; if (sp > XB_SPIN_CAP) { atomicAdd(&bar[XB_TMO], 1u); break; } }
    }
    nloc = mine > 0u ? mine : 1u; nx = cnt > 0u ? cnt : 1u;
}
DEVI void xcd_barrier(const XcdBarrier& b) {
    asm volatile("s_waitcnt vmcnt(0)" ::: "memory");
    __syncthreads();
    if (threadIdx.x == 0) {
        unsigned* bar = b.bar;
        __builtin_amdgcn_s_waitcnt(0);
        unsigned nloc = b.st[0], nx = b.st[1];
        if (nloc == 0u) { xcd_barrier_complete(bar, b.x, nloc, nx); b.st[0] = nloc; b.st[1] = nx; }
        const unsigned old = xb_add(&bar[XB_XSUB(b.x)], 1u);
        const unsigned gen = old / nloc;
        if (old + 1u == (gen + 1u) * nloc) {
            __builtin_amdgcn_fence(__ATOMIC_RELEASE, "agent");
            asm volatile("s_waitcnt vmcnt(0)" ::: "memory");
            const unsigned og = xb_add(&bar[XB_TOP], 1u);
            const unsigned tg = og / nx;
            if (og + 1u == (tg + 1u) * nx) xb_add(&bar[XB_TOPGEN], 1u);
            else XB_SPIN(xb_ld(&bar[XB_TOPGEN]) == tg, bar);
            __builtin_amdgcn_fence(__ATOMIC_ACQUIRE, "agent");
            xb_add(&bar[XB_XGEN(b.x)], 1u);
            asm volatile("s_waitcnt vmcnt(0)" ::: "memory");
        } else {
            XB_SPIN(xb_ld(&bar[XB_XGEN(b.x)]) == gen, bar);
            __builtin_amdgcn_fence(__ATOMIC_ACQUIRE, "agent");
            asm volatile("s_waitcnt vmcnt(0)" ::: "memory");
        }
    }
    __syncthreads();
}

DEVI void run_phase(const Params& p, int ph, unsigned char* lds) {
    const int G = gridDim.x;
    bf16_t* H = (bf16_t*)(p.ws + WS_H);
    bf16_t* U = (bf16_t*)(p.ws + WS_U);
    bf16_t* SZ = (bf16_t*)(p.ws + WS_SZ);
    bf16_t* VT = (bf16_t*)(p.ws + WS_VT);
    bf16_t* Y = (bf16_t*)(p.ws + WS_Y);
    float* X1 = (float*)(p.ws + WS_X1);
    const float* mod = (const float*)(p.ws + WS_MOD);
    switch (ph) {
    case 0: {
        phase0(p, lds);
        if (threadIdx.x == 0) {
            unsigned* cnt = (unsigned*)(p.ws + WS_CNT); unsigned sp = 0;
            while (__hip_atomic_load(cnt, __ATOMIC_RELAXED, __HIP_MEMORY_SCOPE_AGENT) < 384u) { __builtin_amdgcn_s_sleep(4); if (++sp > (1u << 22)) break; }
        }
        __syncthreads();
        const float* modp = (const float*)(p.ws + WS_MODP);
        if (blockIdx.x < 72) {
            const int i = blockIdx.x * 256 + threadIdx.x, l = i / 9216, j = i % 3072;
            float s = (l ? p.b_mod1 : p.b_mod0)[j];
#pragma unroll
            for (int ks = 0; ks < 4; ++ks) s += __hip_atomic_load(modp + ks * 18432 + i, __ATOMIC_RELAXED, __HIP_MEMORY_SCOPE_AGENT);
            ((float*)(p.ws + WS_MOD))[i] = s;
        }
        float* lmod = (float*)lds;
        {
            float tmp[24];
#pragma unroll
            for (int q = 0; q < 24; ++q) {
                const int i = threadIdx.x + 256 * q, src_i = (i >> 11) * 3072 + (i & 2047);
                float s = p.b_mod0[i & 2047];
#pragma unroll
                for (int ks = 0; ks < 4; ++ks) s += __hip_atomic_load(modp + ks * 18432 + src_i, __ATOMIC_RELAXED, __HIP_MEMORY_SCOPE_AGENT);
                tmp[q] = s;
            }
#pragma unroll
            for (int q = 0; q < 24; ++q) lmod[threadIdx.x + 256 * q] = tmp[q];
        }
        __syncthreads();
        phase_norm(p, 0, lmod);
    } break;
    case 2: {
        EpiInL0 e{U, SZ};
        for (int t = blockIdx.x; t < 768; t += G) {
            const int tt = xcd_remap(t, 768);
            gemm_tile(H, D, (const bf16_t*)(p.ws + WS_WT0IN), D, 16, lds, e, (tt >> 4) * 128, (tt & 15) * 128);
        }
    } break;
    case 3: {
        bias1_items(p);
        for (int t = blockIdx.x; t < 768; t += G) {
            const int tt = xcd_remap(t, 768);
            const int mt = tt & 3, g = (tt >> 2) & 3, nt = tt >> 4;
            EpiChanDft e{VT, g};
            gemm_tile((const bf16_t*)(p.ws + WS_TW256), 256, U + g * 256, D, 4, lds, e, mt * 128, nt * 128);
        }
    } break;
    case 4: {
        for (int t = blockIdx.x; t < 512; t += G) {
            if (t < 256) {
                const int nt = t & 1, mt = (t >> 1) & 15, bg = t >> 5;
                EpiSeqDft<1> e{SZ, Y, NCTX + (bg >> 2) * 1024, bg & 3};
                gemm_tile<1>((const bf16_t*)(p.ws + WS_TS1024), 2048, VT + (size_t)64 * 256 * 512 + (size_t)bg * 256 * 2048, 2048, 32, lds, e, mt * 64, nt * 128);
            } else {
                const int u = t - 256, nt = u & 1, mt = (u >> 1) & 1, bg = u >> 2;
                EpiSeqDft<2> e{SZ, Y, (bg >> 2) * 256, bg & 3};
                gemm_tile<2>((const bf16_t*)(p.ws + WS_TS256), 512, VT + (size_t)bg * 256 * 512, 512, 8, lds, e, mt * 128, nt * 128);
            }
        }
    } break;
    case 5: {
        EpiOut<true, 2> e{p.x_prompt, p.x_sample, mod, X1, p.norm_w1, mod + 3 * 3072, H, (float*)(p.ws + WS_ROWSS)};
        EpiOut<true, 1> e1{p.x_prompt, p.x_sample, mod, X1, p.norm_w1, mod + 3 * 3072, H, (float*)(p.ws + WS_ROWSS)};
        if (G == 512) {
            if (blockIdx.x < 256) { const int tt = xcd_remap(blockIdx.x, 256); gemm_tile<2>(Y, D, (const bf16_t*)(p.ws + WS_WT0OUT), D, 16, lds, e, (tt >> 3) * 128, (tt & 7) * 128); }
            else { const int tt = xcd_remap(blockIdx.x - 256, 256); gemm_tile<1>(Y, D, (const bf16_t*)(p.ws + WS_WT0OUT), D, 16, lds, e1, 4096 + (tt >> 3) * 64, (tt & 7) * 128); }
        } else
        for (int t = blockIdx.x; t < 384; t += G) {
            const int tt = xcd_remap(t, 384);
            gemm_tile(Y, D, (const bf16_t*)(p.ws + WS_WT0OUT), D, 16, lds, e, (tt >> 3) * 128, (tt & 7) * 128);
        }
    } break;
    case 7: {
        EpiInL1 e{p.qnw, p.knw, (const float*)(p.ws + WS_ROPEC), (const float*)(p.ws + WS_ROPES),
                  (bf16_t*)(p.ws + WS_Q), (bf16_t*)(p.ws + WS_KB), (bf16_t*)(p.ws + WS_VTB), SZ,
                  p.out + (size_t)NTOK * D, p.out + (size_t)NTOK * D + (size_t)NCTX * 256,
                  (const float*)(p.ws + WS_ROWSS), (const float*)(p.ws + WS_BIAS1)};
        for (int t = blockIdx.x; t < 960; t += G) {
            const int tt = xcd_remap(t, 960);
            gemm_tile(H, D, (const bf16_t*)(p.ws + WS_WT1IN), D, 16, lds, e, (tt / 20) * 128, (tt % 20) * 128);
        }
    } break;
    case 8: {
        if (G == 512) {
            if (blockIdx.x < 256) attn_item(p, blockIdx.x, lds);
            else { attn_item(p, 256 + 2 * (blockIdx.x - 256), lds); attn_item(p, 257 + 2 * (blockIdx.x - 256), lds); }
        } else
            for (int t = blockIdx.x; t < 768; t += G) attn_item(p, t, lds);
    } break;
    case 9: {
        EpiOut<false, 2> e{X1, X1 + (size_t)NCTX * D, mod + 3 * 3072, p.out, nullptr, nullptr, nullptr, nullptr};
        EpiOut<false, 1> e1{X1, X1 + (size_t)NCTX * D, mod + 3 * 3072, p.out, nullptr, nullptr, nullptr, nullptr};
        if (G == 512) {
            if (blockIdx.x < 256) { const int tt = xcd_remap(blockIdx.x, 256); gemm_tile<2>(Y, D, (const bf16_t*)(p.ws + WS_WT1OUT), D, 16, lds, e, (tt >> 3) * 128, (tt & 7) * 128); }
            else { const int tt = xcd_remap(blockIdx.x - 256, 256); gemm_tile<1>(Y, D, (const bf16_t*)(p.ws + WS_WT1OUT), D, 16, lds, e1, 4096 + (tt >> 3) * 64, (tt & 7) * 128); }
        } else
        for (int t = blockIdx.x; t < 384; t += G) {
            const int tt = xcd_remap(t, 384);
            gemm_tile(Y, D, (const bf16_t*)(p.ws + WS_WT1OUT), D, 16, lds, e, (tt >> 3) * 128, (tt & 7) * 128);
        }
    } break;
    }
}

__global__ void __launch_bounds__(256, 2) mega(Params p) {
    __shared__ __attribute__((aligned(16))) unsigned char lds[65536 + 16];
    cg::grid_group grid = cg::this_grid();
#if SINGLE_LAUNCH
    volatile LAS unsigned* st = (volatile LAS unsigned*)(lds + 65536);
    if (threadIdx.x < 4) st[threadIdx.x] = 0u;
    __syncthreads();
    XcdBarrier bar = xcd_barrier_post((unsigned*)(p.ws + WS_BAR), st);
    if (p.ph_hi == 777) grid.sync();
#ifndef REP_PH
#define REP_PH -1
#endif
#ifndef REP_SY
#define REP_SY 0
#endif
#define PH(n) run_phase(p, n, lds); if (REP_PH == n) run_phase(p, n, lds);
#define SY() xcd_barrier(bar); if (REP_SY) xcd_barrier(bar);
#else
    const int lo = (int)p.ph_lo, hi = (int)p.ph_hi;
#define PH(n) if (lo <= n && n < hi) run_phase(p, n, lds);
#define SY()
#endif
    PH(0) SY() PH(2) SY() PH(3) SY() PH(4) SY() PH(5) SY() PH(7) SY() PH(8) SY() PH(9)
}

extern "C" void kernel_launch(void* const* d_in, const int* in_sizes, int n_in, void* d_out, int out_size, void* d_ws, size_t ws_size, hipStream_t stream) {
    static int grid_blocks = 0;
    if (!grid_blocks) {
        int dev = 0, cus = 0, per_cu = 0;
        hipGetDevice(&dev);
        hipDeviceGetAttribute(&cus, hipDeviceAttributeMultiprocessorCount, dev);
        hipOccupancyMaxActiveBlocksPerMultiprocessor(&per_cu, mega, 256, 0);
        if (per_cu > 2) per_cu = 2;
        if (per_cu < 1) per_cu = 1;
        grid_blocks = cus * per_cu;
    }
    Params p{};
    const float* const* in = (const float* const*)d_in;
    p.x_prompt = in[0]; p.x_sample = in[1]; p.cache_k = in[2]; p.cache_v = in[3]; p.c = in[4]; p.c_ctx = in[5];
    p.norm_w0 = in[6]; p.w_mod0 = in[7]; p.b_mod0 = in[8]; p.w_in0 = in[9]; p.w_out0 = in[10];
    p.norm_w1 = in[11]; p.w_mod1 = in[12]; p.b_mod1 = in[13]; p.w_in1 = in[14]; p.qnw = in[15]; p.knw = in[16]; p.sink = in[17]; p.w_out1 = in[18];
    p.out = (float*)d_out; p.ws = (unsigned char*)d_ws;
#if SINGLE_LAUNCH
    p.ph_lo = 0; p.ph_hi = 10;
    hipMemsetAsync((unsigned char*)d_ws + WS_BAR, 0, 16384, stream);
    void* args[] = {&p};
    hipError_t e = hipLaunchCooperativeKernel((void*)mega, dim3(grid_blocks), dim3(256), args, 0, stream);
    if (e != hipSuccess) fprintf(stderr, "cooperative launch failed: %s (grid %d)\n", hipGetErrorString(e), grid_blocks);
#else
    for (int ph = 0; ph < 10; ++ph) {
        p.ph_lo = ph; p.ph_hi = ph + 1;
        hipLaunchKernelGGL(mega, dim3(grid_blocks), dim3(256), 0, stream, p);
    }
#endif
}
```

```cpp
#include <hip/hip_runtime.h>
#include <hip/hip_cooperative_groups.h>
#include <stdint.h>
#include <cstdio>
namespace cg = cooperative_groups;

#ifndef SINGLE_LAUNCH
#define SINGLE_LAUNCH 1
#endif

typedef unsigned short bf16_t;
typedef short bf16x8 __attribute__((ext_vector_type(8)));
typedef float f32x16 __attribute__((ext_vector_type(16)));
typedef float f32x4 __attribute__((ext_vector_type(4)));
typedef unsigned u32x4 __attribute__((ext_vector_type(4)));
typedef unsigned u32x2 __attribute__((ext_vector_type(2)));
#define DEVI __device__ __forceinline__

constexpr int NTOK = 6144, NCTX = 4096, D = 1024;
constexpr float EPSV = 1e-6f;
constexpr float LOG2E = 1.4426950408889634f;

constexpr size_t WS_MOD = 0;
constexpr size_t WS_WT0IN = 1 << 20;
constexpr size_t WS_WT0OUT = WS_WT0IN + (size_t)2048 * 1024 * 2;
constexpr size_t WS_WT1IN = WS_WT0OUT + (size_t)1024 * 1024 * 2;
constexpr size_t WS_WT1OUT = WS_WT1IN + (size_t)2560 * 1024 * 2;
constexpr size_t WS_TW256 = WS_WT1OUT + (size_t)1024 * 1024 * 2;
constexpr size_t WS_TS256 = WS_TW256 + (size_t)512 * 256 * 2;
constexpr size_t WS_TS1024 = WS_TS256 + (size_t)256 * 512 * 2;
constexpr size_t WS_ROPEC = WS_TS1024 + (size_t)1024 * 2048 * 2;
constexpr size_t WS_ROPES = WS_ROPEC + (size_t)1024 * 32 * 4;
constexpr size_t WS_KC = WS_ROPES + (size_t)1024 * 32 * 4;
constexpr size_t WS_VCT = WS_KC + (size_t)2 * 256 * 256 * 2;
constexpr size_t WS_H = WS_VCT + (size_t)2 * 256 * 256 * 2;
constexpr size_t WS_U = WS_H + (size_t)NTOK * D * 2;
constexpr size_t WS_SZ = WS_U + (size_t)NTOK * D * 2;
constexpr size_t WS_VT = WS_SZ + (size_t)NTOK * D * 2;
constexpr size_t WS_Y = WS_VT + (size_t)NTOK * 2048 * 2;
constexpr size_t WS_X1 = WS_Y + (size_t)NTOK * D * 2;
constexpr size_t WS_Q = WS_X1 + (size_t)NTOK * D * 4;
constexpr size_t WS_KB = WS_Q + (size_t)NTOK * D * 2;
constexpr size_t WS_VTB = WS_KB + (size_t)NTOK * 256 * 2;
constexpr size_t WS_BAR = WS_VTB + (size_t)NTOK * 256 * 2;
constexpr size_t WS_CNT = WS_BAR + 14336;
constexpr size_t WS_ROWSS = WS_BAR + 16384;
constexpr size_t WS_BIAS1 = WS_ROWSS + 6144 * 4;
constexpr size_t WS_MODP = WS_BIAS1 + 3 * 2560 * 4;
constexpr size_t WS_END = WS_MODP + (size_t)4 * 18432 * 4;

struct Params {
    const float *x_prompt, *x_sample, *cache_k, *cache_v, *c, *c_ctx;
    const float *norm_w0, *w_mod0, *b_mod0, *w_in0, *w_out0;
    const float *norm_w1, *w_mod1, *b_mod1, *w_in1, *qnw, *knw, *sink, *w_out1;
    float* out;
    unsigned char* ws;
    long long ph_lo, ph_hi;
};

DEVI unsigned cvt_pk_bf16(float lo, float hi) { unsigned r; asm("v_cvt_pk_bf16_f32 %0, %1, %2" : "=v"(r) : "v"(lo), "v"(hi)); return r; }
DEVI bf16_t f2bf(float f) { return (bf16_t)(cvt_pk_bf16(f, 0.f) & 0xffffu); }
DEVI float silu_f(float v) { return v * __builtin_amdgcn_rcpf(1.f + __expf(-v)); }
DEVI int swap23(int x) { return (x & ~12) | ((x & 4) << 1) | ((x & 8) >> 1); }
DEVI int cond_of(int m) { return m < NCTX ? 0 : 1 + ((m - NCTX) >> 10); }

DEVI void st8(bf16_t* p, u32x2 a, u32x2 b) {
    const auto r0 = __builtin_amdgcn_permlane32_swap(a.x, b.x, false, false);
    const auto r1 = __builtin_amdgcn_permlane32_swap(a.y, b.y, false, false);
    u32x4 w; w.x = r0[0]; w.y = r1[0]; w.z = r0[1]; w.w = r1[1];
    *(u32x4*)p = w;
}
DEVI void put8(unsigned char* wl, int r, int c, u32x2 a, u32x2 b) {
    const auto r0 = __builtin_amdgcn_permlane32_swap(a.x, b.x, false, false);
    const auto r1 = __builtin_amdgcn_permlane32_swap(a.y, b.y, false, false);
    u32x4 w; w.x = r0[0]; w.y = r1[0]; w.z = r0[1]; w.w = r1[1];
    *(u32x4*)(wl + r * 128 + ((c ^ (r & 7)) << 4)) = w;
}
template <int ROWS, class RowPtr>
DEVI void flush8(const unsigned char* wl, int lane, const RowPtr& rowptr) {
#pragma unroll
    for (int i = 0; i < ROWS / 8; ++i) {
        const int r = i * 8 + (lane >> 3), c = lane & 7;
        const u32x4 w = *(const u32x4*)(wl + r * 128 + ((c ^ (r & 7)) << 4));
        *(u32x4*)(rowptr(r) + c * 8) = w;
    }
}
DEVI float xhalf_sum(float x) { const auto r = __builtin_amdgcn_permlane32_swap(__float_as_uint(x), __float_as_uint(x), false, false); return __uint_as_float(r[0]) + __uint_as_float(r[1]); }
DEVI float xhalf_max(float x) { const auto r = __builtin_amdgcn_permlane32_swap(__float_as_uint(x), __float_as_uint(x), false, false); return fmaxf(__uint_as_float(r[0]), __uint_as_float(r[1])); }

DEVI void glds16(const void* g, void* l) { __builtin_amdgcn_global_load_lds(g, l, 16, 0, 0); }

template <int MB = 2, class Epi>
DEVI void gemm_tile(const bf16_t* __restrict__ A, int lda, const bf16_t* __restrict__ B, int ldb, int nk,
                    unsigned char* lds, const Epi& epi, int m0, int n0) {
    const int tid = threadIdx.x, lane = tid & 63, wid = tid >> 6, wr = wid >> 1, wc = wid & 1;
    const int srow = tid >> 3;
    const int slc = (tid & 7) ^ ((tid >> 4) & 7);
    const bf16_t* gA = A + (size_t)(m0 + srow) * lda + slc * 8;
    const bf16_t* gB = B + (size_t)(n0 + srow) * ldb + slc * 8;
    const int fr = lane & 31, fh = lane >> 5, sw = (lane >> 1) & 7;
    const unsigned aoff = (wr * 32 * MB + fr) * 128, boff = 16384 + (wc * 64 + fr) * 128;
    f32x16 acc[MB][2];
#pragma unroll
    for (int i = 0; i < MB; ++i)
#pragma unroll
        for (int j = 0; j < 2; ++j)
#pragma unroll
            for (int r = 0; r < 16; ++r) acc[i][j][r] = 0.f;
    {
        unsigned char* la = lds + tid * 16;
#pragma unroll
        for (int i = 0; i < 4; ++i) {
            if (i < 2 * MB) glds16(gA + (size_t)i * 32 * lda, la + i * 4096);
            glds16(gB + (size_t)i * 32 * ldb, la + 16384 + i * 4096);
        }
    }
    for (int kt = 0; kt < nk; ++kt) {
        asm volatile("s_waitcnt vmcnt(0)" ::: "memory");
        __syncthreads();
        if (kt + 1 < nk) {
            unsigned char* la = lds + ((kt + 1) & 1) * 32768 + tid * 16;
            const int ko = (kt + 1) * 64;
#pragma unroll
            for (int i = 0; i < 4; ++i) {
                if (i < 2 * MB) glds16(gA + (size_t)i * 32 * lda + ko, la + i * 4096);
                glds16(gB + (size_t)i * 32 * ldb + ko, la + 16384 + i * 4096);
            }
        }
        const unsigned char* base = lds + (kt & 1) * 32768;
        bf16x8 af[4][2], bfr[4][2];
#define LDFRAG(ks) { const int ch = ((2 * (ks) + fh) ^ sw) * 16; \
            af[ks][0] = *(const bf16x8*)(base + aoff + ch); bfr[ks][0] = *(const bf16x8*)(base + boff + ch); \
            bfr[ks][1] = *(const bf16x8*)(base + boff + 4096 + ch); if (MB == 2) af[ks][1] = *(const bf16x8*)(base + aoff + 4096 + ch); }
#define MFMA4(ks) { acc[0][0] = __builtin_amdgcn_mfma_f32_32x32x16_bf16(bfr[ks][0], af[ks][0], acc[0][0], 0, 0, 0); \
            acc[0][1] = __builtin_amdgcn_mfma_f32_32x32x16_bf16(bfr[ks][1], af[ks][0], acc[0][1], 0, 0, 0); \
            if (MB == 2) { acc[MB - 1][0] = __builtin_amdgcn_mfma_f32_32x32x16_bf16(bfr[ks][0], af[ks][1], acc[MB - 1][0], 0, 0, 0); \
            acc[MB - 1][1] = __builtin_amdgcn_mfma_f32_32x32x16_bf16(bfr[ks][1], af[ks][1], acc[MB - 1][1], 0, 0, 0); } }
        LDFRAG(0) LDFRAG(1)
        __builtin_amdgcn_sched_barrier(0);
        MFMA4(0) LDFRAG(2)
        __builtin_amdgcn_sched_barrier(0);
        MFMA4(1) LDFRAG(3)
        __builtin_amdgcn_sched_barrier(0);
        MFMA4(2)
        __builtin_amdgcn_sched_barrier(0);
        MFMA4(3)
#undef LDFRAG
#undef MFMA4
    }
    epi(acc, m0 + wr * 32 * MB, n0 + wc * 64, fr, fh, lds + wid * 8192);
    __syncthreads();
}

DEVI int xcd_remap(int t, int T) { return (t & 7) * (T >> 3) + (t >> 3); }

DEVI void mod_item(const Params& p, int it, unsigned char* lds) {
    const int tid = threadIdx.x;
    const int ks = it & 3, lc = it >> 2, l = lc / 48, cc = lc % 48;
    float* sc = (float*)lds;
    for (int i = tid; i < 768; i += 256) {
        const int cv = i >> 8, k = ks * 256 + (i & 255);
        const float cval = cv == 0 ? p.c_ctx[k] : p.c[(cv - 1) * 1024 + k];
        sc[i] = silu_f(cval);
    }
    __syncthreads();
    const float* W = (l ? p.w_mod1 : p.w_mod0) + (size_t)ks * 256 * 3072;
    const int cg4 = tid & 15, rg = tid >> 4, c0 = cc * 64 + cg4 * 4;
    f32x4 w[16];
#pragma unroll
    for (int i = 0; i < 16; ++i) w[i] = *(const f32x4*)(W + (size_t)(rg + 16 * i) * 3072 + c0);
    f32x4 a0 = {0.f, 0.f, 0.f, 0.f}, a1 = a0, a2 = a0;
#pragma unroll
    for (int i = 0; i < 16; ++i) { const int k = rg + 16 * i; a0 += sc[k] * w[i]; a1 += sc[256 + k] * w[i]; a2 += sc[512 + k] * w[i]; }
    float* red = (float*)(lds + 12288);
#pragma unroll
    for (int e = 0; e < 4; ++e) {
        red[(rg * 3 + 0) * 64 + cg4 * 4 + e] = a0[e];
        red[(rg * 3 + 1) * 64 + cg4 * 4 + e] = a1[e];
        red[(rg * 3 + 2) * 64 + cg4 * 4 + e] = a2[e];
    }
    __syncthreads();
    if (tid < 192) {
        const int cv = tid >> 6, j = tid & 63;
        float s = 0.f;
#pragma unroll
        for (int r = 0; r < 16; ++r) s += red[(r * 3 + cv) * 64 + j];
        float* modp = (float*)(p.ws + WS_MODP) + (size_t)ks * 18432;
        __hip_atomic_store(&modp[(l * 3 + cv) * 3072 + cc * 64 + j], s, __ATOMIC_RELAXED, __HIP_MEMORY_SCOPE_AGENT);
    }
    asm volatile("s_waitcnt vmcnt(0)" ::: "memory");
    __syncthreads();
    if (tid == 0) __hip_atomic_fetch_add((unsigned*)(p.ws + WS_CNT), 1u, __ATOMIC_RELAXED, __HIP_MEMORY_SCOPE_AGENT);
}

struct TrDesc { const float* src; bf16_t* dst; int N, kt, nt; };
DEVI TrDesc tr_desc(const Params& p, int idx) {
    TrDesc d;
    if (idx < 512) { d.src = p.w_in0; d.dst = (bf16_t*)(p.ws + WS_WT0IN); d.N = 2048; }
    else if (idx < 768) { idx -= 512; d.src = p.w_out0; d.dst = (bf16_t*)(p.ws + WS_WT0OUT); d.N = 1024; }
    else if (idx < 1408) { idx -= 768; d.src = p.w_in1; d.dst = (bf16_t*)(p.ws + WS_WT1IN); d.N = 2560; }
    else { idx -= 1408; d.src = p.w_out1; d.dst = (bf16_t*)(p.ws + WS_WT1OUT); d.N = 1024; }
    const int ntn = d.N >> 6;
    d.kt = idx / ntn; d.nt = idx % ntn;
    return d;
}
DEVI void transpose_items(const Params& p, int first, int end, int stride, unsigned char* lds) {
    const int tid = threadIdx.x;
    float* tl = (float*)lds;
    if (first >= end) return;
    f32x4 v[4];
    TrDesc d = tr_desc(p, first);
#pragma unroll
    for (int pass = 0; pass < 4; ++pass) v[pass] = *(const f32x4*)(d.src + (size_t)(d.kt * 64 + pass * 16 + (tid >> 4)) * d.N + d.nt * 64 + (tid & 15) * 4);
    for (int idx = first; idx < end; idx += stride) {
#pragma unroll
        for (int pass = 0; pass < 4; ++pass) {
            const int r = pass * 16 + (tid >> 4), c4 = (tid & 15) * 4;
#pragma unroll
            for (int e = 0; e < 4; ++e) tl[r * 65 + c4 + e] = v[pass][e];
        }
        const TrDesc cur = d;
        if (idx + stride < end) {
            d = tr_desc(p, idx + stride);
#pragma unroll
            for (int pass = 0; pass < 4; ++pass) v[pass] = *(const f32x4*)(d.src + (size_t)(d.kt * 64 + pass * 16 + (tid >> 4)) * d.N + d.nt * 64 + (tid & 15) * 4);
        }
        __syncthreads();
#pragma unroll
        for (int pass = 0; pass < 2; ++pass) {
            const int n = pass * 32 + (tid >> 3), kc = tid & 7;
            float x[8];
#pragma unroll
            for (int j = 0; j < 8; ++j) x[j] = tl[(kc * 8 + j) * 65 + n];
            u32x4 w;
            w.x = cvt_pk_bf16(x[0], x[1]); w.y = cvt_pk_bf16(x[2], x[3]); w.z = cvt_pk_bf16(x[4], x[5]); w.w = cvt_pk_bf16(x[6], x[7]);
            *(u32x4*)(cur.dst + (size_t)(cur.nt * 64 + n) * 1024 + cur.kt * 64 + kc * 8) = w;
        }
        __syncthreads();
    }
}

DEVI void phase0(const Params& p, unsigned char* lds) {
    for (int it = blockIdx.x; it < 384; it += gridDim.x) mod_item(p, it, lds);
    transpose_items(p, (blockIdx.x + 128) % gridDim.x, 1664, gridDim.x, lds);
    const int gt = blockIdx.x * 256 + threadIdx.x, gs = gridDim.x * 256;
    bf16_t* tw256 = (bf16_t*)(p.ws + WS_TW256);
    bf16_t* ts256 = (bf16_t*)(p.ws + WS_TS256);
    bf16_t* ts1024 = (bf16_t*)(p.ws + WS_TS1024);
    float* lut = (float*)(lds + 32768);
    __syncthreads();
    for (int r = threadIdx.x; r < 1024; r += 256) lut[r] = cospif((float)r * (1.f / 512.f));
    __syncthreads();
    for (int i = gt; i < 512 * 256; i += gs) {
        const int m = i >> 8, j = i & 255, which = m >> 8, cp = m & 255;
        const int r = ((cp * j) & 255) << 2;
        tw256[i] = f2bf(which ? lut[(r - 256) & 1023] : lut[r]);
    }
    for (int i = gt; i < 256 * 512; i += gs) {
        const int sp = i >> 9, k2 = i & 511, which = k2 >> 8, s0 = k2 & 255;
        const int r = ((sp * s0) & 255) << 2;
        ts256[i] = f2bf((which ? -lut[(r - 256) & 1023] : lut[r]) * (1.f / 256.f));
    }
    for (int i = gt; i < 1024 * 2048; i += gs) {
        const int sp = i >> 11, k2 = i & 2047, which = k2 >> 10, s0 = k2 & 1023;
        const int r = (sp * s0) & 1023;
        ts1024[i] = f2bf((which ? -lut[(r - 256) & 1023] : lut[r]) * (1.f / 512.f));
    }
    float* ropec = (float*)(p.ws + WS_ROPEC);
    float* ropes = (float*)(p.ws + WS_ROPES);
    for (int i = gt; i < 1024 * 32; i += gs) {
        const int pos = i >> 5, f = i & 31;
        const int row = pos >> 6, col = pos & 63;
        const float inv = powf(10000.f, -(float)(f & 15) * (1.f / 16.f));
        const float ang = (float)(f < 16 ? row : col) * inv;
        float s, c; sincosf(ang, &s, &c);
        ropec[i] = c; ropes[i] = s;
    }
    for (int i = gt; i < NTOK; i += gs) ((float*)(p.ws + WS_ROWSS))[i] = 0.f;
    bf16_t* kc = (bf16_t*)(p.ws + WS_KC);
    bf16_t* vct = (bf16_t*)(p.ws + WS_VCT);
    for (int i = gt; i < 2 * 256 * 256; i += gs) {
        kc[i] = f2bf(p.cache_k[i]);
        const int b = i >> 16, kvh = (i >> 14) & 3, d = (i >> 8) & 63, pp = i & 255;
        const int key = swap23(pp);
        vct[i] = f2bf(p.cache_v[((b * 256 + key) * 4 + kvh) * 64 + d]);
    }
}

DEVI void phase_norm(const Params& p, int layer, const float* lmod  ) {
    const int lane = threadIdx.x & 63, wid = threadIdx.x >> 6;
    const float* nw = layer ? p.norm_w1 : p.norm_w0;
    bf16_t* H = (bf16_t*)(p.ws + WS_H);
    for (int row = blockIdx.x * 4 + wid; row < NTOK; row += gridDim.x * 4) {
        const float* xr;
        if (layer == 0) xr = row < NCTX ? p.x_prompt + (size_t)row * D : p.x_sample + (size_t)(row - NCTX) * D;
        else xr = (const float*)(p.ws + WS_X1) + (size_t)row * D;
        const float* mv = lmod + cond_of(row) * 2048;
        f32x4 v[4];
        float ss = 0.f;
#pragma unroll
        for (int i = 0; i < 4; ++i) {
            v[i] = *(const f32x4*)(xr + i * 256 + lane * 4);
            ss += v[i][0] * v[i][0] + v[i][1] * v[i][1] + v[i][2] * v[i][2] + v[i][3] * v[i][3];
        }
#pragma unroll
        for (int o = 32; o >= 1; o >>= 1) ss += __shfl_xor(ss, o);
        const float rstd = rsqrtf(ss * (1.f / 1024.f) + EPSV);
#pragma unroll
        for (int i = 0; i < 4; ++i) {
            const int k = i * 256 + lane * 4;
            const f32x4 w = *(const f32x4*)(nw + k);
            const f32x4 sh = *(const f32x4*)(mv + k);
            const f32x4 scl = *(const f32x4*)(mv + 1024 + k);
            float h[4];
#pragma unroll
            for (int e = 0; e < 4; ++e) h[e] = (v[i][e] * rstd * w[e]) * (1.f + scl[e]) + sh[e];
            u32x2 o; o.x = cvt_pk_bf16(h[0], h[1]); o.y = cvt_pk_bf16(h[2], h[3]);
            *(u32x2*)(H + (size_t)row * D + k) = o;
        }
    }
}

DEVI void bias1_items(const Params& p) {
    const int lane = threadIdx.x & 63, gw = blockIdx.x * 4 + (threadIdx.x >> 6), nw = gridDim.x * 4;
    const float* mod1 = (const float*)(p.ws + WS_MOD) + 3 * 3072;
    const bf16_t* WT = (const bf16_t*)(p.ws + WS_WT1IN);
    float* bias1 = (float*)(p.ws + WS_BIAS1);
    for (int n = gw; n < 2560; n += nw) {
        float w[16];
        const u32x4 r0 = *(const u32x4*)(WT + (size_t)n * 1024 + lane * 16), r1 = *(const u32x4*)(WT + (size_t)n * 1024 + lane * 16 + 8);
        const unsigned rr[8] = {r0.x, r0.y, r0.z, r0.w, r1.x, r1.y, r1.z, r1.w};
#pragma unroll
        for (int i = 0; i < 8; ++i) { w[2 * i] = __uint_as_float(rr[i] << 16); w[2 * i + 1] = __uint_as_float(rr[i] & 0xffff0000u); }
        float s[3];
#pragma unroll
        for (int cv = 0; cv < 3; ++cv) {
            float a = 0.f;
#pragma unroll
            for (int q = 0; q < 4; ++q) {
                const f32x4 sh = *(const f32x4*)(mod1 + cv * 3072 + lane * 16 + q * 4);
#pragma unroll
                for (int e = 0; e < 4; ++e) a += sh[e] * w[q * 4 + e];
            }
#pragma unroll
            for (int o = 32; o >= 1; o >>= 1) a += __shfl_xor(a, o);
            s[cv] = a;
        }
        if (lane == 0) { bias1[n] = s[0]; bias1[2560 + n] = s[1]; bias1[5120 + n] = s[2]; }
    }
}

struct EpiInL0 {
    bf16_t *U, *SZ;
    DEVI void operator()(const f32x16 (&acc)[2][2], int mbase, int nbase, int fr, int fh, unsigned char* wl) const {
        const bool isz = nbase >= 1024;
        bf16_t* dst = isz ? SZ : U;
        const int nb0 = isz ? nbase - 1024 : nbase;
        u32x2 keep = {0u, 0u};
#pragma unroll
        for (int mb = 0; mb < 2; ++mb)
#pragma unroll
            for (int nb = 0; nb < 2; ++nb)
#pragma unroll
                for (int g = 0; g < 4; ++g) {
                    const int m = mbase + mb * 32 + fr, n = nb0 + nb * 32 + 8 * g + 4 * fh;
                    float v[4];
#pragma unroll
                    for (int e = 0; e < 4; ++e) { v[e] = acc[mb][nb][4 * g + e]; if (isz) v[e] = silu_f(v[e]); }
                    u32x2 o; o.x = cvt_pk_bf16(v[0], v[1]); o.y = cvt_pk_bf16(v[2], v[3]);
                    if ((g & 1) == 0) keep = o; else put8(wl, mb * 32 + fr, nb * 4 + (g - 1) + fh, keep, o);
                }
        flush8<64>(wl, fh * 32 + fr, [&](int r) { return dst + (size_t)(mbase + r) * D + nb0; });
    }
};

struct EpiChanDft {
    bf16_t* VT; int g;
    DEVI void operator()(const f32x16 (&acc)[2][2], int mbase, int nbase, int fr, int fh, unsigned char* wl) const {
        int S, bgi, s0; bf16_t* base;
        if (nbase < NCTX) { S = 256; bgi = (nbase >> 8) * 4 + g; s0 = nbase & 255; base = VT; }
        else { const int t = nbase - NCTX; S = 1024; bgi = (t >> 10) * 4 + g; s0 = t & 1023; base = VT + (size_t)64 * 256 * 512; }
        u32x2 keep = {0u, 0u};
#pragma unroll
        for (int mb = 0; mb < 2; ++mb)
#pragma unroll
            for (int nb = 0; nb < 2; ++nb)
#pragma unroll
                for (int gq = 0; gq < 4; ++gq) {
                    const int m = mbase + mb * 32 + fr, which = m >> 8, cp = m & 255;
                    const int s = s0 + nb * 32 + 8 * gq + 4 * fh;
                    u32x2 o; o.x = cvt_pk_bf16(acc[mb][nb][4 * gq], acc[mb][nb][4 * gq + 1]); o.y = cvt_pk_bf16(acc[mb][nb][4 * gq + 2], acc[mb][nb][4 * gq + 3]);
                    if ((gq & 1) == 0) keep = o; else put8(wl, mb * 32 + fr, nb * 4 + (gq - 1) + fh, keep, o);
                }
        flush8<64>(wl, fh * 32 + fr, [&](int r) { const int m = mbase + r; return base + ((size_t)bgi * 256 + (m & 255)) * (2 * S) + (m >> 8) * S + s0; });
    }
};

template <int MB> struct EpiSeqDft {
    const bf16_t* SZ; bf16_t* Y; int tok0, g;
    DEVI void operator()(const f32x16 (&acc)[MB][2], int mbase, int nbase, int fr, int fh, unsigned char* wl) const {
        u32x2 keep = {0u, 0u};
#pragma unroll
        for (int mb = 0; mb < MB; ++mb)
#pragma unroll
            for (int nb = 0; nb < 2; ++nb)
#pragma unroll
                for (int gq = 0; gq < 4; ++gq) {
                    const int tok = tok0 + mbase + mb * 32 + fr;
                    const int col = g * 256 + nbase + nb * 32 + 8 * gq + 4 * fh;
                    const u32x2 z = *(const u32x2*)(SZ + (size_t)tok * D + col);
                    const float z0 = __uint_as_float(z.x << 16), z1 = __uint_as_float(z.x & 0xffff0000u);
                    const float z2 = __uint_as_float(z.y << 16), z3 = __uint_as_float(z.y & 0xffff0000u);
                    u32x2 o; o.x = cvt_pk_bf16(acc[mb][nb][4 * gq] * z0, acc[mb][nb][4 * gq + 1] * z1);
                    o.y = cvt_pk_bf16(acc[mb][nb][4 * gq + 2] * z2, acc[mb][nb][4 * gq + 3] * z3);
                    if ((gq & 1) == 0) keep = o; else put8(wl, mb * 32 + fr, nb * 4 + (gq - 1) + fh, keep, o);
                }
        flush8<32 * MB>(wl, fh * 32 + fr, [&](int r) { return Y + (size_t)(tok0 + mbase + r) * D + g * 256 + nbase; });
    }
};

#define DPP_ADD(x, CTRL) ((x) + __uint_as_float((unsigned)__builtin_amdgcn_update_dpp(0, (int)__float_as_uint(x), CTRL, 0xF, 0xF, true)))
DEVI float row16_sum(float x) {
    x = DPP_ADD(x, 0xB1);
    x = DPP_ADD(x, 0x4E);
    x = DPP_ADD(x, 0x141);
    x = DPP_ADD(x, 0x140);
    return x;
}
template <bool NEXT, int MB> struct EpiOut {
    const float* xa; const float* xb;
    const float* mod;
    float* out;
    const float* nw1; const float* mod1; bf16_t* Hn; float* rowss;
    DEVI void operator()(const f32x16 (&acc)[MB][2], int mbase, int nbase, int fr, int fh, unsigned char* wl) const {
        const int lane = fh * 32 + fr, c4 = lane & 15, rsub = lane >> 4;
        const int cv = cond_of(mbase);
        const int n = nbase + c4 * 4;
        const f32x4 gv = *(const f32x4*)(mod + cv * 3072 + 2048 + n);
        f32x4 hv = {0.f, 0.f, 0.f, 0.f};
        if (NEXT) {
            const f32x4 w = *(const f32x4*)(nw1 + n);
            const f32x4 sc = *(const f32x4*)(mod1 + cv * 3072 + 1024 + n);
#pragma unroll
            for (int e = 0; e < 4; ++e) hv[e] = w[e] * (1.f + sc[e]);
        }
#pragma unroll
        for (int mb = 0; mb < MB; ++mb) {
#pragma unroll
            for (int nb = 0; nb < 2; ++nb)
#pragma unroll
                for (int g = 0; g < 4; ++g) {
                    f32x4 a = {acc[mb][nb][4 * g], acc[mb][nb][4 * g + 1], acc[mb][nb][4 * g + 2], acc[mb][nb][4 * g + 3]};
                    *(f32x4*)(wl + fr * 256 + (((nb * 8 + 2 * g + fh) ^ (fr & 15)) << 4)) = a;
                }
#pragma unroll
            for (int i = 0; i < 8; ++i) {
                const int r = i * 4 + rsub, m = mbase + mb * 32 + r;
                const f32x4 a = *(const f32x4*)(wl + r * 256 + ((c4 ^ (r & 15)) << 4));
                const float* xr = m < NCTX ? xa + (size_t)m * D : xb + (size_t)(m - NCTX) * D;
                const f32x4 xv = *(const f32x4*)(xr + n);
                f32x4 o;
#pragma unroll
                for (int e = 0; e < 4; ++e) o[e] = xv[e] + gv[e] * a[e];
                *(f32x4*)(out + (size_t)m * D + n) = o;
                if (NEXT) {
                    float ss = (o[0] * o[0] + o[1] * o[1]) + (o[2] * o[2] + o[3] * o[3]);
                    ss = row16_sum(ss);
                    if (c4 == 0) atomicAdd(rowss + m, ss);
                    u32x2 hb; hb.x = cvt_pk_bf16(o[0] * hv[0], o[1] * hv[1]); hb.y = cvt_pk_bf16(o[2] * hv[2], o[3] * hv[3]);
                    *(u32x2*)(Hn + (size_t)m * D + n) = hb;
                }
            }
        }
    }
};

struct EpiInL1 {
    const float *qnw, *knw, *ropec, *ropes;
    bf16_t *Q, *KB, *VTB, *SZ;
    float *outk, *outv;
    const float* rowss; const float* bias1;
    DEVI void operator()(const f32x16 (&acc_in)[2][2], int mbase, int nbase, int fr, int fh, unsigned char* wl) const {
        const bool lat = mbase >= NCTX;
        u32x2 keep1 = {0u, 0u}, keep2 = {0u, 0u};
        f32x16 acc[2][2];
        {
            const float* bp = bias1 + cond_of(mbase) * 2560 + nbase;
#pragma unroll
            for (int mb = 0; mb < 2; ++mb) {
                const float rstd = rsqrtf(rowss[mbase + mb * 32 + fr] * (1.f / 1024.f) + EPSV);
#pragma unroll
                for (int nb = 0; nb < 2; ++nb)
#pragma unroll
                    for (int g = 0; g < 4; ++g) {
                        const f32x4 bv = *(const f32x4*)(bp + nb * 32 + 8 * g + 4 * fh);
#pragma unroll
                        for (int e = 0; e < 4; ++e) acc[mb][nb][4 * g + e] = acc_in[mb][nb][4 * g + e] * rstd + bv[e];
                    }
            }
        }
        if (nbase < 1280) {
            const bool isq = nbase < 1024;
            const float* nwp = isq ? qnw : knw;
#pragma unroll
            for (int mb = 0; mb < 2; ++mb) {
                const int m = mbase + mb * 32 + fr;
                float ss = 0.f;
#pragma unroll
                for (int nb = 0; nb < 2; ++nb)
#pragma unroll
                    for (int r = 0; r < 16; ++r) ss += acc[mb][nb][r] * acc[mb][nb][r];
                ss = xhalf_sum(ss);
                const float rn = rsqrtf(ss * (1.f / 64.f) + EPSV);
                const int pos = lat ? ((m - NCTX) & 1023) : 0;
#pragma unroll
                for (int g = 0; g < 4; ++g) {
                    const int d0 = 8 * g + 4 * fh;
                    const f32x4 w1 = *(const f32x4*)(nwp + d0), w2 = *(const f32x4*)(nwp + 32 + d0);
                    float x1[4], x2[4];
#pragma unroll
                    for (int e = 0; e < 4; ++e) { x1[e] = acc[mb][0][4 * g + e] * rn * w1[e]; x2[e] = acc[mb][1][4 * g + e] * rn * w2[e]; }
                    if (lat) {
                        const f32x4 cv = *(const f32x4*)(ropec + pos * 32 + d0), sv = *(const f32x4*)(ropes + pos * 32 + d0);
#pragma unroll
                        for (int e = 0; e < 4; ++e) { const float a = x1[e], b = x2[e]; x1[e] = a * cv[e] - b * sv[e]; x2[e] = a * sv[e] + b * cv[e]; }
                    }
                    if (isq) {
                        const float qs = 0.125f * LOG2E;
                        u32x2 o1, o2;
                        o1.x = cvt_pk_bf16(x1[0] * qs, x1[1] * qs); o1.y = cvt_pk_bf16(x1[2] * qs, x1[3] * qs);
                        o2.x = cvt_pk_bf16(x2[0] * qs, x2[1] * qs); o2.y = cvt_pk_bf16(x2[2] * qs, x2[3] * qs);
                        if ((g & 1) == 0) { keep1 = o1; keep2 = o2; }
                        else { put8(wl, mb * 32 + fr, (g - 1) + fh, keep1, o1); put8(wl, mb * 32 + fr, 4 + (g - 1) + fh, keep2, o2); }
                    } else {
                        const int kc = nbase - 1024;
                        u32x2 o1, o2;
                        o1.x = cvt_pk_bf16(x1[0], x1[1]); o1.y = cvt_pk_bf16(x1[2], x1[3]);
                        o2.x = cvt_pk_bf16(x2[0], x2[1]); o2.y = cvt_pk_bf16(x2[2], x2[3]);
                        if ((g & 1) == 0) { keep1 = o1; keep2 = o2; }
                        else { put8(wl, mb * 32 + fr, (g - 1) + fh, keep1, o1); put8(wl, mb * 32 + fr, 4 + (g - 1) + fh, keep2, o2); }
                        if (!lat) {
                            f32x4 f1 = {x1[0], x1[1], x1[2], x1[3]}, f2 = {x2[0], x2[1], x2[2], x2[3]};
                            *(f32x4*)(outk + (size_t)m * 256 + kc + d0) = f1;
                            *(f32x4*)(outk + (size_t)m * 256 + kc + 32 + d0) = f2;
                        }
                    }
                }
            }
            if (isq) flush8<64>(wl, fh * 32 + fr, [&](int r) { return Q + (size_t)(mbase + r) * D + nbase; });
            else flush8<64>(wl, fh * 32 + fr, [&](int r) { return KB + (size_t)(mbase + r) * 256 + (nbase - 1024); });
        } else if (nbase < 1536) {
            const int vc = nbase - 1280, kvh = vc >> 6;
            bf16_t* vtb; int S, sbase;
            if (!lat) { S = 256; sbase = mbase & 255; vtb = VTB + ((size_t)((mbase >> 8) * 4 + kvh) * 64) * 256; }
            else { const int t = mbase - NCTX; S = 1024; sbase = t & 1023; vtb = VTB + (size_t)16 * 4 * 64 * 256 + ((size_t)((t >> 10) * 4 + kvh) * 64) * 1024; }
#pragma unroll
            for (int mb = 0; mb < 2; ++mb) {
                const int m = mbase + mb * 32 + fr;
                const int cpos = swap23(mb * 32 + fr);
                unsigned char* wcol = wl + ((cpos & 7) << 1);
                const int cch = cpos >> 3;
#pragma unroll
                for (int nb = 0; nb < 2; ++nb)
#pragma unroll
                    for (int g = 0; g < 4; ++g) {
                        const int d0 = nb * 32 + 8 * g + 4 * fh;
#pragma unroll
                        for (int e = 0; e < 4; ++e) { const int d = d0 + e; *(bf16_t*)(wcol + d * 128 + ((cch ^ (d & 7)) << 4)) = f2bf(acc[mb][nb][4 * g + e]); }
                        if (!lat) {
                            f32x4 f = {acc[mb][nb][4 * g], acc[mb][nb][4 * g + 1], acc[mb][nb][4 * g + 2], acc[mb][nb][4 * g + 3]};
                            *(f32x4*)(outv + (size_t)m * 256 + vc + d0) = f;
                        }
                    }
            }
            flush8<64>(wl, fh * 32 + fr, [&](int r) { return vtb + (size_t)r * S + sbase; });
        } else {
            const int zc = nbase - 1536;
#pragma unroll
            for (int mb = 0; mb < 2; ++mb)
#pragma unroll
                for (int nb = 0; nb < 2; ++nb)
#pragma unroll
                    for (int g = 0; g < 4; ++g) {
                        const int m = mbase + mb * 32 + fr, n = zc + nb * 32 + 8 * g + 4 * fh;
                        u32x2 o; o.x = cvt_pk_bf16(silu_f(acc[mb][nb][4 * g]), silu_f(acc[mb][nb][4 * g + 1]));
                        o.y = cvt_pk_bf16(silu_f(acc[mb][nb][4 * g + 2]), silu_f(acc[mb][nb][4 * g + 3]));
                        if ((g & 1) == 0) keep1 = o; else put8(wl, mb * 32 + fr, nb * 4 + (g - 1) + fh, keep1, o);
                    }
            flush8<64>(wl, fh * 32 + fr, [&](int r) { return SZ + (size_t)(mbase + r) * D + zc; });
        }
    }
};

DEVI void attn_item(const Params& p, int item, unsigned char* lds) {
    const int lane = threadIdx.x & 63, w = threadIdx.x >> 6, fr = lane & 31, fh = lane >> 5;
    const bf16_t* Q = (const bf16_t*)(p.ws + WS_Q);
    const bf16_t* KB = (const bf16_t*)(p.ws + WS_KB);
    const bf16_t* VTB = (const bf16_t*)(p.ws + WS_VTB);
    const bf16_t* KC = (const bf16_t*)(p.ws + WS_KC);
    const bf16_t* VCT = (const bf16_t*)(p.ws + WS_VCT);
    const bf16_t* SZ = (const bf16_t*)(p.ws + WS_SZ);
    bf16_t* Y = (bf16_t*)(p.ws + WS_Y);
    bool lat; int b, kvh, qb, tb;
    if (item < 256) { lat = true; b = item >> 7; kvh = (item >> 5) & 3; qb = item & 31; tb = NCTX + b * 1024; }
    else { const int it = item - 256; lat = false; b = it >> 5; kvh = (it >> 3) & 3; qb = it & 7; tb = b * 256; }
    const int head = kvh * 4 + w;
    const int qtok = tb + qb * 32 + fr;
    bf16x8 qf[4];
#pragma unroll
    for (int ks = 0; ks < 4; ++ks) qf[ks] = *(const bf16x8*)(Q + (size_t)qtok * D + head * 64 + ks * 16 + fh * 8);
    float m_run = p.sink[head] * LOG2E, l_run = 1.f;
    f32x16 O[2];
#pragma unroll
    for (int i = 0; i < 2; ++i)
#pragma unroll
        for (int r = 0; r < 16; ++r) O[i][r] = 0.f;

    int nloc, k_lo = 0; const bf16_t *kloc, *vloc; int ldloc;
    if (lat) {
        k_lo = qb - 4 < 0 ? 0 : qb - 4; const int k_hi = qb + 4 > 31 ? 31 : qb + 4; nloc = k_hi - k_lo + 1;
        kloc = KB + (size_t)(tb + k_lo * 32) * 256 + kvh * 64;
        vloc = VTB + (size_t)16 * 4 * 64 * 256 + ((size_t)(b * 4 + kvh) * 64) * 1024 + k_lo * 32; ldloc = 1024;
    } else {
        nloc = 8; kloc = KB + (size_t)tb * 256 + kvh * 64; vloc = VTB + ((size_t)(b * 4 + kvh) * 64) * 256; ldloc = 256;
    }
    const int nblk = lat ? nloc + 8 : 8;
    const bf16_t* kcb = KC + (size_t)(b * 256) * 256 + kvh * 64;
    const bf16_t* vcb = VCT + ((size_t)(b * 4 + kvh) * 64) * 256;
    const int tid = threadIdx.x;
    const int kkey = tid >> 3, kch = tid & 7, vd = tid >> 2, vch = tid & 3;
    const unsigned kst = kkey * 128 + ((kch ^ ((kkey >> 1) & 7)) << 4), vst = 4096 + vd * 64 + ((vch ^ ((vd >> 2) & 3)) << 4);
    const unsigned ksw = (fr >> 1) & 7, vsw = (fr >> 2) & 3;
    u32x4 kreg, vreg;
    auto loadkv = [&](int j) {
        const bf16_t *kp, *vp; int ldv;
        if (j < nloc) { kp = kloc + (size_t)j * 32 * 256; vp = vloc + j * 32; ldv = ldloc; }
        else { const int c = j - nloc; kp = kcb + (size_t)c * 32 * 256; vp = vcb + c * 32; ldv = 256; }
        kreg = *(const u32x4*)(kp + (size_t)kkey * 256 + kch * 8);
        vreg = *(const u32x4*)(vp + (size_t)vd * ldv + vch * 8);
    };
    loadkv(0);
    *(u32x4*)(lds + kst) = kreg; *(u32x4*)(lds + vst) = vreg;
    if (nblk > 1) loadkv(1);
    __syncthreads();
    for (int j = 0; j < nblk; ++j) {
        const unsigned char* lb = lds + (j & 1) * 8192;
        bf16x8 kf[4], vf[4];
#pragma unroll
        for (int ks = 0; ks < 4; ++ks) kf[ks] = *(const bf16x8*)(lb + fr * 128 + (((2 * ks + fh) ^ ksw) << 4));
#pragma unroll
        for (int s2 = 0; s2 < 2; ++s2)
#pragma unroll
            for (int db = 0; db < 2; ++db) vf[s2 * 2 + db] = *(const bf16x8*)(lb + 4096 + (db * 32 + fr) * 64 + (((2 * s2 + fh) ^ vsw) << 4));
        f32x16 s;
#pragma unroll
        for (int r = 0; r < 16; ++r) s[r] = 0.f;
#pragma unroll
        for (int ks = 0; ks < 4; ++ks) s = __builtin_amdgcn_mfma_f32_32x32x16_bf16(kf[ks], qf[ks], s, 0, 0, 0);
        if (lat && j < nloc) {
            const int kb = k_lo + j;
            const int mode = (kb == qb - 4) ? 1 : (kb == qb + 4) ? 2 : 0;
            if (mode) {
                const int dpos = (kb - qb) * 32;
#pragma unroll
                for (int r = 0; r < 16; ++r) {
                    const int rel = dpos + (r & 3) + 8 * (r >> 2) + 4 * fh - fr;
                    const bool ok = mode == 1 ? (rel >= -128) : (rel <= 128);
                    if (!ok) s[r] = -1e30f;
                }
            }
        }
        float mx = s[0];
#pragma unroll
        for (int r = 1; r < 16; ++r) mx = fmaxf(mx, s[r]);
        mx = xhalf_max(mx);
        const float m_new = fmaxf(m_run, mx);
        const float alpha = __builtin_amdgcn_exp2f(m_run - m_new);
        float rs = 0.f;
#pragma unroll
        for (int r = 0; r < 16; ++r) { s[r] = __builtin_amdgcn_exp2f(s[r] - m_new); rs += s[r]; }
        rs = xhalf_sum(rs);
        l_run = l_run * alpha + rs; m_run = m_new;
#pragma unroll
        for (int i = 0; i < 2; ++i)
#pragma unroll
            for (int r = 0; r < 16; ++r) O[i][r] *= alpha;
#pragma unroll
        for (int s2 = 0; s2 < 2; ++s2) {
            union { u32x4 u; bf16x8 v; } pf;
            pf.u.x = cvt_pk_bf16(s[8 * s2 + 0], s[8 * s2 + 1]); pf.u.y = cvt_pk_bf16(s[8 * s2 + 2], s[8 * s2 + 3]);
            pf.u.z = cvt_pk_bf16(s[8 * s2 + 4], s[8 * s2 + 5]); pf.u.w = cvt_pk_bf16(s[8 * s2 + 6], s[8 * s2 + 7]);
#pragma unroll
            for (int db = 0; db < 2; ++db) O[db] = __builtin_amdgcn_mfma_f32_32x32x16_bf16(vf[s2 * 2 + db], pf.v, O[db], 0, 0, 0);
        }
        if (j + 1 < nblk) {
            unsigned char* nb = lds + ((j + 1) & 1) * 8192;
            *(u32x4*)(nb + kst) = kreg; *(u32x4*)(nb + vst) = vreg;
            if (j + 2 < nblk) loadkv(j + 2);
        }
        __syncthreads();
    }
    const float il = 1.f / l_run;
    u32x2 keepy = {0u, 0u};
#pragma unroll
    for (int db = 0; db < 2; ++db)
#pragma unroll
        for (int g = 0; g < 4; ++g) {
            const int col = head * 64 + db * 32 + 8 * g + 4 * fh;
            const u32x2 z = *(const u32x2*)(SZ + (size_t)qtok * D + col);
            const float z0 = __uint_as_float(z.x << 16), z1 = __uint_as_float(z.x & 0xffff0000u);
            const float z2 = __uint_as_float(z.y << 16), z3 = __uint_as_float(z.y & 0xffff0000u);
            u32x2 o; o.x = cvt_pk_bf16(O[db][4 * g] * il * z0, O[db][4 * g + 1] * il * z1);
            o.y = cvt_pk_bf16(O[db][4 * g + 2] * il * z2, O[db][4 * g + 3] * il * z3);
            if ((g & 1) == 0) keepy = o; else put8(lds + w * 8192, fr, db * 4 + (g - 1) + fh, keepy, o);
        }
    flush8<32>(lds + w * 8192, lane, [&](int r) { return Y + (size_t)(tb + qb * 32 + r) * D + head * 64; });
    __syncthreads();
}


#define XB_TMO      128
#define XB_XCNT(j)  (256  + 64 * (j))
#define XB_XSUB(j)  (1280 + 64 * (j))
#define XB_XGEN(j)  (2304 + 64 * (j))
#define XB_TOP      3328
#define XB_TOPGEN   3392
#define XCD_BAR_WORDS 3456
#define XB_SPIN_CAP (1u << 18)
#define LAS __attribute__((address_space(3)))
DEVI unsigned xb_ld(unsigned* p)              { return __hip_atomic_load(p, __ATOMIC_RELAXED, __HIP_MEMORY_SCOPE_AGENT); }
DEVI unsigned xb_add(unsigned* p, unsigned v) { return __hip_atomic_fetch_add(p, v, __ATOMIC_RELAXED, __HIP_MEMORY_SCOPE_AGENT); }
DEVI unsigned xb_xcc_id() { return (unsigned)__builtin_amdgcn_s_getreg((3 << 11) | 20) & 0xFu; }
#define XB_SPIN(cond, bar) do { unsigned _sp = 0; while (cond) { __builtin_amdgcn_s_sleep(1); \
    if ((++_sp & 255u) == 0u) { if (xb_ld(&(bar)[XB_TMO])) break; if (_sp > XB_SPIN_CAP) { atomicAdd(&(bar)[XB_TMO], 1u); break; } } } } while (0)
struct XcdBarrier { unsigned* bar; unsigned x; volatile LAS unsigned* st; };
DEVI XcdBarrier xcd_barrier_post(unsigned* bar, volatile LAS unsigned* st) {
    XcdBarrier b; b.bar = bar; b.x = xb_xcc_id(); b.st = st;
    if (threadIdx.x == 0) (void)xb_add(&bar[XB_XCNT(b.x)], 1u);
    return b;
}
DEVI void xcd_barrier_complete(unsigned* bar, unsigned x, unsigned& nloc, unsigned& nx) {
    const unsigned G = gridDim.x * gridDim.y * gridDim.z;
    unsigned sum, cnt, mine, sp = 0u;
    for (;;) {
        sum = 0u; cnt = 0u; mine = 0u;
#pragma unroll
        for (unsigned j = 0; j < 16; ++j) { const unsigned c = xb_ld(&bar[XB_XCNT(j)]); sum += c; cnt += (c > 0u) ? 1u : 0u; mine = (j == x) ? c : mine; }
        if (sum == G) break;
        __builtin_amdgcn_s_sleep(1);
        if ((++sp & 255u) == 0u) { if (xb_ld(&bar[XB_TMO])) break; if (sp > XB_SPIN_CAP) { atomicAdd(&bar[XB_TMO], 1u); break; } }
    }
    nloc = mine > 0u ? mine : 1u; nx = cnt > 0u ? cnt : 1u;
}
DEVI void xcd_barrier(const XcdBarrier& b) {
    asm volatile("s_waitcnt vmcnt(0)" ::: "memory");
    __syncthreads();
    if (threadIdx.x == 0) {
        unsigned* bar = b.bar;
        __builtin_amdgcn_s_waitcnt(0);
        unsigned nloc = b.st[0], nx = b.st[1];
        if (nloc == 0u) { xcd_barrier_complete(bar, b.x, nloc, nx); b.st[0] = nloc; b.st[1] = nx; }
        const unsigned old = xb_add(&bar[XB_XSUB(b.x)], 1u);
        const unsigned gen = old / nloc;
        if (old + 1u == (gen + 1u) * nloc) {
            __builtin_amdgcn_fence(__ATOMIC_RELEASE, "agent");
            asm volatile("s_waitcnt vmcnt(0)" ::: "memory");
            const unsigned og = xb_add(&bar[XB_TOP], 1u);
            const unsigned tg = og / nx;
            if (og + 1u == (tg + 1u) * nx) xb_add(&bar[XB_TOPGEN], 1u);
            else XB_SPIN(xb_ld(&bar[XB_TOPGEN]) == tg, bar);
            __builtin_amdgcn_fence(__ATOMIC_ACQUIRE, "agent");
            xb_add(&bar[XB_XGEN(b.x)], 1u);
            asm volatile("s_waitcnt vmcnt(0)" ::: "memory");
        } else {
            XB_SPIN(xb_ld(&bar[XB_XGEN(b.x)]) == gen, bar);
            __builtin_amdgcn_fence(__ATOMIC_ACQUIRE, "agent");
            asm volatile("s_waitcnt vmcnt(0)" ::: "memory");
        }
    }
    __syncthreads();
}

DEVI void run_phase(const Params& p, int ph, unsigned char* lds) {
    const int G = gridDim.x;
    bf16_t* H = (bf16_t*)(p.ws + WS_H);
    bf16_t* U = (bf16_t*)(p.ws + WS_U);
    bf16_t* SZ = (bf16_t*)(p.ws + WS_SZ);
    bf16_t* VT = (bf16_t*)(p.ws + WS_VT);
    bf16_t* Y = (bf16_t*)(p.ws + WS_Y);
    float* X1 = (float*)(p.ws + WS_X1);
    const float* mod = (const float*)(p.ws + WS_MOD);
    switch (ph) {
    case 0: {
        phase0(p, lds);
        if (threadIdx.x == 0) {
            unsigned* cnt = (unsigned*)(p.ws + WS_CNT); unsigned sp = 0;
            while (__hip_atomic_load(cnt, __ATOMIC_RELAXED, __HIP_MEMORY_SCOPE_AGENT) < 384u) { __builtin_amdgcn_s_sleep(4); if (++sp > (1u << 22)) break; }
        }
        __syncthreads();
        const float* modp = (const float*)(p.ws + WS_MODP);
        if (blockIdx.x < 72) {
            const int i = blockIdx.x * 256 + threadIdx.x, l = i / 9216, j = i % 3072;
            float s = (l ? p.b_mod1 : p.b_mod0)[j];
#pragma unroll
            for (int ks = 0; ks < 4; ++ks) s += __hip_atomic_load(modp + ks * 18432 + i, __ATOMIC_RELAXED, __HIP_MEMORY_SCOPE_AGENT);
            ((float*)(p.ws + WS_MOD))[i] = s;
        }
        float* lmod = (float*)lds;
        {
            float tmp[24];
#pragma unroll
            for (int q = 0; q < 24; ++q) {
                const int i = threadIdx.x + 256 * q, src_i = (i >> 11) * 3072 + (i & 2047);
                float s = p.b_mod0[i & 2047];
#pragma unroll
                for (int ks = 0; ks < 4; ++ks) s += __hip_atomic_load(modp + ks * 18432 + src_i, __ATOMIC_RELAXED, __HIP_MEMORY_SCOPE_AGENT);
                tmp[q] = s;
            }
#pragma unroll
            for (int q = 0; q < 24; ++q) lmod[threadIdx.x + 256 * q] = tmp[q];
        }
        __syncthreads();
        phase_norm(p, 0, lmod);
    } break;
    case 2: {
        EpiInL0 e{U, SZ};
        for (int t = blockIdx.x; t < 768; t += G) {
            const int tt = xcd_remap(t, 768);
            gemm_tile(H, D, (const bf16_t*)(p.ws + WS_WT0IN), D, 16, lds, e, (tt >> 4) * 128, (tt & 15) * 128);
        }
    } break;
    case 3: {
        bias1_items(p);
        for (int t = blockIdx.x; t < 768; t += G) {
            const int tt = xcd_remap(t, 768);
            const int mt = tt & 3, g = (tt >> 2) & 3, nt = tt >> 4;
            EpiChanDft e{VT, g};
            gemm_tile((const bf16_t*)(p.ws + WS_TW256), 256, U + g * 256, D, 4, lds, e, mt * 128, nt * 128);
        }
    } break;
    case 4: {
        for (int t = blockIdx.x; t < 512; t += G) {
            if (t < 256) {
                const int nt = t & 1, mt = (t >> 1) & 15, bg = t >> 5;
                EpiSeqDft<1> e{SZ, Y, NCTX + (bg >> 2) * 1024, bg & 3};
                gemm_tile<1>((const bf16_t*)(p.ws + WS_TS1024), 2048, VT + (size_t)64 * 256 * 512 + (size_t)bg * 256 * 2048, 2048, 32, lds, e, mt * 64, nt * 128);
            } else {
                const int u = t - 256, nt = u & 1, mt = (u >> 1) & 1, bg = u >> 2;
                EpiSeqDft<2> e{SZ, Y, (bg >> 2) * 256, bg & 3};
                gemm_tile<2>((const bf16_t*)(p.ws + WS_TS256), 512, VT + (size_t)bg * 256 * 512, 512, 8, lds, e, mt * 128, nt * 128);
            }
        }
    } break;
    case 5: {
        EpiOut<true, 2> e{p.x_prompt, p.x_sample, mod, X1, p.norm_w1, mod + 3 * 3072, H, (float*)(p.ws + WS_ROWSS)};
        EpiOut<true, 1> e1{p.x_prompt, p.x_sample, mod, X1, p.norm_w1, mod + 3 * 3072, H, (float*)(p.ws + WS_ROWSS)};
        if (G == 512) {
            if (blockIdx.x < 256) { const int tt = xcd_remap(blockIdx.x, 256); gemm_tile<2>(Y, D, (const bf16_t*)(p.ws + WS_WT0OUT), D, 16, lds, e, (tt >> 3) * 128, (tt & 7) * 128); }
            else { const int tt = xcd_remap(blockIdx.x - 256, 256); gemm_tile<1>(Y, D, (const bf16_t*)(p.ws + WS_WT0OUT), D, 16, lds, e1, 4096 + (tt >> 3) * 64, (tt & 7) * 128); }
        } else
        for (int t = blockIdx.x; t < 384; t += G) {
            const int tt = xcd_remap(t, 384);
            gemm_tile(Y, D, (const bf16_t*)(p.ws + WS_WT0OUT), D, 16, lds, e, (tt >> 3) * 128, (tt & 7) * 128);
        }
    } break;
    case 7: {
        EpiInL1 e{p.qnw, p.knw, (const float*)(p.ws + WS_ROPEC), (const float*)(p.ws + WS_ROPES),
                  (bf16_t*)(p.ws + WS_Q), (bf16_t*)(p.ws + WS_KB), (bf16_t*)(p.ws + WS_VTB), SZ,
                  p.out + (size_t)NTOK * D, p.out + (size_t)NTOK * D + (size_t)NCTX * 256,
                  (const float*)(p.ws + WS_ROWSS), (const float*)(p.ws + WS_BIAS1)};
        for (int t = blockIdx.x; t < 960; t += G) {
            const int tt = xcd_remap(t, 960);
            gemm_tile(H, D, (const bf16_t*)(p.ws + WS_WT1IN), D, 16, lds, e, (tt / 20) * 128, (tt % 20) * 128);
        }
    } break;
    case 8: {
        if (G == 512) {
            if (blockIdx.x < 256) attn_item(p, blockIdx.x, lds);
            else { attn_item(p, 256 + 2 * (blockIdx.x - 256), lds); attn_item(p, 257 + 2 * (blockIdx.x - 256), lds); }
        } else
            for (int t = blockIdx.x; t < 768; t += G) attn_item(p, t, lds);
    } break;
    case 9: {
        EpiOut<false, 2> e{X1, X1 + (size_t)NCTX * D, mod + 3 * 3072, p.out, nullptr, nullptr, nullptr, nullptr};
        EpiOut<false, 1> e1{X1, X1 + (size_t)NCTX * D, mod + 3 * 3072, p.out, nullptr, nullptr, nullptr, nullptr};
        if (G == 512) {
            if (blockIdx.x < 256) { const int tt = xcd_remap(blockIdx.x, 256); gemm_tile<2>(Y, D, (const bf16_t*)(p.ws + WS_WT1OUT), D, 16, lds, e, (tt >> 3) * 128, (tt & 7) * 128); }
            else { const int tt = xcd_remap(blockIdx.x - 256, 256); gemm_tile<1>(Y, D, (const bf16_t*)(p.ws + WS_WT1OUT), D, 16, lds, e1, 4096 + (tt >> 3) * 64, (tt & 7) * 128); }
        } else
        for (int t = blockIdx.x; t < 384; t += G) {
            const int tt = xcd_remap(t, 384);
            gemm_tile(Y, D, (const bf16_t*)(p.ws + WS_WT1OUT), D, 16, lds, e, (tt >> 3) * 128, (tt & 7) * 128);
        }
    } break;
    }
}

__global__ void __launch_bounds__(256, 2) mega(Params p) {
    __shared__ __attribute__((aligned(16))) unsigned char lds[65536 + 16];
    cg::grid_group grid = cg::this_grid();
#if SINGLE_LAUNCH
    volatile LAS unsigned* st = (volatile LAS unsigned*)(lds + 65536);
    if (threadIdx.x < 4) st[threadIdx.x] = 0u;
    __syncthreads();
    XcdBarrier bar = xcd_barrier_post((unsigned*)(p.ws + WS_BAR), st);
    if (p.ph_hi == 777) grid.sync();
#ifndef REP_PH
#define REP_PH -1
#endif
#ifndef REP_SY
#define REP_SY 0
#endif
#define PH(n) run_phase(p, n, lds); if (REP_PH == n) run_phase(p, n, lds);
#define SY() xcd_barrier(bar); if (REP_SY) xcd_barrier(bar);
#else
    const int lo = (int)p.ph_lo, hi = (int)p.ph_hi;
#define PH(n) if (lo <= n && n < hi) run_phase(p, n, lds);
#define SY()
#endif
    PH(0) SY() PH(2) SY() PH(3) SY() PH(4) SY() PH(5) SY() PH(7) SY() PH(8) SY() PH(9)
}

extern "C" void kernel_launch(void* const* d_in, const int* in_sizes, int n_in, void* d_out, int out_size, void* d_ws, size_t ws_size, hipStream_t stream) {
    static int grid_blocks = 0;
    if (!grid_blocks) {
        int dev = 0, cus = 0, per_cu = 0;
        hipGetDevice(&dev);
        hipDeviceGetAttribute(&cus, hipDeviceAttributeMultiprocessorCount, dev);
        hipOccupancyMaxActiveBlocksPerMultiprocessor(&per_cu, mega, 256, 0);
        if (per_cu > 2) per_cu = 2;
        if (per_cu < 1) per_cu = 1;
        grid_blocks = cus * per_cu;
    }
    Params p{};
    const float* const* in = (const float* const*)d_in;
    p.x_prompt = in[0]; p.x_sample = in[1]; p.cache_k = in[2]; p.cache_v = in[3]; p.c = in[4]; p.c_ctx = in[5];
    p.norm_w0 = in[6]; p.w_mod0 = in[7]; p.b_mod0 = in[8]; p.w_in0 = in[9]; p.w_out0 = in[10];
    p.norm_w1 = in[11]; p.w_mod1 = in[12]; p.b_mod1 = in[13]; p.w_in1 = in[14]; p.qnw = in[15]; p.knw = in[16]; p.sink = in[17]; p.w_out1 = in[18];
    p.out = (float*)d_out; p.ws = (unsigned char*)d_ws;
#if SINGLE_LAUNCH
    p.ph_lo = 0; p.ph_hi = 10;
    hipMemsetAsync((unsigned char*)d_ws + WS_BAR, 0, 16384, stream);
    void* args[] = {&p};
    hipError_t e = hipLaunchCooperativeKernel((void*)mega, dim3(grid_blocks), dim3(256), args, 0, stream);
    if (e != hipSuccess) fprintf(stderr, "cooperative launch failed: %s (grid %d)\n", hipGetErrorString(e), grid_blocks);
#else
    for (int ph = 0; ph < 10; ++ph) {
        p.ph_lo = ph; p.ph_hi = ph + 1;
        hipLaunchKernelGGL(mega, dim3(grid_blocks), dim3(256), 0, stream, p);
    }
#endif
}
```

```cpp
#include <hip/hip_runtime.h>
#include <hip/hip_cooperative_groups.h>
#include <stdint.h>
#include <cstdio>
namespace cg = cooperative_groups;

#ifndef SINGLE_LAUNCH
#define SINGLE_LAUNCH 1
#endif

typedef unsigned short bf16_t;
typedef short bf16x8 __attribute__((ext_vector_type(8)));
typedef float f32x16 __attribute__((ext_vector_type(16)));
typedef float f32x4 __attribute__((ext_vector_type(4)));
typedef unsigned u32x4 __attribute__((ext_vector_type(4)));
typedef unsigned u32x2 __attribute__((ext_vector_type(2)));
#define DEVI __device__ __forceinline__

constexpr int NTOK = 6144, NCTX = 4096, D = 1024;
constexpr float EPSV = 1e-6f;
constexpr float LOG2E = 1.4426950408889634f;

constexpr size_t WS_MOD = 0;
constexpr size_t WS_WT0IN = 1 << 20;
constexpr size_t WS_WT0OUT = WS_WT0IN + (size_t)2048 * 1024 * 2;
constexpr size_t WS_WT1IN = WS_WT0OUT + (size_t)1024 * 1024 * 2;
constexpr size_t WS_WT1OUT = WS_WT1IN + (size_t)2560 * 1024 * 2;
constexpr size_t WS_TW256 = WS_WT1OUT + (size_t)1024 * 1024 * 2;
constexpr size_t WS_TS256 = WS_TW256 + (size_t)512 * 256 * 2;
constexpr size_t WS_TS1024 = WS_TS256 + (size_t)256 * 512 * 2;
constexpr size_t WS_ROPEC = WS_TS1024 + (size_t)1024 * 2048 * 2;
constexpr size_t WS_ROPES = WS_ROPEC + (size_t)1024 * 32 * 4;
constexpr size_t WS_KC = WS_ROPES + (size_t)1024 * 32 * 4;
constexpr size_t WS_VCT = WS_KC + (size_t)2 * 256 * 256 * 2;
constexpr size_t WS_H = WS_VCT + (size_t)2 * 256 * 256 * 2;
constexpr size_t WS_U = WS_H + (size_t)NTOK * D * 2;
constexpr size_t WS_SZ = WS_U + (size_t)NTOK * D * 2;
constexpr size_t WS_VT = WS_SZ + (size_t)NTOK * D * 2;
constexpr size_t WS_Y = WS_VT + (size_t)NTOK * 2048 * 2;
constexpr size_t WS_X1 = WS_Y + (size_t)NTOK * D * 2;
constexpr size_t WS_Q = WS_X1 + (size_t)NTOK * D * 4;
constexpr size_t WS_KB = WS_Q + (size_t)NTOK * D * 2;
constexpr size_t WS_VTB = WS_KB + (size_t)NTOK * 256 * 2;
constexpr size_t WS_BAR = WS_VTB + (size_t)NTOK * 256 * 2;
constexpr size_t WS_CNT = WS_BAR + 14336;
constexpr size_t WS_ROWSS = WS_BAR + 16384;
constexpr size_t WS_BIAS1 = WS_ROWSS + 6144 * 4;
constexpr size_t WS_MODP = WS_BIAS1 + 3 * 2560 * 4;
constexpr size_t WS_END = WS_MODP + (size_t)4 * 18432 * 4;

struct Params {
    const float *x_prompt, *x_sample, *cache_k, *cache_v, *c, *c_ctx;
    const float *norm_w0, *w_mod0, *b_mod0, *w_in0, *w_out0;
    const float *norm_w1, *w_mod1, *b_mod1, *w_in1, *qnw, *knw, *sink, *w_out1;
    float* out;
    unsigned char* ws;
    long long ph_lo, ph_hi;
};

DEVI unsigned cvt_pk_bf16(float lo, float hi) { unsigned r; asm("v_cvt_pk_bf16_f32 %0, %1, %2" : "=v"(r) : "v"(lo), "v"(hi)); return r; }
DEVI bf16_t f2bf(float f) { return (bf16_t)(cvt_pk_bf16(f, 0.f) & 0xffffu); }
DEVI float silu_f(float v) { return v * __builtin_amdgcn_rcpf(1.f + __expf(-v)); }
DEVI int swap23(int x) { return (x & ~12) | ((x & 4) << 1) | ((x & 8) >> 1); }
DEVI int cond_of(int m) { return m < NCTX ? 0 : 1 + ((m - NCTX) >> 10); }

DEVI void st8(bf16_t* p, u32x2 a, u32x2 b) {
    const auto r0 = __builtin_amdgcn_permlane32_swap(a.x, b.x, false, false);
    const auto r1 = __builtin_amdgcn_permlane32_swap(a.y, b.y, false, false);
    u32x4 w; w.x = r0[0]; w.y = r1[0]; w.z = r0[1]; w.w = r1[1];
    *(u32x4*)p = w;
}
DEVI void put8(unsigned char* wl, int r, int c, u32x2 a, u32x2 b) {
    const auto r0 = __builtin_amdgcn_permlane32_swap(a.x, b.x, false, false);
    const auto r1 = __builtin_amdgcn_permlane32_swap(a.y, b.y, false, false);
    u32x4 w; w.x = r0[0]; w.y = r1[0]; w.z = r0[1]; w.w = r1[1];
    *(u32x4*)(wl + r * 128 + ((c ^ (r & 7)) << 4)) = w;
}
template <int ROWS, class RowPtr>
DEVI void flush8(const unsigned char* wl, int lane, const RowPtr& rowptr) {
#pragma unroll
    for (int i = 0; i < ROWS / 8; ++i) {
        const int r = i * 8 + (lane >> 3), c = lane & 7;
        const u32x4 w = *(const u32x4*)(wl + r * 128 + ((c ^ (r & 7)) << 4));
        *(u32x4*)(rowptr(r) + c * 8) = w;
    }
}
DEVI float xhalf_sum(float x) { const auto r = __builtin_amdgcn_permlane32_swap(__float_as_uint(x), __float_as_uint(x), false, false); return __uint_as_float(r[0]) + __uint_as_float(r[1]); }
DEVI float xhalf_max(float x) { const auto r = __builtin_amdgcn_permlane32_swap(__float_as_uint(x), __float_as_uint(x), false, false); return fmaxf(__uint_as_float(r[0]), __uint_as_float(r[1])); }

DEVI void glds16(const void* g, void* l) { __builtin_amdgcn_global_load_lds(g, l, 16, 0, 0); }

template <int MB = 2, class Epi>
DEVI void gemm_tile(const bf16_t* __restrict__ A, int lda, const bf16_t* __restrict__ B, int ldb, int nk,
                    unsigned char* lds, const Epi& epi, int m0, int n0) {
    const int tid = threadIdx.x, lane = tid & 63, wid = tid >> 6, wr = wid >> 1, wc = wid & 1;
    const int srow = tid >> 3;
    const int slc = (tid & 7) ^ ((tid >> 4) & 7);
    const bf16_t* gA = A + (size_t)(m0 + srow) * lda + slc * 8;
    const bf16_t* gB = B + (size_t)(n0 + srow) * ldb + slc * 8;
    const int fr = lane & 31, fh = lane >> 5, sw = (lane >> 1) & 7;
    const unsigned aoff = (wr * 32 * MB + fr) * 128, boff = 16384 + (wc * 64 + fr) * 128;
    f32x16 acc[MB][2];
#pragma unroll
    for (int i = 0; i < MB; ++i)
#pragma unroll
        for (int j = 0; j < 2; ++j)
#pragma unroll
            for (int r = 0; r < 16; ++r) acc[i][j][r] = 0.f;
    {
        unsigned char* la = lds + tid * 16;
#pragma unroll
        for (int i = 0; i < 4; ++i) {
            if (i < 2 * MB) glds16(gA + (size_t)i * 32 * lda, la + i * 4096);
            glds16(gB + (size_t)i * 32 * ldb, la + 16384 + i * 4096);
        }
        la += 32768;
#pragma unroll
        for (int i = 0; i < 4; ++i) {
            if (i < 2 * MB) glds16(gA + (size_t)i * 32 * lda + 64, la + i * 4096);
            glds16(gB + (size_t)i * 32 * ldb + 64, la + 16384 + i * 4096);
        }
    }
    for (int kt = 0; kt < nk; ++kt) {
        if (kt == 0) {
            if (MB == 2) asm volatile("s_waitcnt vmcnt(8) lgkmcnt(0)" ::: "memory"); else asm volatile("s_waitcnt vmcnt(6) lgkmcnt(0)" ::: "memory");
            __builtin_amdgcn_sched_barrier(0); __builtin_amdgcn_s_barrier(); __builtin_amdgcn_sched_barrier(0);
        } else {
            asm volatile("s_waitcnt vmcnt(0)" ::: "memory");
            __syncthreads();
        }
        if (kt >= 1 && kt + 1 < nk) {
            unsigned char* la = lds + ((kt + 1) & 1) * 32768 + tid * 16;
            const int ko = (kt + 1) * 64;
#pragma unroll
            for (int i = 0; i < 4; ++i) {
                if (i < 2 * MB) glds16(gA + (size_t)i * 32 * lda + ko, la + i * 4096);
                glds16(gB + (size_t)i * 32 * ldb + ko, la + 16384 + i * 4096);
            }
        }
        const unsigned char* base = lds + (kt & 1) * 32768;
        bf16x8 af[4][2], bfr[4][2];
#define LDFRAG(ks) { const int ch = ((2 * (ks) + fh) ^ sw) * 16; \
            af[ks][0] = *(const bf16x8*)(base + aoff + ch); bfr[ks][0] = *(const bf16x8*)(base + boff + ch); \
            bfr[ks][1] = *(const bf16x8*)(base + boff + 4096 + ch); if (MB == 2) af[ks][1] = *(const bf16x8*)(base + aoff + 4096 + ch); }
#define MFMA4(ks) { acc[0][0] = __builtin_amdgcn_mfma_f32_32x32x16_bf16(bfr[ks][0], af[ks][0], acc[0][0], 0, 0, 0); \
            acc[0][1] = __builtin_amdgcn_mfma_f32_32x32x16_bf16(bfr[ks][1], af[ks][0], acc[0][1], 0, 0, 0); \
            if (MB == 2) { acc[MB - 1][0] = __builtin_amdgcn_mfma_f32_32x32x16_bf16(bfr[ks][0], af[ks][1], acc[MB - 1][0], 0, 0, 0); \
            acc[MB - 1][1] = __builtin_amdgcn_mfma_f32_32x32x16_bf16(bfr[ks][1], af[ks][1], acc[MB - 1][1], 0, 0, 0); } }
        LDFRAG(0) LDFRAG(1)
        __builtin_amdgcn_sched_barrier(0);
        MFMA4(0) LDFRAG(2)
        __builtin_amdgcn_sched_barrier(0);
        MFMA4(1) LDFRAG(3)
        __builtin_amdgcn_sched_barrier(0);
        MFMA4(2)
        __builtin_amdgcn_sched_barrier(0);
        MFMA4(3)
#undef LDFRAG
#undef MFMA4
    }
    epi(acc, m0 + wr * 32 * MB, n0 + wc * 64, fr, fh, lds + wid * 8192);
    __syncthreads();
}

DEVI int xcd_remap(int t, int T) { return (t & 7) * (T >> 3) + (t >> 3); }

DEVI void mod_item(const Params& p, int it, unsigned char* lds) {
    const int tid = threadIdx.x;
    const int ks = it & 3, lc = it >> 2, l = lc / 48, cc = lc % 48;
    float* sc = (float*)lds;
    for (int i = tid; i < 768; i += 256) {
        const int cv = i >> 8, k = ks * 256 + (i & 255);
        const float cval = cv == 0 ? p.c_ctx[k] : p.c[(cv - 1) * 1024 + k];
        sc[i] = silu_f(cval);
    }
    __syncthreads();
    const float* W = (l ? p.w_mod1 : p.w_mod0) + (size_t)ks * 256 * 3072;
    const int cg4 = tid & 15, rg = tid >> 4, c0 = cc * 64 + cg4 * 4;
    f32x4 w[16];
#pragma unroll
    for (int i = 0; i < 16; ++i) w[i] = *(const f32x4*)(W + (size_t)(rg + 16 * i) * 3072 + c0);
    f32x4 a0 = {0.f, 0.f, 0.f, 0.f}, a1 = a0, a2 = a0;
#pragma unroll
    for (int i = 0; i < 16; ++i) { const int k = rg + 16 * i; a0 += sc[k] * w[i]; a1 += sc[256 + k] * w[i]; a2 += sc[512 + k] * w[i]; }
    float* red = (float*)(lds + 12288);
#pragma unroll
    for (int e = 0; e < 4; ++e) {
        red[(rg * 3 + 0) * 64 + cg4 * 4 + e] = a0[e];
        red[(rg * 3 + 1) * 64 + cg4 * 4 + e] = a1[e];
        red[(rg * 3 + 2) * 64 + cg4 * 4 + e] = a2[e];
    }
    __syncthreads();
    if (tid < 192) {
        const int cv = tid >> 6, j = tid & 63;
        float s = 0.f;
#pragma unroll
        for (int r = 0; r < 16; ++r) s += red[(r * 3 + cv) * 64 + j];
        float* modp = (float*)(p.ws + WS_MODP) + (size_t)ks * 18432;
        __hip_atomic_store(&modp[(l * 3 + cv) * 3072 + cc * 64 + j], s, __ATOMIC_RELAXED, __HIP_MEMORY_SCOPE_AGENT);
    }
    asm volatile("s_waitcnt vmcnt(0)" ::: "memory");
    __syncthreads();
    if (tid == 0) __hip_atomic_fetch_add((unsigned*)(p.ws + WS_CNT), 1u, __ATOMIC_RELAXED, __HIP_MEMORY_SCOPE_AGENT);
}

struct TrDesc { const float* src; bf16_t* dst; int N, kt, nt; };
DEVI TrDesc tr_desc(const Params& p, int idx) {
    TrDesc d;
    if (idx < 512) { d.src = p.w_in0; d.dst = (bf16_t*)(p.ws + WS_WT0IN); d.N = 2048; }
    else if (idx < 768) { idx -= 512; d.src = p.w_out0; d.dst = (bf16_t*)(p.ws + WS_WT0OUT); d.N = 1024; }
    else if (idx < 1408) { idx -= 768; d.src = p.w_in1; d.dst = (bf16_t*)(p.ws + WS_WT1IN); d.N = 2560; }
    else { idx -= 1408; d.src = p.w_out1; d.dst = (bf16_t*)(p.ws + WS_WT1OUT); d.N = 1024; }
    const int ntn = d.N >> 6;
    d.kt = idx / ntn; d.nt = idx % ntn;
    return d;
}
DEVI void transpose_items(const Params& p, int first, int end, int stride, unsigned char* lds) {
    const int tid = threadIdx.x;
    float* tl = (float*)lds;
    if (first >= end) return;
    f32x4 v[4];
    TrDesc d = tr_desc(p, first);
#pragma unroll
    for (int pass = 0; pass < 4; ++pass) v[pass] = *(const f32x4*)(d.src + (size_t)(d.kt * 64 + pass * 16 + (tid >> 4)) * d.N + d.nt * 64 + (tid & 15) * 4);
    for (int idx = first; idx < end; idx += stride) {
#pragma unroll
        for (int pass = 0; pass < 4; ++pass) {
            const int r = pass * 16 + (tid >> 4), c4 = (tid & 15) * 4;
#pragma unroll
            for (int e = 0; e < 4; ++e) tl[r * 65 + c4 + e] = v[pass][e];
        }
        const TrDesc cur = d;
        if (idx + stride < end) {
            d = tr_desc(p, idx + stride);
#pragma unroll
            for (int pass = 0; pass < 4; ++pass) v[pass] = *(const f32x4*)(d.src + (size_t)(d.kt * 64 + pass * 16 + (tid >> 4)) * d.N + d.nt * 64 + (tid & 15) * 4);
        }
        __syncthreads();
#pragma unroll
        for (int pass = 0; pass < 2; ++pass) {
            const int n = pass * 32 + (tid >> 3), kc = tid & 7;
            float x[8];
#pragma unroll
            for (int j = 0; j < 8; ++j) x[j] = tl[(kc * 8 + j) * 65 + n];
            u32x4 w;
            w.x = cvt_pk_bf16(x[0], x[1]); w.y = cvt_pk_bf16(x[2], x[3]); w.z = cvt_pk_bf16(x[4], x[5]); w.w = cvt_pk_bf16(x[6], x[7]);
            *(u32x4*)(cur.dst + (size_t)(cur.nt * 64 + n) * 1024 + cur.kt * 64 + kc * 8) = w;
        }
        __syncthreads();
    }
}

DEVI void phase0(const Params& p, unsigned char* lds) {
    for (int it = blockIdx.x; it < 384; it += gridDim.x) mod_item(p, it, lds);
    transpose_items(p, (blockIdx.x + 128) % gridDim.x, 1664, gridDim.x, lds);
    const int gt = blockIdx.x * 256 + threadIdx.x, gs = gridDim.x * 256;
    bf16_t* tw256 = (bf16_t*)(p.ws + WS_TW256);
    bf16_t* ts256 = (bf16_t*)(p.ws + WS_TS256);
    bf16_t* ts1024 = (bf16_t*)(p.ws + WS_TS1024);
    float* lut = (float*)(lds + 32768);
    __syncthreads();
    for (int r = threadIdx.x; r < 1024; r += 256) lut[r] = cospif((float)r * (1.f / 512.f));
    __syncthreads();
    for (int i = gt; i < 512 * 256; i += gs) {
        const int m = i >> 8, j = i & 255, which = m >> 8, cp = m & 255;
        const int r = ((cp * j) & 255) << 2;
        tw256[i] = f2bf(which ? lut[(r - 256) & 1023] : lut[r]);
    }
    for (int i = gt; i < 256 * 512; i += gs) {
        const int sp = i >> 9, k2 = i & 511, which = k2 >> 8, s0 = k2 & 255;
        const int r = ((sp * s0) & 255) << 2;
        ts256[i] = f2bf((which ? -lut[(r - 256) & 1023] : lut[r]) * (1.f / 256.f));
    }
    for (int i = gt; i < 1024 * 2048; i += gs) {
        const int sp = i >> 11, k2 = i & 2047, which = k2 >> 10, s0 = k2 & 1023;
        const int r = (sp * s0) & 1023;
        ts1024[i] = f2bf((which ? -lut[(r - 256) & 1023] : lut[r]) * (1.f / 512.f));
    }
    float* ropec = (float*)(p.ws + WS_ROPEC);
    float* ropes = (float*)(p.ws + WS_ROPES);
    for (int i = gt; i < 1024 * 32; i += gs) {
        const int pos = i >> 5, f = i & 31;
        const int row = pos >> 6, col = pos & 63;
        const float inv = powf(10000.f, -(float)(f & 15) * (1.f / 16.f));
        const float ang = (float)(f < 16 ? row : col) * inv;
        float s, c; sincosf(ang, &s, &c);
        ropec[i] = c; ropes[i] = s;
    }
    for (int i = gt; i < NTOK; i += gs) ((float*)(p.ws + WS_ROWSS))[i] = 0.f;
    bf16_t* kc = (bf16_t*)(p.ws + WS_KC);
    bf16_t* vct = (bf16_t*)(p.ws + WS_VCT);
    for (int i = gt; i < 2 * 256 * 256; i += gs) {
        kc[i] = f2bf(p.cache_k[i]);
        const int b = i >> 16, kvh = (i >> 14) & 3, d = (i >> 8) & 63, pp = i & 255;
        const int key = swap23(pp);
        vct[i] = f2bf(p.cache_v[((b * 256 + key) * 4 + kvh) * 64 + d]);
    }
}

DEVI void phase_norm(const Params& p, int layer, const float* lmod  ) {
    const int lane = threadIdx.x & 63, wid = threadIdx.x >> 6;
    const float* nw = layer ? p.norm_w1 : p.norm_w0;
    bf16_t* H = (bf16_t*)(p.ws + WS_H);
    for (int row = blockIdx.x * 4 + wid; row < NTOK; row += gridDim.x * 4) {
        const float* xr;
        if (layer == 0) xr = row < NCTX ? p.x_prompt + (size_t)row * D : p.x_sample + (size_t)(row - NCTX) * D;
        else xr = (const float*)(p.ws + WS_X1) + (size_t)row * D;
        const float* mv = lmod + cond_of(row) * 2048;
        f32x4 v[4];
        float ss = 0.f;
#pragma unroll
        for (int i = 0; i < 4; ++i) {
            v[i] = *(const f32x4*)(xr + i * 256 + lane * 4);
            ss += v[i][0] * v[i][0] + v[i][1] * v[i][1] + v[i][2] * v[i][2] + v[i][3] * v[i][3];
        }
#pragma unroll
        for (int o = 32; o >= 1; o >>= 1) ss += __shfl_xor(ss, o);
        const float rstd = rsqrtf(ss * (1.f / 1024.f) + EPSV);
#pragma unroll
        for (int i = 0; i < 4; ++i) {
            const int k = i * 256 + lane * 4;
            const f32x4 w = *(const f32x4*)(nw + k);
            const f32x4 sh = *(const f32x4*)(mv + k);
            const f32x4 scl = *(const f32x4*)(mv + 1024 + k);
            float h[4];
#pragma unroll
            for (int e = 0; e < 4; ++e) h[e] = (v[i][e] * rstd * w[e]) * (1.f + scl[e]) + sh[e];
            u32x2 o; o.x = cvt_pk_bf16(h[0], h[1]); o.y = cvt_pk_bf16(h[2], h[3]);
            *(u32x2*)(H + (size_t)row * D + k) = o;
        }
    }
}

DEVI void bias1_items(const Params& p) {
    const int lane = threadIdx.x & 63, gw = blockIdx.x * 4 + (threadIdx.x >> 6), nw = gridDim.x * 4;
    const float* mod1 = (const float*)(p.ws + WS_MOD) + 3 * 3072;
    const bf16_t* WT = (const bf16_t*)(p.ws + WS_WT1IN);
    float* bias1 = (float*)(p.ws + WS_BIAS1);
    for (int n = gw; n < 2560; n += nw) {
        float w[16];
        const u32x4 r0 = *(const u32x4*)(WT + (size_t)n * 1024 + lane * 16), r1 = *(const u32x4*)(WT + (size_t)n * 1024 + lane * 16 + 8);
        const unsigned rr[8] = {r0.x, r0.y, r0.z, r0.w, r1.x, r1.y, r1.z, r1.w};
#pragma unroll
        for (int i = 0; i < 8; ++i) { w[2 * i] = __uint_as_float(rr[i] << 16); w[2 * i + 1] = __uint_as_float(rr[i] & 0xffff0000u); }
        float s[3];
#pragma unroll
        for (int cv = 0; cv < 3; ++cv) {
            float a = 0.f;
#pragma unroll
            for (int q = 0; q < 4; ++q) {
                const f32x4 sh = *(const f32x4*)(mod1 + cv * 3072 + lane * 16 + q * 4);
#pragma unroll
                for (int e = 0; e < 4; ++e) a += sh[e] * w[q * 4 + e];
            }
#pragma unroll
            for (int o = 32; o >= 1; o >>= 1) a += __shfl_xor(a, o);
            s[cv] = a;
        }
        if (lane == 0) { bias1[n] = s[0]; bias1[2560 + n] = s[1]; bias1[5120 + n] = s[2]; }
    }
}

struct EpiInL0 {
    bf16_t *U, *SZ;
    DEVI void operator()(const f32x16 (&acc)[2][2], int mbase, int nbase, int fr, int fh, unsigned char* wl) const {
        const bool isz = nbase >= 1024;
        bf16_t* dst = isz ? SZ : U;
        const int nb0 = isz ? nbase - 1024 : nbase;
        u32x2 keep = {0u, 0u};
#pragma unroll
        for (int mb = 0; mb < 2; ++mb)
#pragma unroll
            for (int nb = 0; nb < 2; ++nb)
#pragma unroll
                for (int g = 0; g < 4; ++g) {
                    const int m = mbase + mb * 32 + fr, n = nb0 + nb * 32 + 8 * g + 4 * fh;
                    float v[4];
#pragma unroll
                    for (int e = 0; e < 4; ++e) { v[e] = acc[mb][nb][4 * g + e]; if (isz) v[e] = silu_f(v[e]); }
                    u32x2 o; o.x = cvt_pk_bf16(v[0], v[1]); o.y = cvt_pk_bf16(v[2], v[3]);
                    if ((g & 1) == 0) keep = o; else put8(wl, mb * 32 + fr, nb * 4 + (g - 1) + fh, keep, o);
                }
        flush8<64>(wl, fh * 32 + fr, [&](int r) { return dst + (size_t)(mbase + r) * D + nb0; });
    }
};

struct EpiChanDft {
    bf16_t* VT; int g;
    DEVI void operator()(const f32x16 (&acc)[2][2], int mbase, int nbase, int fr, int fh, unsigned char* wl) const {
        int S, bgi, s0; bf16_t* base;
        if (nbase < NCTX) { S = 256; bgi = (nbase >> 8) * 4 + g; s0 = nbase & 255; base = VT; }
        else { const int t = nbase - NCTX; S = 1024; bgi = (t >> 10) * 4 + g; s0 = t & 1023; base = VT + (size_t)64 * 256 * 512; }
        u32x2 keep = {0u, 0u};
#pragma unroll
        for (int mb = 0; mb < 2; ++mb)
#pragma unroll
            for (int nb = 0; nb < 2; ++nb)
#pragma unroll
                for (int gq = 0; gq < 4; ++gq) {
                    const int m = mbase + mb * 32 + fr, which = m >> 8, cp = m & 255;
                    const int s = s0 + nb * 32 + 8 * gq + 4 * fh;
                    u32x2 o; o.x = cvt_pk_bf16(acc[mb][nb][4 * gq], acc[mb][nb][4 * gq + 1]); o.y = cvt_pk_bf16(acc[mb][nb][4 * gq + 2], acc[mb][nb][4 * gq + 3]);
                    if ((gq & 1) == 0) keep = o; else put8(wl, mb * 32 + fr, nb * 4 + (gq - 1) + fh, keep, o);
                }
        flush8<64>(wl, fh * 32 + fr, [&](int r) { const int m = mbase + r; return base + ((size_t)bgi * 256 + (m & 255)) * (2 * S) + (m >> 8) * S + s0; });
    }
};

template <int MB> struct EpiSeqDft {
    const bf16_t* SZ; bf16_t* Y; int tok0, g;
    DEVI void operator()(const f32x16 (&acc)[MB][2], int mbase, int nbase, int fr, int fh, unsigned char* wl) const {
        u32x2 keep = {0u, 0u};
#pragma unroll
        for (int mb = 0; mb < MB; ++mb)
#pragma unroll
            for (int nb = 0; nb < 2; ++nb)
#pragma unroll
                for (int gq = 0; gq < 4; ++gq) {
                    const int tok = tok0 + mbase + mb * 32 + fr;
                    const int col = g * 256 + nbase + nb * 32 + 8 * gq + 4 * fh;
                    const u32x2 z = *(const u32x2*)(SZ + (size_t)tok * D + col);
                    const float z0 = __uint_as_float(z.x << 16), z1 = __uint_as_float(z.x & 0xffff0000u);
                    const float z2 = __uint_as_float(z.y << 16), z3 = __uint_as_float(z.y & 0xffff0000u);
                    u32x2 o; o.x = cvt_pk_bf16(acc[mb][nb][4 * gq] * z0, acc[mb][nb][4 * gq + 1] * z1);
                    o.y = cvt_pk_bf16(acc[mb][nb][4 * gq + 2] * z2, acc[mb][nb][4 * gq + 3] * z3);
                    if ((gq & 1) == 0) keep = o; else put8(wl, mb * 32 + fr, nb * 4 + (gq - 1) + fh, keep, o);
                }
        flush8<32 * MB>(wl, fh * 32 + fr, [&](int r) { return Y + (size_t)(tok0 + mbase + r) * D + g * 256 + nbase; });
    }
};

#define DPP_ADD(x, CTRL) ((x) + __uint_as_float((unsigned)__builtin_amdgcn_update_dpp(0, (int)__float_as_uint(x), CTRL, 0xF, 0xF, true)))
DEVI float row16_sum(float x) {
    x = DPP_ADD(x, 0xB1);
    x = DPP_ADD(x, 0x4E);
    x = DPP_ADD(x, 0x141);
    x = DPP_ADD(x, 0x140);
    return x;
}
template <bool NEXT, int MB> struct EpiOut {
    const float* xa; const float* xb;
    const float* mod;
    float* out;
    const float* nw1; const float* mod1; bf16_t* Hn; float* rowss;
    DEVI void operator()(const f32x16 (&acc)[MB][2], int mbase, int nbase, int fr, int fh, unsigned char* wl) const {
        const int lane = fh * 32 + fr, c4 = lane & 15, rsub = lane >> 4;
        const int cv = cond_of(mbase);
        const int n = nbase + c4 * 4;
        const f32x4 gv = *(const f32x4*)(mod + cv * 3072 + 2048 + n);
        f32x4 hv = {0.f, 0.f, 0.f, 0.f};
        if (NEXT) {
            const f32x4 w = *(const f32x4*)(nw1 + n);
            const f32x4 sc = *(const f32x4*)(mod1 + cv * 3072 + 1024 + n);
#pragma unroll
            for (int e = 0; e < 4; ++e) hv[e] = w[e] * (1.f + sc[e]);
        }
#pragma unroll
        for (int mb = 0; mb < MB; ++mb) {
#pragma unroll
            for (int nb = 0; nb < 2; ++nb)
#pragma unroll
                for (int g = 0; g < 4; ++g) {
                    f32x4 a = {acc[mb][nb][4 * g], acc[mb][nb][4 * g + 1], acc[mb][nb][4 * g + 2], acc[mb][nb][4 * g + 3]};
                    *(f32x4*)(wl + fr * 256 + (((nb * 8 + 2 * g + fh) ^ (fr & 15)) << 4)) = a;
                }
#pragma unroll
            for (int i = 0; i < 8; ++i) {
                const int r = i * 4 + rsub, m = mbase + mb * 32 + r;
                const f32x4 a = *(const f32x4*)(wl + r * 256 + ((c4 ^ (r & 15)) << 4));
                const float* xr = m < NCTX ? xa + (size_t)m * D : xb + (size_t)(m - NCTX) * D;
                const f32x4 xv = *(const f32x4*)(xr + n);
                f32x4 o;
#pragma unroll
                for (int e = 0; e < 4; ++e) o[e] = xv[e] + gv[e] * a[e];
                *(f32x4*)(out + (size_t)m * D + n) = o;
                if (NEXT) {
                    float ss = (o[0] * o[0] + o[1] * o[1]) + (o[2] * o[2] + o[3] * o[3]);
                    ss = row16_sum(ss);
                    if (c4 == 0) atomicAdd(rowss + m, ss);
                    u32x2 hb; hb.x = cvt_pk_bf16(o[0] * hv[0], o[1] * hv[1]); hb.y = cvt_pk_bf16(o[2] * hv[2], o[3] * hv[3]);
                    *(u32x2*)(Hn + (size_t)m * D + n) = hb;
                }
            }
        }
    }
};

struct EpiInL1 {
    const float *qnw, *knw, *ropec, *ropes;
    bf16_t *Q, *KB, *VTB, *SZ;
    float *outk, *outv;
    const float* rowss; const float* bias1;
    DEVI void operator()(const f32x16 (&acc_in)[2][2], int mbase, int nbase, int fr, int fh, unsigned char* wl) const {
        const bool lat = mbase >= NCTX;
        u32x2 keep1 = {0u, 0u}, keep2 = {0u, 0u};
        f32x16 acc[2][2];
        {
            const float* bp = bias1 + cond_of(mbase) * 2560 + nbase;
#pragma unroll
            for (int mb = 0; mb < 2; ++mb) {
                const float rstd = rsqrtf(rowss[mbase + mb * 32 + fr] * (1.f / 1024.f) + EPSV);
#pragma unroll
                for (int nb = 0; nb < 2; ++nb)
#pragma unroll
                    for (int g = 0; g < 4; ++g) {
                        const f32x4 bv = *(const f32x4*)(bp + nb * 32 + 8 * g + 4 * fh);
#pragma unroll
                        for (int e = 0; e < 4; ++e) acc[mb][nb][4 * g + e] = acc_in[mb][nb][4 * g + e] * rstd + bv[e];
                    }
            }
        }
        if (nbase < 1280) {
            const bool isq = nbase < 1024;
            const float* nwp = isq ? qnw : knw;
#pragma unroll
            for (int mb = 0; mb < 2; ++mb) {
                const int m = mbase + mb * 32 + fr;
                float ss = 0.f;
#pragma unroll
                for (int nb = 0; nb < 2; ++nb)
#pragma unroll
                    for (int r = 0; r < 16; ++r) ss += acc[mb][nb][r] * acc[mb][nb][r];
                ss = xhalf_sum(ss);
                const float rn = rsqrtf(ss * (1.f / 64.f) + EPSV);
                const int pos = lat ? ((m - NCTX) & 1023) : 0;
#pragma unroll
                for (int g = 0; g < 4; ++g) {
                    const int d0 = 8 * g + 4 * fh;
                    const f32x4 w1 = *(const f32x4*)(nwp + d0), w2 = *(const f32x4*)(nwp + 32 + d0);
                    float x1[4], x2[4];
#pragma unroll
                    for (int e = 0; e < 4; ++e) { x1[e] = acc[mb][0][4 * g + e] * rn * w1[e]; x2[e] = acc[mb][1][4 * g + e] * rn * w2[e]; }
                    if (lat) {
                        const f32x4 cv = *(const f32x4*)(ropec + pos * 32 + d0), sv = *(const f32x4*)(ropes + pos * 32 + d0);
#pragma unroll
                        for (int e = 0; e < 4; ++e) { const float a = x1[e], b = x2[e]; x1[e] = a * cv[e] - b * sv[e]; x2[e] = a * sv[e] + b * cv[e]; }
                    }
                    if (isq) {
                        const float qs = 0.125f * LOG2E;
                        u32x2 o1, o2;
                        o1.x = cvt_pk_bf16(x1[0] * qs, x1[1] * qs); o1.y = cvt_pk_bf16(x1[2] * qs, x1[3] * qs);
                        o2.x = cvt_pk_bf16(x2[0] * qs, x2[1] * qs); o2.y = cvt_pk_bf16(x2[2] * qs, x2[3] * qs);
                        if ((g & 1) == 0) { keep1 = o1; keep2 = o2; }
                        else { put8(wl, mb * 32 + fr, (g - 1) + fh, keep1, o1); put8(wl, mb * 32 + fr, 4 + (g - 1) + fh, keep2, o2); }
                    } else {
                        const int kc = nbase - 1024;
                        u32x2 o1, o2;
                        o1.x = cvt_pk_bf16(x1[0], x1[1]); o1.y = cvt_pk_bf16(x1[2], x1[3]);
                        o2.x = cvt_pk_bf16(x2[0], x2[1]); o2.y = cvt_pk_bf16(x2[2], x2[3]);
                        if ((g & 1) == 0) { keep1 = o1; keep2 = o2; }
                        else { put8(wl, mb * 32 + fr, (g - 1) + fh, keep1, o1); put8(wl, mb * 32 + fr, 4 + (g - 1) + fh, keep2, o2); }
                        if (!lat) {
                            f32x4 f1 = {x1[0], x1[1], x1[2], x1[3]}, f2 = {x2[0], x2[1], x2[2], x2[3]};
                            *(f32x4*)(outk + (size_t)m * 256 + kc + d0) = f1;
                            *(f32x4*)(outk + (size_t)m * 256 + kc + 32 + d0) = f2;
                        }
                    }
                }
            }
            if (isq) flush8<64>(wl, fh * 32 + fr, [&](int r) { return Q + (size_t)(mbase + r) * D + nbase; });
            else flush8<64>(wl, fh * 32 + fr, [&](int r) { return KB + (size_t)(mbase + r) * 256 + (nbase - 1024); });
        } else if (nbase < 1536) {
            const int vc = nbase - 1280, kvh = vc >> 6;
            bf16_t* vtb; int S, sbase;
            if (!lat) { S = 256; sbase = mbase & 255; vtb = VTB + ((size_t)((mbase >> 8) * 4 + kvh) * 64) * 256; }
            else { const int t = mbase - NCTX; S = 1024; sbase = t & 1023; vtb = VTB + (size_t)16 * 4 * 64 * 256 + ((size_t)((t >> 10) * 4 + kvh) * 64) * 1024; }
#pragma unroll
            for (int mb = 0; mb < 2; ++mb) {
                const int m = mbase + mb * 32 + fr;
                const int cpos = swap23(mb * 32 + fr);
                unsigned char* wcol = wl + ((cpos & 7) << 1);
                const int cch = cpos >> 3;
#pragma unroll
                for (int nb = 0; nb < 2; ++nb)
#pragma unroll
                    for (int g = 0; g < 4; ++g) {
                        const int d0 = nb * 32 + 8 * g + 4 * fh;
#pragma unroll
                        for (int e = 0; e < 4; ++e) { const int d = d0 + e; *(bf16_t*)(wcol + d * 128 + ((cch ^ (d & 7)) << 4)) = f2bf(acc[mb][nb][4 * g + e]); }
                        if (!lat) {
                            f32x4 f = {acc[mb][nb][4 * g], acc[mb][nb][4 * g + 1], acc[mb][nb][4 * g + 2], acc[mb][nb][4 * g + 3]};
                            *(f32x4*)(outv + (size_t)m * 256 + vc + d0) = f;
                        }
                    }
            }
            flush8<64>(wl, fh * 32 + fr, [&](int r) { return vtb + (size_t)r * S + sbase; });
        } else {
            const int zc = nbase - 1536;
#pragma unroll
            for (int mb = 0; mb < 2; ++mb)
#pragma unroll
                for (int nb = 0; nb < 2; ++nb)
#pragma unroll
                    for (int g = 0; g < 4; ++g) {
                        const int m = mbase + mb * 32 + fr, n = zc + nb * 32 + 8 * g + 4 * fh;
                        u32x2 o; o.x = cvt_pk_bf16(silu_f(acc[mb][nb][4 * g]), silu_f(acc[mb][nb][4 * g + 1]));
                        o.y = cvt_pk_bf16(silu_f(acc[mb][nb][4 * g + 2]), silu_f(acc[mb][nb][4 * g + 3]));
                        if ((g & 1) == 0) keep1 = o; else put8(wl, mb * 32 + fr, nb * 4 + (g - 1) + fh, keep1, o);
                    }
            flush8<64>(wl, fh * 32 + fr, [&](int r) { return SZ + (size_t)(mbase + r) * D + zc; });
        }
    }
};

DEVI void attn_item(const Params& p, int item, unsigned char* lds) {
    const int lane = threadIdx.x & 63, w = threadIdx.x >> 6, fr = lane & 31, fh = lane >> 5;
    const bf16_t* Q = (const bf16_t*)(p.ws + WS_Q);
    const bf16_t* KB = (const bf16_t*)(p.ws + WS_KB);
    const bf16_t* VTB = (const bf16_t*)(p.ws + WS_VTB);
    const bf16_t* KC = (const bf16_t*)(p.ws + WS_KC);
    const bf16_t* VCT = (const bf16_t*)(p.ws + WS_VCT);
    const bf16_t* SZ = (const bf16_t*)(p.ws + WS_SZ);
    bf16_t* Y = (bf16_t*)(p.ws + WS_Y);
    bool lat; int b, kvh, qb, tb;
    if (item < 256) { lat = true; b = item >> 7; kvh = (item >> 5) & 3; qb = item & 31; tb = NCTX + b * 1024; }
    else { const int it = item - 256; lat = false; b = it >> 5; kvh = (it >> 3) & 3; qb = it & 7; tb = b * 256; }
    const int head = kvh * 4 + w;
    const int qtok = tb + qb * 32 + fr;
    bf16x8 qf[4];
#pragma unroll
    for (int ks = 0; ks < 4; ++ks) qf[ks] = *(const bf16x8*)(Q + (size_t)qtok * D + head * 64 + ks * 16 + fh * 8);
    float m_run = p.sink[head] * LOG2E, l_run = 1.f;
    f32x16 O[2];
#pragma unroll
    for (int i = 0; i < 2; ++i)
#pragma unroll
        for (int r = 0; r < 16; ++r) O[i][r] = 0.f;

    int nloc, k_lo = 0; const bf16_t *kloc, *vloc; int ldloc;
    if (lat) {
        k_lo = qb - 4 < 0 ? 0 : qb - 4; const int k_hi = qb + 4 > 31 ? 31 : qb + 4; nloc = k_hi - k_lo + 1;
        kloc = KB + (size_t)(tb + k_lo * 32) * 256 + kvh * 64;
        vloc = VTB + (size_t)16 * 4 * 64 * 256 + ((size_t)(b * 4 + kvh) * 64) * 1024 + k_lo * 32; ldloc = 1024;
    } else {
        nloc = 8; kloc = KB + (size_t)tb * 256 + kvh * 64; vloc = VTB + ((size_t)(b * 4 + kvh) * 64) * 256; ldloc = 256;
    }
    const int nblk = lat ? nloc + 8 : 8;
    const bf16_t* kcb = KC + (size_t)(b * 256) * 256 + kvh * 64;
    const bf16_t* vcb = VCT + ((size_t)(b * 4 + kvh) * 64) * 256;
    const int tid = threadIdx.x;
    const int kkey = tid >> 3, kch = tid & 7, vd = tid >> 2, vch = tid & 3;
    const unsigned kst = kkey * 128 + ((kch ^ ((kkey >> 1) & 7)) << 4), vst = 4096 + vd * 64 + ((vch ^ ((vd >> 2) & 3)) << 4);
    const unsigned ksw = (fr >> 1) & 7, vsw = (fr >> 2) & 3;
    u32x4 kreg, vreg;
    auto loadkv = [&](int j) {
        const bf16_t *kp, *vp; int ldv;
        if (j < nloc) { kp = kloc + (size_t)j * 32 * 256; vp = vloc + j * 32; ldv = ldloc; }
        else { const int c = j - nloc; kp = kcb + (size_t)c * 32 * 256; vp = vcb + c * 32; ldv = 256; }
        kreg = *(const u32x4*)(kp + (size_t)kkey * 256 + kch * 8);
        vreg = *(const u32x4*)(vp + (size_t)vd * ldv + vch * 8);
    };
    loadkv(0);
    *(u32x4*)(lds + kst) = kreg; *(u32x4*)(lds + vst) = vreg;
    if (nblk > 1) loadkv(1);
    __syncthreads();
    for (int j = 0; j < nblk; ++j) {
        const unsigned char* lb = lds + (j & 1) * 8192;
        bf16x8 kf[4], vf[4];
#pragma unroll
        for (int ks = 0; ks < 4; ++ks) kf[ks] = *(const bf16x8*)(lb + fr * 128 + (((2 * ks + fh) ^ ksw) << 4));
#pragma unroll
        for (int s2 = 0; s2 < 2; ++s2)
#pragma unroll
            for (int db = 0; db < 2; ++db) vf[s2 * 2 + db] = *(const bf16x8*)(lb + 4096 + (db * 32 + fr) * 64 + (((2 * s2 + fh) ^ vsw) << 4));
        f32x16 s;
#pragma unroll
        for (int r = 0; r < 16; ++r) s[r] = 0.f;
#pragma unroll
        for (int ks = 0; ks < 4; ++ks) s = __builtin_amdgcn_mfma_f32_32x32x16_bf16(kf[ks], qf[ks], s, 0, 0, 0);
        if (lat && j < nloc) {
            const int kb = k_lo + j;
            const int mode = (kb == qb - 4) ? 1 : (kb == qb + 4) ? 2 : 0;
            if (mode) {
                const int dpos = (kb - qb) * 32;
#pragma unroll
                for (int r = 0; r < 16; ++r) {
                    const int rel = dpos + (r & 3) + 8 * (r >> 2) + 4 * fh - fr;
                    const bool ok = mode == 1 ? (rel >= -128) : (rel <= 128);
                    if (!ok) s[r] = -1e30f;
                }
            }
        }
        float mx = s[0];
#pragma unroll
        for (int r = 1; r < 16; ++r) mx = fmaxf(mx, s[r]);
        mx = xhalf_max(mx);
        const float m_new = fmaxf(m_run, mx);
        const float alpha = __builtin_amdgcn_exp2f(m_run - m_new);
        float rs = 0.f;
#pragma unroll
        for (int r = 0; r < 16; ++r) { s[r] = __builtin_amdgcn_exp2f(s[r] - m_new); rs += s[r]; }
        rs = xhalf_sum(rs);
        l_run = l_run * alpha + rs; m_run = m_new;
#pragma unroll
        for (int i = 0; i < 2; ++i)
#pragma unroll
            for (int r = 0; r < 16; ++r) O[i][r] *= alpha;
#pragma unroll
        for (int s2 = 0; s2 < 2; ++s2) {
            union { u32x4 u; bf16x8 v; } pf;
            pf.u.x = cvt_pk_bf16(s[8 * s2 + 0], s[8 * s2 + 1]); pf.u.y = cvt_pk_bf16(s[8 * s2 + 2], s[8 * s2 + 3]);
            pf.u.z = cvt_pk_bf16(s[8 * s2 + 4], s[8 * s2 + 5]); pf.u.w = cvt_pk_bf16(s[8 * s2 + 6], s[8 * s2 + 7]);
#pragma unroll
            for (int db = 0; db < 2; ++db) O[db] = __builtin_amdgcn_mfma_f32_32x32x16_bf16(vf[s2 * 2 + db], pf.v, O[db], 0, 0, 0);
        }
        if (j + 1 < nblk) {
            unsigned char* nb = lds + ((j + 1) & 1) * 8192;
            *(u32x4*)(nb + kst) = kreg; *(u32x4*)(nb + vst) = vreg;
            if (j + 2 < nblk) loadkv(j + 2);
        }
        __syncthreads();
    }
    const float il = 1.f / l_run;
    u32x2 keepy = {0u, 0u};
#pragma unroll
    for (int db = 0; db < 2; ++db)
#pragma unroll
        for (int g = 0; g < 4; ++g) {
            const int col = head * 64 + db * 32 + 8 * g + 4 * fh;
            const u32x2 z = *(const u32x2*)(SZ + (size_t)qtok * D + col);
            const float z0 = __uint_as_float(z.x << 16), z1 = __uint_as_float(z.x & 0xffff0000u);
            const float z2 = __uint_as_float(z.y << 16), z3 = __uint_as_float(z.y & 0xffff0000u);
            u32x2 o; o.x = cvt_pk_bf16(O[db][4 * g] * il * z0, O[db][4 * g + 1] * il * z1);
            o.y = cvt_pk_bf16(O[db][4 * g + 2] * il * z2, O[db][4 * g + 3] * il * z3);
            if ((g & 1) == 0) keepy = o; else put8(lds + w * 8192, fr, db * 4 + (g - 1) + fh, keepy, o);
        }
    flush8<32>(lds + w * 8192, lane, [&](int r) { return Y + (size_t)(tb + qb * 32 + r) * D + head * 64; });
    __syncthreads();
}


#define XB_TMO      128
#define XB_XCNT(j)  (256  + 64 * (j))
#define XB_XSUB(j)  (1280 + 64 * (j))
#define XB_XGEN(j)  (2304 + 64 * (j))
#define XB_TOP      3328
#define XB_TOPGEN   3392
#define XCD_BAR_WORDS 3456
#define XB_SPIN_CAP (1u << 18)
#define LAS __attribute__((address_space(3)))
DEVI unsigned xb_ld(unsigned* p)              { return __hip_atomic_load(p, __ATOMIC_RELAXED, __HIP_MEMORY_SCOPE_AGENT); }
DEVI unsigned xb_add(unsigned* p, unsigned v) { return __hip_atomic_fetch_add(p, v, __ATOMIC_RELAXED, __HIP_MEMORY_SCOPE_AGENT); }
DEVI unsigned xb_xcc_id() { return (unsigned)__builtin_amdgcn_s_getreg((3 << 11) | 20) & 0xFu; }
#define XB_SPIN(cond, bar) do { unsigned _sp = 0; while (cond) { __builtin_amdgcn_s_sleep(1); \
    if ((++_sp & 255u) == 0u) { if (xb_ld(&(bar)[XB_TMO])) break; if (_sp > XB_SPIN_CAP) { atomicAdd(&(bar)[XB_TMO], 1u); break; } } } } while (0)
struct XcdBarrier { unsigned* bar; unsigned x; volatile LAS unsigned* st; };
DEVI XcdBarrier xcd_barrier_post(unsigned* bar, volatile LAS unsigned* st) {
    XcdBarrier b; b.bar = bar; b.x = xb_xcc_id(); b.st = st;
    if (threadIdx.x == 0) (void)xb_add(&bar[XB_XCNT(b.x)], 1u);
    return b;
}
DEVI void xcd_barrier_complete(unsigned* bar, unsigned x, unsigned& nloc, unsigned& nx) {
    const unsigned G = gridDim.x * gridDim.y * gridDim.z;
    unsigned sum, cnt, mine, sp = 0u;
    for (;;) {
        sum = 0u; cnt = 0u; mine = 0u;
#pragma unroll
        for (unsigned j = 0; j < 16; ++j) { const unsigned c = xb_ld(&bar[XB_XCNT(j)]); sum += c; cnt += (c > 0u) ? 1u : 0u; mine = (j == x) ? c : mine; }
        if (sum == G) break;
        __builtin_amdgcn_s_sleep(1);
        if ((++sp & 255u) == 0u) { if (xb_ld(&bar[XB_TMO])) break; if (sp > XB_SPIN_CAP) { atomicAdd(&bar[XB_TMO], 1u); break; } }
    }
    nloc = mine > 0u ? mine : 1u; nx = cnt > 0u ? cnt : 1u;
}
DEVI void xcd_barrier(const XcdBarrier& b) {
    asm volatile("s_waitcnt vmcnt(0)" ::: "memory");
    __syncthreads();
    if (threadIdx.x == 0) {
        unsigned* bar = b.bar;
        __builtin_amdgcn_s_waitcnt(0);
        unsigned nloc = b.st[0], nx = b.st[1];
        if (nloc == 0u) { xcd_barrier_complete(bar, b.x, nloc, nx); b.st[0] = nloc; b.st[1] = nx; }
        const unsigned old = xb_add(&bar[XB_XSUB(b.x)], 1u);
        const unsigned gen = old / nloc;
        if (old + 1u == (gen + 1u) * nloc) {
            __builtin_amdgcn_fence(__ATOMIC_RELEASE, "agent");
            asm volatile("s_waitcnt vmcnt(0)" ::: "memory");
            const unsigned og = xb_add(&bar[XB_TOP], 1u);
            const unsigned tg = og / nx;
            if (og + 1u == (tg + 1u) * nx) xb_add(&bar[XB_TOPGEN], 1u);
            else XB_SPIN(xb_ld(&bar[XB_TOPGEN]) == tg, bar);
            __builtin_amdgcn_fence(__ATOMIC_ACQUIRE, "agent");
            xb_add(&bar[XB_XGEN(b.x)], 1u);
            asm volatile("s_waitcnt vmcnt(0)" ::: "memory");
        } else {
            XB_SPIN(xb_ld(&bar[XB_XGEN(b.x)]) == gen, bar);
            __builtin_amdgcn_fence(__ATOMIC_ACQUIRE, "agent");
            asm volatile("s_waitcnt vmcnt(0)" ::: "memory");
        }
    }
    __syncthreads();
}

DEVI void run_phase(const Params& p, int ph, unsigned char* lds) {
    const int G = gridDim.x;
    bf16_t* H = (bf16_t*)(p.ws + WS_H);
    bf16_t* U = (bf16_t*)(p.ws + WS_U);
    bf16_t* SZ = (bf16_t*)(p.ws + WS_SZ);
    bf16_t* VT = (bf16_t*)(p.ws + WS_VT);
    bf16_t* Y = (bf16_t*)(p.ws + WS_Y);
    float* X1 = (float*)(p.ws + WS_X1);
    const float* mod = (const float*)(p.ws + WS_MOD);
    switch (ph) {
    case 0: {
        phase0(p, lds);
        if (threadIdx.x == 0) {
            unsigned* cnt = (unsigned*)(p.ws + WS_CNT); unsigned sp = 0;
            while (__hip_atomic_load(cnt, __ATOMIC_RELAXED, __HIP_MEMORY_SCOPE_AGENT) < 384u) { __builtin_amdgcn_s_sleep(4); if (++sp > (1u << 22)) break; }
        }
        __syncthreads();
        const float* modp = (const float*)(p.ws + WS_MODP);
        if (blockIdx.x < 72) {
            const int i = blockIdx.x * 256 + threadIdx.x, l = i / 9216, j = i % 3072;
            float s = (l ? p.b_mod1 : p.b_mod0)[j];
#pragma unroll
            for (int ks = 0; ks < 4; ++ks) s += __hip_atomic_load(modp + ks * 18432 + i, __ATOMIC_RELAXED, __HIP_MEMORY_SCOPE_AGENT);
            ((float*)(p.ws + WS_MOD))[i] = s;
        }
        float* lmod = (float*)lds;
        {
            float tmp[24];
#pragma unroll
            for (int q = 0; q < 24; ++q) {
                const int i = threadIdx.x + 256 * q, src_i = (i >> 11) * 3072 + (i & 2047);
                float s = p.b_mod0[i & 2047];
#pragma unroll
                for (int ks = 0; ks < 4; ++ks) s += __hip_atomic_load(modp + ks * 18432 + src_i, __ATOMIC_RELAXED, __HIP_MEMORY_SCOPE_AGENT);
                tmp[q] = s;
            }
#pragma unroll
            for (int q = 0; q < 24; ++q) lmod[threadIdx.x + 256 * q] = tmp[q];
        }
        __syncthreads();
        phase_norm(p, 0, lmod);
    } break;
    case 2: {
        EpiInL0 e{U, SZ};
        for (int t = blockIdx.x; t < 768; t += G) {
            const int tt = xcd_remap(t, 768);
            gemm_tile(H, D, (const bf16_t*)(p.ws + WS_WT0IN), D, 16, lds, e, (tt >> 4) * 128, (tt & 15) * 128);
        }
    } break;
    case 3: {
        bias1_items(p);
        for (int t = blockIdx.x; t < 768; t += G) {
            const int tt = xcd_remap(t, 768);
            const int mt = tt & 3, g = (tt >> 2) & 3, nt = tt >> 4;
            EpiChanDft e{VT, g};
            gemm_tile((const bf16_t*)(p.ws + WS_TW256), 256, U + g * 256, D, 4, lds, e, mt * 128, nt * 128);
        }
    } break;
    case 4: {
        for (int t = blockIdx.x; t < 512; t += G) {
            if (t < 256) {
                const int nt = t & 1, mt = (t >> 1) & 15, bg = t >> 5;
                EpiSeqDft<1> e{SZ, Y, NCTX + (bg >> 2) * 1024, bg & 3};
                gemm_tile<1>((const bf16_t*)(p.ws + WS_TS1024), 2048, VT + (size_t)64 * 256 * 512 + (size_t)bg * 256 * 2048, 2048, 32, lds, e, mt * 64, nt * 128);
            } else {
                const int u = t - 256, nt = u & 1, mt = (u >> 1) & 1, bg = u >> 2;
                EpiSeqDft<2> e{SZ, Y, (bg >> 2) * 256, bg & 3};
                gemm_tile<2>((const bf16_t*)(p.ws + WS_TS256), 512, VT + (size_t)bg * 256 * 512, 512, 8, lds, e, mt * 128, nt * 128);
            }
        }
    } break;
    case 5: {
        EpiOut<true, 2> e{p.x_prompt, p.x_sample, mod, X1, p.norm_w1, mod + 3 * 3072, H, (float*)(p.ws + WS_ROWSS)};
        EpiOut<true, 1> e1{p.x_prompt, p.x_sample, mod, X1, p.norm_w1, mod + 3 * 3072, H, (float*)(p.ws + WS_ROWSS)};
        if (G == 512) {
            if (blockIdx.x < 256) { const int tt = xcd_remap(blockIdx.x, 256); gemm_tile<2>(Y, D, (const bf16_t*)(p.ws + WS_WT0OUT), D, 16, lds, e, (tt >> 3) * 128, (tt & 7) * 128); }
            else { const int tt = xcd_remap(blockIdx.x - 256, 256); gemm_tile<1>(Y, D, (const bf16_t*)(p.ws + WS_WT0OUT), D, 16, lds, e1, 4096 + (tt >> 3) * 64, (tt & 7) * 128); }
        } else
        for (int t = blockIdx.x; t < 384; t += G) {
            const int tt = xcd_remap(t, 384);
            gemm_tile(Y, D, (const bf16_t*)(p.ws + WS_WT0OUT), D, 16, lds, e, (tt >> 3) * 128, (tt & 7) * 128);
        }
    } break;
    case 7: {
        EpiInL1 e{p.qnw, p.knw, (const float*)(p.ws + WS_ROPEC), (const float*)(p.ws + WS_ROPES),
                  (bf16_t*)(p.ws + WS_Q), (bf16_t*)(p.ws + WS_KB), (bf16_t*)(p.ws + WS_VTB), SZ,
                  p.out + (size_t)NTOK * D, p.out + (size_t)NTOK * D + (size_t)NCTX * 256,
                  (const float*)(p.ws + WS_ROWSS), (const float*)(p.ws + WS_BIAS1)};
        for (int t = blockIdx.x; t < 960; t += G) {
            const int tt = xcd_remap(t, 960);
            gemm_tile(H, D, (const bf16_t*)(p.ws + WS_WT1IN), D, 16, lds, e, (tt / 20) * 128, (tt % 20) * 128);
        }
    } break;
    case 8: {
        if (G == 512) {
            if (blockIdx.x < 256) attn_item(p, blockIdx.x, lds);
            else { attn_item(p, 256 + 2 * (blockIdx.x - 256), lds); attn_item(p, 257 + 2 * (blockIdx.x - 256), lds); }
        } else
            for (int t = blockIdx.x; t < 768; t += G) attn_item(p, t, lds);
    } break;
    case 9: {
        EpiOut<false, 2> e{X1, X1 + (size_t)NCTX * D, mod + 3 * 3072, p.out, nullptr, nullptr, nullptr, nullptr};
        EpiOut<false, 1> e1{X1, X1 + (size_t)NCTX * D, mod + 3 * 3072, p.out, nullptr, nullptr, nullptr, nullptr};
        if (G == 512) {
            if (blockIdx.x < 256) { const int tt = xcd_remap(blockIdx.x, 256); gemm_tile<2>(Y, D, (const bf16_t*)(p.ws + WS_WT1OUT), D, 16, lds, e, (tt >> 3) * 128, (tt & 7) * 128); }
            else { const int tt = xcd_remap(blockIdx.x - 256, 256); gemm_tile<1>(Y, D, (const bf16_t*)(p.ws + WS_WT1OUT), D, 16, lds, e1, 4096 + (tt >> 3) * 64, (tt & 7) * 128); }
        } else
        for (int t = blockIdx.x; t < 384; t += G) {
            const int tt = xcd_remap(t, 384);
            gemm_tile(Y, D, (const bf16_t*)(p.ws + WS_WT1OUT), D, 16, lds, e, (tt >> 3) * 128, (tt & 7) * 128);
        }
    } break;
    }
}

__global__ void __launch_bounds__(256, 2) mega(Params p) {
    __shared__ __attribute__((aligned(16))) unsigned char lds[65536 + 16];
    cg::grid_group grid = cg::this_grid();
#if SINGLE_LAUNCH
    volatile LAS unsigned* st = (volatile LAS unsigned*)(lds + 65536);
    if (threadIdx.x < 4) st[threadIdx.x] = 0u;
    __syncthreads();
    XcdBarrier bar = xcd_barrier_post((unsigned*)(p.ws + WS_BAR), st);
    if (p.ph_hi == 777) grid.sync();
#ifndef REP_PH
#define REP_PH -1
#endif
#ifndef REP_SY
#define REP_SY 0
#endif
#define PH(n) run_phase(p, n, lds); if (REP_PH == n) run_phase(p, n, lds);
#define SY() xcd_barrier(bar); if (REP_SY) xcd_barrier(bar);
#else
    const int lo = (int)p.ph_lo, hi = (int)p.ph_hi;
#define PH(n) if (lo <= n && n < hi) run_phase(p, n, lds);
#define SY()
#endif
    PH(0) SY() PH(2) SY() PH(3) SY() PH(4) SY() PH(5) SY() PH(7) SY() PH(8) SY() PH(9)
}

extern "C" void kernel_launch(void* const* d_in, const int* in_sizes, int n_in, void* d_out, int out_size, void* d_ws, size_t ws_size, hipStream_t stream) {
    static int grid_blocks = 0;
    if (!grid_blocks) {
        int dev = 0, cus = 0, per_cu = 0;
        hipGetDevice(&dev);
        hipDeviceGetAttribute(&cus, hipDeviceAttributeMultiprocessorCount, dev);
        hipOccupancyMaxActiveBlocksPerMultiprocessor(&per_cu, mega, 256, 0);
        if (per_cu > 2) per_cu = 2;
        if (per_cu < 1) per_cu = 1;
        grid_blocks = cus * per_cu;
    }
    Params p{};
    const float* const* in = (const float* const*)d_in;
    p.x_prompt = in[0]; p.x_sample = in[1]; p.cache_k = in[2]; p.cache_v = in[3]; p.c = in[4]; p.c_ctx = in[5];
    p.norm_w0 = in[6]; p.w_mod0 = in[7]; p.b_mod0 = in[8]; p.w_in0 = in[9]; p.w_out0 = in[10];
    p.norm_w1 = in[11]; p.w_mod1 = in[12]; p.b_mod1 = in[13]; p.w_in1 = in[14]; p.qnw = in[15]; p.knw = in[16]; p.sink = in[17]; p.w_out1 = in[18];
    p.out = (float*)d_out; p.ws = (unsigned char*)d_ws;
#if SINGLE_LAUNCH
    p.ph_lo = 0; p.ph_hi = 10;
    hipMemsetAsync((unsigned char*)d_ws + WS_BAR, 0, 16384, stream);
    void* args[] = {&p};
    hipError_t e = hipLaunchCooperativeKernel((void*)mega, dim3(grid_blocks), dim3(256), args, 0, stream);
    if (e != hipSuccess) fprintf(stderr, "cooperative launch failed: %s (grid %d)\n", hipGetErrorString(e), grid_blocks);
#else
    for (int ph = 0; ph < 10; ++ph) {
        p.ph_lo = ph; p.ph_hi = ph + 1;
        hipLaunchKernelGGL(mega, dim3(grid_blocks), dim3(256), 0, stream, p);
    }
#endif
}
```

```cpp
#include <hip/hip_runtime.h>
#include <hip/hip_cooperative_groups.h>
#include <stdint.h>
#include <cstdio>
namespace cg = cooperative_groups;

#ifndef SINGLE_LAUNCH
#define SINGLE_LAUNCH 1
#endif

typedef unsigned short bf16_t;
typedef short bf16x8 __attribute__((ext_vector_type(8)));
typedef float f32x16 __attribute__((ext_vector_type(16)));
typedef float f32x4 __attribute__((ext_vector_type(4)));
typedef unsigned u32x4 __attribute__((ext_vector_type(4)));
typedef unsigned u32x2 __attribute__((ext_vector_type(2)));
#define DEVI __device__ __forceinline__

constexpr int NTOK = 6144, NCTX = 4096, D = 1024;
constexpr float EPSV = 1e-6f;
constexpr float LOG2E = 1.4426950408889634f;

constexpr size_t WS_MOD = 0;
constexpr size_t WS_WT0IN = 1 << 20;
constexpr size_t WS_WT0OUT = WS_WT0IN + (size_t)2048 * 1024 * 2;
constexpr size_t WS_WT1IN = WS_WT0OUT + (size_t)1024 * 1024 * 2;
constexpr size_t WS_WT1OUT = WS_WT1IN + (size_t)2560 * 1024 * 2;
constexpr size_t WS_TW256 = WS_WT1OUT + (size_t)1024 * 1024 * 2;
constexpr size_t WS_TS256 = WS_TW256 + (size_t)512 * 256 * 2;
constexpr size_t WS_TS1024 = WS_TS256 + (size_t)256 * 512 * 2;
constexpr size_t WS_ROPEC = WS_TS1024 + (size_t)1024 * 2048 * 2;
constexpr size_t WS_ROPES = WS_ROPEC + (size_t)1024 * 32 * 4;
constexpr size_t WS_KC = WS_ROPES + (size_t)1024 * 32 * 4;
constexpr size_t WS_VCT = WS_KC + (size_t)2 * 256 * 256 * 2;
constexpr size_t WS_H = WS_VCT + (size_t)2 * 256 * 256 * 2;
constexpr size_t WS_U = WS_H + (size_t)NTOK * D * 2;
constexpr size_t WS_SZ = WS_U + (size_t)NTOK * D * 2;
constexpr size_t WS_VT = WS_SZ + (size_t)NTOK * D * 2;
constexpr size_t WS_Y = WS_VT + (size_t)NTOK * 2048 * 2;
constexpr size_t WS_X1 = WS_Y + (size_t)NTOK * D * 2;
constexpr size_t WS_Q = WS_X1 + (size_t)NTOK * D * 4;
constexpr size_t WS_KB = WS_Q + (size_t)NTOK * D * 2;
constexpr size_t WS_VTB = WS_KB + (size_t)NTOK * 256 * 2;
constexpr size_t WS_BAR = WS_VTB + (size_t)NTOK * 256 * 2;
constexpr size_t WS_CNT = WS_BAR + 14336;
constexpr size_t WS_ROWSS = WS_BAR + 16384;
constexpr size_t WS_BIAS1 = WS_ROWSS + 6144 * 4;
constexpr size_t WS_MODP = WS_BIAS1 + 3 * 2560 * 4;
constexpr size_t WS_END = WS_MODP + (size_t)4 * 18432 * 4;

struct Params {
    const float *x_prompt, *x_sample, *cache_k, *cache_v, *c, *c_ctx;
    const float *norm_w0, *w_mod0, *b_mod0, *w_in0, *w_out0;
    const float *norm_w1, *w_mod1, *b_mod1, *w_in1, *qnw, *knw, *sink, *w_out1;
    float* out;
    unsigned char* ws;
    long long ph_lo, ph_hi;
};

DEVI unsigned cvt_pk_bf16(float lo, float hi) { unsigned r; asm("v_cvt_pk_bf16_f32 %0, %1, %2" : "=v"(r) : "v"(lo), "v"(hi)); return r; }
DEVI bf16_t f2bf(float f) { return (bf16_t)(cvt_pk_bf16(f, 0.f) & 0xffffu); }
DEVI float silu_f(float v) { return v * __builtin_amdgcn_rcpf(1.f + __expf(-v)); }
DEVI int swap23(int x) { return (x & ~12) | ((x & 4) << 1) | ((x & 8) >> 1); }
DEVI int cond_of(int m) { return m < NCTX ? 0 : 1 + ((m - NCTX) >> 10); }

DEVI void st8(bf16_t* p, u32x2 a, u32x2 b) {
    const auto r0 = __builtin_amdgcn_permlane32_swap(a.x, b.x, false, false);
    const auto r1 = __builtin_amdgcn_permlane32_swap(a.y, b.y, false, false);
    u32x4 w; w.x = r0[0]; w.y = r1[0]; w.z = r0[1]; w.w = r1[1];
    *(u32x4*)p = w;
}
DEVI void put8(unsigned char* wl, int r, int c, u32x2 a, u32x2 b) {
    const auto r0 = __builtin_amdgcn_permlane32_swap(a.x, b.x, false, false);
    const auto r1 = __builtin_amdgcn_permlane32_swap(a.y, b.y, false, false);
    u32x4 w; w.x = r0[0]; w.y = r1[0]; w.z = r0[1]; w.w = r1[1];
    *(u32x4*)(wl + r * 128 + ((c ^ (r & 7)) << 4)) = w;
}
template <int ROWS, class RowPtr>
DEVI void flush8(const unsigned char* wl, int lane, const RowPtr& rowptr) {
#pragma unroll
    for (int i = 0; i < ROWS / 8; ++i) {
        const int r = i * 8 + (lane >> 3), c = lane & 7;
        const u32x4 w = *(const u32x4*)(wl + r * 128 + ((c ^ (r & 7)) << 4));
        *(u32x4*)(rowptr(r) + c * 8) = w;
    }
}
DEVI float xhalf_sum(float x) { const auto r = __builtin_amdgcn_permlane32_swap(__float_as_uint(x), __float_as_uint(x), false, false); return __uint_as_float(r[0]) + __uint_as_float(r[1]); }
DEVI float xhalf_max(float x) { const auto r = __builtin_amdgcn_permlane32_swap(__float_as_uint(x), __float_as_uint(x), false, false); return fmaxf(__uint_as_float(r[0]), __uint_as_float(r[1])); }

DEVI void glds16(const void* g, void* l) { __builtin_amdgcn_global_load_lds(g, l, 16, 0, 0); }

template <int MB = 2, class Epi>
DEVI void gemm_tile(const bf16_t* __restrict__ A, int lda, const bf16_t* __restrict__ B, int ldb, int nk,
                    unsigned char* lds, const Epi& epi, int m0, int n0) {
    const int tid = threadIdx.x, lane = tid & 63, wid = tid >> 6, wr = wid >> 1, wc = wid & 1;
    const int srow = tid >> 3;
    const int slc = (tid & 7) ^ ((tid >> 4) & 7);
    const bf16_t* gA = A + (size_t)(m0 + srow) * lda + slc * 8;
    const bf16_t* gB = B + (size_t)(n0 + srow) * ldb + slc * 8;
    const int fr = lane & 31, fh = lane >> 5, sw = (lane >> 1) & 7;
    const unsigned aoff = (wr * 32 * MB + fr) * 128, boff = 16384 + (wc * 64 + fr) * 128;
    f32x16 acc[MB][2];
#pragma unroll
    for (int i = 0; i < MB; ++i)
#pragma unroll
        for (int j = 0; j < 2; ++j)
#pragma unroll
            for (int r = 0; r < 16; ++r) acc[i][j][r] = 0.f;
    {
        unsigned char* la = lds + tid * 16;
#pragma unroll
        for (int i = 0; i < 4; ++i) {
            if (i < 2 * MB) glds16(gA + (size_t)i * 32 * lda, la + i * 4096);
            glds16(gB + (size_t)i * 32 * ldb, la + 16384 + i * 4096);
        }
        la += 32768;
#pragma unroll
        for (int i = 0; i < 4; ++i) {
            if (i < 2 * MB) glds16(gA + (size_t)i * 32 * lda + 64, la + i * 4096);
            glds16(gB + (size_t)i * 32 * ldb + 64, la + 16384 + i * 4096);
        }
    }
    for (int kt = 0; kt < nk; ++kt) {
        if (kt == 0) {
            if (MB == 2) asm volatile("s_waitcnt vmcnt(8) lgkmcnt(0)" ::: "memory"); else asm volatile("s_waitcnt vmcnt(6) lgkmcnt(0)" ::: "memory");
            __builtin_amdgcn_sched_barrier(0); __builtin_amdgcn_s_barrier(); __builtin_amdgcn_sched_barrier(0);
        } else {
            asm volatile("s_waitcnt vmcnt(0)" ::: "memory");
            __syncthreads();
        }
        if (kt >= 1 && kt + 1 < nk) {
            unsigned char* la = lds + ((kt + 1) & 1) * 32768 + tid * 16;
            const int ko = (kt + 1) * 64;
#pragma unroll
            for (int i = 0; i < 4; ++i) {
                if (i < 2 * MB) glds16(gA + (size_t)i * 32 * lda + ko, la + i * 4096);
                glds16(gB + (size_t)i * 32 * ldb + ko, la + 16384 + i * 4096);
            }
        }
        const unsigned char* base = lds + (kt & 1) * 32768;
        bf16x8 af[4][2], bfr[4][2];
#define LDFRAG(ks) { const int ch = ((2 * (ks) + fh) ^ sw) * 16; \
            af[ks][0] = *(const bf16x8*)(base + aoff + ch); bfr[ks][0] = *(const bf16x8*)(base + boff + ch); \
            bfr[ks][1] = *(const bf16x8*)(base + boff + 4096 + ch); if (MB == 2) af[ks][1] = *(const bf16x8*)(base + aoff + 4096 + ch); }
#define MFMA4(ks) { acc[0][0] = __builtin_amdgcn_mfma_f32_32x32x16_bf16(bfr[ks][0], af[ks][0], acc[0][0], 0, 0, 0); \
            acc[0][1] = __builtin_amdgcn_mfma_f32_32x32x16_bf16(bfr[ks][1], af[ks][0], acc[0][1], 0, 0, 0); \
            if (MB == 2) { acc[MB - 1][0] = __builtin_amdgcn_mfma_f32_32x32x16_bf16(bfr[ks][0], af[ks][1], acc[MB - 1][0], 0, 0, 0); \
            acc[MB - 1][1] = __builtin_amdgcn_mfma_f32_32x32x16_bf16(bfr[ks][1], af[ks][1], acc[MB - 1][1], 0, 0, 0); } }
        LDFRAG(0) LDFRAG(1)
        __builtin_amdgcn_sched_barrier(0);
        MFMA4(0) LDFRAG(2)
        __builtin_amdgcn_sched_barrier(0);
        MFMA4(1) LDFRAG(3)
        __builtin_amdgcn_sched_barrier(0);
        MFMA4(2)
        __builtin_amdgcn_sched_barrier(0);
        MFMA4(3)
#undef LDFRAG
#undef MFMA4
    }
    epi(acc, m0 + wr * 32 * MB, n0 + wc * 64, fr, fh, lds + wid * 8192);
    __syncthreads();
}

DEVI int xcd_remap(int t, int T) { return (t & 7) * (T >> 3) + (t >> 3); }

DEVI void mod_item(const Params& p, int it, unsigned char* lds) {
    const int tid = threadIdx.x;
    const int ks = it & 3, lc = it >> 2, l = lc / 48, cc = lc % 48;
    float* sc = (float*)lds;
    for (int i = tid; i < 768; i += 256) {
        const int cv = i >> 8, k = ks * 256 + (i & 255);
        const float cval = cv == 0 ? p.c_ctx[k] : p.c[(cv - 1) * 1024 + k];
        sc[i] = silu_f(cval);
    }
    __syncthreads();
    const float* W = (l ? p.w_mod1 : p.w_mod0) + (size_t)ks * 256 * 3072;
    const int cg4 = tid & 15, rg = tid >> 4, c0 = cc * 64 + cg4 * 4;
    f32x4 w[16];
#pragma unroll
    for (int i = 0; i < 16; ++i) w[i] = *(const f32x4*)(W + (size_t)(rg + 16 * i) * 3072 + c0);
    f32x4 a0 = {0.f, 0.f, 0.f, 0.f}, a1 = a0, a2 = a0;
#pragma unroll
    for (int i = 0; i < 16; ++i) { const int k = rg + 16 * i; a0 += sc[k] * w[i]; a1 += sc[256 + k] * w[i]; a2 += sc[512 + k] * w[i]; }
    float* red = (float*)(lds + 12288);
#pragma unroll
    for (int e = 0; e < 4; ++e) {
        red[(rg * 3 + 0) * 64 + cg4 * 4 + e] = a0[e];
        red[(rg * 3 + 1) * 64 + cg4 * 4 + e] = a1[e];
        red[(rg * 3 + 2) * 64 + cg4 * 4 + e] = a2[e];
    }
    __syncthreads();
    if (tid < 192) {
        const int cv = tid >> 6, j = tid & 63;
        float s = 0.f;
#pragma unroll
        for (int r = 0; r < 16; ++r) s += red[(r * 3 + cv) * 64 + j];
        float* modp = (float*)(p.ws + WS_MODP) + (size_t)ks * 18432;
        __hip_atomic_store(&modp[(l * 3 + cv) * 3072 + cc * 64 + j], s, __ATOMIC_RELAXED, __HIP_MEMORY_SCOPE_AGENT);
    }
    asm volatile("s_waitcnt vmcnt(0)" ::: "memory");
    __syncthreads();
    if (tid == 0) __hip_atomic_fetch_add((unsigned*)(p.ws + WS_CNT), 1u, __ATOMIC_RELAXED, __HIP_MEMORY_SCOPE_AGENT);
}

struct TrDesc { const float* src; bf16_t* dst; int N, kt, nt; };
DEVI TrDesc tr_desc(const Params& p, int idx) {
    TrDesc d;
    if (idx < 512) { d.src = p.w_in0; d.dst = (bf16_t*)(p.ws + WS_WT0IN); d.N = 2048; }
    else if (idx < 768) { idx -= 512; d.src = p.w_out0; d.dst = (bf16_t*)(p.ws + WS_WT0OUT); d.N = 1024; }
    else if (idx < 1408) { idx -= 768; d.src = p.w_in1; d.dst = (bf16_t*)(p.ws + WS_WT1IN); d.N = 2560; }
    else { idx -= 1408; d.src = p.w_out1; d.dst = (bf16_t*)(p.ws + WS_WT1OUT); d.N = 1024; }
    const int ntn = d.N >> 6;
    d.kt = idx / ntn; d.nt = idx % ntn;
    return d;
}
DEVI void transpose_items(const Params& p, int first, int end, int stride, unsigned char* lds) {
    const int tid = threadIdx.x;
    float* tl = (float*)lds;
    if (first >= end) return;
    f32x4 v[4];
    TrDesc d = tr_desc(p, first);
#pragma unroll
    for (int pass = 0; pass < 4; ++pass) v[pass] = *(const f32x4*)(d.src + (size_t)(d.kt * 64 + pass * 16 + (tid >> 4)) * d.N + d.nt * 64 + (tid & 15) * 4);
    for (int idx = first; idx < end; idx += stride) {
#pragma unroll
        for (int pass = 0; pass < 4; ++pass) {
            const int r = pass * 16 + (tid >> 4), c4 = (tid & 15) * 4;
#pragma unroll
            for (int e = 0; e < 4; ++e) tl[r * 65 + c4 + e] = v[pass][e];
        }
        const TrDesc cur = d;
        if (idx + stride < end) {
            d = tr_desc(p, idx + stride);
#pragma unroll
            for (int pass = 0; pass < 4; ++pass) v[pass] = *(const f32x4*)(d.src + (size_t)(d.kt * 64 + pass * 16 + (tid >> 4)) * d.N + d.nt * 64 + (tid & 15) * 4);
        }
        __syncthreads();
#pragma unroll
        for (int pass = 0; pass < 2; ++pass) {
            const int n = pass * 32 + (tid >> 3), kc = tid & 7;
            float x[8];
#pragma unroll
            for (int j = 0; j < 8; ++j) x[j] = tl[(kc * 8 + j) * 65 + n];
            u32x4 w;
            w.x = cvt_pk_bf16(x[0], x[1]); w.y = cvt_pk_bf16(x[2], x[3]); w.z = cvt_pk_bf16(x[4], x[5]); w.w = cvt_pk_bf16(x[6], x[7]);
            *(u32x4*)(cur.dst + (size_t)(cur.nt * 64 + n) * 1024 + cur.kt * 64 + kc * 8) = w;
        }
        __syncthreads();
    }
}

DEVI void phase0(const Params& p, unsigned char* lds) {
    for (int it = blockIdx.x; it < 384; it += gridDim.x) mod_item(p, it, lds);
    transpose_items(p, (blockIdx.x + 128) % gridDim.x, 1664, gridDim.x, lds);
    const int gt = blockIdx.x * 256 + threadIdx.x, gs = gridDim.x * 256;
    bf16_t* tw256 = (bf16_t*)(p.ws + WS_TW256);
    bf16_t* ts256 = (bf16_t*)(p.ws + WS_TS256);
    bf16_t* ts1024 = (bf16_t*)(p.ws + WS_TS1024);
    float* lut = (float*)(lds + 32768);
    __syncthreads();
    for (int r = threadIdx.x; r < 1024; r += 256) lut[r] = cospif((float)r * (1.f / 512.f));
    __syncthreads();
    for (int i = gt; i < 512 * 256; i += gs) {
        const int m = i >> 8, j = i & 255, which = m >> 8, cp = m & 255;
        const int r = ((cp * j) & 255) << 2;
        tw256[i] = f2bf(which ? lut[(r - 256) & 1023] : lut[r]);
    }
    for (int i = gt; i < 256 * 512; i += gs) {
        const int sp = i >> 9, k2 = i & 511, which = k2 >> 8, s0 = k2 & 255;
        const int r = ((sp * s0) & 255) << 2;
        ts256[i] = f2bf((which ? -lut[(r - 256) & 1023] : lut[r]) * (1.f / 256.f));
    }
    for (int i = gt; i < 1024 * 2048; i += gs) {
        const int sp = i >> 11, k2 = i & 2047, which = k2 >> 10, s0 = k2 & 1023;
        const int r = (sp * s0) & 1023;
        ts1024[i] = f2bf((which ? -lut[(r - 256) & 1023] : lut[r]) * (1.f / 512.f));
    }
    float* ropec = (float*)(p.ws + WS_ROPEC);
    float* ropes = (float*)(p.ws + WS_ROPES);
    for (int i = gt; i < 1024 * 32; i += gs) {
        const int pos = i >> 5, f = i & 31;
        const int row = pos >> 6, col = pos & 63;
        const float inv = powf(10000.f, -(float)(f & 15) * (1.f / 16.f));
        const float ang = (float)(f < 16 ? row : col) * inv;
        float s, c; sincosf(ang, &s, &c);
        ropec[i] = c; ropes[i] = s;
    }
    for (int i = gt; i < NTOK; i += gs) ((float*)(p.ws + WS_ROWSS))[i] = 0.f;
    bf16_t* kc = (bf16_t*)(p.ws + WS_KC);
    bf16_t* vct = (bf16_t*)(p.ws + WS_VCT);
    for (int i = gt; i < 2 * 256 * 256; i += gs) {
        kc[i] = f2bf(p.cache_k[i]);
        const int b = i >> 16, kvh = (i >> 14) & 3, d = (i >> 8) & 63, pp = i & 255;
        const int key = swap23(pp);
        vct[i] = f2bf(p.cache_v[((b * 256 + key) * 4 + kvh) * 64 + d]);
    }
}

DEVI void phase_norm(const Params& p, int layer, const float* lmod  ) {
    const int lane = threadIdx.x & 63, wid = threadIdx.x >> 6;
    const float* nw = layer ? p.norm_w1 : p.norm_w0;
    bf16_t* H = (bf16_t*)(p.ws + WS_H);
    for (int row = blockIdx.x * 4 + wid; row < NTOK; row += gridDim.x * 4) {
        const float* xr;
        if (layer == 0) xr = row < NCTX ? p.x_prompt + (size_t)row * D : p.x_sample + (size_t)(row - NCTX) * D;
        else xr = (const float*)(p.ws + WS_X1) + (size_t)row * D;
        const float* mv = lmod + cond_of(row) * 2048;
        f32x4 v[4];
        float ss = 0.f;
#pragma unroll
        for (int i = 0; i < 4; ++i) {
            v[i] = *(const f32x4*)(xr + i * 256 + lane * 4);
            ss += v[i][0] * v[i][0] + v[i][1] * v[i][1] + v[i][2] * v[i][2] + v[i][3] * v[i][3];
        }
#pragma unroll
        for (int o = 32; o >= 1; o >>= 1) ss += __shfl_xor(ss, o);
        const float rstd = rsqrtf(ss * (1.f / 1024.f) + EPSV);
#pragma unroll
        for (int i = 0; i < 4; ++i) {
            const int k = i * 256 + lane * 4;
            const f32x4 w = *(const f32x4*)(nw + k);
            const f32x4 sh = *(const f32x4*)(mv + k);
            const f32x4 scl = *(const f32x4*)(mv + 1024 + k);
            float h[4];
#pragma unroll
            for (int e = 0; e < 4; ++e) h[e] = (v[i][e] * rstd * w[e]) * (1.f + scl[e]) + sh[e];
            u32x2 o; o.x = cvt_pk_bf16(h[0], h[1]); o.y = cvt_pk_bf16(h[2], h[3]);
            *(u32x2*)(H + (size_t)row * D + k) = o;
        }
    }
}

DEVI void bias1_items(const Params& p) {
    const int lane = threadIdx.x & 63, gw = blockIdx.x * 4 + (threadIdx.x >> 6), nw = gridDim.x * 4;
    const float* mod1 = (const float*)(p.ws + WS_MOD) + 3 * 3072;
    const bf16_t* WT = (const bf16_t*)(p.ws + WS_WT1IN);
    float* bias1 = (float*)(p.ws + WS_BIAS1);
    for (int n = gw; n < 2560; n += nw) {
        float w[16];
        const u32x4 r0 = *(const u32x4*)(WT + (size_t)n * 1024 + lane * 16), r1 = *(const u32x4*)(WT + (size_t)n * 1024 + lane * 16 + 8);
        const unsigned rr[8] = {r0.x, r0.y, r0.z, r0.w, r1.x, r1.y, r1.z, r1.w};
#pragma unroll
        for (int i = 0; i < 8; ++i) { w[2 * i] = __uint_as_float(rr[i] << 16); w[2 * i + 1] = __uint_as_float(rr[i] & 0xffff0000u); }
        float s[3];
#pragma unroll
        for (int cv = 0; cv < 3; ++cv) {
            float a = 0.f;
#pragma unroll
            for (int q = 0; q < 4; ++q) {
                const f32x4 sh = *(const f32x4*)(mod1 + cv * 3072 + lane * 16 + q * 4);
#pragma unroll
                for (int e = 0; e < 4; ++e) a += sh[e] * w[q * 4 + e];
            }
#pragma unroll
            for (int o = 32; o >= 1; o >>= 1) a += __shfl_xor(a, o);
            s[cv] = a;
        }
        if (lane == 0) { bias1[n] = s[0]; bias1[2560 + n] = s[1]; bias1[5120 + n] = s[2]; }
    }
}

struct EpiInL0 {
    bf16_t *U, *SZ;
    DEVI void operator()(const f32x16 (&acc)[2][2], int mbase, int nbase, int fr, int fh, unsigned char* wl) const {
        const bool isz = nbase >= 1024;
        bf16_t* dst = isz ? SZ : U;
        const int nb0 = isz ? nbase - 1024 : nbase;
        u32x2 keep = {0u, 0u};
#pragma unroll
        for (int mb = 0; mb < 2; ++mb)
#pragma unroll
            for (int nb = 0; nb < 2; ++nb)
#pragma unroll
                for (int g = 0; g < 4; ++g) {
                    const int m = mbase + mb * 32 + fr, n = nb0 + nb * 32 + 8 * g + 4 * fh;
                    float v[4];
#pragma unroll
                    for (int e = 0; e < 4; ++e) { v[e] = acc[mb][nb][4 * g + e]; if (isz) v[e] = silu_f(v[e]); }
                    u32x2 o; o.x = cvt_pk_bf16(v[0], v[1]); o.y = cvt_pk_bf16(v[2], v[3]);
                    if ((g & 1) == 0) keep = o; else put8(wl, mb * 32 + fr, nb * 4 + (g - 1) + fh, keep, o);
                }
        flush8<64>(wl, fh * 32 + fr, [&](int r) { return dst + (size_t)(mbase + r) * D + nb0; });
    }
};

struct EpiChanDft {
    bf16_t* VT; int g;
    DEVI void operator()(const f32x16 (&acc)[2][2], int mbase, int nbase, int fr, int fh, unsigned char* wl) const {
        int S, bgi, s0; bf16_t* base;
        if (nbase < NCTX) { S = 256; bgi = (nbase >> 8) * 4 + g; s0 = nbase & 255; base = VT; }
        else { const int t = nbase - NCTX; S = 1024; bgi = (t >> 10) * 4 + g; s0 = t & 1023; base = VT + (size_t)64 * 256 * 512; }
        u32x2 keep = {0u, 0u};
#pragma unroll
        for (int mb = 0; mb < 2; ++mb)
#pragma unroll
            for (int nb = 0; nb < 2; ++nb)
#pragma unroll
                for (int gq = 0; gq < 4; ++gq) {
                    const int m = mbase + mb * 32 + fr, which = m >> 8, cp = m & 255;
                    const int s = s0 + nb * 32 + 8 * gq + 4 * fh;
                    u32x2 o; o.x = cvt_pk_bf16(acc[mb][nb][4 * gq], acc[mb][nb][4 * gq + 1]); o.y = cvt_pk_bf16(acc[mb][nb][4 * gq + 2], acc[mb][nb][4 * gq + 3]);
                    if ((gq & 1) == 0) keep = o; else put8(wl, mb * 32 + fr, nb * 4 + (gq - 1) + fh, keep, o);
                }
        flush8<64>(wl, fh * 32 + fr, [&](int r) { const int m = mbase + r; return base + ((size_t)bgi * 256 + (m & 255)) * (2 * S) + (m >> 8) * S + s0; });
    }
};

template <int MB> struct EpiSeqDft {
    const bf16_t* SZ; bf16_t* Y; int tok0, g;
    DEVI void operator()(const f32x16 (&acc)[MB][2], int mbase, int nbase, int fr, int fh, unsigned char* wl) const {
        u32x2 keep = {0u, 0u};
#pragma unroll
        for (int mb = 0; mb < MB; ++mb)
#pragma unroll
            for (int nb = 0; nb < 2; ++nb)
#pragma unroll
                for (int gq = 0; gq < 4; ++gq) {
                    const int tok = tok0 + mbase + mb * 32 + fr;
                    const int col = g * 256 + nbase + nb * 32 + 8 * gq + 4 * fh;
                    const u32x2 z = *(const u32x2*)(SZ + (size_t)tok * D + col);
                    const float z0 = __uint_as_float(z.x << 16), z1 = __uint_as_float(z.x & 0xffff0000u);
                    const float z2 = __uint_as_float(z.y << 16), z3 = __uint_as_float(z.y & 0xffff0000u);
                    u32x2 o; o.x = cvt_pk_bf16(acc[mb][nb][4 * gq] * z0, acc[mb][nb][4 * gq + 1] * z1);
                    o.y = cvt_pk_bf16(acc[mb][nb][4 * gq + 2] * z2, acc[mb][nb][4 * gq + 3] * z3);
                    if ((gq & 1) == 0) keep = o; else put8(wl, mb * 32 + fr, nb * 4 + (gq - 1) + fh, keep, o);
                }
        flush8<32 * MB>(wl, fh * 32 + fr, [&](int r) { return Y + (size_t)(tok0 + mbase + r) * D + g * 256 + nbase; });
    }
};

#define DPP_ADD(x, CTRL) ((x) + __uint_as_float((unsigned)__builtin_amdgcn_update_dpp(0, (int)__float_as_uint(x), CTRL, 0xF, 0xF, true)))
DEVI float row16_sum(float x) {
    x = DPP_ADD(x, 0xB1);
    x = DPP_ADD(x, 0x4E);
    x = DPP_ADD(x, 0x141);
    x = DPP_ADD(x, 0x140);
    return x;
}
template <bool NEXT, int MB> struct EpiOut {
    const float* xa; const float* xb;
    const float* mod;
    float* out;
    const float* nw1; const float* mod1; bf16_t* Hn; float* rowss;
    DEVI void operator()(const f32x16 (&acc)[MB][2], int mbase, int nbase, int fr, int fh, unsigned char* wl) const {
        const int lane = fh * 32 + fr, c4 = lane & 15, rsub = lane >> 4;
        const int cv = cond_of(mbase);
        const int n = nbase + c4 * 4;
        const f32x4 gv = *(const f32x4*)(mod + cv * 3072 + 2048 + n);
        f32x4 hv = {0.f, 0.f, 0.f, 0.f};
        if (NEXT) {
            const f32x4 w = *(const f32x4*)(nw1 + n);
            const f32x4 sc = *(const f32x4*)(mod1 + cv * 3072 + 1024 + n);
#pragma unroll
            for (int e = 0; e < 4; ++e) hv[e] = w[e] * (1.f + sc[e]);
        }
#pragma unroll
        for (int mb = 0; mb < MB; ++mb) {
#pragma unroll
            for (int nb = 0; nb < 2; ++nb)
#pragma unroll
                for (int g = 0; g < 4; ++g) {
                    f32x4 a = {acc[mb][nb][4 * g], acc[mb][nb][4 * g + 1], acc[mb][nb][4 * g + 2], acc[mb][nb][4 * g + 3]};
                    *(f32x4*)(wl + fr * 256 + (((nb * 8 + 2 * g + fh) ^ (fr & 15)) << 4)) = a;
                }
#pragma unroll
            for (int i = 0; i < 8; ++i) {
                const int r = i * 4 + rsub, m = mbase + mb * 32 + r;
                const f32x4 a = *(const f32x4*)(wl + r * 256 + ((c4 ^ (r & 15)) << 4));
                const float* xr = m < NCTX ? xa + (size_t)m * D : xb + (size_t)(m - NCTX) * D;
                const f32x4 xv = *(const f32x4*)(xr + n);
                f32x4 o;
#pragma unroll
                for (int e = 0; e < 4; ++e) o[e] = xv[e] + gv[e] * a[e];
                *(f32x4*)(out + (size_t)m * D + n) = o;
                if (NEXT) {
                    float ss = (o[0] * o[0] + o[1] * o[1]) + (o[2] * o[2] + o[3] * o[3]);
                    ss = row16_sum(ss);
                    if (c4 == 0) atomicAdd(rowss + m, ss);
                    u32x2 hb; hb.x = cvt_pk_bf16(o[0] * hv[0], o[1] * hv[1]); hb.y = cvt_pk_bf16(o[2] * hv[2], o[3] * hv[3]);
                    *(u32x2*)(Hn + (size_t)m * D + n) = hb;
                }
            }
        }
    }
};

struct EpiInL1 {
    const float *qnw, *knw, *ropec, *ropes;
    bf16_t *Q, *KB, *VTB, *SZ;
    float *outk, *outv;
    const float* rowss; const float* bias1;
    DEVI void operator()(const f32x16 (&acc_in)[2][2], int mbase, int nbase, int fr, int fh, unsigned char* wl) const {
        const bool lat = mbase >= NCTX;
        u32x2 keep1 = {0u, 0u}, keep2 = {0u, 0u};
        f32x16 acc[2][2];
        {
            const float* bp = bias1 + cond_of(mbase) * 2560 + nbase;
#pragma unroll
            for (int mb = 0; mb < 2; ++mb) {
                const float rstd = rsqrtf(rowss[mbase + mb * 32 + fr] * (1.f / 1024.f) + EPSV);
#pragma unroll
                for (int nb = 0; nb < 2; ++nb)
#pragma unroll
                    for (int g = 0; g < 4; ++g) {
                        const f32x4 bv = *(const f32x4*)(bp + nb * 32 + 8 * g + 4 * fh);
#pragma unroll
                        for (int e = 0; e < 4; ++e) acc[mb][nb][4 * g + e] = acc_in[mb][nb][4 * g + e] * rstd + bv[e];
                    }
            }
        }
        if (nbase < 1280) {
            const bool isq = nbase < 1024;
            const float* nwp = isq ? qnw : knw;
#pragma unroll
            for (int mb = 0; mb < 2; ++mb) {
                const int m = mbase + mb * 32 + fr;
                float ss = 0.f;
#pragma unroll
                for (int nb = 0; nb < 2; ++nb)
#pragma unroll
                    for (int r = 0; r < 16; ++r) ss += acc[mb][nb][r] * acc[mb][nb][r];
                ss = xhalf_sum(ss);
                const float rn = rsqrtf(ss * (1.f / 64.f) + EPSV);
                const int pos = lat ? ((m - NCTX) & 1023) : 0;
#pragma unroll
                for (int g = 0; g < 4; ++g) {
                    const int d0 = 8 * g + 4 * fh;
                    const f32x4 w1 = *(const f32x4*)(nwp + d0), w2 = *(const f32x4*)(nwp + 32 + d0);
                    float x1[4], x2[4];
#pragma unroll
                    for (int e = 0; e < 4; ++e) { x1[e] = acc[mb][0][4 * g + e] * rn * w1[e]; x2[e] = acc[mb][1][4 * g + e] * rn * w2[e]; }
                    if (lat) {
                        const f32x4 cv = *(const f32x4*)(ropec + pos * 32 + d0), sv = *(const f32x4*)(ropes + pos * 32 + d0);
#pragma unroll
                        for (int e = 0; e < 4; ++e) { const float a = x1[e], b = x2[e]; x1[e] = a * cv[e] - b * sv[e]; x2[e] = a * sv[e] + b * cv[e]; }
                    }
                    if (isq) {
                        const float qs = 0.125f * LOG2E;
                        u32x2 o1, o2;
                        o1.x = cvt_pk_bf16(x1[0] * qs, x1[1] * qs); o1.y = cvt_pk_bf16(x1[2] * qs, x1[3] * qs);
                        o2.x = cvt_pk_bf16(x2[0] * qs, x2[1] * qs); o2.y = cvt_pk_bf16(x2[2] * qs, x2[3] * qs);
                        if ((g & 1) == 0) { keep1 = o1; keep2 = o2; }
                        else { put8(wl, mb * 32 + fr, (g - 1) + fh, keep1, o1); put8(wl, mb * 32 + fr, 4 + (g - 1) + fh, keep2, o2); }
                    } else {
                        const int kc = nbase - 1024;
                        u32x2 o1, o2;
                        o1.x = cvt_pk_bf16(x1[0], x1[1]); o1.y = cvt_pk_bf16(x1[2], x1[3]);
                        o2.x = cvt_pk_bf16(x2[0], x2[1]); o2.y = cvt_pk_bf16(x2[2], x2[3]);
                        if ((g & 1) == 0) { keep1 = o1; keep2 = o2; }
                        else { put8(wl, mb * 32 + fr, (g - 1) + fh, keep1, o1); put8(wl, mb * 32 + fr, 4 + (g - 1) + fh, keep2, o2); }
                        if (!lat) {
                            f32x4 f1 = {x1[0], x1[1], x1[2], x1[3]}, f2 = {x2[0], x2[1], x2[2], x2[3]};
                            *(f32x4*)(outk + (size_t)m * 256 + kc + d0) = f1;
                            *(f32x4*)(outk + (size_t)m * 256 + kc + 32 + d0) = f2;
                        }
                    }
                }
            }
            if (isq) flush8<64>(wl, fh * 32 + fr, [&](int r) { return Q + (size_t)(mbase + r) * D + nbase; });
            else flush8<64>(wl, fh * 32 + fr, [&](int r) { return KB + (size_t)(mbase + r) * 256 + (nbase - 1024); });
        } else if (nbase < 1536) {
            const int vc = nbase - 1280, kvh = vc >> 6;
            bf16_t* vtb; int S, sbase;
            if (!lat) { S = 256; sbase = mbase & 255; vtb = VTB + ((size_t)((mbase >> 8) * 4 + kvh) * 64) * 256; }
            else { const int t = mbase - NCTX; S = 1024; sbase = t & 1023; vtb = VTB + (size_t)16 * 4 * 64 * 256 + ((size_t)((t >> 10) * 4 + kvh) * 64) * 1024; }
#pragma unroll
            for (int mb = 0; mb < 2; ++mb) {
                const int m = mbase + mb * 32 + fr;
                const int cpos = swap23(mb * 32 + fr);
                unsigned char* wcol = wl + ((cpos & 7) << 1);
                const int cch = cpos >> 3;
#pragma unroll
                for (int nb = 0; nb < 2; ++nb)
#pragma unroll
                    for (int g = 0; g < 4; ++g) {
                        const int d0 = nb * 32 + 8 * g + 4 * fh;
#pragma unroll
                        for (int e = 0; e < 4; ++e) { const int d = d0 + e; *(bf16_t*)(wcol + d * 128 + ((cch ^ (d & 7)) << 4)) = f2bf(acc[mb][nb][4 * g + e]); }
                        if (!lat) {
                            f32x4 f = {acc[mb][nb][4 * g], acc[mb][nb][4 * g + 1], acc[mb][nb][4 * g + 2], acc[mb][nb][4 * g + 3]};
                            *(f32x4*)(outv + (size_t)m * 256 + vc + d0) = f;
                        }
                    }
            }
            flush8<64>(wl, fh * 32 + fr, [&](int r) { return vtb + (size_t)r * S + sbase; });
        } else {
            const int zc = nbase - 1536;
#pragma unroll
            for (int mb = 0; mb < 2; ++mb)
#pragma unroll
                for (int nb = 0; nb < 2; ++nb)
#pragma unroll
                    for (int g = 0; g < 4; ++g) {
                        const int m = mbase + mb * 32 + fr, n = zc + nb * 32 + 8 * g + 4 * fh;
                        u32x2 o; o.x = cvt_pk_bf16(silu_f(acc[mb][nb][4 * g]), silu_f(acc[mb][nb][4 * g + 1]));
                        o.y = cvt_pk_bf16(silu_f(acc[mb][nb][4 * g + 2]), silu_f(acc[mb][nb][4 * g + 3]));
                        if ((g & 1) == 0) keep1 = o; else put8(wl, mb * 32 + fr, nb * 4 + (g - 1) + fh, keep1, o);
                    }
            flush8<64>(wl, fh * 32 + fr, [&](int r) { return SZ + (size_t)(mbase + r) * D + zc; });
        }
    }
};

DEVI void attn_item(const Params& p, int item, unsigned char* lds) {
    const int lane = threadIdx.x & 63, w = threadIdx.x >> 6, fr = lane & 31, fh = lane >> 5;
    const bf16_t* Q = (const bf16_t*)(p.ws + WS_Q);
    const bf16_t* KB = (const bf16_t*)(p.ws + WS_KB);
    const bf16_t* VTB = (const bf16_t*)(p.ws + WS_VTB);
    const bf16_t* KC = (const bf16_t*)(p.ws + WS_KC);
    const bf16_t* VCT = (const bf16_t*)(p.ws + WS_VCT);
    const bf16_t* SZ = (const bf16_t*)(p.ws + WS_SZ);
    bf16_t* Y = (bf16_t*)(p.ws + WS_Y);
    bool lat; int b, kvh, qb, tb;
    if (item < 256) { lat = true; b = item >> 7; kvh = (item >> 5) & 3; qb = item & 31; tb = NCTX + b * 1024; }
    else { const int it = item - 256; lat = false; b = it >> 5; kvh = (it >> 3) & 3; qb = it & 7; tb = b * 256; }
    const int head = kvh * 4 + w;
    const int qtok = tb + qb * 32 + fr;
    bf16x8 qf[4];
#pragma unroll
    for (int ks = 0; ks < 4; ++ks) qf[ks] = *(const bf16x8*)(Q + (size_t)qtok * D + head * 64 + ks * 16 + fh * 8);
    float m_run = p.sink[head] * LOG2E, l_run = 1.f;
    f32x16 O[2];
#pragma unroll
    for (int i = 0; i < 2; ++i)
#pragma unroll
        for (int r = 0; r < 16; ++r) O[i][r] = 0.f;

    int nloc, k_lo = 0; const bf16_t *kloc, *vloc; int ldloc;
    if (lat) {
        k_lo = qb - 4 < 0 ? 0 : qb - 4; const int k_hi = qb + 4 > 31 ? 31 : qb + 4; nloc = k_hi - k_lo + 1;
        kloc = KB + (size_t)(tb + k_lo * 32) * 256 + kvh * 64;
        vloc = VTB + (size_t)16 * 4 * 64 * 256 + ((size_t)(b * 4 + kvh) * 64) * 1024 + k_lo * 32; ldloc = 1024;
    } else {
        nloc = 8; kloc = KB + (size_t)tb * 256 + kvh * 64; vloc = VTB + ((size_t)(b * 4 + kvh) * 64) * 256; ldloc = 256;
    }
    const int nblk = lat ? nloc + 8 : 8;
    const bf16_t* kcb = KC + (size_t)(b * 256) * 256 + kvh * 64;
    const bf16_t* vcb = VCT + ((size_t)(b * 4 + kvh) * 64) * 256;
    const int tid = threadIdx.x;
    const int kkey = tid >> 3, kch = tid & 7, vd = tid >> 2, vch = tid & 3;
    const unsigned kst = kkey * 128 + ((kch ^ ((kkey >> 1) & 7)) << 4), vst = 4096 + vd * 64 + ((vch ^ ((vd >> 2) & 3)) << 4);
    const unsigned ksw = (fr >> 1) & 7, vsw = (fr >> 2) & 3;
    u32x4 kA, vA, kB, vB;
#define LOADKV(j, KR, VR) { const bf16_t *kp_, *vp_; int ldv_; \
        if ((j) < nloc) { kp_ = kloc + (size_t)(j) * 32 * 256; vp_ = vloc + (j) * 32; ldv_ = ldloc; } \
        else { const int c_ = (j) - nloc; kp_ = kcb + (size_t)c_ * 32 * 256; vp_ = vcb + c_ * 32; ldv_ = 256; } \
        KR = *(const u32x4*)(kp_ + (size_t)kkey * 256 + kch * 8); VR = *(const u32x4*)(vp_ + (size_t)vd * ldv_ + vch * 8); }
    auto compute = [&](int j) {
        const unsigned char* lb = lds + (j & 1) * 8192;
        bf16x8 kf[4], vf[4];
#pragma unroll
        for (int ks = 0; ks < 4; ++ks) kf[ks] = *(const bf16x8*)(lb + fr * 128 + (((2 * ks + fh) ^ ksw) << 4));
#pragma unroll
        for (int s2 = 0; s2 < 2; ++s2)
#pragma unroll
            for (int db = 0; db < 2; ++db) vf[s2 * 2 + db] = *(const bf16x8*)(lb + 4096 + (db * 32 + fr) * 64 + (((2 * s2 + fh) ^ vsw) << 4));
        f32x16 s;
#pragma unroll
        for (int r = 0; r < 16; ++r) s[r] = 0.f;
#pragma unroll
        for (int ks = 0; ks < 4; ++ks) s = __builtin_amdgcn_mfma_f32_32x32x16_bf16(kf[ks], qf[ks], s, 0, 0, 0);
        if (lat && j < nloc) {
            const int kb = k_lo + j;
            const int mode = (kb == qb - 4) ? 1 : (kb == qb + 4) ? 2 : 0;
            if (mode) {
                const int dpos = (kb - qb) * 32;
#pragma unroll
                for (int r = 0; r < 16; ++r) {
                    const int rel = dpos + (r & 3) + 8 * (r >> 2) + 4 * fh - fr;
                    const bool ok = mode == 1 ? (rel >= -128) : (rel <= 128);
                    if (!ok) s[r] = -1e30f;
                }
            }
        }
        float mx = s[0];
#pragma unroll
        for (int r = 1; r < 16; ++r) mx = fmaxf(mx, s[r]);
        mx = xhalf_max(mx);
        const float m_new = fmaxf(m_run, mx);
        const float alpha = __builtin_amdgcn_exp2f(m_run - m_new);
        float rs = 0.f;
#pragma unroll
        for (int r = 0; r < 16; ++r) { s[r] = __builtin_amdgcn_exp2f(s[r] - m_new); rs += s[r]; }
        rs = xhalf_sum(rs);
        l_run = l_run * alpha + rs; m_run = m_new;
#pragma unroll
        for (int i = 0; i < 2; ++i)
#pragma unroll
            for (int r = 0; r < 16; ++r) O[i][r] *= alpha;
#pragma unroll
        for (int s2 = 0; s2 < 2; ++s2) {
            union { u32x4 u; bf16x8 v; } pf;
            pf.u.x = cvt_pk_bf16(s[8 * s2 + 0], s[8 * s2 + 1]); pf.u.y = cvt_pk_bf16(s[8 * s2 + 2], s[8 * s2 + 3]);
            pf.u.z = cvt_pk_bf16(s[8 * s2 + 4], s[8 * s2 + 5]); pf.u.w = cvt_pk_bf16(s[8 * s2 + 6], s[8 * s2 + 7]);
#pragma unroll
            for (int db = 0; db < 2; ++db) O[db] = __builtin_amdgcn_mfma_f32_32x32x16_bf16(vf[s2 * 2 + db], pf.v, O[db], 0, 0, 0);
        }
    };
    LOADKV(0, kA, vA)
    *(u32x4*)(lds + kst) = kA; *(u32x4*)(lds + vst) = vA;
    if (nblk > 1) LOADKV(1, kA, vA)
    if (nblk > 2) LOADKV(2, kB, vB)
    __syncthreads();
    for (int j = 0; j < nblk; j += 2) {
        compute(j);
        if (j + 1 < nblk) { *(u32x4*)(lds + 8192 + kst) = kA; *(u32x4*)(lds + 8192 + vst) = vA; }
        if (j + 3 < nblk) LOADKV(j + 3, kA, vA)
        __syncthreads();
        if (j + 1 < nblk) {
            compute(j + 1);
            if (j + 2 < nblk) { *(u32x4*)(lds + kst) = kB; *(u32x4*)(lds + vst) = vB; }
            if (j + 4 < nblk) LOADKV(j + 4, kB, vB)
            __syncthreads();
        }
    }
#undef LOADKV
    const float il = 1.f / l_run;
    u32x2 keepy = {0u, 0u};
#pragma unroll
    for (int db = 0; db < 2; ++db)
#pragma unroll
        for (int g = 0; g < 4; ++g) {
            const int col = head * 64 + db * 32 + 8 * g + 4 * fh;
            const u32x2 z = *(const u32x2*)(SZ + (size_t)qtok * D + col);
            const float z0 = __uint_as_float(z.x << 16), z1 = __uint_as_float(z.x & 0xffff0000u);
            const float z2 = __uint_as_float(z.y << 16), z3 = __uint_as_float(z.y & 0xffff0000u);
            u32x2 o; o.x = cvt_pk_bf16(O[db][4 * g] * il * z0, O[db][4 * g + 1] * il * z1);
            o.y = cvt_pk_bf16(O[db][4 * g + 2] * il * z2, O[db][4 * g + 3] * il * z3);
            if ((g & 1) == 0) keepy = o; else put8(lds + w * 8192, fr, db * 4 + (g - 1) + fh, keepy, o);
        }
    flush8<32>(lds + w * 8192, lane, [&](int r) { return Y + (size_t)(tb + qb * 32 + r) * D + head * 64; });
    __syncthreads();
}


#define XB_TMO      128
#define XB_XCNT(j)  (256  + 64 * (j))
#define XB_XSUB(j)  (1280 + 64 * (j))
#define XB_XGEN(j)  (2304 + 64 * (j))
#define XB_TOP      3328
#define XB_TOPGEN   3392
#define XCD_BAR_WORDS 3456
#define XB_SPIN_CAP (1u << 18)
#define LAS __attribute__((address_space(3)))
DEVI unsigned xb_ld(unsigned* p)              { return __hip_atomic_load(p, __ATOMIC_RELAXED, __HIP_MEMORY_SCOPE_AGENT); }
DEVI unsigned xb_add(unsigned* p, unsigned v) { return __hip_atomic_fetch_add(p, v, __ATOMIC_RELAXED, __HIP_MEMORY_SCOPE_AGENT); }
DEVI unsigned xb_xcc_id() { return (unsigned)__builtin_amdgcn_s_getreg((3 << 11) | 20) & 0xFu; }
#define XB_SPIN(cond, bar) do { unsigned _sp = 0; while (cond) { __builtin_amdgcn_s_sleep(1); \
    if ((++_sp & 255u) == 0u) { if (xb_ld(&(bar)[XB_TMO])) break; if (_sp > XB_SPIN_CAP) { atomicAdd(&(bar)[XB_TMO], 1u); break; } } } } while (0)
struct XcdBarrier { unsigned* bar; unsigned x; volatile LAS unsigned* st; };
DEVI XcdBarrier xcd_barrier_post(unsigned* bar, volatile LAS unsigned* st) {
    XcdBarrier b; b.bar = bar; b.x = xb_xcc_id(); b.st = st;
    if (threadIdx.x == 0) (void)xb_add(&bar[XB_XCNT(b.x)], 1u);
    return b;
}
DEVI void xcd_barrier_complete(unsigned* bar, unsigned x, unsigned& nloc, unsigned& nx) {
    const unsigned G = gridDim.x * gridDim.y * gridDim.z;
    unsigned sum, cnt, mine, sp = 0u;
    for (;;) {
        sum = 0u; cnt = 0u; mine = 0u;
#pragma unroll
        for (unsigned j = 0; j < 16; ++j) { const unsigned c = xb_ld(&bar[XB_XCNT(j)]); sum += c; cnt += (c > 0u) ? 1u : 0u; mine = (j == x) ? c : mine; }
        if (sum == G) break;
        __builtin_amdgcn_s_sleep(1);
        if ((++sp & 255u) == 0u) { if (xb_ld(&bar[XB_TMO])) break; if (sp > XB_SPIN_CAP) { atomicAdd(&bar[XB_TMO], 1u); break; } }
    }
    nloc = mine > 0u ? mine : 1u; nx = cnt > 0u ? cnt : 1u;
}
DEVI void xcd_barrier(const XcdBarrier& b) {
    asm volatile("s_waitcnt vmcnt(0)" ::: "memory");
    __syncthreads();
    if (threadIdx.x == 0) {
        unsigned* bar = b.bar;
        __builtin_amdgcn_s_waitcnt(0);
        unsigned nloc = b.st[0], nx = b.st[1];
        if (nloc == 0u) { xcd_barrier_complete(bar, b.x, nloc, nx); b.st[0] = nloc; b.st[1] = nx; }
        const unsigned old = xb_add(&bar[XB_XSUB(b.x)], 1u);
        const unsigned gen = old / nloc;
        if (old + 1u == (gen + 1u) * nloc) {
            __builtin_amdgcn_fence(__ATOMIC_RELEASE, "agent");
            asm volatile("s_waitcnt vmcnt(0)" ::: "memory");
            const unsigned og = xb_add(&bar[XB_TOP], 1u);
            const unsigned tg = og / nx;
            if (og + 1u == (tg + 1u) * nx) xb_add(&bar[XB_TOPGEN], 1u);
            else XB_SPIN(xb_ld(&bar[XB_TOPGEN]) == tg, bar);
            __builtin_amdgcn_fence(__ATOMIC_ACQUIRE, "agent");
            xb_add(&bar[XB_XGEN(b.x)], 1u);
            asm volatile("s_waitcnt vmcnt(0)" ::: "memory");
        } else {
            XB_SPIN(xb_ld(&bar[XB_XGEN(b.x)]) == gen, bar);
            __builtin_amdgcn_fence(__ATOMIC_ACQUIRE, "agent");
            asm volatile("s_waitcnt vmcnt(0)" ::: "memory");
        }
    }
    __syncthreads();
}

DEVI void run_phase(const Params& p, int ph, unsigned char* lds) {
    const int G = gridDim.x;
    bf16_t* H = (bf16_t*)(p.ws + WS_H);
    bf16_t* U = (bf16_t*)(p.ws + WS_U);
    bf16_t* SZ = (bf16_t*)(p.ws + WS_SZ);
    bf16_t* VT = (bf16_t*)(p.ws + WS_VT);
    bf16_t* Y = (bf16_t*)(p.ws + WS_Y);
    float* X1 = (float*)(p.ws + WS_X1);
    const float* mod = (const float*)(p.ws + WS_MOD);
    switch (ph) {
    case 0: {
        phase0(p, lds);
        if (threadIdx.x == 0) {
            unsigned* cnt = (unsigned*)(p.ws + WS_CNT); unsigned sp = 0;
            while (__hip_atomic_load(cnt, __ATOMIC_RELAXED, __HIP_MEMORY_SCOPE_AGENT) < 384u) { __builtin_amdgcn_s_sleep(4); if (++sp > (1u << 22)) break; }
        }
        __syncthreads();
        const float* modp = (const float*)(p.ws + WS_MODP);
        if (blockIdx.x < 72) {
            const int i = blockIdx.x * 256 + threadIdx.x, l = i / 9216, j = i % 3072;
            float s = (l ? p.b_mod1 : p.b_mod0)[j];
#pragma unroll
            for (int ks = 0; ks < 4; ++ks) s += __hip_atomic_load(modp + ks * 18432 + i, __ATOMIC_RELAXED, __HIP_MEMORY_SCOPE_AGENT);
            ((float*)(p.ws + WS_MOD))[i] = s;
        }
        float* lmod = (float*)lds;
        {
            float tmp[24];
#pragma unroll
            for (int q = 0; q < 24; ++q) {
                const int i = threadIdx.x + 256 * q, src_i = (i >> 11) * 3072 + (i & 2047);
                float s = p.b_mod0[i & 2047];
#pragma unroll
                for (int ks = 0; ks < 4; ++ks) s += __hip_atomic_load(modp + ks * 18432 + src_i, __ATOMIC_RELAXED, __HIP_MEMORY_SCOPE_AGENT);
                tmp[q] = s;
            }
#pragma unroll
            for (int q = 0; q < 24; ++q) lmod[threadIdx.x + 256 * q] = tmp[q];
        }
        __syncthreads();
        phase_norm(p, 0, lmod);
    } break;
    case 2: {
        EpiInL0 e{U, SZ};
        for (int t = blockIdx.x; t < 768; t += G) {
            const int tt = xcd_remap(t, 768);
            gemm_tile(H, D, (const bf16_t*)(p.ws + WS_WT0IN), D, 16, lds, e, (tt >> 4) * 128, (tt & 15) * 128);
        }
    } break;
    case 3: {
        bias1_items(p);
        for (int t = blockIdx.x; t < 768; t += G) {
            const int tt = xcd_remap(t, 768);
            const int mt = tt & 3, g = (tt >> 2) & 3, nt = tt >> 4;
            EpiChanDft e{VT, g};
            gemm_tile((const bf16_t*)(p.ws + WS_TW256), 256, U + g * 256, D, 4, lds, e, mt * 128, nt * 128);
        }
    } break;
    case 4: {
        for (int t = blockIdx.x; t < 512; t += G) {
            if (t < 256) {
                const int nt = t & 1, mt = (t >> 1) & 15, bg = t >> 5;
                EpiSeqDft<1> e{SZ, Y, NCTX + (bg >> 2) * 1024, bg & 3};
                gemm_tile<1>((const bf16_t*)(p.ws + WS_TS1024), 2048, VT + (size_t)64 * 256 * 512 + (size_t)bg * 256 * 2048, 2048, 32, lds, e, mt * 64, nt * 128);
            } else {
                const int u = t - 256, nt = u & 1, mt = (u >> 1) & 1, bg = u >> 2;
                EpiSeqDft<2> e{SZ, Y, (bg >> 2) * 256, bg & 3};
                gemm_tile<2>((const bf16_t*)(p.ws + WS_TS256), 512, VT + (size_t)bg * 256 * 512, 512, 8, lds, e, mt * 128, nt * 128);
            }
        }
    } break;
    case 5: {
        EpiOut<true, 2> e{p.x_prompt, p.x_sample, mod, X1, p.norm_w1, mod + 3 * 3072, H, (float*)(p.ws + WS_ROWSS)};
        EpiOut<true, 1> e1{p.x_prompt, p.x_sample, mod, X1, p.norm_w1, mod + 3 * 3072, H, (float*)(p.ws + WS_ROWSS)};
        if (G == 512) {
            if (blockIdx.x < 256) { const int tt = xcd_remap(blockIdx.x, 256); gemm_tile<2>(Y, D, (const bf16_t*)(p.ws + WS_WT0OUT), D, 16, lds, e, (tt >> 3) * 128, (tt & 7) * 128); }
            else { const int tt = xcd_remap(blockIdx.x - 256, 256); gemm_tile<1>(Y, D, (const bf16_t*)(p.ws + WS_WT0OUT), D, 16, lds, e1, 4096 + (tt >> 3) * 64, (tt & 7) * 128); }
        } else
        for (int t = blockIdx.x; t < 384; t += G) {
            const int tt = xcd_remap(t, 384);
            gemm_tile(Y, D, (const bf16_t*)(p.ws + WS_WT0OUT), D, 16, lds, e, (tt >> 3) * 128, (tt & 7) * 128);
        }
    } break;
    case 7: {
        EpiInL1 e{p.qnw, p.knw, (const float*)(p.ws + WS_ROPEC), (const float*)(p.ws + WS_ROPES),
                  (bf16_t*)(p.ws + WS_Q), (bf16_t*)(p.ws + WS_KB), (bf16_t*)(p.ws + WS_VTB), SZ,
                  p.out + (size_t)NTOK * D, p.out + (size_t)NTOK * D + (size_t)NCTX * 256,
                  (const float*)(p.ws + WS_ROWSS), (const float*)(p.ws + WS_BIAS1)};
        for (int t = blockIdx.x; t < 960; t += G) {
            const int tt = xcd_remap(t, 960);
            gemm_tile(H, D, (const bf16_t*)(p.ws + WS_WT1IN), D, 16, lds, e, (tt / 20) * 128, (tt % 20) * 128);
        }
    } break;
    case 8: {
        if (G == 512) {
            if (blockIdx.x < 256) attn_item(p, blockIdx.x, lds);
            else { attn_item(p, 256 + 2 * (blockIdx.x - 256), lds); attn_item(p, 257 + 2 * (blockIdx.x - 256), lds); }
        } else
            for (int t = blockIdx.x; t < 768; t += G) attn_item(p, t, lds);
    } break;
    case 9: {
        EpiOut<false, 2> e{X1, X1 + (size_t)NCTX * D, mod + 3 * 3072, p.out, nullptr, nullptr, nullptr, nullptr};
        EpiOut<false, 1> e1{X1, X1 + (size_t)NCTX * D, mod + 3 * 3072, p.out, nullptr, nullptr, nullptr, nullptr};
        if (G == 512) {
            if (blockIdx.x < 256) { const int tt = xcd_remap(blockIdx.x, 256); gemm_tile<2>(Y, D, (const bf16_t*)(p.ws + WS_WT1OUT), D, 16, lds, e, (tt >> 3) * 128, (tt & 7) * 128); }
            else { const int tt = xcd_remap(blockIdx.x - 256, 256); gemm_tile<1>(Y, D, (const bf16_t*)(p.ws + WS_WT1OUT), D, 16, lds, e1, 4096 + (tt >> 3) * 64, (tt & 7) * 128); }
        } else
        for (int t = blockIdx.x; t < 384; t += G) {
            const int tt = xcd_remap(t, 384);
            gemm_tile(Y, D, (const bf16_t*)(p.ws + WS_WT1OUT), D, 16, lds, e, (tt >> 3) * 128, (tt & 7) * 128);
        }
    } break;
    }
}

__global__ void __launch_bounds__(256, 2) mega(Params p) {
    __shared__ __attribute__((aligned(16))) unsigned char lds[65536 + 16];
    cg::grid_group grid = cg::this_grid();
#if SINGLE_LAUNCH
    volatile LAS unsigned* st = (volatile LAS unsigned*)(lds + 65536);
    if (threadIdx.x < 4) st[threadIdx.x] = 0u;
    __syncthreads();
    XcdBarrier bar = xcd_barrier_post((unsigned*)(p.ws + WS_BAR), st);
    if (p.ph_hi == 777) grid.sync();
#ifndef REP_PH
#define REP_PH -1
#endif
#ifndef REP_SY
#define REP_SY 0
#endif
#define PH(n) run_phase(p, n, lds); if (REP_PH == n) run_phase(p, n, lds);
#define SY() xcd_barrier(bar); if (REP_SY) xcd_barrier(bar);
#else
    const int lo = (int)p.ph_lo, hi = (int)p.ph_hi;
#define PH(n) if (lo <= n && n < hi) run_phase(p, n, lds);
#define SY()
#endif
    PH(0) SY() PH(2) SY() PH(3) SY() PH(4) SY() PH(5) SY() PH(7) SY() PH(8) SY() PH(9)
}

extern "C" void kernel_launch(void* const* d_in, const int* in_sizes, int n_in, void* d_out, int out_size, void* d_ws, size_t ws_size, hipStream_t stream) {
    static int grid_blocks = 0;
    if (!grid_blocks) {
        int dev = 0, cus = 0, per_cu = 0;
        hipGetDevice(&dev);
        hipDeviceGetAttribute(&cus, hipDeviceAttributeMultiprocessorCount, dev);
        hipOccupancyMaxActiveBlocksPerMultiprocessor(&per_cu, mega, 256, 0);
        if (per_cu > 2) per_cu = 2;
        if (per_cu < 1) per_cu = 1;
        grid_blocks = cus * per_cu;
    }
    Params p{};
    const float* const* in = (const float* const*)d_in;
    p.x_prompt = in[0]; p.x_sample = in[1]; p.cache_k = in[2]; p.cache_v = in[3]; p.c = in[4]; p.c_ctx = in[5];
    p.norm_w0 = in[6]; p.w_mod0 = in[7]; p.b_mod0 = in[8]; p.w_in0 = in[9]; p.w_out0 = in[10];
    p.norm_w1 = in[11]; p.w_mod1 = in[12]; p.b_mod1 = in[13]; p.w_in1 = in[14]; p.qnw = in[15]; p.knw = in[16]; p.sink = in[17]; p.w_out1 = in[18];
    p.out = (float*)d_out; p.ws = (unsigned char*)d_ws;
#if SINGLE_LAUNCH
    p.ph_lo = 0; p.ph_hi = 10;
    hipMemsetAsync((unsigned char*)d_ws + WS_BAR, 0, 16384, stream);
    void* args[] = {&p};
    hipError_t e = hipLaunchCooperativeKernel((void*)mega, dim3(grid_blocks), dim3(256), args, 0, stream);
    if (e != hipSuccess) fprintf(stderr, "cooperative launch failed: %s (grid %d)\n", hipGetErrorString(e), grid_blocks);
#else
    for (int ph = 0; ph < 10; ++ph) {
        p.ph_lo = ph; p.ph_hi = ph + 1;
        hipLaunchKernelGGL(mega, dim3(grid_blocks), dim3(256), 0, stream, p);
    }
#endif
}
```

```cpp
#include <hip/hip_runtime.h>
#include <hip/hip_cooperative_groups.h>
#include <stdint.h>
#include <cstdio>
namespace cg = cooperative_groups;

#ifndef SINGLE_LAUNCH
#define SINGLE_LAUNCH 1
#endif

typedef unsigned short bf16_t;
typedef short bf16x8 __attribute__((ext_vector_type(8)));
typedef float f32x16 __attribute__((ext_vector_type(16)));
typedef float f32x4 __attribute__((ext_vector_type(4)));
typedef unsigned u32x4 __attribute__((ext_vector_type(4)));
typedef unsigned u32x2 __attribute__((ext_vector_type(2)));
#define DEVI __device__ __forceinline__

constexpr int NTOK = 6144, NCTX = 4096, D = 1024;
constexpr float EPSV = 1e-6f;
constexpr float LOG2E = 1.4426950408889634f;

constexpr size_t WS_MOD = 0;
constexpr size_t WS_WT0IN = 1 << 20;
constexpr size_t WS_WT0OUT = WS_WT0IN + (size_t)2048 * 1024 * 2;
constexpr size_t WS_WT1IN = WS_WT0OUT + (size_t)1024 * 1024 * 2;
constexpr size_t WS_WT1OUT = WS_WT1IN + (size_t)2560 * 1024 * 2;
constexpr size_t WS_TW256 = WS_WT1OUT + (size_t)1024 * 1024 * 2;
constexpr size_t WS_TS256 = WS_TW256 + (size_t)512 * 256 * 2;
constexpr size_t WS_TS1024 = WS_TS256 + (size_t)256 * 512 * 2;
constexpr size_t WS_ROPEC = WS_TS1024 + (size_t)1024 * 2048 * 2;
constexpr size_t WS_ROPES = WS_ROPEC + (size_t)1024 * 32 * 4;
constexpr size_t WS_KC = WS_ROPES + (size_t)1024 * 32 * 4;
constexpr size_t WS_VCT = WS_KC + (size_t)2 * 256 * 256 * 2;
constexpr size_t WS_H = WS_VCT + (size_t)2 * 256 * 256 * 2;
constexpr size_t WS_U = WS_H + (size_t)NTOK * D * 2;
constexpr size_t WS_SZ = WS_U + (size_t)NTOK * D * 2;
constexpr size_t WS_VT = WS_SZ + (size_t)NTOK * D * 2;
constexpr size_t WS_Y = WS_VT + (size_t)NTOK * 2048 * 2;
constexpr size_t WS_X1 = WS_Y + (size_t)NTOK * D * 2;
constexpr size_t WS_Q = WS_X1 + (size_t)NTOK * D * 4;
constexpr size_t WS_KB = WS_Q + (size_t)NTOK * D * 2;
constexpr size_t WS_VTB = WS_KB + (size_t)NTOK * 256 * 2;
constexpr size_t WS_BAR = WS_VTB + (size_t)NTOK * 256 * 2;
constexpr size_t WS_CNT = WS_BAR + 14336;
constexpr size_t WS_ROWSS = WS_BAR + 16384;
constexpr size_t WS_BIAS1 = WS_ROWSS + 6144 * 4;
constexpr size_t WS_MODP = WS_BIAS1 + 3 * 2560 * 4;
constexpr size_t WS_END = WS_MODP + (size_t)4 * 18432 * 4;

struct Params {
    const float *x_prompt, *x_sample, *cache_k, *cache_v, *c, *c_ctx;
    const float *norm_w0, *w_mod0, *b_mod0, *w_in0, *w_out0;
    const float *norm_w1, *w_mod1, *b_mod1, *w_in1, *qnw, *knw, *sink, *w_out1;
    float* out;
    unsigned char* ws;
    long long ph_lo, ph_hi;
};

DEVI unsigned cvt_pk_bf16(float lo, float hi) { unsigned r; asm("v_cvt_pk_bf16_f32 %0, %1, %2" : "=v"(r) : "v"(lo), "v"(hi)); return r; }
DEVI bf16_t f2bf(float f) { return (bf16_t)(cvt_pk_bf16(f, 0.f) & 0xffffu); }
DEVI float silu_f(float v) { return v * __builtin_amdgcn_rcpf(1.f + __expf(-v)); }
DEVI int swap23(int x) { return (x & ~12) | ((x & 4) << 1) | ((x & 8) >> 1); }
DEVI int cond_of(int m) { return m < NCTX ? 0 : 1 + ((m - NCTX) >> 10); }

DEVI void st8(bf16_t* p, u32x2 a, u32x2 b) {
    const auto r0 = __builtin_amdgcn_permlane32_swap(a.x, b.x, false, false);
    const auto r1 = __builtin_amdgcn_permlane32_swap(a.y, b.y, false, false);
    u32x4 w; w.x = r0[0]; w.y = r1[0]; w.z = r0[1]; w.w = r1[1];
    *(u32x4*)p = w;
}
DEVI void put8(unsigned char* wl, int r, int c, u32x2 a, u32x2 b) {
    const auto r0 = __builtin_amdgcn_permlane32_swap(a.x, b.x, false, false);
    const auto r1 = __builtin_amdgcn_permlane32_swap(a.y, b.y, false, false);
    u32x4 w; w.x = r0[0]; w.y = r1[0]; w.z = r0[1]; w.w = r1[1];
    *(u32x4*)(wl + r * 128 + ((c ^ (r & 7)) << 4)) = w;
}
template <int ROWS, class RowPtr>
DEVI void flush8(const unsigned char* wl, int lane, const RowPtr& rowptr) {
#pragma unroll
    for (int i = 0; i < ROWS / 8; ++i) {
        const int r = i * 8 + (lane >> 3), c = lane & 7;
        const u32x4 w = *(const u32x4*)(wl + r * 128 + ((c ^ (r & 7)) << 4));
        *(u32x4*)(rowptr(r) + c * 8) = w;
    }
}
#define DPP_ADD0(x, CTRL) ((x) + __uint_as_float((unsigned)__builtin_amdgcn_update_dpp(0, (int)__float_as_uint(x), CTRL, 0xF, 0xF, true)))
DEVI float wave_sum(float x) {
    x = DPP_ADD0(x, 0xB1); x = DPP_ADD0(x, 0x4E); x = DPP_ADD0(x, 0x141); x = DPP_ADD0(x, 0x140);
    const auto r = __builtin_amdgcn_permlane16_swap(__float_as_uint(x), __float_as_uint(x), false, false);
    x = __uint_as_float(r[0]) + __uint_as_float(r[1]);
    const auto q = __builtin_amdgcn_permlane32_swap(__float_as_uint(x), __float_as_uint(x), false, false);
    return __uint_as_float(q[0]) + __uint_as_float(q[1]);
}
DEVI float xhalf_sum(float x) { const auto r = __builtin_amdgcn_permlane32_swap(__float_as_uint(x), __float_as_uint(x), false, false); return __uint_as_float(r[0]) + __uint_as_float(r[1]); }
DEVI float xhalf_max(float x) { const auto r = __builtin_amdgcn_permlane32_swap(__float_as_uint(x), __float_as_uint(x), false, false); return fmaxf(__uint_as_float(r[0]), __uint_as_float(r[1])); }

DEVI void glds16(const void* g, void* l) { __builtin_amdgcn_global_load_lds(g, l, 16, 0, 0); }

template <int MB = 2, class Epi>
DEVI void gemm_tile(const bf16_t* __restrict__ A, int lda, const bf16_t* __restrict__ B, int ldb, int nk,
                    unsigned char* lds, const Epi& epi, int m0, int n0) {
    const int tid = threadIdx.x, lane = tid & 63, wid = tid >> 6, wr = wid >> 1, wc = wid & 1;
    const int srow = tid >> 3;
    const int slc = (tid & 7) ^ ((tid >> 4) & 7);
    const bf16_t* gA = A + (size_t)(m0 + srow) * lda + slc * 8;
    const bf16_t* gB = B + (size_t)(n0 + srow) * ldb + slc * 8;
    const int fr = lane & 31, fh = lane >> 5, sw = (lane >> 1) & 7;
    const unsigned aoff = (wr * 32 * MB + fr) * 128, boff = 16384 + (wc * 64 + fr) * 128;
    f32x16 acc[MB][2];
#pragma unroll
    for (int i = 0; i < MB; ++i)
#pragma unroll
        for (int j = 0; j < 2; ++j)
#pragma unroll
            for (int r = 0; r < 16; ++r) acc[i][j][r] = 0.f;
    {
        unsigned char* la = lds + tid * 16;
#pragma unroll
        for (int i = 0; i < 4; ++i) {
            if (i < 2 * MB) glds16(gA + (size_t)i * 32 * lda, la + i * 4096);
            glds16(gB + (size_t)i * 32 * ldb, la + 16384 + i * 4096);
        }
        la += 32768;
#pragma unroll
        for (int i = 0; i < 4; ++i) {
            if (i < 2 * MB) glds16(gA + (size_t)i * 32 * lda + 64, la + i * 4096);
            glds16(gB + (size_t)i * 32 * ldb + 64, la + 16384 + i * 4096);
        }
    }
    for (int kt = 0; kt < nk; ++kt) {
        if (kt == 0) {
            if (MB == 2) asm volatile("s_waitcnt vmcnt(8) lgkmcnt(0)" ::: "memory"); else asm volatile("s_waitcnt vmcnt(6) lgkmcnt(0)" ::: "memory");
            __builtin_amdgcn_sched_barrier(0); __builtin_amdgcn_s_barrier(); __builtin_amdgcn_sched_barrier(0);
        } else {
            asm volatile("s_waitcnt vmcnt(0)" ::: "memory");
            __syncthreads();
        }
        if (kt >= 1 && kt + 1 < nk) {
            unsigned char* la = lds + ((kt + 1) & 1) * 32768 + tid * 16;
            const int ko = (kt + 1) * 64;
#pragma unroll
            for (int i = 0; i < 4; ++i) {
                if (i < 2 * MB) glds16(gA + (size_t)i * 32 * lda + ko, la + i * 4096);
                glds16(gB + (size_t)i * 32 * ldb + ko, la + 16384 + i * 4096);
            }
        }
        const unsigned char* base = lds + (kt & 1) * 32768;
        bf16x8 af[4][2], bfr[4][2];
#define LDFRAG(ks) { const int ch = ((2 * (ks) + fh) ^ sw) * 16; \
            af[ks][0] = *(const bf16x8*)(base + aoff + ch); bfr[ks][0] = *(const bf16x8*)(base + boff + ch); \
            bfr[ks][1] = *(const bf16x8*)(base + boff + 4096 + ch); if (MB == 2) af[ks][1] = *(const bf16x8*)(base + aoff + 4096 + ch); }
#define MFMA4(ks) { acc[0][0] = __builtin_amdgcn_mfma_f32_32x32x16_bf16(bfr[ks][0], af[ks][0], acc[0][0], 0, 0, 0); \
            acc[0][1] = __builtin_amdgcn_mfma_f32_32x32x16_bf16(bfr[ks][1], af[ks][0], acc[0][1], 0, 0, 0); \
            if (MB == 2) { acc[MB - 1][0] = __builtin_amdgcn_mfma_f32_32x32x16_bf16(bfr[ks][0], af[ks][1], acc[MB - 1][0], 0, 0, 0); \
            acc[MB - 1][1] = __builtin_amdgcn_mfma_f32_32x32x16_bf16(bfr[ks][1], af[ks][1], acc[MB - 1][1], 0, 0, 0); } }
        LDFRAG(0) LDFRAG(1)
        __builtin_amdgcn_sched_barrier(0);
        MFMA4(0) LDFRAG(2)
        __builtin_amdgcn_sched_barrier(0);
        MFMA4(1) LDFRAG(3)
        __builtin_amdgcn_sched_barrier(0);
        MFMA4(2)
        __builtin_amdgcn_sched_barrier(0);
        MFMA4(3)
#undef LDFRAG
#undef MFMA4
    }
    epi(acc, m0 + wr * 32 * MB, n0 + wc * 64, fr, fh, lds + wid * 8192);
    __syncthreads();
}

DEVI int xcd_remap(int t, int T) { return (t & 7) * (T >> 3) + (t >> 3); }

DEVI void mod_item(const Params& p, int it, unsigned char* lds) {
    const int tid = threadIdx.x;
    const int ks = it & 3, lc = it >> 2, l = lc / 48, cc = lc % 48;
    float* sc = (float*)lds;
    for (int i = tid; i < 768; i += 256) {
        const int cv = i >> 8, k = ks * 256 + (i & 255);
        const float cval = cv == 0 ? p.c_ctx[k] : p.c[(cv - 1) * 1024 + k];
        sc[i] = silu_f(cval);
    }
    __syncthreads();
    const float* W = (l ? p.w_mod1 : p.w_mod0) + (size_t)ks * 256 * 3072;
    const int cg4 = tid & 15, rg = tid >> 4, c0 = cc * 64 + cg4 * 4;
    f32x4 w[16];
#pragma unroll
    for (int i = 0; i < 16; ++i) w[i] = *(const f32x4*)(W + (size_t)(rg + 16 * i) * 3072 + c0);
    f32x4 a0 = {0.f, 0.f, 0.f, 0.f}, a1 = a0, a2 = a0;
#pragma unroll
    for (int i = 0; i < 16; ++i) { const int k = rg + 16 * i; a0 += sc[k] * w[i]; a1 += sc[256 + k] * w[i]; a2 += sc[512 + k] * w[i]; }
    float* red = (float*)(lds + 12288);
#pragma unroll
    for (int e = 0; e < 4; ++e) {
        red[(rg * 3 + 0) * 64 + cg4 * 4 + e] = a0[e];
        red[(rg * 3 + 1) * 64 + cg4 * 4 + e] = a1[e];
        red[(rg * 3 + 2) * 64 + cg4 * 4 + e] = a2[e];
    }
    __syncthreads();
    if (tid < 192) {
        const int cv = tid >> 6, j = tid & 63;
        float s = 0.f;
#pragma unroll
        for (int r = 0; r < 16; ++r) s += red[(r * 3 + cv) * 64 + j];
        float* modp = (float*)(p.ws + WS_MODP) + (size_t)ks * 18432;
        __hip_atomic_store(&modp[(l * 3 + cv) * 3072 + cc * 64 + j], s, __ATOMIC_RELAXED, __HIP_MEMORY_SCOPE_AGENT);
    }
    asm volatile("s_waitcnt vmcnt(0)" ::: "memory");
    __syncthreads();
    if (tid == 0) __hip_atomic_fetch_add((unsigned*)(p.ws + WS_CNT), 1u, __ATOMIC_RELAXED, __HIP_MEMORY_SCOPE_AGENT);
}

struct TrDesc { const float* src; bf16_t* dst; int N, kt, nt; };
DEVI TrDesc tr_desc(const Params& p, int idx) {
    TrDesc d;
    if (idx < 512) { d.src = p.w_in0; d.dst = (bf16_t*)(p.ws + WS_WT0IN); d.N = 2048; }
    else if (idx < 768) { idx -= 512; d.src = p.w_out0; d.dst = (bf16_t*)(p.ws + WS_WT0OUT); d.N = 1024; }
    else if (idx < 1408) { idx -= 768; d.src = p.w_in1; d.dst = (bf16_t*)(p.ws + WS_WT1IN); d.N = 2560; }
    else { idx -= 1408; d.src = p.w_out1; d.dst = (bf16_t*)(p.ws + WS_WT1OUT); d.N = 1024; }
    const int ntn = d.N >> 6;
    d.kt = idx / ntn; d.nt = idx % ntn;
    return d;
}
DEVI void transpose_items(const Params& p, int first, int end, int stride, unsigned char* lds) {
    const int tid = threadIdx.x;
    float* tl = (float*)lds;
    if (first >= end) return;
    f32x4 v[4];
    TrDesc d = tr_desc(p, first);
#pragma unroll
    for (int pass = 0; pass < 4; ++pass) v[pass] = *(const f32x4*)(d.src + (size_t)(d.kt * 64 + pass * 16 + (tid >> 4)) * d.N + d.nt * 64 + (tid & 15) * 4);
    for (int idx = first; idx < end; idx += stride) {
#pragma unroll
        for (int pass = 0; pass < 4; ++pass) {
            const int r = pass * 16 + (tid >> 4), c4 = (tid & 15) * 4;
#pragma unroll
            for (int e = 0; e < 4; ++e) tl[r * 65 + c4 + e] = v[pass][e];
        }
        const TrDesc cur = d;
        if (idx + stride < end) {
            d = tr_desc(p, idx + stride);
#pragma unroll
            for (int pass = 0; pass < 4; ++pass) v[pass] = *(const f32x4*)(d.src + (size_t)(d.kt * 64 + pass * 16 + (tid >> 4)) * d.N + d.nt * 64 + (tid & 15) * 4);
        }
        __syncthreads();
#pragma unroll
        for (int pass = 0; pass < 2; ++pass) {
            const int n = pass * 32 + (tid >> 3), kc = tid & 7;
            float x[8];
#pragma unroll
            for (int j = 0; j < 8; ++j) x[j] = tl[(kc * 8 + j) * 65 + n];
            u32x4 w;
            w.x = cvt_pk_bf16(x[0], x[1]); w.y = cvt_pk_bf16(x[2], x[3]); w.z = cvt_pk_bf16(x[4], x[5]); w.w = cvt_pk_bf16(x[6], x[7]);
            *(u32x4*)(cur.dst + (size_t)(cur.nt * 64 + n) * 1024 + cur.kt * 64 + kc * 8) = w;
        }
        __syncthreads();
    }
}

DEVI void phase0(const Params& p, unsigned char* lds) {
    for (int it = blockIdx.x; it < 384; it += gridDim.x) mod_item(p, it, lds);
    transpose_items(p, (blockIdx.x + 128) % gridDim.x, 1664, gridDim.x, lds);
    const int gt = blockIdx.x * 256 + threadIdx.x, gs = gridDim.x * 256;
    bf16_t* tw256 = (bf16_t*)(p.ws + WS_TW256);
    bf16_t* ts256 = (bf16_t*)(p.ws + WS_TS256);
    bf16_t* ts1024 = (bf16_t*)(p.ws + WS_TS1024);
    float* lut = (float*)(lds + 32768);
    __syncthreads();
    for (int r = threadIdx.x; r < 1024; r += 256) lut[r] = cospif((float)r * (1.f / 512.f));
    __syncthreads();
    for (int i = gt; i < 512 * 256; i += gs) {
        const int m = i >> 8, j = i & 255, which = m >> 8, cp = m & 255;
        const int r = ((cp * j) & 255) << 2;
        tw256[i] = f2bf(which ? lut[(r - 256) & 1023] : lut[r]);
    }
    for (int i = gt; i < 256 * 512; i += gs) {
        const int sp = i >> 9, k2 = i & 511, which = k2 >> 8, s0 = k2 & 255;
        const int r = ((sp * s0) & 255) << 2;
        ts256[i] = f2bf((which ? -lut[(r - 256) & 1023] : lut[r]) * (1.f / 256.f));
    }
    for (int i = gt; i < 1024 * 2048; i += gs) {
        const int sp = i >> 11, k2 = i & 2047, which = k2 >> 10, s0 = k2 & 1023;
        const int r = (sp * s0) & 1023;
        ts1024[i] = f2bf((which ? -lut[(r - 256) & 1023] : lut[r]) * (1.f / 512.f));
    }
    float* ropec = (float*)(p.ws + WS_ROPEC);
    float* ropes = (float*)(p.ws + WS_ROPES);
    for (int i = gt; i < 1024 * 32; i += gs) {
        const int pos = i >> 5, f = i & 31;
        const int row = pos >> 6, col = pos & 63;
        const float inv = powf(10000.f, -(float)(f & 15) * (1.f / 16.f));
        const float ang = (float)(f < 16 ? row : col) * inv;
        float s, c; sincosf(ang, &s, &c);
        ropec[i] = c; ropes[i] = s;
    }
    for (int i = gt; i < NTOK; i += gs) ((float*)(p.ws + WS_ROWSS))[i] = 0.f;
    bf16_t* kc = (bf16_t*)(p.ws + WS_KC);
    bf16_t* vct = (bf16_t*)(p.ws + WS_VCT);
    for (int i = gt; i < 2 * 256 * 256; i += gs) {
        kc[i] = f2bf(p.cache_k[i]);
        const int b = i >> 16, kvh = (i >> 14) & 3, d = (i >> 8) & 63, pp = i & 255;
        const int key = swap23(pp);
        vct[i] = f2bf(p.cache_v[((b * 256 + key) * 4 + kvh) * 64 + d]);
    }
}

DEVI void phase_norm(const Params& p, int layer, const float* lmod  ) {
    const int lane = threadIdx.x & 63, wid = threadIdx.x >> 6;
    const float* nw = layer ? p.norm_w1 : p.norm_w0;
    bf16_t* H = (bf16_t*)(p.ws + WS_H);
    const int stride = gridDim.x * 4;
    auto rowptr = [&](int row) -> const float* {
        if (layer == 0) return row < NCTX ? p.x_prompt + (size_t)row * D : p.x_sample + (size_t)(row - NCTX) * D;
        return (const float*)(p.ws + WS_X1) + (size_t)row * D;
    };
    int row = blockIdx.x * 4 + wid;
    if (row >= NTOK) return;
    f32x4 v[4], vn[4];
    {
        const float* xr = rowptr(row);
#pragma unroll
        for (int i = 0; i < 4; ++i) v[i] = *(const f32x4*)(xr + i * 256 + lane * 4);
    }
    for (; row < NTOK; row += stride) {
        const int nrow = row + stride;
        if (nrow < NTOK) {
            const float* xr = rowptr(nrow);
#pragma unroll
            for (int i = 0; i < 4; ++i) vn[i] = *(const f32x4*)(xr + i * 256 + lane * 4);
        }
        const float* mv = lmod + cond_of(row) * 2048;
        float ss = 0.f;
#pragma unroll
        for (int i = 0; i < 4; ++i) ss += v[i][0] * v[i][0] + v[i][1] * v[i][1] + v[i][2] * v[i][2] + v[i][3] * v[i][3];
        ss = wave_sum(ss);
        const float rstd = rsqrtf(ss * (1.f / 1024.f) + EPSV);
#pragma unroll
        for (int i = 0; i < 4; ++i) {
            const int k = i * 256 + lane * 4;
            const f32x4 w = *(const f32x4*)(nw + k);
            const f32x4 sh = *(const f32x4*)(mv + k);
            const f32x4 scl = *(const f32x4*)(mv + 1024 + k);
            float h[4];
#pragma unroll
            for (int e = 0; e < 4; ++e) h[e] = (v[i][e] * rstd * w[e]) * (1.f + scl[e]) + sh[e];
            u32x2 o; o.x = cvt_pk_bf16(h[0], h[1]); o.y = cvt_pk_bf16(h[2], h[3]);
            *(u32x2*)(H + (size_t)row * D + k) = o;
        }
#pragma unroll
        for (int i = 0; i < 4; ++i) v[i] = vn[i];
    }
}

DEVI void bias1_items(const Params& p, int lb, int nb) {
    const int lane = threadIdx.x & 63, gw = lb * 4 + (threadIdx.x >> 6), nw = nb * 4;
    const float* mod1 = (const float*)(p.ws + WS_MOD) + 3 * 3072;
    const bf16_t* WT = (const bf16_t*)(p.ws + WS_WT1IN);
    float* bias1 = (float*)(p.ws + WS_BIAS1);
    for (int n = gw; n < 2560; n += nw) {
        float w[16];
        const u32x4 r0 = *(const u32x4*)(WT + (size_t)n * 1024 + lane * 16), r1 = *(const u32x4*)(WT + (size_t)n * 1024 + lane * 16 + 8);
        const unsigned rr[8] = {r0.x, r0.y, r0.z, r0.w, r1.x, r1.y, r1.z, r1.w};
#pragma unroll
        for (int i = 0; i < 8; ++i) { w[2 * i] = __uint_as_float(rr[i] << 16); w[2 * i + 1] = __uint_as_float(rr[i] & 0xffff0000u); }
        float s[3];
#pragma unroll
        for (int cv = 0; cv < 3; ++cv) {
            float a = 0.f;
#pragma unroll
            for (int q = 0; q < 4; ++q) {
                const f32x4 sh = *(const f32x4*)(mod1 + cv * 3072 + lane * 16 + q * 4);
#pragma unroll
                for (int e = 0; e < 4; ++e) a += sh[e] * w[q * 4 + e];
            }
            s[cv] = wave_sum(a);
        }
        if (lane == 0) { bias1[n] = s[0]; bias1[2560 + n] = s[1]; bias1[5120 + n] = s[2]; }
    }
}

struct EpiInL0 {
    bf16_t *U, *SZ;
    DEVI void operator()(const f32x16 (&acc)[2][2], int mbase, int nbase, int fr, int fh, unsigned char* wl) const {
        const bool isz = nbase >= 1024;
        bf16_t* dst = isz ? SZ : U;
        const int nb0 = isz ? nbase - 1024 : nbase;
        u32x2 keep = {0u, 0u};
#pragma unroll
        for (int mb = 0; mb < 2; ++mb)
#pragma unroll
            for (int nb = 0; nb < 2; ++nb)
#pragma unroll
                for (int g = 0; g < 4; ++g) {
                    const int m = mbase + mb * 32 + fr, n = nb0 + nb * 32 + 8 * g + 4 * fh;
                    float v[4];
#pragma unroll
                    for (int e = 0; e < 4; ++e) { v[e] = acc[mb][nb][4 * g + e]; if (isz) v[e] = silu_f(v[e]); }
                    u32x2 o; o.x = cvt_pk_bf16(v[0], v[1]); o.y = cvt_pk_bf16(v[2], v[3]);
                    if ((g & 1) == 0) keep = o; else put8(wl, mb * 32 + fr, nb * 4 + (g - 1) + fh, keep, o);
                }
        flush8<64>(wl, fh * 32 + fr, [&](int r) { return dst + (size_t)(mbase + r) * D + nb0; });
    }
};

struct EpiChanDft {
    bf16_t* VT; int g;
    DEVI void operator()(const f32x16 (&acc)[2][2], int mbase, int nbase, int fr, int fh, unsigned char* wl) const {
        int S, bgi, s0; bf16_t* base;
        if (nbase < NCTX) { S = 256; bgi = (nbase >> 8) * 4 + g; s0 = nbase & 255; base = VT; }
        else { const int t = nbase - NCTX; S = 1024; bgi = (t >> 10) * 4 + g; s0 = t & 1023; base = VT + (size_t)64 * 256 * 512; }
        u32x2 keep = {0u, 0u};
#pragma unroll
        for (int mb = 0; mb < 2; ++mb)
#pragma unroll
            for (int nb = 0; nb < 2; ++nb)
#pragma unroll
                for (int gq = 0; gq < 4; ++gq) {
                    const int m = mbase + mb * 32 + fr, which = m >> 8, cp = m & 255;
                    const int s = s0 + nb * 32 + 8 * gq + 4 * fh;
                    u32x2 o; o.x = cvt_pk_bf16(acc[mb][nb][4 * gq], acc[mb][nb][4 * gq + 1]); o.y = cvt_pk_bf16(acc[mb][nb][4 * gq + 2], acc[mb][nb][4 * gq + 3]);
                    if ((gq & 1) == 0) keep = o; else put8(wl, mb * 32 + fr, nb * 4 + (gq - 1) + fh, keep, o);
                }
        flush8<64>(wl, fh * 32 + fr, [&](int r) { const int m = mbase + r; return base + ((size_t)bgi * 256 + (m & 255)) * (2 * S) + (m >> 8) * S + s0; });
    }
};

template <int MB> struct EpiSeqDft {
    const bf16_t* SZ; bf16_t* Y; int tok0, g;
    DEVI void operator()(const f32x16 (&acc)[MB][2], int mbase, int nbase, int fr, int fh, unsigned char* wl) const {
        u32x2 keep = {0u, 0u};
#pragma unroll
        for (int mb = 0; mb < MB; ++mb)
#pragma unroll
            for (int nb = 0; nb < 2; ++nb)
#pragma unroll
                for (int gq = 0; gq < 4; ++gq) {
                    const int tok = tok0 + mbase + mb * 32 + fr;
                    const int col = g * 256 + nbase + nb * 32 + 8 * gq + 4 * fh;
                    const u32x2 z = *(const u32x2*)(SZ + (size_t)tok * D + col);
                    const float z0 = __uint_as_float(z.x << 16), z1 = __uint_as_float(z.x & 0xffff0000u);
                    const float z2 = __uint_as_float(z.y << 16), z3 = __uint_as_float(z.y & 0xffff0000u);
                    u32x2 o; o.x = cvt_pk_bf16(acc[mb][nb][4 * gq] * z0, acc[mb][nb][4 * gq + 1] * z1);
                    o.y = cvt_pk_bf16(acc[mb][nb][4 * gq + 2] * z2, acc[mb][nb][4 * gq + 3] * z3);
                    if ((gq & 1) == 0) keep = o; else put8(wl, mb * 32 + fr, nb * 4 + (gq - 1) + fh, keep, o);
                }
        flush8<32 * MB>(wl, fh * 32 + fr, [&](int r) { return Y + (size_t)(tok0 + mbase + r) * D + g * 256 + nbase; });
    }
};

#define DPP_ADD(x, CTRL) ((x) + __uint_as_float((unsigned)__builtin_amdgcn_update_dpp(0, (int)__float_as_uint(x), CTRL, 0xF, 0xF, true)))
DEVI float row16_sum(float x) {
    x = DPP_ADD(x, 0xB1);
    x = DPP_ADD(x, 0x4E);
    x = DPP_ADD(x, 0x141);
    x = DPP_ADD(x, 0x140);
    return x;
}
template <bool NEXT, int MB> struct EpiOut {
    const float* xa; const float* xb;
    const float* mod;
    float* out;
    const float* nw1; const float* mod1; bf16_t* Hn; float* rowss;
    DEVI void operator()(const f32x16 (&acc)[MB][2], int mbase, int nbase, int fr, int fh, unsigned char* wl) const {
        const int lane = fh * 32 + fr, c4 = lane & 15, rsub = lane >> 4;
        const int cv = cond_of(mbase);
        const int n = nbase + c4 * 4;
        const f32x4 gv = *(const f32x4*)(mod + cv * 3072 + 2048 + n);
        f32x4 hv = {0.f, 0.f, 0.f, 0.f};
        if (NEXT) {
            const f32x4 w = *(const f32x4*)(nw1 + n);
            const f32x4 sc = *(const f32x4*)(mod1 + cv * 3072 + 1024 + n);
#pragma unroll
            for (int e = 0; e < 4; ++e) hv[e] = w[e] * (1.f + sc[e]);
        }
#pragma unroll
        for (int mb = 0; mb < MB; ++mb) {
#pragma unroll
            for (int nb = 0; nb < 2; ++nb)
#pragma unroll
                for (int g = 0; g < 4; ++g) {
                    f32x4 a = {acc[mb][nb][4 * g], acc[mb][nb][4 * g + 1], acc[mb][nb][4 * g + 2], acc[mb][nb][4 * g + 3]};
                    *(f32x4*)(wl + fr * 256 + (((nb * 8 + 2 * g + fh) ^ (fr & 15)) << 4)) = a;
                }
#pragma unroll
            for (int i = 0; i < 8; ++i) {
                const int r = i * 4 + rsub, m = mbase + mb * 32 + r;
                const f32x4 a = *(const f32x4*)(wl + r * 256 + ((c4 ^ (r & 15)) << 4));
                const float* xr = m < NCTX ? xa + (size_t)m * D : xb + (size_t)(m - NCTX) * D;
                const f32x4 xv = *(const f32x4*)(xr + n);
                f32x4 o;
#pragma unroll
                for (int e = 0; e < 4; ++e) o[e] = xv[e] + gv[e] * a[e];
                *(f32x4*)(out + (size_t)m * D + n) = o;
                if (NEXT) {
                    float ss = (o[0] * o[0] + o[1] * o[1]) + (o[2] * o[2] + o[3] * o[3]);
                    ss = row16_sum(ss);
                    if (c4 == 0) atomicAdd(rowss + m, ss);
                    u32x2 hb; hb.x = cvt_pk_bf16(o[0] * hv[0], o[1] * hv[1]); hb.y = cvt_pk_bf16(o[2] * hv[2], o[3] * hv[3]);
                    *(u32x2*)(Hn + (size_t)m * D + n) = hb;
                }
            }
        }
    }
};

struct EpiInL1 {
    const float *qnw, *knw, *ropec, *ropes;
    bf16_t *Q, *KB, *VTB, *SZ;
    float *outk, *outv;
    const float* rowss; const float* bias1;
    DEVI void operator()(const f32x16 (&acc_in)[2][2], int mbase, int nbase, int fr, int fh, unsigned char* wl) const {
        const bool lat = mbase >= NCTX;
        u32x2 keep1 = {0u, 0u}, keep2 = {0u, 0u};
        f32x16 acc[2][2];
        {
            const float* bp = bias1 + cond_of(mbase) * 2560 + nbase;
#pragma unroll
            for (int mb = 0; mb < 2; ++mb) {
                const float rstd = rsqrtf(rowss[mbase + mb * 32 + fr] * (1.f / 1024.f) + EPSV);
#pragma unroll
                for (int nb = 0; nb < 2; ++nb)
#pragma unroll
                    for (int g = 0; g < 4; ++g) {
                        const f32x4 bv = *(const f32x4*)(bp + nb * 32 + 8 * g + 4 * fh);
#pragma unroll
                        for (int e = 0; e < 4; ++e) acc[mb][nb][4 * g + e] = acc_in[mb][nb][4 * g + e] * rstd + bv[e];
                    }
            }
        }
        if (nbase < 1280) {
            const bool isq = nbase < 1024;
            const float* nwp = isq ? qnw : knw;
#pragma unroll
            for (int mb = 0; mb < 2; ++mb) {
                const int m = mbase + mb * 32 + fr;
                float ss = 0.f;
#pragma unroll
                for (int nb = 0; nb < 2; ++nb)
#pragma unroll
                    for (int r = 0; r < 16; ++r) ss += acc[mb][nb][r] * acc[mb][nb][r];
                ss = xhalf_sum(ss);
                const float rn = rsqrtf(ss * (1.f / 64.f) + EPSV);
                const int pos = lat ? ((m - NCTX) & 1023) : 0;
#pragma unroll
                for (int g = 0; g < 4; ++g) {
                    const int d0 = 8 * g + 4 * fh;
                    const f32x4 w1 = *(const f32x4*)(nwp + d0), w2 = *(const f32x4*)(nwp + 32 + d0);
                    float x1[4], x2[4];
#pragma unroll
                    for (int e = 0; e < 4; ++e) { x1[e] = acc[mb][0][4 * g + e] * rn * w1[e]; x2[e] = acc[mb][1][4 * g + e] * rn * w2[e]; }
                    if (lat) {
                        const f32x4 cv = *(const f32x4*)(ropec + pos * 32 + d0), sv = *(const f32x4*)(ropes + pos * 32 + d0);
#pragma unroll
                        for (int e = 0; e < 4; ++e) { const float a = x1[e], b = x2[e]; x1[e] = a * cv[e] - b * sv[e]; x2[e] = a * sv[e] + b * cv[e]; }
                    }
                    if (isq) {
                        const float qs = 0.125f * LOG2E;
                        u32x2 o1, o2;
                        o1.x = cvt_pk_bf16(x1[0] * qs, x1[1] * qs); o1.y = cvt_pk_bf16(x1[2] * qs, x1[3] * qs);
                        o2.x = cvt_pk_bf16(x2[0] * qs, x2[1] * qs); o2.y = cvt_pk_bf16(x2[2] * qs, x2[3] * qs);
                        if ((g & 1) == 0) { keep1 = o1; keep2 = o2; }
                        else { put8(wl, mb * 32 + fr, (g - 1) + fh, keep1, o1); put8(wl, mb * 32 + fr, 4 + (g - 1) + fh, keep2, o2); }
                    } else {
                        const int kc = nbase - 1024;
                        u32x2 o1, o2;
                        o1.x = cvt_pk_bf16(x1[0], x1[1]); o1.y = cvt_pk_bf16(x1[2], x1[3]);
                        o2.x = cvt_pk_bf16(x2[0], x2[1]); o2.y = cvt_pk_bf16(x2[2], x2[3]);
                        if ((g & 1) == 0) { keep1 = o1; keep2 = o2; }
                        else { put8(wl, mb * 32 + fr, (g - 1) + fh, keep1, o1); put8(wl, mb * 32 + fr, 4 + (g - 1) + fh, keep2, o2); }
                        if (!lat) {
                            f32x4 f1 = {x1[0], x1[1], x1[2], x1[3]}, f2 = {x2[0], x2[1], x2[2], x2[3]};
                            *(f32x4*)(outk + (size_t)m * 256 + kc + d0) = f1;
                            *(f32x4*)(outk + (size_t)m * 256 + kc + 32 + d0) = f2;
                        }
                    }
                }
            }
            if (isq) flush8<64>(wl, fh * 32 + fr, [&](int r) { return Q + (size_t)(mbase + r) * D + nbase; });
            else flush8<64>(wl, fh * 32 + fr, [&](int r) { return KB + (size_t)(mbase + r) * 256 + (nbase - 1024); });
        } else if (nbase < 1536) {
            const int vc = nbase - 1280, kvh = vc >> 6;
            bf16_t* vtb; int S, sbase;
            if (!lat) { S = 256; sbase = mbase & 255; vtb = VTB + ((size_t)((mbase >> 8) * 4 + kvh) * 64) * 256; }
            else { const int t = mbase - NCTX; S = 1024; sbase = t & 1023; vtb = VTB + (size_t)16 * 4 * 64 * 256 + ((size_t)((t >> 10) * 4 + kvh) * 64) * 1024; }
#pragma unroll
            for (int mb = 0; mb < 2; ++mb) {
                const int m = mbase + mb * 32 + fr;
                const int cpos = swap23(mb * 32 + fr);
                unsigned char* wcol = wl + ((cpos & 7) << 1);
                const int cch = cpos >> 3;
#pragma unroll
                for (int nb = 0; nb < 2; ++nb)
#pragma unroll
                    for (int g = 0; g < 4; ++g) {
                        const int d0 = nb * 32 + 8 * g + 4 * fh;
#pragma unroll
                        for (int e = 0; e < 4; ++e) { const int d = d0 + e; *(bf16_t*)(wcol + d * 128 + ((cch ^ (d & 7)) << 4)) = f2bf(acc[mb][nb][4 * g + e]); }
                        if (!lat) {
                            f32x4 f = {acc[mb][nb][4 * g], acc[mb][nb][4 * g + 1], acc[mb][nb][4 * g + 2], acc[mb][nb][4 * g + 3]};
                            *(f32x4*)(outv + (size_t)m * 256 + vc + d0) = f;
                        }
                    }
            }
            flush8<64>(wl, fh * 32 + fr, [&](int r) { return vtb + (size_t)r * S + sbase; });
        } else {
            const int zc = nbase - 1536;
#pragma unroll
            for (int mb = 0; mb < 2; ++mb)
#pragma unroll
                for (int nb = 0; nb < 2; ++nb)
#pragma unroll
                    for (int g = 0; g < 4; ++g) {
                        const int m = mbase + mb * 32 + fr, n = zc + nb * 32 + 8 * g + 4 * fh;
                        u32x2 o; o.x = cvt_pk_bf16(silu_f(acc[mb][nb][4 * g]), silu_f(acc[mb][nb][4 * g + 1]));
                        o.y = cvt_pk_bf16(silu_f(acc[mb][nb][4 * g + 2]), silu_f(acc[mb][nb][4 * g + 3]));
                        if ((g & 1) == 0) keep1 = o; else put8(wl, mb * 32 + fr, nb * 4 + (g - 1) + fh, keep1, o);
                    }
            flush8<64>(wl, fh * 32 + fr, [&](int r) { return SZ + (size_t)(mbase + r) * D + zc; });
        }
    }
};

DEVI void attn_item(const Params& p, int item, unsigned char* lds) {
    const int lane = threadIdx.x & 63, w = threadIdx.x >> 6, fr = lane & 31, fh = lane >> 5;
    const bf16_t* Q = (const bf16_t*)(p.ws + WS_Q);
    const bf16_t* KB = (const bf16_t*)(p.ws + WS_KB);
    const bf16_t* VTB = (const bf16_t*)(p.ws + WS_VTB);
    const bf16_t* KC = (const bf16_t*)(p.ws + WS_KC);
    const bf16_t* VCT = (const bf16_t*)(p.ws + WS_VCT);
    const bf16_t* SZ = (const bf16_t*)(p.ws + WS_SZ);
    bf16_t* Y = (bf16_t*)(p.ws + WS_Y);
    bool lat; int b, kvh, qb, tb;
    if (item < 256) { lat = true; b = item >> 7; kvh = (item >> 5) & 3; qb = item & 31; tb = NCTX + b * 1024; }
    else { const int it = item - 256; lat = false; b = it >> 5; kvh = (it >> 3) & 3; qb = it & 7; tb = b * 256; }
    const int head = kvh * 4 + w;
    const int qtok = tb + qb * 32 + fr;
    bf16x8 qf[4];
#pragma unroll
    for (int ks = 0; ks < 4; ++ks) qf[ks] = *(const bf16x8*)(Q + (size_t)qtok * D + head * 64 + ks * 16 + fh * 8);
    float m_run = p.sink[head] * LOG2E, l_run = 1.f;
    f32x16 O[2];
#pragma unroll
    for (int i = 0; i < 2; ++i)
#pragma unroll
        for (int r = 0; r < 16; ++r) O[i][r] = 0.f;

    int nloc, k_lo = 0; const bf16_t *kloc, *vloc; int ldloc;
    if (lat) {
        k_lo = qb - 4 < 0 ? 0 : qb - 4; const int k_hi = qb + 4 > 31 ? 31 : qb + 4; nloc = k_hi - k_lo + 1;
        kloc = KB + (size_t)(tb + k_lo * 32) * 256 + kvh * 64;
        vloc = VTB + (size_t)16 * 4 * 64 * 256 + ((size_t)(b * 4 + kvh) * 64) * 1024 + k_lo * 32; ldloc = 1024;
    } else {
        nloc = 8; kloc = KB + (size_t)tb * 256 + kvh * 64; vloc = VTB + ((size_t)(b * 4 + kvh) * 64) * 256; ldloc = 256;
    }
    const int nblk = lat ? nloc + 8 : 8;
    const bf16_t* kcb = KC + (size_t)(b * 256) * 256 + kvh * 64;
    const bf16_t* vcb = VCT + ((size_t)(b * 4 + kvh) * 64) * 256;
    const int tid = threadIdx.x;
    const int kkey = tid >> 3, kch = tid & 7, vd = tid >> 2, vch = tid & 3;
    const unsigned kst = kkey * 128 + ((kch ^ ((kkey >> 1) & 7)) << 4), vst = 4096 + vd * 64 + ((vch ^ ((vd >> 2) & 3)) << 4);
    const unsigned ksw = (fr >> 1) & 7, vsw = (fr >> 2) & 3;
    u32x4 kA, vA, kB, vB;
#define LOADKV(j, KR, VR) { const bf16_t *kp_, *vp_; int ldv_; \
        if ((j) < nloc) { kp_ = kloc + (size_t)(j) * 32 * 256; vp_ = vloc + (j) * 32; ldv_ = ldloc; } \
        else { const int c_ = (j) - nloc; kp_ = kcb + (size_t)c_ * 32 * 256; vp_ = vcb + c_ * 32; ldv_ = 256; } \
        KR = *(const u32x4*)(kp_ + (size_t)kkey * 256 + kch * 8); VR = *(const u32x4*)(vp_ + (size_t)vd * ldv_ + vch * 8); }
    auto compute = [&](int j) {
        const unsigned char* lb = lds + (j & 1) * 8192;
        bf16x8 kf[4], vf[4];
#pragma unroll
        for (int ks = 0; ks < 4; ++ks) kf[ks] = *(const bf16x8*)(lb + fr * 128 + (((2 * ks + fh) ^ ksw) << 4));
#pragma unroll
        for (int s2 = 0; s2 < 2; ++s2)
#pragma unroll
            for (int db = 0; db < 2; ++db) vf[s2 * 2 + db] = *(const bf16x8*)(lb + 4096 + (db * 32 + fr) * 64 + (((2 * s2 + fh) ^ vsw) << 4));
        f32x16 s;
#pragma unroll
        for (int r = 0; r < 16; ++r) s[r] = 0.f;
#pragma unroll
        for (int ks = 0; ks < 4; ++ks) s = __builtin_amdgcn_mfma_f32_32x32x16_bf16(kf[ks], qf[ks], s, 0, 0, 0);
        if (lat && j < nloc) {
            const int kb = k_lo + j;
            const int mode = (kb == qb - 4) ? 1 : (kb == qb + 4) ? 2 : 0;
            if (mode) {
                const int dpos = (kb - qb) * 32;
#pragma unroll
                for (int r = 0; r < 16; ++r) {
                    const int rel = dpos + (r & 3) + 8 * (r >> 2) + 4 * fh - fr;
                    const bool ok = mode == 1 ? (rel >= -128) : (rel <= 128);
                    if (!ok) s[r] = -1e30f;
                }
            }
        }
        float mx = s[0];
#pragma unroll
        for (int r = 1; r < 16; ++r) mx = fmaxf(mx, s[r]);
        mx = xhalf_max(mx);
        const float m_new = fmaxf(m_run, mx);
        const float alpha = __builtin_amdgcn_exp2f(m_run - m_new);
        float rs = 0.f;
#pragma unroll
        for (int r = 0; r < 16; ++r) { s[r] = __builtin_amdgcn_exp2f(s[r] - m_new); rs += s[r]; }
        rs = xhalf_sum(rs);
        l_run = l_run * alpha + rs; m_run = m_new;
#pragma unroll
        for (int i = 0; i < 2; ++i)
#pragma unroll
            for (int r = 0; r < 16; ++r) O[i][r] *= alpha;
#pragma unroll
        for (int s2 = 0; s2 < 2; ++s2) {
            union { u32x4 u; bf16x8 v; } pf;
            pf.u.x = cvt_pk_bf16(s[8 * s2 + 0], s[8 * s2 + 1]); pf.u.y = cvt_pk_bf16(s[8 * s2 + 2], s[8 * s2 + 3]);
            pf.u.z = cvt_pk_bf16(s[8 * s2 + 4], s[8 * s2 + 5]); pf.u.w = cvt_pk_bf16(s[8 * s2 + 6], s[8 * s2 + 7]);
#pragma unroll
            for (int db = 0; db < 2; ++db) O[db] = __builtin_amdgcn_mfma_f32_32x32x16_bf16(vf[s2 * 2 + db], pf.v, O[db], 0, 0, 0);
        }
    };
    LOADKV(0, kA, vA)
    *(u32x4*)(lds + kst) = kA; *(u32x4*)(lds + vst) = vA;
    if (nblk > 1) LOADKV(1, kA, vA)
    if (nblk > 2) LOADKV(2, kB, vB)
    __syncthreads();
    for (int j = 0; j < nblk; j += 2) {
        compute(j);
        if (j + 1 < nblk) { *(u32x4*)(lds + 8192 + kst) = kA; *(u32x4*)(lds + 8192 + vst) = vA; }
        if (j + 3 < nblk) LOADKV(j + 3, kA, vA)
        __syncthreads();
        if (j + 1 < nblk) {
            compute(j + 1);
            if (j + 2 < nblk) { *(u32x4*)(lds + kst) = kB; *(u32x4*)(lds + vst) = vB; }
            if (j + 4 < nblk) LOADKV(j + 4, kB, vB)
            __syncthreads();
        }
    }
#undef LOADKV
    const float il = 1.f / l_run;
    u32x2 keepy = {0u, 0u};
#pragma unroll
    for (int db = 0; db < 2; ++db)
#pragma unroll
        for (int g = 0; g < 4; ++g) {
            const int col = head * 64 + db * 32 + 8 * g + 4 * fh;
            const u32x2 z = *(const u32x2*)(SZ + (size_t)qtok * D + col);
            const float z0 = __uint_as_float(z.x << 16), z1 = __uint_as_float(z.x & 0xffff0000u);
            const float z2 = __uint_as_float(z.y << 16), z3 = __uint_as_float(z.y & 0xffff0000u);
            u32x2 o; o.x = cvt_pk_bf16(O[db][4 * g] * il * z0, O[db][4 * g + 1] * il * z1);
            o.y = cvt_pk_bf16(O[db][4 * g + 2] * il * z2, O[db][4 * g + 3] * il * z3);
            if ((g & 1) == 0) keepy = o; else put8(lds + w * 8192, fr, db * 4 + (g - 1) + fh, keepy, o);
        }
    flush8<32>(lds + w * 8192, lane, [&](int r) { return Y + (size_t)(tb + qb * 32 + r) * D + head * 64; });
    __syncthreads();
}


#define XB_TMO      128
#define XB_XCNT(j)  (256  + 64 * (j))
#define XB_XSUB(j)  (1280 + 64 * (j))
#define XB_XGEN(j)  (2304 + 64 * (j))
#define XB_TOP      3328
#define XB_TOPGEN   3392
#define XCD_BAR_WORDS 3456
#define XB_SPIN_CAP (1u << 18)
#define LAS __attribute__((address_space(3)))
DEVI unsigned xb_ld(unsigned* p)              { return __hip_atomic_load(p, __ATOMIC_RELAXED, __HIP_MEMORY_SCOPE_AGENT); }
DEVI unsigned xb_add(unsigned* p, unsigned v) { return __hip_atomic_fetch_add(p, v, __ATOMIC_RELAXED, __HIP_MEMORY_SCOPE_AGENT); }
DEVI unsigned xb_xcc_id() { return (unsigned)__builtin_amdgcn_s_getreg((3 << 11) | 20) & 0xFu; }
#define XB_SPIN(cond, bar) do { unsigned _sp = 0; while (cond) { __builtin_amdgcn_s_sleep(1); \
    if ((++_sp & 255u) == 0u) { if (xb_ld(&(bar)[XB_TMO])) break; if (_sp > XB_SPIN_CAP) { atomicAdd(&(bar)[XB_TMO], 1u); break; } } } } while (0)
struct XcdBarrier { unsigned* bar; unsigned x; volatile LAS unsigned* st; };
DEVI XcdBarrier xcd_barrier_post(unsigned* bar, volatile LAS unsigned* st) {
    XcdBarrier b; b.bar = bar; b.x = xb_xcc_id(); b.st = st;
    if (threadIdx.x == 0) (void)xb_add(&bar[XB_XCNT(b.x)], 1u);
    return b;
}
DEVI void xcd_barrier_complete(unsigned* bar, unsigned x, unsigned& nloc, unsigned& nx) {
    const unsigned G = gridDim.x * gridDim.y * gridDim.z;
    unsigned sum, cnt, mine, sp = 0u;
    for (;;) {
        sum = 0u; cnt = 0u; mine = 0u;
#pragma unroll
        for (unsigned j = 0; j < 16; ++j) { const unsigned c = xb_ld(&bar[XB_XCNT(j)]); sum += c; cnt += (c > 0u) ? 1u : 0u; mine = (j == x) ? c : mine; }
        if (sum == G) break;
        __builtin_amdgcn_s_sleep(1);
        if ((++sp & 255u) == 0u) { if (xb_ld(&bar[XB_TMO])) break; if (sp > XB_SPIN_CAP) { atomicAdd(&bar[XB_TMO], 1u); break; } }
    }
    nloc = mine > 0u ? mine : 1u; nx = cnt > 0u ? cnt : 1u;
}
DEVI void xcd_barrier(const XcdBarrier& b) {
    asm volatile("s_waitcnt vmcnt(0)" ::: "memory");
    __syncthreads();
    if (threadIdx.x == 0) {
        unsigned* bar = b.bar;
        __builtin_amdgcn_s_waitcnt(0);
        unsigned nloc = b.st[0], nx = b.st[1];
        if (nloc == 0u) { xcd_barrier_complete(bar, b.x, nloc, nx); b.st[0] = nloc; b.st[1] = nx; }
        const unsigned old = xb_add(&bar[XB_XSUB(b.x)], 1u);
        const unsigned gen = old / nloc;
        if (old + 1u == (gen + 1u) * nloc) {
            __builtin_amdgcn_fence(__ATOMIC_RELEASE, "agent");
            asm volatile("s_waitcnt vmcnt(0)" ::: "memory");
            const unsigned og = xb_add(&bar[XB_TOP], 1u);
            const unsigned tg = og / nx;
            if (og + 1u == (tg + 1u) * nx) xb_add(&bar[XB_TOPGEN], 1u);
            else XB_SPIN(xb_ld(&bar[XB_TOPGEN]) == tg, bar);
            __builtin_amdgcn_fence(__ATOMIC_ACQUIRE, "agent");
            xb_add(&bar[XB_XGEN(b.x)], 1u);
            asm volatile("s_waitcnt vmcnt(0)" ::: "memory");
        } else {
            XB_SPIN(xb_ld(&bar[XB_XGEN(b.x)]) == gen, bar);
            __builtin_amdgcn_fence(__ATOMIC_ACQUIRE, "agent");
            asm volatile("s_waitcnt vmcnt(0)" ::: "memory");
        }
    }
    __syncthreads();
}

DEVI void run_phase(const Params& p, int ph, unsigned char* lds) {
    const int G = gridDim.x;
    bf16_t* H = (bf16_t*)(p.ws + WS_H);
    bf16_t* U = (bf16_t*)(p.ws + WS_U);
    bf16_t* SZ = (bf16_t*)(p.ws + WS_SZ);
    bf16_t* VT = (bf16_t*)(p.ws + WS_VT);
    bf16_t* Y = (bf16_t*)(p.ws + WS_Y);
    float* X1 = (float*)(p.ws + WS_X1);
    const float* mod = (const float*)(p.ws + WS_MOD);
    switch (ph) {
    case 0: {
        phase0(p, lds);
        if (threadIdx.x == 0) {
            unsigned* cnt = (unsigned*)(p.ws + WS_CNT); unsigned sp = 0;
            while (__hip_atomic_load(cnt, __ATOMIC_RELAXED, __HIP_MEMORY_SCOPE_AGENT) < 384u) { __builtin_amdgcn_s_sleep(4); if (++sp > (1u << 22)) break; }
        }
        __syncthreads();
        const float* modp = (const float*)(p.ws + WS_MODP);
        if (blockIdx.x < 72) {
            const int i = blockIdx.x * 256 + threadIdx.x, l = i / 9216, j = i % 3072;
            float s = (l ? p.b_mod1 : p.b_mod0)[j];
#pragma unroll
            for (int ks = 0; ks < 4; ++ks) s += __hip_atomic_load(modp + ks * 18432 + i, __ATOMIC_RELAXED, __HIP_MEMORY_SCOPE_AGENT);
            ((float*)(p.ws + WS_MOD))[i] = s;
        }
        float* lmod = (float*)lds;
        {
            float tmp[24];
#pragma unroll
            for (int q = 0; q < 24; ++q) {
                const int i = threadIdx.x + 256 * q, src_i = (i >> 11) * 3072 + (i & 2047);
                float s = p.b_mod0[i & 2047];
#pragma unroll
                for (int ks = 0; ks < 4; ++ks) s += __hip_atomic_load(modp + ks * 18432 + src_i, __ATOMIC_RELAXED, __HIP_MEMORY_SCOPE_AGENT);
                tmp[q] = s;
            }
#pragma unroll
            for (int q = 0; q < 24; ++q) lmod[threadIdx.x + 256 * q] = tmp[q];
        }
        __syncthreads();
        phase_norm(p, 0, lmod);
    } break;
    case 2: {
        EpiInL0 e{U, SZ};
        for (int t = blockIdx.x; t < 768; t += G) {
            const int tt = xcd_remap(t, 768);
            gemm_tile(H, D, (const bf16_t*)(p.ws + WS_WT0IN), D, 16, lds, e, (tt >> 4) * 128, (tt & 15) * 128);
        }
        if (G == 512) { if (blockIdx.x >= 256) bias1_items(p, blockIdx.x - 256, 256); }
        else bias1_items(p, blockIdx.x, G);
    } break;
    case 3: {
        for (int t = blockIdx.x; t < 768; t += G) {
            const int tt = xcd_remap(t, 768);
            const int mt = tt & 3, g = (tt >> 2) & 3, nt = tt >> 4;
            EpiChanDft e{VT, g};
            gemm_tile((const bf16_t*)(p.ws + WS_TW256), 256, U + g * 256, D, 4, lds, e, mt * 128, nt * 128);
        }
    } break;
    case 4: {
        for (int t = blockIdx.x; t < 512; t += G) {
            if (t < 256) {
                const int nt = t & 1, mt = (t >> 1) & 15, bg = t >> 5;
                EpiSeqDft<1> e{SZ, Y, NCTX + (bg >> 2) * 1024, bg & 3};
                gemm_tile<1>((const bf16_t*)(p.ws + WS_TS1024), 2048, VT + (size_t)64 * 256 * 512 + (size_t)bg * 256 * 2048, 2048, 32, lds, e, mt * 64, nt * 128);
            } else {
                const int u = t - 256, nt = u & 1, mt = (u >> 1) & 1, bg = u >> 2;
                EpiSeqDft<2> e{SZ, Y, (bg >> 2) * 256, bg & 3};
                gemm_tile<2>((const bf16_t*)(p.ws + WS_TS256), 512, VT + (size_t)bg * 256 * 512, 512, 8, lds, e, mt * 128, nt * 128);
            }
        }
    } break;
    case 5: {
        EpiOut<true, 2> e{p.x_prompt, p.x_sample, mod, X1, p.norm_w1, mod + 3 * 3072, H, (float*)(p.ws + WS_ROWSS)};
        EpiOut<true, 1> e1{p.x_prompt, p.x_sample, mod, X1, p.norm_w1, mod + 3 * 3072, H, (float*)(p.ws + WS_ROWSS)};
        if (G == 512) {
            if (blockIdx.x < 256) { const int tt = xcd_remap(blockIdx.x, 256); gemm_tile<2>(Y, D, (const bf16_t*)(p.ws + WS_WT0OUT), D, 16, lds, e, (tt >> 3) * 128, (tt & 7) * 128); }
            else { const int tt = xcd_remap(blockIdx.x - 256, 256); gemm_tile<1>(Y, D, (const bf16_t*)(p.ws + WS_WT0OUT), D, 16, lds, e1, 4096 + (tt >> 3) * 64, (tt & 7) * 128); }
        } else
        for (int t = blockIdx.x; t < 384; t += G) {
            const int tt = xcd_remap(t, 384);
            gemm_tile(Y, D, (const bf16_t*)(p.ws + WS_WT0OUT), D, 16, lds, e, (tt >> 3) * 128, (tt & 7) * 128);
        }
    } break;
    case 7: {
        EpiInL1 e{p.qnw, p.knw, (const float*)(p.ws + WS_ROPEC), (const float*)(p.ws + WS_ROPES),
                  (bf16_t*)(p.ws + WS_Q), (bf16_t*)(p.ws + WS_KB), (bf16_t*)(p.ws + WS_VTB), SZ,
                  p.out + (size_t)NTOK * D, p.out + (size_t)NTOK * D + (size_t)NCTX * 256,
                  (const float*)(p.ws + WS_ROWSS), (const float*)(p.ws + WS_BIAS1)};
        for (int t = blockIdx.x; t < 960; t += G) {
            const int tt = xcd_remap(t, 960);
            gemm_tile(H, D, (const bf16_t*)(p.ws + WS_WT1IN), D, 16, lds, e, (tt / 20) * 128, (tt % 20) * 128);
        }
    } break;
    case 8: {
        if (G == 512) {
            if (blockIdx.x < 256) attn_item(p, blockIdx.x, lds);
            else { attn_item(p, 256 + 2 * (blockIdx.x - 256), lds); attn_item(p, 257 + 2 * (blockIdx.x - 256), lds); }
        } else
            for (int t = blockIdx.x; t < 768; t += G) attn_item(p, t, lds);
    } break;
    case 9: {
        EpiOut<false, 2> e{X1, X1 + (size_t)NCTX * D, mod + 3 * 3072, p.out, nullptr, nullptr, nullptr, nullptr};
        EpiOut<false, 1> e1{X1, X1 + (size_t)NCTX * D, mod + 3 * 3072, p.out, nullptr, nullptr, nullptr, nullptr};
        if (G == 512) {
            if (blockIdx.x < 256) { const int tt = xcd_remap(blockIdx.x, 256); gemm_tile<2>(Y, D, (const bf16_t*)(p.ws + WS_WT1OUT), D, 16, lds, e, (tt >> 3) * 128, (tt & 7) * 128); }
            else { const int tt = xcd_remap(blockIdx.x - 256, 256); gemm_tile<1>(Y, D, (const bf16_t*)(p.ws + WS_WT1OUT), D, 16, lds, e1, 4096 + (tt >> 3) * 64, (tt & 7) * 128); }
        } else
        for (int t = blockIdx.x; t < 384; t += G) {
            const int tt = xcd_remap(t, 384);
            gemm_tile(Y, D, (const bf16_t*)(p.ws + WS_WT1OUT), D, 16, lds, e, (tt >> 3) * 128, (tt & 7) * 128);
        }
    } break;
    }
}

__global__ void __launch_bounds__(256, 2) mega(Params p) {
    __shared__ __attribute__((aligned(16))) unsigned char lds[65536 + 16];
    cg::grid_group grid = cg::this_grid();
#if SINGLE_LAUNCH
    volatile LAS unsigned* st = (volatile LAS unsigned*)(lds + 65536);
    if (threadIdx.x < 4) st[threadIdx.x] = 0u;
    __syncthreads();
    XcdBarrier bar = xcd_barrier_post((unsigned*)(p.ws + WS_BAR), st);
    if (p.ph_hi == 777) grid.sync();
#ifndef REP_PH
#define REP_PH -1
#endif
#ifndef REP_SY
#define REP_SY 0
#endif
#define PH(n) run_phase(p, n, lds); if (REP_PH == n) run_phase(p, n, lds);
#define SY() xcd_barrier(bar); if (REP_SY) xcd_barrier(bar);
#else
    const int lo = (int)p.ph_lo, hi = (int)p.ph_hi;
#define PH(n) if (lo <= n && n < hi) run_phase(p, n, lds);
#define SY()
#endif
    PH(0) SY() PH(2) SY() PH(3) SY() PH(4) SY() PH(5) SY() PH(7) SY() PH(8) SY() PH(9)
}

extern "C" void kernel_launch(void* const* d_in, const int* in_sizes, int n_in, void* d_out, int out_size, void* d_ws, size_t ws_size, hipStream_t stream) {
    static int grid_blocks = 0;
    if (!grid_blocks) {
        int dev = 0, cus = 0, per_cu = 0;
        hipGetDevice(&dev);
        hipDeviceGetAttribute(&cus, hipDeviceAttributeMultiprocessorCount, dev);
        hipOccupancyMaxActiveBlocksPerMultiprocessor(&per_cu, mega, 256, 0);
        if (per_cu > 2) per_cu = 2;
        if (per_cu < 1) per_cu = 1;
        grid_blocks = cus * per_cu;
    }
    Params p{};
    const float* const* in = (const float* const*)d_in;
    p.x_prompt = in[0]; p.x_sample = in[1]; p.cache_k = in[2]; p.cache_v = in[3]; p.c = in[4]; p.c_ctx = in[5];
    p.norm_w0 = in[6]; p.w_mod0 = in[7]; p.b_mod0 = in[8]; p.w_in0 = in[9]; p.w_out0 = in[10];
    p.norm_w1 = in[11]; p.w_mod1 = in[12]; p.b_mod1 = in[13]; p.w_in1 = in[14]; p.qnw = in[15]; p.knw = in[16]; p.sink = in[17]; p.w_out1 = in[18];
    p.out = (float*)d_out; p.ws = (unsigned char*)d_ws;
#if SINGLE_LAUNCH
    p.ph_lo = 0; p.ph_hi = 10;
    hipMemsetAsync((unsigned char*)d_ws + WS_BAR, 0, 16384, stream);
    void* args[] = {&p};
    hipError_t e = hipLaunchCooperativeKernel((void*)mega, dim3(grid_blocks), dim3(256), args, 0, stream);
    if (e != hipSuccess) fprintf(stderr, "cooperative launch failed: %s (grid %d)\n", hipGetErrorString(e), grid_blocks);
#else
    for (int ph = 0; ph < 10; ++ph) {
        p.ph_lo = ph; p.ph_hi = ph + 1;
        hipLaunchKernelGGL(mega, dim3(grid_blocks), dim3(256), 0, stream, p);
    }
#endif
}
```

```cpp
#include <hip/hip_runtime.h>
#include <hip/hip_cooperative_groups.h>
#include <stdint.h>
#include <cstdio>
namespace cg = cooperative_groups;

#ifndef SINGLE_LAUNCH
#define SINGLE_LAUNCH 1
#endif

typedef unsigned short bf16_t;
typedef short bf16x8 __attribute__((ext_vector_type(8)));
typedef float f32x16 __attribute__((ext_vector_type(16)));
typedef float f32x4 __attribute__((ext_vector_type(4)));
typedef unsigned u32x4 __attribute__((ext_vector_type(4)));
typedef unsigned u32x2 __attribute__((ext_vector_type(2)));
#define DEVI __device__ __forceinline__

constexpr int NTOK = 6144, NCTX = 4096, D = 1024;
constexpr float EPSV = 1e-6f;
constexpr float LOG2E = 1.4426950408889634f;

constexpr size_t WS_MOD = 0;
constexpr size_t WS_WT0IN = 1 << 20;
constexpr size_t WS_WT0OUT = WS_WT0IN + (size_t)2048 * 1024 * 2;
constexpr size_t WS_WT1IN = WS_WT0OUT + (size_t)1024 * 1024 * 2;
constexpr size_t WS_WT1OUT = WS_WT1IN + (size_t)2560 * 1024 * 2;
constexpr size_t WS_TW256 = WS_WT1OUT + (size_t)1024 * 1024 * 2;
constexpr size_t WS_TS256 = WS_TW256 + (size_t)512 * 256 * 2;
constexpr size_t WS_TS1024 = WS_TS256 + (size_t)256 * 512 * 2;
constexpr size_t WS_ROPEC = WS_TS1024 + (size_t)1024 * 2048 * 2;
constexpr size_t WS_ROPES = WS_ROPEC + (size_t)1024 * 32 * 4;
constexpr size_t WS_KC = WS_ROPES + (size_t)1024 * 32 * 4;
constexpr size_t WS_VCT = WS_KC + (size_t)2 * 256 * 256 * 2;
constexpr size_t WS_H = WS_VCT + (size_t)2 * 256 * 256 * 2;
constexpr size_t WS_U = WS_H + (size_t)NTOK * D * 2;
constexpr size_t WS_SZ = WS_U + (size_t)NTOK * D * 2;
constexpr size_t WS_VT = WS_SZ + (size_t)NTOK * D * 2;
constexpr size_t WS_Y = WS_VT + (size_t)NTOK * 2048 * 2;
constexpr size_t WS_X1 = WS_Y + (size_t)NTOK * D * 2;
constexpr size_t WS_Q = WS_X1 + (size_t)NTOK * D * 4;
constexpr size_t WS_KB = WS_Q + (size_t)NTOK * D * 2;
constexpr size_t WS_VTB = WS_KB + (size_t)NTOK * 256 * 2;
constexpr size_t WS_BAR = WS_VTB + (size_t)NTOK * 256 * 2;
constexpr size_t WS_CNT = WS_BAR + 14336;
constexpr size_t WS_ROWSS = WS_BAR + 16384;
constexpr size_t WS_BIAS1 = WS_ROWSS + 6144 * 4;
constexpr size_t WS_MODP = WS_BIAS1 + 3 * 2560 * 4;
constexpr size_t WS_END = WS_MODP + (size_t)4 * 18432 * 4;

struct Params {
    const float *x_prompt, *x_sample, *cache_k, *cache_v, *c, *c_ctx;
    const float *norm_w0, *w_mod0, *b_mod0, *w_in0, *w_out0;
    const float *norm_w1, *w_mod1, *b_mod1, *w_in1, *qnw, *knw, *sink, *w_out1;
    float* out;
    unsigned char* ws;
    long long ph_lo, ph_hi;
};

DEVI unsigned cvt_pk_bf16(float lo, float hi) { unsigned r; asm("v_cvt_pk_bf16_f32 %0, %1, %2" : "=v"(r) : "v"(lo), "v"(hi)); return r; }
DEVI bf16_t f2bf(float f) { return (bf16_t)(cvt_pk_bf16(f, 0.f) & 0xffffu); }
DEVI float silu_f(float v) { return v * __builtin_amdgcn_rcpf(1.f + __expf(-v)); }
DEVI int swap23(int x) { return (x & ~12) | ((x & 4) << 1) | ((x & 8) >> 1); }
DEVI int cond_of(int m) { return m < NCTX ? 0 : 1 + ((m - NCTX) >> 10); }

DEVI void st8(bf16_t* p, u32x2 a, u32x2 b) {
    const auto r0 = __builtin_amdgcn_permlane32_swap(a.x, b.x, false, false);
    const auto r1 = __builtin_amdgcn_permlane32_swap(a.y, b.y, false, false);
    u32x4 w; w.x = r0[0]; w.y = r1[0]; w.z = r0[1]; w.w = r1[1];
    *(u32x4*)p = w;
}
DEVI void put8(unsigned char* wl, int r, int c, u32x2 a, u32x2 b) {
    const auto r0 = __builtin_amdgcn_permlane32_swap(a.x, b.x, false, false);
    const auto r1 = __builtin_amdgcn_permlane32_swap(a.y, b.y, false, false);
    u32x4 w; w.x = r0[0]; w.y = r1[0]; w.z = r0[1]; w.w = r1[1];
    *(u32x4*)(wl + r * 128 + ((c ^ (r & 7)) << 4)) = w;
}
template <int ROWS, class RowPtr>
DEVI void flush8(const unsigned char* wl, int lane, const RowPtr& rowptr) {
#pragma unroll
    for (int i = 0; i < ROWS / 8; ++i) {
        const int r = i * 8 + (lane >> 3), c = lane & 7;
        const u32x4 w = *(const u32x4*)(wl + r * 128 + ((c ^ (r & 7)) << 4));
        *(u32x4*)(rowptr(r) + c * 8) = w;
    }
}
#define DPP_ADD0(x, CTRL) ((x) + __uint_as_float((unsigned)__builtin_amdgcn_update_dpp(0, (int)__float_as_uint(x), CTRL, 0xF, 0xF, true)))
DEVI float wave_sum(float x) {
    x = DPP_ADD0(x, 0xB1); x = DPP_ADD0(x, 0x4E); x = DPP_ADD0(x, 0x141); x = DPP_ADD0(x, 0x140);
    const auto r = __builtin_amdgcn_permlane16_swap(__float_as_uint(x), __float_as_uint(x), false, false);
    x = __uint_as_float(r[0]) + __uint_as_float(r[1]);
    const auto q = __builtin_amdgcn_permlane32_swap(__float_as_uint(x), __float_as_uint(x), false, false);
    return __uint_as_float(q[0]) + __uint_as_float(q[1]);
}
DEVI float xhalf_sum(float x) { const auto r = __builtin_amdgcn_permlane32_swap(__float_as_uint(x), __float_as_uint(x), false, false); return __uint_as_float(r[0]) + __uint_as_float(r[1]); }
DEVI float xhalf_max(float x) { const auto r = __builtin_amdgcn_permlane32_swap(__float_as_uint(x), __float_as_uint(x), false, false); return fmaxf(__uint_as_float(r[0]), __uint_as_float(r[1])); }

DEVI void glds16(const void* g, void* l) { __builtin_amdgcn_global_load_lds(g, l, 16, 0, 0); }

template <int MB = 2, class Epi>
DEVI void gemm_tile(const bf16_t* __restrict__ A, int lda, const bf16_t* __restrict__ B, int ldb, int nk,
                    unsigned char* lds, const Epi& epi, int m0, int n0) {
    const int tid = threadIdx.x, lane = tid & 63, wid = tid >> 6, wr = wid >> 1, wc = wid & 1;
    const int srow = tid >> 3;
    const int slc = (tid & 7) ^ ((tid >> 4) & 7);
    const bf16_t* gA = A + (size_t)(m0 + srow) * lda + slc * 8;
    const bf16_t* gB = B + (size_t)(n0 + srow) * ldb + slc * 8;
    const int fr = lane & 31, fh = lane >> 5, sw = (lane >> 1) & 7;
    const unsigned aoff = (wr * 32 * MB + fr) * 128, boff = 16384 + (wc * 64 + fr) * 128;
    f32x16 acc[MB][2];
#pragma unroll
    for (int i = 0; i < MB; ++i)
#pragma unroll
        for (int j = 0; j < 2; ++j)
#pragma unroll
            for (int r = 0; r < 16; ++r) acc[i][j][r] = 0.f;
    {
        unsigned char* la = lds + tid * 16;
#pragma unroll
        for (int i = 0; i < 4; ++i) {
            if (i < 2 * MB) glds16(gA + (size_t)i * 32 * lda, la + i * 4096);
            glds16(gB + (size_t)i * 32 * ldb, la + 16384 + i * 4096);
        }
        la += 32768;
#pragma unroll
        for (int i = 0; i < 4; ++i) {
            if (i < 2 * MB) glds16(gA + (size_t)i * 32 * lda + 64, la + i * 4096);
            glds16(gB + (size_t)i * 32 * ldb + 64, la + 16384 + i * 4096);
        }
    }
    for (int kt = 0; kt < nk; ++kt) {
        if (kt == 0) {
            if (MB == 2) asm volatile("s_waitcnt vmcnt(8) lgkmcnt(0)" ::: "memory"); else asm volatile("s_waitcnt vmcnt(6) lgkmcnt(0)" ::: "memory");
            __builtin_amdgcn_sched_barrier(0); __builtin_amdgcn_s_barrier(); __builtin_amdgcn_sched_barrier(0);
        } else {
            asm volatile("s_waitcnt vmcnt(0)" ::: "memory");
            __syncthreads();
        }
        if (kt >= 1 && kt + 1 < nk) {
            unsigned char* la = lds + ((kt + 1) & 1) * 32768 + tid * 16;
            const int ko = (kt + 1) * 64;
#pragma unroll
            for (int i = 0; i < 4; ++i) {
                if (i < 2 * MB) glds16(gA + (size_t)i * 32 * lda + ko, la + i * 4096);
                glds16(gB + (size_t)i * 32 * ldb + ko, la + 16384 + i * 4096);
            }
        }
        const unsigned char* base = lds + (kt & 1) * 32768;
        bf16x8 af[4][2], bfr[4][2];
#define LDFRAG(ks) { const int ch = ((2 * (ks) + fh) ^ sw) * 16; \
            af[ks][0] = *(const bf16x8*)(base + aoff + ch); bfr[ks][0] = *(const bf16x8*)(base + boff + ch); \
            bfr[ks][1] = *(const bf16x8*)(base + boff + 4096 + ch); if (MB == 2) af[ks][1] = *(const bf16x8*)(base + aoff + 4096 + ch); }
#define MFMA4(ks) { acc[0][0] = __builtin_amdgcn_mfma_f32_32x32x16_bf16(bfr[ks][0], af[ks][0], acc[0][0], 0, 0, 0); \
            acc[0][1] = __builtin_amdgcn_mfma_f32_32x32x16_bf16(bfr[ks][1], af[ks][0], acc[0][1], 0, 0, 0); \
            if (MB == 2) { acc[MB - 1][0] = __builtin_amdgcn_mfma_f32_32x32x16_bf16(bfr[ks][0], af[ks][1], acc[MB - 1][0], 0, 0, 0); \
            acc[MB - 1][1] = __builtin_amdgcn_mfma_f32_32x32x16_bf16(bfr[ks][1], af[ks][1], acc[MB - 1][1], 0, 0, 0); } }
        LDFRAG(0) LDFRAG(1)
        __builtin_amdgcn_sched_barrier(0);
        MFMA4(0) LDFRAG(2)
        __builtin_amdgcn_sched_barrier(0);
        MFMA4(1) LDFRAG(3)
        __builtin_amdgcn_sched_barrier(0);
        MFMA4(2)
        __builtin_amdgcn_sched_barrier(0);
        MFMA4(3)
#undef LDFRAG
#undef MFMA4
    }
    epi(acc, m0 + wr * 32 * MB, n0 + wc * 64, fr, fh, lds + wid * 8192);
    __syncthreads();
}

DEVI int xcd_remap(int t, int T) { return (t & 7) * (T >> 3) + (t >> 3); }

DEVI void mod_item(const Params& p, int it, unsigned char* lds) {
    const int tid = threadIdx.x;
    const int ks = it & 3, lc = it >> 2, l = lc / 48, cc = lc % 48;
    float* sc = (float*)lds;
    for (int i = tid; i < 768; i += 256) {
        const int cv = i >> 8, k = ks * 256 + (i & 255);
        const float cval = cv == 0 ? p.c_ctx[k] : p.c[(cv - 1) * 1024 + k];
        sc[i] = silu_f(cval);
    }
    __syncthreads();
    const float* W = (l ? p.w_mod1 : p.w_mod0) + (size_t)ks * 256 * 3072;
    const int cg4 = tid & 15, rg = tid >> 4, c0 = cc * 64 + cg4 * 4;
    f32x4 w[16];
#pragma unroll
    for (int i = 0; i < 16; ++i) w[i] = *(const f32x4*)(W + (size_t)(rg + 16 * i) * 3072 + c0);
    f32x4 a0 = {0.f, 0.f, 0.f, 0.f}, a1 = a0, a2 = a0;
#pragma unroll
    for (int i = 0; i < 16; ++i) { const int k = rg + 16 * i; a0 += sc[k] * w[i]; a1 += sc[256 + k] * w[i]; a2 += sc[512 + k] * w[i]; }
    float* red = (float*)(lds + 12288);
#pragma unroll
    for (int e = 0; e < 4; ++e) {
        red[(rg * 3 + 0) * 64 + cg4 * 4 + e] = a0[e];
        red[(rg * 3 + 1) * 64 + cg4 * 4 + e] = a1[e];
        red[(rg * 3 + 2) * 64 + cg4 * 4 + e] = a2[e];
    }
    __syncthreads();
    if (tid < 192) {
        const int cv = tid >> 6, j = tid & 63;
        float s = 0.f;
#pragma unroll
        for (int r = 0; r < 16; ++r) s += red[(r * 3 + cv) * 64 + j];
        float* modp = (float*)(p.ws + WS_MODP) + (size_t)ks * 18432;
        __hip_atomic_store(&modp[(l * 3 + cv) * 3072 + cc * 64 + j], s, __ATOMIC_RELAXED, __HIP_MEMORY_SCOPE_AGENT);
    }
    asm volatile("s_waitcnt vmcnt(0)" ::: "memory");
    __syncthreads();
    if (tid == 0) __hip_atomic_fetch_add((unsigned*)(p.ws + WS_CNT), 1u, __ATOMIC_RELAXED, __HIP_MEMORY_SCOPE_AGENT);
}

struct TrDesc { const float* src; bf16_t* dst; int N, kt, nt; };
DEVI TrDesc tr_desc(const Params& p, int idx) {
    TrDesc d;
    if (idx < 512) { d.src = p.w_in0; d.dst = (bf16_t*)(p.ws + WS_WT0IN); d.N = 2048; }
    else if (idx < 768) { idx -= 512; d.src = p.w_out0; d.dst = (bf16_t*)(p.ws + WS_WT0OUT); d.N = 1024; }
    else if (idx < 1408) { idx -= 768; d.src = p.w_in1; d.dst = (bf16_t*)(p.ws + WS_WT1IN); d.N = 2560; }
    else { idx -= 1408; d.src = p.w_out1; d.dst = (bf16_t*)(p.ws + WS_WT1OUT); d.N = 1024; }
    const int ntn = d.N >> 6;
    d.kt = idx / ntn; d.nt = idx % ntn;
    return d;
}
DEVI void transpose_items(const Params& p, int first, int end, int stride, unsigned char* lds) {
    const int tid = threadIdx.x;
    float* tl = (float*)lds;
    if (first >= end) return;
    f32x4 v[4];
    TrDesc d = tr_desc(p, first);
#pragma unroll
    for (int pass = 0; pass < 4; ++pass) v[pass] = *(const f32x4*)(d.src + (size_t)(d.kt * 64 + pass * 16 + (tid >> 4)) * d.N + d.nt * 64 + (tid & 15) * 4);
    for (int idx = first; idx < end; idx += stride) {
#pragma unroll
        for (int pass = 0; pass < 4; ++pass) {
            const int r = pass * 16 + (tid >> 4), c4 = (tid & 15) * 4;
#pragma unroll
            for (int e = 0; e < 4; ++e) tl[r * 65 + c4 + e] = v[pass][e];
        }
        const TrDesc cur = d;
        if (idx + stride < end) {
            d = tr_desc(p, idx + stride);
#pragma unroll
            for (int pass = 0; pass < 4; ++pass) v[pass] = *(const f32x4*)(d.src + (size_t)(d.kt * 64 + pass * 16 + (tid >> 4)) * d.N + d.nt * 64 + (tid & 15) * 4);
        }
        __syncthreads();
#pragma unroll
        for (int pass = 0; pass < 2; ++pass) {
            const int n = pass * 32 + (tid >> 3), kc = tid & 7;
            float x[8];
#pragma unroll
            for (int j = 0; j < 8; ++j) x[j] = tl[(kc * 8 + j) * 65 + n];
            u32x4 w;
            w.x = cvt_pk_bf16(x[0], x[1]); w.y = cvt_pk_bf16(x[2], x[3]); w.z = cvt_pk_bf16(x[4], x[5]); w.w = cvt_pk_bf16(x[6], x[7]);
            *(u32x4*)(cur.dst + (size_t)(cur.nt * 64 + n) * 1024 + cur.kt * 64 + kc * 8) = w;
        }
        __syncthreads();
    }
}

DEVI void phase0(const Params& p, unsigned char* lds) {
    for (int it = blockIdx.x; it < 384; it += gridDim.x) mod_item(p, it, lds);
    transpose_items(p, (blockIdx.x + 128) % gridDim.x, 1664, gridDim.x, lds);
    const int gt = blockIdx.x * 256 + threadIdx.x, gs = gridDim.x * 256;
    bf16_t* tw256 = (bf16_t*)(p.ws + WS_TW256);
    bf16_t* ts256 = (bf16_t*)(p.ws + WS_TS256);
    bf16_t* ts1024 = (bf16_t*)(p.ws + WS_TS1024);
    float* lut = (float*)(lds + 32768);
    __syncthreads();
    for (int r = threadIdx.x; r < 1024; r += 256) lut[r] = cospif((float)r * (1.f / 512.f));
    __syncthreads();
    for (int i = gt; i < 512 * 256; i += gs) {
        const int m = i >> 8, j = i & 255, which = m >> 8, cp = m & 255;
        const int r = ((cp * j) & 255) << 2;
        tw256[i] = f2bf(which ? lut[(r - 256) & 1023] : lut[r]);
    }
    for (int i = gt; i < 256 * 512; i += gs) {
        const int sp = i >> 9, k2 = i & 511, which = k2 >> 8, s0 = k2 & 255;
        const int r = ((sp * s0) & 255) << 2;
        ts256[i] = f2bf((which ? -lut[(r - 256) & 1023] : lut[r]) * (1.f / 256.f));
    }
    for (int i = gt; i < 1024 * 2048; i += gs) {
        const int sp = i >> 11, k2 = i & 2047, which = k2 >> 10, s0 = k2 & 1023;
        const int r = (sp * s0) & 1023;
        ts1024[i] = f2bf((which ? -lut[(r - 256) & 1023] : lut[r]) * (1.f / 512.f));
    }
    float* ropec = (float*)(p.ws + WS_ROPEC);
    float* ropes = (float*)(p.ws + WS_ROPES);
    for (int i = gt; i < 1024 * 32; i += gs) {
        const int pos = i >> 5, f = i & 31;
        const int row = pos >> 6, col = pos & 63;
        const float inv = powf(10000.f, -(float)(f & 15) * (1.f / 16.f));
        const float ang = (float)(f < 16 ? row : col) * inv;
        float s, c; sincosf(ang, &s, &c);
        ropec[i] = c; ropes[i] = s;
    }
    for (int i = gt; i < NTOK; i += gs) ((float*)(p.ws + WS_ROWSS))[i] = 0.f;
    bf16_t* kc = (bf16_t*)(p.ws + WS_KC);
    bf16_t* vct = (bf16_t*)(p.ws + WS_VCT);
    for (int i = gt; i < 2 * 256 * 256; i += gs) {
        kc[i] = f2bf(p.cache_k[i]);
        const int b = i >> 16, kvh = (i >> 14) & 3, d = (i >> 8) & 63, pp = i & 255;
        const int key = swap23(pp);
        vct[i] = f2bf(p.cache_v[((b * 256 + key) * 4 + kvh) * 64 + d]);
    }
}

DEVI void phase_norm(const Params& p, int layer, const float* lmod  ) {
    const int lane = threadIdx.x & 63, wid = threadIdx.x >> 6;
    const float* nw = layer ? p.norm_w1 : p.norm_w0;
    bf16_t* H = (bf16_t*)(p.ws + WS_H);
    const int stride = gridDim.x * 4;
    auto rowptr = [&](int row) -> const float* {
        if (layer == 0) return row < NCTX ? p.x_prompt + (size_t)row * D : p.x_sample + (size_t)(row - NCTX) * D;
        return (const float*)(p.ws + WS_X1) + (size_t)row * D;
    };
    int row = blockIdx.x * 4 + wid;
    if (row >= NTOK) return;
    f32x4 v[4], vn[4];
    {
        const float* xr = rowptr(row);
#pragma unroll
        for (int i = 0; i < 4; ++i) v[i] = *(const f32x4*)(xr + i * 256 + lane * 4);
    }
    for (; row < NTOK; row += stride) {
        const int nrow = row + stride;
        if (nrow < NTOK) {
            const float* xr = rowptr(nrow);
#pragma unroll
            for (int i = 0; i < 4; ++i) vn[i] = *(const f32x4*)(xr + i * 256 + lane * 4);
        }
        const float* mv = lmod + cond_of(row) * 2048;
        float ss = 0.f;
#pragma unroll
        for (int i = 0; i < 4; ++i) ss += v[i][0] * v[i][0] + v[i][1] * v[i][1] + v[i][2] * v[i][2] + v[i][3] * v[i][3];
        ss = wave_sum(ss);
        const float rstd = rsqrtf(ss * (1.f / 1024.f) + EPSV);
#pragma unroll
        for (int i = 0; i < 4; ++i) {
            const int k = i * 256 + lane * 4;
            const f32x4 w = *(const f32x4*)(nw + k);
            const f32x4 sh = *(const f32x4*)(mv + k);
            const f32x4 scl = *(const f32x4*)(mv + 1024 + k);
            float h[4];
#pragma unroll
            for (int e = 0; e < 4; ++e) h[e] = (v[i][e] * rstd * w[e]) * (1.f + scl[e]) + sh[e];
            u32x2 o; o.x = cvt_pk_bf16(h[0], h[1]); o.y = cvt_pk_bf16(h[2], h[3]);
            *(u32x2*)(H + (size_t)row * D + k) = o;
        }
#pragma unroll
        for (int i = 0; i < 4; ++i) v[i] = vn[i];
    }
}

DEVI void bias1_items(const Params& p, int lb, int nb) {
    const int lane = threadIdx.x & 63, gw = lb * 4 + (threadIdx.x >> 6), nw = nb * 4;
    const float* mod1 = (const float*)(p.ws + WS_MOD) + 3 * 3072;
    const bf16_t* WT = (const bf16_t*)(p.ws + WS_WT1IN);
    float* bias1 = (float*)(p.ws + WS_BIAS1);
    for (int n = gw; n < 2560; n += nw) {
        float w[16];
        const u32x4 r0 = *(const u32x4*)(WT + (size_t)n * 1024 + lane * 16), r1 = *(const u32x4*)(WT + (size_t)n * 1024 + lane * 16 + 8);
        const unsigned rr[8] = {r0.x, r0.y, r0.z, r0.w, r1.x, r1.y, r1.z, r1.w};
#pragma unroll
        for (int i = 0; i < 8; ++i) { w[2 * i] = __uint_as_float(rr[i] << 16); w[2 * i + 1] = __uint_as_float(rr[i] & 0xffff0000u); }
        float s[3];
#pragma unroll
        for (int cv = 0; cv < 3; ++cv) {
            float a = 0.f;
#pragma unroll
            for (int q = 0; q < 4; ++q) {
                const f32x4 sh = *(const f32x4*)(mod1 + cv * 3072 + lane * 16 + q * 4);
#pragma unroll
                for (int e = 0; e < 4; ++e) a += sh[e] * w[q * 4 + e];
            }
            s[cv] = wave_sum(a);
        }
        if (lane == 0) { bias1[n] = s[0]; bias1[2560 + n] = s[1]; bias1[5120 + n] = s[2]; }
    }
}

struct EpiInL0 {
    bf16_t *U, *SZ;
    DEVI void operator()(const f32x16 (&acc)[2][2], int mbase, int nbase, int fr, int fh, unsigned char* wl) const {
        const bool isz = nbase >= 1024;
        bf16_t* dst = isz ? SZ : U;
        const int nb0 = isz ? nbase - 1024 : nbase;
        u32x2 keep = {0u, 0u};
#pragma unroll
        for (int mb = 0; mb < 2; ++mb)
#pragma unroll
            for (int nb = 0; nb < 2; ++nb)
#pragma unroll
                for (int g = 0; g < 4; ++g) {
                    const int m = mbase + mb * 32 + fr, n = nb0 + nb * 32 + 8 * g + 4 * fh;
                    float v[4];
#pragma unroll
                    for (int e = 0; e < 4; ++e) { v[e] = acc[mb][nb][4 * g + e]; if (isz) v[e] = silu_f(v[e]); }
                    u32x2 o; o.x = cvt_pk_bf16(v[0], v[1]); o.y = cvt_pk_bf16(v[2], v[3]);
                    if ((g & 1) == 0) keep = o; else put8(wl, mb * 32 + fr, nb * 4 + (g - 1) + fh, keep, o);
                }
        flush8<64>(wl, fh * 32 + fr, [&](int r) { return dst + (size_t)(mbase + r) * D + nb0; });
    }
};

struct EpiChanDft {
    bf16_t* VT; int g;
    DEVI void operator()(const f32x16 (&acc)[2][2], int mbase, int nbase, int fr, int fh, unsigned char* wl) const {
        int S, bgi, s0; bf16_t* base;
        if (nbase < NCTX) { S = 256; bgi = (nbase >> 8) * 4 + g; s0 = nbase & 255; base = VT; }
        else { const int t = nbase - NCTX; S = 1024; bgi = (t >> 10) * 4 + g; s0 = t & 1023; base = VT + (size_t)64 * 256 * 512; }
        u32x2 keep = {0u, 0u};
#pragma unroll
        for (int mb = 0; mb < 2; ++mb)
#pragma unroll
            for (int nb = 0; nb < 2; ++nb)
#pragma unroll
                for (int gq = 0; gq < 4; ++gq) {
                    const int m = mbase + mb * 32 + fr, which = m >> 8, cp = m & 255;
                    const int s = s0 + nb * 32 + 8 * gq + 4 * fh;
                    u32x2 o; o.x = cvt_pk_bf16(acc[mb][nb][4 * gq], acc[mb][nb][4 * gq + 1]); o.y = cvt_pk_bf16(acc[mb][nb][4 * gq + 2], acc[mb][nb][4 * gq + 3]);
                    if ((gq & 1) == 0) keep = o; else put8(wl, mb * 32 + fr, nb * 4 + (gq - 1) + fh, keep, o);
                }
        flush8<64>(wl, fh * 32 + fr, [&](int r) { const int m = mbase + r; return base + ((size_t)bgi * 256 + (m & 255)) * (2 * S) + (m >> 8) * S + s0; });
    }
};

template <int MB> struct EpiSeqDft {
    const bf16_t* SZ; bf16_t* Y; int tok0, g;
    DEVI void operator()(const f32x16 (&acc)[MB][2], int mbase, int nbase, int fr, int fh, unsigned char* wl) const {
        u32x2 keep = {0u, 0u};
#pragma unroll
        for (int mb = 0; mb < MB; ++mb)
#pragma unroll
            for (int nb = 0; nb < 2; ++nb)
#pragma unroll
                for (int gq = 0; gq < 4; ++gq) {
                    const int tok = tok0 + mbase + mb * 32 + fr;
                    const int col = g * 256 + nbase + nb * 32 + 8 * gq + 4 * fh;
                    const u32x2 z = *(const u32x2*)(SZ + (size_t)tok * D + col);
                    const float z0 = __uint_as_float(z.x << 16), z1 = __uint_as_float(z.x & 0xffff0000u);
                    const float z2 = __uint_as_float(z.y << 16), z3 = __uint_as_float(z.y & 0xffff0000u);
                    u32x2 o; o.x = cvt_pk_bf16(acc[mb][nb][4 * gq] * z0, acc[mb][nb][4 * gq + 1] * z1);
                    o.y = cvt_pk_bf16(acc[mb][nb][4 * gq + 2] * z2, acc[mb][nb][4 * gq + 3] * z3);
                    if ((gq & 1) == 0) keep = o; else put8(wl, mb * 32 + fr, nb * 4 + (gq - 1) + fh, keep, o);
                }
        flush8<32 * MB>(wl, fh * 32 + fr, [&](int r) { return Y + (size_t)(tok0 + mbase + r) * D + g * 256 + nbase; });
    }
};

#define DPP_ADD(x, CTRL) ((x) + __uint_as_float((unsigned)__builtin_amdgcn_update_dpp(0, (int)__float_as_uint(x), CTRL, 0xF, 0xF, true)))
DEVI float row16_sum(float x) {
    x = DPP_ADD(x, 0xB1);
    x = DPP_ADD(x, 0x4E);
    x = DPP_ADD(x, 0x141);
    x = DPP_ADD(x, 0x140);
    return x;
}
template <bool NEXT, int MB> struct EpiOut {
    const float* xa; const float* xb;
    const float* mod;
    float* out;
    const float* nw1; const float* mod1; bf16_t* Hn; float* rowss;
    DEVI void operator()(const f32x16 (&acc)[MB][2], int mbase, int nbase, int fr, int fh, unsigned char* wl) const {
        const int lane = fh * 32 + fr, c4 = lane & 15, rsub = lane >> 4;
        const int cv = cond_of(mbase);
        const int n = nbase + c4 * 4;
        const f32x4 gv = *(const f32x4*)(mod + cv * 3072 + 2048 + n);
        f32x4 hv = {0.f, 0.f, 0.f, 0.f};
        if (NEXT) {
            const f32x4 w = *(const f32x4*)(nw1 + n);
            const f32x4 sc = *(const f32x4*)(mod1 + cv * 3072 + 1024 + n);
#pragma unroll
            for (int e = 0; e < 4; ++e) hv[e] = w[e] * (1.f + sc[e]);
        }
#pragma unroll
        for (int mb = 0; mb < MB; ++mb) {
#pragma unroll
            for (int nb = 0; nb < 2; ++nb)
#pragma unroll
                for (int g = 0; g < 4; ++g) {
                    f32x4 a = {acc[mb][nb][4 * g], acc[mb][nb][4 * g + 1], acc[mb][nb][4 * g + 2], acc[mb][nb][4 * g + 3]};
                    *(f32x4*)(wl + fr * 256 + (((nb * 8 + 2 * g + fh) ^ (fr & 15)) << 4)) = a;
                }
#pragma unroll
            for (int i = 0; i < 8; ++i) {
                const int r = i * 4 + rsub, m = mbase + mb * 32 + r;
                const f32x4 a = *(const f32x4*)(wl + r * 256 + ((c4 ^ (r & 15)) << 4));
                const float* xr = m < NCTX ? xa + (size_t)m * D : xb + (size_t)(m - NCTX) * D;
                const f32x4 xv = *(const f32x4*)(xr + n);
                f32x4 o;
#pragma unroll
                for (int e = 0; e < 4; ++e) o[e] = xv[e] + gv[e] * a[e];
                *(f32x4*)(out + (size_t)m * D + n) = o;
                if (NEXT) {
                    float ss = (o[0] * o[0] + o[1] * o[1]) + (o[2] * o[2] + o[3] * o[3]);
                    ss = row16_sum(ss);
                    if (c4 == 0) atomicAdd(rowss + m, ss);
                    u32x2 hb; hb.x = cvt_pk_bf16(o[0] * hv[0], o[1] * hv[1]); hb.y = cvt_pk_bf16(o[2] * hv[2], o[3] * hv[3]);
                    *(u32x2*)(Hn + (size_t)m * D + n) = hb;
                }
            }
        }
    }
};

struct EpiInL1 {
    const float *qnw, *knw, *ropec, *ropes;
    bf16_t *Q, *KB, *VTB, *SZ;
    float *outk, *outv;
    const float* rowss; const float* bias1;
    DEVI void operator()(const f32x16 (&acc_in)[2][2], int mbase, int nbase, int fr, int fh, unsigned char* wl) const {
        const bool lat = mbase >= NCTX;
        u32x2 keep1 = {0u, 0u}, keep2 = {0u, 0u};
        f32x16 acc[2][2];
        {
            const float* bp = bias1 + cond_of(mbase) * 2560 + nbase;
#pragma unroll
            for (int mb = 0; mb < 2; ++mb) {
                const float rstd = rsqrtf(rowss[mbase + mb * 32 + fr] * (1.f / 1024.f) + EPSV);
#pragma unroll
                for (int nb = 0; nb < 2; ++nb)
#pragma unroll
                    for (int g = 0; g < 4; ++g) {
                        const f32x4 bv = *(const f32x4*)(bp + nb * 32 + 8 * g + 4 * fh);
#pragma unroll
                        for (int e = 0; e < 4; ++e) acc[mb][nb][4 * g + e] = acc_in[mb][nb][4 * g + e] * rstd + bv[e];
                    }
            }
        }
        if (nbase < 1280) {
            const bool isq = nbase < 1024;
            const float* nwp = isq ? qnw : knw;
#pragma unroll
            for (int mb = 0; mb < 2; ++mb) {
                const int m = mbase + mb * 32 + fr;
                float ss = 0.f;
#pragma unroll
                for (int nb = 0; nb < 2; ++nb)
#pragma unroll
                    for (int r = 0; r < 16; ++r) ss += acc[mb][nb][r] * acc[mb][nb][r];
                ss = xhalf_sum(ss);
                const float rn = rsqrtf(ss * (1.f / 64.f) + EPSV);
                const int pos = lat ? ((m - NCTX) & 1023) : 0;
#pragma unroll
                for (int g = 0; g < 4; ++g) {
                    const int d0 = 8 * g + 4 * fh;
                    const f32x4 w1 = *(const f32x4*)(nwp + d0), w2 = *(const f32x4*)(nwp + 32 + d0);
                    float x1[4], x2[4];
#pragma unroll
                    for (int e = 0; e < 4; ++e) { x1[e] = acc[mb][0][4 * g + e] * rn * w1[e]; x2[e] = acc[mb][1][4 * g + e] * rn * w2[e]; }
                    if (lat) {
                        const f32x4 cv = *(const f32x4*)(ropec + pos * 32 + d0), sv = *(const f32x4*)(ropes + pos * 32 + d0);
#pragma unroll
                        for (int e = 0; e < 4; ++e) { const float a = x1[e], b = x2[e]; x1[e] = a * cv[e] - b * sv[e]; x2[e] = a * sv[e] + b * cv[e]; }
                    }
                    if (isq) {
                        const float qs = 0.125f * LOG2E;
                        u32x2 o1, o2;
                        o1.x = cvt_pk_bf16(x1[0] * qs, x1[1] * qs); o1.y = cvt_pk_bf16(x1[2] * qs, x1[3] * qs);
                        o2.x = cvt_pk_bf16(x2[0] * qs, x2[1] * qs); o2.y = cvt_pk_bf16(x2[2] * qs, x2[3] * qs);
                        if ((g & 1) == 0) { keep1 = o1; keep2 = o2; }
                        else { put8(wl, mb * 32 + fr, (g - 1) + fh, keep1, o1); put8(wl, mb * 32 + fr, 4 + (g - 1) + fh, keep2, o2); }
                    } else {
                        const int kc = nbase - 1024;
                        u32x2 o1, o2;
                        o1.x = cvt_pk_bf16(x1[0], x1[1]); o1.y = cvt_pk_bf16(x1[2], x1[3]);
                        o2.x = cvt_pk_bf16(x2[0], x2[1]); o2.y = cvt_pk_bf16(x2[2], x2[3]);
                        if ((g & 1) == 0) { keep1 = o1; keep2 = o2; }
                        else { put8(wl, mb * 32 + fr, (g - 1) + fh, keep1, o1); put8(wl, mb * 32 + fr, 4 + (g - 1) + fh, keep2, o2); }
                        if (!lat) {
                            f32x4 f1 = {x1[0], x1[1], x1[2], x1[3]}, f2 = {x2[0], x2[1], x2[2], x2[3]};
                            *(f32x4*)(outk + (size_t)m * 256 + kc + d0) = f1;
                            *(f32x4*)(outk + (size_t)m * 256 + kc + 32 + d0) = f2;
                        }
                    }
                }
            }
            if (isq) flush8<64>(wl, fh * 32 + fr, [&](int r) { return Q + (size_t)(mbase + r) * D + nbase; });
            else flush8<64>(wl, fh * 32 + fr, [&](int r) { return KB + (size_t)(mbase + r) * 256 + (nbase - 1024); });
        } else if (nbase < 1536) {
            const int vc = nbase - 1280, kvh = vc >> 6;
            bf16_t* vtb; int S, sbase;
            if (!lat) { S = 256; sbase = mbase & 255; vtb = VTB + ((size_t)((mbase >> 8) * 4 + kvh) * 64) * 256; }
            else { const int t = mbase - NCTX; S = 1024; sbase = t & 1023; vtb = VTB + (size_t)16 * 4 * 64 * 256 + ((size_t)((t >> 10) * 4 + kvh) * 64) * 1024; }
#pragma unroll
            for (int mb = 0; mb < 2; ++mb) {
                const int m = mbase + mb * 32 + fr;
                const int cpos = swap23(mb * 32 + fr);
                unsigned char* wcol = wl + ((cpos & 7) << 1);
                const int cch = cpos >> 3;
#pragma unroll
                for (int nb = 0; nb < 2; ++nb)
#pragma unroll
                    for (int g = 0; g < 4; ++g) {
                        const int d0 = nb * 32 + 8 * g + 4 * fh;
#pragma unroll
                        for (int e = 0; e < 4; ++e) { const int d = d0 + e; *(bf16_t*)(wcol + d * 128 + ((cch ^ (d & 7)) << 4)) = f2bf(acc[mb][nb][4 * g + e]); }
                        if (!lat) {
                            f32x4 f = {acc[mb][nb][4 * g], acc[mb][nb][4 * g + 1], acc[mb][nb][4 * g + 2], acc[mb][nb][4 * g + 3]};
                            *(f32x4*)(outv + (size_t)m * 256 + vc + d0) = f;
                        }
                    }
            }
            flush8<64>(wl, fh * 32 + fr, [&](int r) { return vtb + (size_t)r * S + sbase; });
        } else {
            const int zc = nbase - 1536;
#pragma unroll
            for (int mb = 0; mb < 2; ++mb)
#pragma unroll
                for (int nb = 0; nb < 2; ++nb)
#pragma unroll
                    for (int g = 0; g < 4; ++g) {
                        const int m = mbase + mb * 32 + fr, n = zc + nb * 32 + 8 * g + 4 * fh;
                        u32x2 o; o.x = cvt_pk_bf16(silu_f(acc[mb][nb][4 * g]), silu_f(acc[mb][nb][4 * g + 1]));
                        o.y = cvt_pk_bf16(silu_f(acc[mb][nb][4 * g + 2]), silu_f(acc[mb][nb][4 * g + 3]));
                        if ((g & 1) == 0) keep1 = o; else put8(wl, mb * 32 + fr, nb * 4 + (g - 1) + fh, keep1, o);
                    }
            flush8<64>(wl, fh * 32 + fr, [&](int r) { return SZ + (size_t)(mbase + r) * D + zc; });
        }
    }
};

DEVI void attn_item(const Params& p, int item, unsigned char* lds) {
    const int lane = threadIdx.x & 63, w = threadIdx.x >> 6, fr = lane & 31, fh = lane >> 5;
    const bf16_t* Q = (const bf16_t*)(p.ws + WS_Q);
    const bf16_t* KB = (const bf16_t*)(p.ws + WS_KB);
    const bf16_t* VTB = (const bf16_t*)(p.ws + WS_VTB);
    const bf16_t* KC = (const bf16_t*)(p.ws + WS_KC);
    const bf16_t* VCT = (const bf16_t*)(p.ws + WS_VCT);
    const bf16_t* SZ = (const bf16_t*)(p.ws + WS_SZ);
    bf16_t* Y = (bf16_t*)(p.ws + WS_Y);
    bool lat; int b, kvh, qb, tb;
    if (item < 256) { lat = true; b = item >> 7; kvh = (item >> 5) & 3; qb = item & 31; tb = NCTX + b * 1024; }
    else { const int it = item - 256; lat = false; b = it >> 5; kvh = (it >> 3) & 3; qb = it & 7; tb = b * 256; }
    const int head = kvh * 4 + w;
    const int qtok = tb + qb * 32 + fr;
    bf16x8 qf[4];
#pragma unroll
    for (int ks = 0; ks < 4; ++ks) qf[ks] = *(const bf16x8*)(Q + (size_t)qtok * D + head * 64 + ks * 16 + fh * 8);
    float m_run = p.sink[head] * LOG2E, l_run = 1.f;
    f32x16 O[2];
#pragma unroll
    for (int i = 0; i < 2; ++i)
#pragma unroll
        for (int r = 0; r < 16; ++r) O[i][r] = 0.f;

    int nloc, k_lo = 0; const bf16_t *kloc, *vloc; int ldloc;
    if (lat) {
        k_lo = qb - 4 < 0 ? 0 : qb - 4; const int k_hi = qb + 4 > 31 ? 31 : qb + 4; nloc = k_hi - k_lo + 1;
        kloc = KB + (size_t)(tb + k_lo * 32) * 256 + kvh * 64;
        vloc = VTB + (size_t)16 * 4 * 64 * 256 + ((size_t)(b * 4 + kvh) * 64) * 1024 + k_lo * 32; ldloc = 1024;
    } else {
        nloc = 8; kloc = KB + (size_t)tb * 256 + kvh * 64; vloc = VTB + ((size_t)(b * 4 + kvh) * 64) * 256; ldloc = 256;
    }
    const int nblk = lat ? nloc + 8 : 8;
    const bf16_t* kcb = KC + (size_t)(b * 256) * 256 + kvh * 64;
    const bf16_t* vcb = VCT + ((size_t)(b * 4 + kvh) * 64) * 256;
    const int tid = threadIdx.x;
    const int kkey = tid >> 3, kch = tid & 7, vd = tid >> 2, vch = tid & 3;
    const unsigned kst = kkey * 128 + ((kch ^ ((kkey >> 1) & 7)) << 4), vst = 4096 + vd * 64 + ((vch ^ ((vd >> 2) & 3)) << 4);
    const unsigned ksw = (fr >> 1) & 7, vsw = (fr >> 2) & 3;
    u32x4 kA, vA, kB, vB;
#define LOADKV(j, KR, VR) { const bf16_t *kp_, *vp_; int ldv_; \
        if ((j) < nloc) { kp_ = kloc + (size_t)(j) * 32 * 256; vp_ = vloc + (j) * 32; ldv_ = ldloc; } \
        else { const int c_ = (j) - nloc; kp_ = kcb + (size_t)c_ * 32 * 256; vp_ = vcb + c_ * 32; ldv_ = 256; } \
        KR = *(const u32x4*)(kp_ + (size_t)kkey * 256 + kch * 8); VR = *(const u32x4*)(vp_ + (size_t)vd * ldv_ + vch * 8); }
    auto compute = [&](int j) {
        const unsigned char* lb = lds + (j & 1) * 8192;
        bf16x8 kf[4], vf[4];
#pragma unroll
        for (int ks = 0; ks < 4; ++ks) kf[ks] = *(const bf16x8*)(lb + fr * 128 + (((2 * ks + fh) ^ ksw) << 4));
#pragma unroll
        for (int s2 = 0; s2 < 2; ++s2)
#pragma unroll
            for (int db = 0; db < 2; ++db) vf[s2 * 2 + db] = *(const bf16x8*)(lb + 4096 + (db * 32 + fr) * 64 + (((2 * s2 + fh) ^ vsw) << 4));
        f32x16 s;
#pragma unroll
        for (int r = 0; r < 16; ++r) s[r] = 0.f;
#pragma unroll
        for (int ks = 0; ks < 4; ++ks) s = __builtin_amdgcn_mfma_f32_32x32x16_bf16(kf[ks], qf[ks], s, 0, 0, 0);
        if (lat && j < nloc) {
            const int kb = k_lo + j;
            const int mode = (kb == qb - 4) ? 1 : (kb == qb + 4) ? 2 : 0;
            if (mode) {
                const int dpos = (kb - qb) * 32;
#pragma unroll
                for (int r = 0; r < 16; ++r) {
                    const int rel = dpos + (r & 3) + 8 * (r >> 2) + 4 * fh - fr;
                    const bool ok = mode == 1 ? (rel >= -128) : (rel <= 128);
                    if (!ok) s[r] = -1e30f;
                }
            }
        }
        float mx = s[0];
#pragma unroll
        for (int r = 1; r < 16; ++r) mx = fmaxf(mx, s[r]);
        mx = xhalf_max(mx);
        const float m_new = fmaxf(m_run, mx);
        const float alpha = __builtin_amdgcn_exp2f(m_run - m_new);
        float rs = 0.f;
#pragma unroll
        for (int r = 0; r < 16; ++r) { s[r] = __builtin_amdgcn_exp2f(s[r] - m_new); rs += s[r]; }
        rs = xhalf_sum(rs);
        l_run = l_run * alpha + rs; m_run = m_new;
#pragma unroll
        for (int i = 0; i < 2; ++i)
#pragma unroll
            for (int r = 0; r < 16; ++r) O[i][r] *= alpha;
#pragma unroll
        for (int s2 = 0; s2 < 2; ++s2) {
            union { u32x4 u; bf16x8 v; } pf;
            pf.u.x = cvt_pk_bf16(s[8 * s2 + 0], s[8 * s2 + 1]); pf.u.y = cvt_pk_bf16(s[8 * s2 + 2], s[8 * s2 + 3]);
            pf.u.z = cvt_pk_bf16(s[8 * s2 + 4], s[8 * s2 + 5]); pf.u.w = cvt_pk_bf16(s[8 * s2 + 6], s[8 * s2 + 7]);
#pragma unroll
            for (int db = 0; db < 2; ++db) O[db] = __builtin_amdgcn_mfma_f32_32x32x16_bf16(vf[s2 * 2 + db], pf.v, O[db], 0, 0, 0);
        }
    };
    LOADKV(0, kA, vA)
    *(u32x4*)(lds + kst) = kA; *(u32x4*)(lds + vst) = vA;
    if (nblk > 1) LOADKV(1, kA, vA)
    if (nblk > 2) LOADKV(2, kB, vB)
    __syncthreads();
    for (int j = 0; j < nblk; j += 2) {
        compute(j);
        if (j + 1 < nblk) { *(u32x4*)(lds + 8192 + kst) = kA; *(u32x4*)(lds + 8192 + vst) = vA; }
        if (j + 3 < nblk) LOADKV(j + 3, kA, vA)
        __syncthreads();
        if (j + 1 < nblk) {
            compute(j + 1);
            if (j + 2 < nblk) { *(u32x4*)(lds + kst) = kB; *(u32x4*)(lds + vst) = vB; }
            if (j + 4 < nblk) LOADKV(j + 4, kB, vB)
            __syncthreads();
        }
    }
#undef LOADKV
    const float il = 1.f / l_run;
    u32x2 keepy = {0u, 0u};
#pragma unroll
    for (int db = 0; db < 2; ++db)
#pragma unroll
        for (int g = 0; g < 4; ++g) {
            const int col = head * 64 + db * 32 + 8 * g + 4 * fh;
            const u32x2 z = *(const u32x2*)(SZ + (size_t)qtok * D + col);
            const float z0 = __uint_as_float(z.x << 16), z1 = __uint_as_float(z.x & 0xffff0000u);
            const float z2 = __uint_as_float(z.y << 16), z3 = __uint_as_float(z.y & 0xffff0000u);
            u32x2 o; o.x = cvt_pk_bf16(O[db][4 * g] * il * z0, O[db][4 * g + 1] * il * z1);
            o.y = cvt_pk_bf16(O[db][4 * g + 2] * il * z2, O[db][4 * g + 3] * il * z3);
            if ((g & 1) == 0) keepy = o; else put8(lds + w * 8192, fr, db * 4 + (g - 1) + fh, keepy, o);
        }
    flush8<32>(lds + w * 8192, lane, [&](int r) { return Y + (size_t)(tb + qb * 32 + r) * D + head * 64; });
    __syncthreads();
}


#define XB_TMO      128
#define XB_XCNT(j)  (256  + 64 * (j))
#define XB_XSUB(j)  (1280 + 64 * (j))
#define XB_XGEN(j)  (2304 + 64 * (j))
#define XB_TOP      3328
#define XB_TOPGEN   3392
#define XCD_BAR_WORDS 3456
#define XB_SPIN_CAP (1u << 18)
#define LAS __attribute__((address_space(3)))
DEVI unsigned xb_ld(unsigned* p)              { return __hip_atomic_load(p, __ATOMIC_RELAXED, __HIP_MEMORY_SCOPE_AGENT); }
DEVI unsigned xb_add(unsigned* p, unsigned v) { return __hip_atomic_fetch_add(p, v, __ATOMIC_RELAXED, __HIP_MEMORY_SCOPE_AGENT); }
DEVI unsigned xb_xcc_id() { return (unsigned)__builtin_amdgcn_s_getreg((3 << 11) | 20) & 0xFu; }
#define XB_SPIN(cond, bar) do { unsigned _sp = 0; while (cond) { __builtin_amdgcn_s_sleep(1); \
    if ((++_sp & 255u) == 0u) { if (xb_ld(&(bar)[XB_TMO])) break; if (_sp > XB_SPIN_CAP) { atomicAdd(&(bar)[XB_TMO], 1u); break; } } } } while (0)
struct XcdBarrier { unsigned* bar; unsigned x; volatile LAS unsigned* st; };
DEVI XcdBarrier xcd_barrier_post(unsigned* bar, volatile LAS unsigned* st) {
    XcdBarrier b; b.bar = bar; b.x = xb_xcc_id(); b.st = st;
    if (threadIdx.x == 0) (void)xb_add(&bar[XB_XCNT(b.x)], 1u);
    return b;
}
DEVI void xcd_barrier_complete(unsigned* bar, unsigned x, unsigned& nloc, unsigned& nx) {
    const unsigned G = gridDim.x * gridDim.y * gridDim.z;
    unsigned sum, cnt, mine, sp = 0u;
    for (;;) {
        sum = 0u; cnt = 0u; mine = 0u;
#pragma unroll
        for (unsigned j = 0; j < 16; ++j) { const unsigned c = xb_ld(&bar[XB_XCNT(j)]); sum += c; cnt += (c > 0u) ? 1u : 0u; mine = (j == x) ? c : mine; }
        if (sum == G) break;
        __builtin_amdgcn_s_sleep(1);
        if ((++sp & 255u) == 0u) { if (xb_ld(&bar[XB_TMO])) break; if (sp > XB_SPIN_CAP) { atomicAdd(&bar[XB_TMO], 1u); break; } }
    }
    nloc = mine > 0u ? mine : 1u; nx = cnt > 0u ? cnt : 1u;
}
DEVI void xcd_barrier(const XcdBarrier& b) {
    asm volatile("s_waitcnt vmcnt(0)" ::: "memory");
    __syncthreads();
    if (threadIdx.x == 0) {
        unsigned* bar = b.bar;
        __builtin_amdgcn_s_waitcnt(0);
        unsigned nloc = b.st[0], nx = b.st[1];
        if (nloc == 0u) { xcd_barrier_complete(bar, b.x, nloc, nx); b.st[0] = nloc; b.st[1] = nx; }
        const unsigned old = xb_add(&bar[XB_XSUB(b.x)], 1u);
        const unsigned gen = old / nloc;
        if (old + 1u == (gen + 1u) * nloc) {
            __builtin_amdgcn_fence(__ATOMIC_RELEASE, "agent");
            asm volatile("s_waitcnt vmcnt(0)" ::: "memory");
            const unsigned og = xb_add(&bar[XB_TOP], 1u);
            const unsigned tg = og / nx;
            if (og + 1u == (tg + 1u) * nx) xb_add(&bar[XB_TOPGEN], 1u);
            else XB_SPIN(xb_ld(&bar[XB_TOPGEN]) == tg, bar);
            __builtin_amdgcn_fence(__ATOMIC_ACQUIRE, "agent");
            xb_add(&bar[XB_XGEN(b.x)], 1u);
            asm volatile("s_waitcnt vmcnt(0)" ::: "memory");
        } else {
            XB_SPIN(xb_ld(&bar[XB_XGEN(b.x)]) == gen, bar);
            __builtin_amdgcn_fence(__ATOMIC_ACQUIRE, "agent");
            asm volatile("s_waitcnt vmcnt(0)" ::: "memory");
        }
    }
    __syncthreads();
}

DEVI void run_phase(const Params& p, int ph, unsigned char* lds) {
    const int G = gridDim.x;
    bf16_t* H = (bf16_t*)(p.ws + WS_H);
    bf16_t* U = (bf16_t*)(p.ws + WS_U);
    bf16_t* SZ = (bf16_t*)(p.ws + WS_SZ);
    bf16_t* VT = (bf16_t*)(p.ws + WS_VT);
    bf16_t* Y = (bf16_t*)(p.ws + WS_Y);
    float* X1 = (float*)(p.ws + WS_X1);
    const float* mod = (const float*)(p.ws + WS_MOD);
    switch (ph) {
    case 0: {
        phase0(p, lds);
        if (threadIdx.x == 0) {
            unsigned* cnt = (unsigned*)(p.ws + WS_CNT); unsigned sp = 0;
            while (__hip_atomic_load(cnt, __ATOMIC_RELAXED, __HIP_MEMORY_SCOPE_AGENT) < 384u) { __builtin_amdgcn_s_sleep(4); if (++sp > (1u << 22)) break; }
        }
        __syncthreads();
        const float* modp = (const float*)(p.ws + WS_MODP);
        if (blockIdx.x < 72) {
            const int i = blockIdx.x * 256 + threadIdx.x, l = i / 9216, j = i % 3072;
            float s = (l ? p.b_mod1 : p.b_mod0)[j];
#pragma unroll
            for (int ks = 0; ks < 4; ++ks) s += __hip_atomic_load(modp + ks * 18432 + i, __ATOMIC_RELAXED, __HIP_MEMORY_SCOPE_AGENT);
            ((float*)(p.ws + WS_MOD))[i] = s;
        }
        float* lmod = (float*)lds;
        {
            float tmp[24];
#pragma unroll
            for (int q = 0; q < 24; ++q) {
                const int i = threadIdx.x + 256 * q, src_i = (i >> 11) * 3072 + (i & 2047);
                float s = p.b_mod0[i & 2047];
#pragma unroll
                for (int ks = 0; ks < 4; ++ks) s += __hip_atomic_load(modp + ks * 18432 + src_i, __ATOMIC_RELAXED, __HIP_MEMORY_SCOPE_AGENT);
                tmp[q] = s;
            }
#pragma unroll
            for (int q = 0; q < 24; ++q) lmod[threadIdx.x + 256 * q] = tmp[q];
        }
        __syncthreads();
        phase_norm(p, 0, lmod);
    } break;
    case 2: {
        EpiInL0 e{U, SZ};
        const bf16_t* W0 = (const bf16_t*)(p.ws + WS_WT0IN);
        auto run_list = [&](int kind, int a, int bq, int cnt) {
#pragma unroll 1
            for (int i = 0; i < cnt; ++i) {
                int m0v, n0v;
                if (kind == 0) { m0v = a * 128; n0v = bq * 256 + i * 128; }
                else { const int zt = a + i; m0v = (zt >> 3) * 128; n0v = 1024 + (zt & 7) * 128; }
                asm volatile("" : "+s"(m0v), "+s"(n0v));
                gemm_tile(H, D, W0, D, 16, lds, e, m0v, n0v);
            }
            if (kind == 0) {
                __builtin_amdgcn_fence(__ATOMIC_RELEASE, "workgroup");
                asm volatile("s_waitcnt vmcnt(0)" ::: "memory");
                __syncthreads();
                __builtin_amdgcn_fence(__ATOMIC_ACQUIRE, "workgroup");
                EpiChanDft ec{VT, bq};
#pragma unroll 1
                for (int m4 = 0; m4 < 4; ++m4) {
                    int m0v = m4 * 128, n0v = a * 128;
                    asm volatile("" : "+s"(m0v), "+s"(n0v));
                    gemm_tile((const bf16_t*)(p.ws + WS_TW256), 256, U + bq * 256, D, 4, lds, ec, m0v, n0v);
                }
            }
        };
        if (G == 512) {
            const int b = blockIdx.x;
            if (b < 192) { const int tt = (b & 7) * 24 + (b >> 3); run_list(0, tt >> 2, tt & 3, 2); }
            else if (b < 256) run_list(1, 3 * (b - 192), 0, 3);
            else if (b < 448) { const int l = b - 256; run_list(1, 192 + (l & 7) * 24 + (l >> 3), 0, 1); }
            else bias1_items(p, b - 448, 64);
        } else {
            for (int it = blockIdx.x; it < 576; it += G) { if (it < 192) run_list(0, it >> 2, it & 3, 2); else run_list(1, it - 192, 0, 1); }
            bias1_items(p, blockIdx.x, G);
        }
    } break;
    case 4: {
        for (int t = blockIdx.x; t < 512; t += G) {
            if (t < 256) {
                const int nt = t & 1, mt = (t >> 1) & 15, bg = t >> 5;
                EpiSeqDft<1> e{SZ, Y, NCTX + (bg >> 2) * 1024, bg & 3};
                gemm_tile<1>((const bf16_t*)(p.ws + WS_TS1024), 2048, VT + (size_t)64 * 256 * 512 + (size_t)bg * 256 * 2048, 2048, 32, lds, e, mt * 64, nt * 128);
            } else {
                const int u = t - 256, nt = u & 1, mt = (u >> 1) & 1, bg = u >> 2;
                EpiSeqDft<2> e{SZ, Y, (bg >> 2) * 256, bg & 3};
                gemm_tile<2>((const bf16_t*)(p.ws + WS_TS256), 512, VT + (size_t)bg * 256 * 512, 512, 8, lds, e, mt * 128, nt * 128);
            }
        }
    } break;
    case 5: {
        EpiOut<true, 2> e{p.x_prompt, p.x_sample, mod, X1, p.norm_w1, mod + 3 * 3072, H, (float*)(p.ws + WS_ROWSS)};
        EpiOut<true, 1> e1{p.x_prompt, p.x_sample, mod, X1, p.norm_w1, mod + 3 * 3072, H, (float*)(p.ws + WS_ROWSS)};
        if (G == 512) {
            if (blockIdx.x < 256) { const int tt = xcd_remap(blockIdx.x, 256); gemm_tile<2>(Y, D, (const bf16_t*)(p.ws + WS_WT0OUT), D, 16, lds, e, (tt >> 3) * 128, (tt & 7) * 128); }
            else { const int tt = xcd_remap(blockIdx.x - 256, 256); gemm_tile<1>(Y, D, (const bf16_t*)(p.ws + WS_WT0OUT), D, 16, lds, e1, 4096 + (tt >> 3) * 64, (tt & 7) * 128); }
        } else
        for (int t = blockIdx.x; t < 384; t += G) {
            const int tt = xcd_remap(t, 384);
            gemm_tile(Y, D, (const bf16_t*)(p.ws + WS_WT0OUT), D, 16, lds, e, (tt >> 3) * 128, (tt & 7) * 128);
        }
    } break;
    case 7: {
        EpiInL1 e{p.qnw, p.knw, (const float*)(p.ws + WS_ROPEC), (const float*)(p.ws + WS_ROPES),
                  (bf16_t*)(p.ws + WS_Q), (bf16_t*)(p.ws + WS_KB), (bf16_t*)(p.ws + WS_VTB), SZ,
                  p.out + (size_t)NTOK * D, p.out + (size_t)NTOK * D + (size_t)NCTX * 256,
                  (const float*)(p.ws + WS_ROWSS), (const float*)(p.ws + WS_BIAS1)};
        for (int t = blockIdx.x; t < 960; t += G) {
            const int tt = xcd_remap(t, 960);
            gemm_tile(H, D, (const bf16_t*)(p.ws + WS_WT1IN), D, 16, lds, e, (tt / 20) * 128, (tt % 20) * 128);
        }
    } break;
    case 8: {
        if (G == 512) {
            if (blockIdx.x < 256) attn_item(p, blockIdx.x, lds);
            else { attn_item(p, 256 + 2 * (blockIdx.x - 256), lds); attn_item(p, 257 + 2 * (blockIdx.x - 256), lds); }
        } else
            for (int t = blockIdx.x; t < 768; t += G) attn_item(p, t, lds);
    } break;
    case 9: {
        EpiOut<false, 2> e{X1, X1 + (size_t)NCTX * D, mod + 3 * 3072, p.out, nullptr, nullptr, nullptr, nullptr};
        EpiOut<false, 1> e1{X1, X1 + (size_t)NCTX * D, mod + 3 * 3072, p.out, nullptr, nullptr, nullptr, nullptr};
        if (G == 512) {
            if (blockIdx.x < 256) { const int tt = xcd_remap(blockIdx.x, 256); gemm_tile<2>(Y, D, (const bf16_t*)(p.ws + WS_WT1OUT), D, 16, lds, e, (tt >> 3) * 128, (tt & 7) * 128); }
            else { const int tt = xcd_remap(blockIdx.x - 256, 256); gemm_tile<1>(Y, D, (const bf16_t*)(p.ws + WS_WT1OUT), D, 16, lds, e1, 4096 + (tt >> 3) * 64, (tt & 7) * 128); }
        } else
        for (int t = blockIdx.x; t < 384; t += G) {
            const int tt = xcd_remap(t, 384);
            gemm_tile(Y, D, (const bf16_t*)(p.ws + WS_WT1OUT), D, 16, lds, e, (tt >> 3) * 128, (tt & 7) * 128);
        }
    } break;
    }
}

__global__ void __launch_bounds__(256, 2) mega(Params p) {
    __shared__ __attribute__((aligned(16))) unsigned char lds[65536 + 16];
    cg::grid_group grid = cg::this_grid();
#if SINGLE_LAUNCH
    volatile LAS unsigned* st = (volatile LAS unsigned*)(lds + 65536);
    if (threadIdx.x < 4) st[threadIdx.x] = 0u;
    __syncthreads();
    XcdBarrier bar = xcd_barrier_post((unsigned*)(p.ws + WS_BAR), st);
    if (p.ph_hi == 777) grid.sync();
#ifndef REP_PH
#define REP_PH -1
#endif
#ifndef REP_SY
#define REP_SY 0
#endif
#define PH(n) run_phase(p, n, lds); if (REP_PH == n) run_phase(p, n, lds);
#define SY() xcd_barrier(bar); if (REP_SY) xcd_barrier(bar);
#else
    const int lo = (int)p.ph_lo, hi = (int)p.ph_hi;
#define PH(n) if (lo <= n && n < hi) run_phase(p, n, lds);
#define SY()
#endif
    PH(0) SY() PH(2) SY() PH(4) SY() PH(5) SY() PH(7) SY() PH(8) SY() PH(9)
}

extern "C" void kernel_launch(void* const* d_in, const int* in_sizes, int n_in, void* d_out, int out_size, void* d_ws, size_t ws_size, hipStream_t stream) {
    static int grid_blocks = 0;
    if (!grid_blocks) {
        int dev = 0, cus = 0, per_cu = 0;
        hipGetDevice(&dev);
        hipDeviceGetAttribute(&cus, hipDeviceAttributeMultiprocessorCount, dev);
        hipOccupancyMaxActiveBlocksPerMultiprocessor(&per_cu, mega, 256, 0);
        if (per_cu > 2) per_cu = 2;
        if (per_cu < 1) per_cu = 1;
        grid_blocks = cus * per_cu;
    }
    Params p{};
    const float* const* in = (const float* const*)d_in;
    p.x_prompt = in[0]; p.x_sample = in[1]; p.cache_k = in[2]; p.cache_v = in[3]; p.c = in[4]; p.c_ctx = in[5];
    p.norm_w0 = in[6]; p.w_mod0 = in[7]; p.b_mod0 = in[8]; p.w_in0 = in[9]; p.w_out0 = in[10];
    p.norm_w1 = in[11]; p.w_mod1 = in[12]; p.b_mod1 = in[13]; p.w_in1 = in[14]; p.qnw = in[15]; p.knw = in[16]; p.sink = in[17]; p.w_out1 = in[18];
    p.out = (float*)d_out; p.ws = (unsigned char*)d_ws;
#if SINGLE_LAUNCH
    p.ph_lo = 0; p.ph_hi = 10;
    hipMemsetAsync((unsigned char*)d_ws + WS_BAR, 0, 16384, stream);
    void* args[] = {&p};
    hipError_t e = hipLaunchCooperativeKernel((void*)mega, dim3(grid_blocks), dim3(256), args, 0, stream);
    if (e != hipSuccess) fprintf(stderr, "cooperative launch failed: %s (grid %d)\n", hipGetErrorString(e), grid_blocks);
#else
    for (int ph = 0; ph < 10; ++ph) {
        p.ph_lo = ph; p.ph_hi = ph + 1;
        hipLaunchKernelGGL(mega, dim3(grid_blocks), dim3(256), 0, stream, p);
    }
#endif
}
```

```cpp
#include <hip/hip_runtime.h>
#include <hip/hip_cooperative_groups.h>
#include <stdint.h>
#include <cstdio>
namespace cg = cooperative_groups;

#ifndef SINGLE_LAUNCH
#define SINGLE_LAUNCH 1
#endif

typedef unsigned short bf16_t;
typedef short bf16x8 __attribute__((ext_vector_type(8)));
typedef float f32x16 __attribute__((ext_vector_type(16)));
typedef float f32x4 __attribute__((ext_vector_type(4)));
typedef unsigned u32x4 __attribute__((ext_vector_type(4)));
typedef unsigned u32x2 __attribute__((ext_vector_type(2)));
#define DEVI __device__ __forceinline__

constexpr int NTOK = 6144, NCTX = 4096, D = 1024;
constexpr float EPSV = 1e-6f;
constexpr float LOG2E = 1.4426950408889634f;

constexpr size_t WS_MOD = 0;
constexpr size_t WS_WT0IN = 1 << 20;
constexpr size_t WS_WT0OUT = WS_WT0IN + (size_t)2048 * 1024 * 2;
constexpr size_t WS_WT1IN = WS_WT0OUT + (size_t)1024 * 1024 * 2;
constexpr size_t WS_WT1OUT = WS_WT1IN + (size_t)2560 * 1024 * 2;
constexpr size_t WS_TW256 = WS_WT1OUT + (size_t)1024 * 1024 * 2;
constexpr size_t WS_TS256 = WS_TW256 + (size_t)512 * 256 * 2;
constexpr size_t WS_TS1024 = WS_TS256 + (size_t)256 * 512 * 2;
constexpr size_t WS_ROPEC = WS_TS1024 + (size_t)1024 * 2048 * 2;
constexpr size_t WS_ROPES = WS_ROPEC + (size_t)1024 * 32 * 4;
constexpr size_t WS_KC = WS_ROPES + (size_t)1024 * 32 * 4;
constexpr size_t WS_VCT = WS_KC + (size_t)2 * 256 * 256 * 2;
constexpr size_t WS_H = WS_VCT + (size_t)2 * 256 * 256 * 2;
constexpr size_t WS_U = WS_H + (size_t)NTOK * D * 2;
constexpr size_t WS_SZ = WS_U + (size_t)NTOK * D * 2;
constexpr size_t WS_VT = WS_SZ + (size_t)NTOK * D * 2;
constexpr size_t WS_Y = WS_VT + (size_t)NTOK * 2048 * 2;
constexpr size_t WS_X1 = WS_Y + (size_t)NTOK * D * 2;
constexpr size_t WS_Q = WS_X1 + (size_t)NTOK * D * 4;
constexpr size_t WS_KB = WS_Q + (size_t)NTOK * D * 2;
constexpr size_t WS_VTB = WS_KB + (size_t)NTOK * 256 * 2;
constexpr size_t WS_BAR = WS_VTB + (size_t)NTOK * 256 * 2;
constexpr size_t WS_CNT = WS_BAR + 14336;
constexpr size_t WS_ROWSS = WS_BAR + 16384;
constexpr size_t WS_BIAS1 = WS_ROWSS + 6144 * 4;
constexpr size_t WS_MODP = WS_BIAS1 + 3 * 2560 * 4;
constexpr size_t WS_END = WS_MODP + (size_t)4 * 18432 * 4;

struct Params {
    const float *x_prompt, *x_sample, *cache_k, *cache_v, *c, *c_ctx;
    const float *norm_w0, *w_mod0, *b_mod0, *w_in0, *w_out0;
    const float *norm_w1, *w_mod1, *b_mod1, *w_in1, *qnw, *knw, *sink, *w_out1;
    float* out;
    unsigned char* ws;
    long long ph_lo, ph_hi;
};

DEVI unsigned cvt_pk_bf16(float lo, float hi) { unsigned r; asm("v_cvt_pk_bf16_f32 %0, %1, %2" : "=v"(r) : "v"(lo), "v"(hi)); return r; }
DEVI bf16_t f2bf(float f) { return (bf16_t)(cvt_pk_bf16(f, 0.f) & 0xffffu); }
DEVI float silu_f(float v) { return v * __builtin_amdgcn_rcpf(1.f + __expf(-v)); }
DEVI int swap23(int x) { return (x & ~12) | ((x & 4) << 1) | ((x & 8) >> 1); }
DEVI int cond_of(int m) { return m < NCTX ? 0 : 1 + ((m - NCTX) >> 10); }

DEVI void st8(bf16_t* p, u32x2 a, u32x2 b) {
    const auto r0 = __builtin_amdgcn_permlane32_swap(a.x, b.x, false, false);
    const auto r1 = __builtin_amdgcn_permlane32_swap(a.y, b.y, false, false);
    u32x4 w; w.x = r0[0]; w.y = r1[0]; w.z = r0[1]; w.w = r1[1];
    *(u32x4*)p = w;
}
DEVI void put8(unsigned char* wl, int r, int c, u32x2 a, u32x2 b) {
    const auto r0 = __builtin_amdgcn_permlane32_swap(a.x, b.x, false, false);
    const auto r1 = __builtin_amdgcn_permlane32_swap(a.y, b.y, false, false);
    u32x4 w; w.x = r0[0]; w.y = r1[0]; w.z = r0[1]; w.w = r1[1];
    *(u32x4*)(wl + r * 128 + ((c ^ (r & 7)) << 4)) = w;
}
template <int ROWS, class RowPtr>
DEVI void flush8(const unsigned char* wl, int lane, const RowPtr& rowptr) {
#pragma unroll
    for (int i = 0; i < ROWS / 8; ++i) {
        const int r = i * 8 + (lane >> 3), c = lane & 7;
        const u32x4 w = *(const u32x4*)(wl + r * 128 + ((c ^ (r & 7)) << 4));
        *(u32x4*)(rowptr(r) + c * 8) = w;
    }
}
#define DPP_ADD0(x, CTRL) ((x) + __uint_as_float((unsigned)__builtin_amdgcn_update_dpp(0, (int)__float_as_uint(x), CTRL, 0xF, 0xF, true)))
DEVI float wave_sum(float x) {
    x = DPP_ADD0(x, 0xB1); x = DPP_ADD0(x, 0x4E); x = DPP_ADD0(x, 0x141); x = DPP_ADD0(x, 0x140);
    const auto r = __builtin_amdgcn_permlane16_swap(__float_as_uint(x), __float_as_uint(x), false, false);
    x = __uint_as_float(r[0]) + __uint_as_float(r[1]);
    const auto q = __builtin_amdgcn_permlane32_swap(__float_as_uint(x), __float_as_uint(x), false, false);
    return __uint_as_float(q[0]) + __uint_as_float(q[1]);
}
DEVI float xhalf_sum(float x) { const auto r = __builtin_amdgcn_permlane32_swap(__float_as_uint(x), __float_as_uint(x), false, false); return __uint_as_float(r[0]) + __uint_as_float(r[1]); }
DEVI float xhalf_max(float x) { const auto r = __builtin_amdgcn_permlane32_swap(__float_as_uint(x), __float_as_uint(x), false, false); return fmaxf(__uint_as_float(r[0]), __uint_as_float(r[1])); }

DEVI void glds16(const void* g, void* l) { __builtin_amdgcn_global_load_lds(g, l, 16, 0, 0); }

template <int MB = 2, class Epi>
DEVI void gemm_tile(const bf16_t* __restrict__ A, int lda, const bf16_t* __restrict__ B, int ldb, int nk,
                    unsigned char* lds, const Epi& epi, int m0, int n0) {
    const int tid = threadIdx.x, lane = tid & 63, wid = tid >> 6, wr = wid >> 1, wc = wid & 1;
    const int srow = tid >> 3;
    const int slc = (tid & 7) ^ ((tid >> 4) & 7);
    const bf16_t* gA = A + (size_t)(m0 + srow) * lda + slc * 8;
    const bf16_t* gB = B + (size_t)(n0 + srow) * ldb + slc * 8;
    const int fr = lane & 31, fh = lane >> 5, sw = (lane >> 1) & 7;
    const unsigned aoff = (wr * 32 * MB + fr) * 128, boff = 16384 + (wc * 64 + fr) * 128;
    f32x16 acc[MB][2];
#pragma unroll
    for (int i = 0; i < MB; ++i)
#pragma unroll
        for (int j = 0; j < 2; ++j)
#pragma unroll
            for (int r = 0; r < 16; ++r) acc[i][j][r] = 0.f;
    {
        unsigned char* la = lds + tid * 16;
#pragma unroll
        for (int i = 0; i < 4; ++i) {
            if (i < 2 * MB) glds16(gA + (size_t)i * 32 * lda, la + i * 4096);
            glds16(gB + (size_t)i * 32 * ldb, la + 16384 + i * 4096);
        }
        la += 32768;
#pragma unroll
        for (int i = 0; i < 4; ++i) {
            if (i < 2 * MB) glds16(gA + (size_t)i * 32 * lda + 64, la + i * 4096);
            glds16(gB + (size_t)i * 32 * ldb + 64, la + 16384 + i * 4096);
        }
    }
    for (int kt = 0; kt < nk; ++kt) {
        if (kt == 0) {
            if (MB == 2) asm volatile("s_waitcnt vmcnt(8) lgkmcnt(0)" ::: "memory"); else asm volatile("s_waitcnt vmcnt(6) lgkmcnt(0)" ::: "memory");
            __builtin_amdgcn_sched_barrier(0); __builtin_amdgcn_s_barrier(); __builtin_amdgcn_sched_barrier(0);
        } else {
            asm volatile("s_waitcnt vmcnt(0)" ::: "memory");
            __syncthreads();
        }
        if (kt >= 1 && kt + 1 < nk) {
            unsigned char* la = lds + ((kt + 1) & 1) * 32768 + tid * 16;
            const int ko = (kt + 1) * 64;
#pragma unroll
            for (int i = 0; i < 4; ++i) {
                if (i < 2 * MB) glds16(gA + (size_t)i * 32 * lda + ko, la + i * 4096);
                glds16(gB + (size_t)i * 32 * ldb + ko, la + 16384 + i * 4096);
            }
        }
        const unsigned char* base = lds + (kt & 1) * 32768;
        bf16x8 af[4][2], bfr[4][2];
#define LDFRAG(ks) { const int ch = ((2 * (ks) + fh) ^ sw) * 16; \
            af[ks][0] = *(const bf16x8*)(base + aoff + ch); bfr[ks][0] = *(const bf16x8*)(base + boff + ch); \
            bfr[ks][1] = *(const bf16x8*)(base + boff + 4096 + ch); if (MB == 2) af[ks][1] = *(const bf16x8*)(base + aoff + 4096 + ch); }
#define MFMA4(ks) { acc[0][0] = __builtin_amdgcn_mfma_f32_32x32x16_bf16(bfr[ks][0], af[ks][0], acc[0][0], 0, 0, 0); \
            acc[0][1] = __builtin_amdgcn_mfma_f32_32x32x16_bf16(bfr[ks][1], af[ks][0], acc[0][1], 0, 0, 0); \
            if (MB == 2) { acc[MB - 1][0] = __builtin_amdgcn_mfma_f32_32x32x16_bf16(bfr[ks][0], af[ks][1], acc[MB - 1][0], 0, 0, 0); \
            acc[MB - 1][1] = __builtin_amdgcn_mfma_f32_32x32x16_bf16(bfr[ks][1], af[ks][1], acc[MB - 1][1], 0, 0, 0); } }
        LDFRAG(0) LDFRAG(1)
        __builtin_amdgcn_sched_barrier(0);
        MFMA4(0) LDFRAG(2)
        __builtin_amdgcn_sched_barrier(0);
        MFMA4(1) LDFRAG(3)
        __builtin_amdgcn_sched_barrier(0);
        MFMA4(2)
        __builtin_amdgcn_sched_barrier(0);
        MFMA4(3)
#undef LDFRAG
#undef MFMA4
    }
    epi(acc, m0 + wr * 32 * MB, n0 + wc * 64, fr, fh, lds + wid * 8192);
    __syncthreads();
}

DEVI int xcd_remap(int t, int T) { return (t & 7) * (T >> 3) + (t >> 3); }

DEVI void mod_item(const Params& p, int it, unsigned char* lds) {
    const int tid = threadIdx.x;
    const int ks = it & 3, lc = it >> 2, l = lc / 48, cc = lc % 48;
    float* sc = (float*)lds;
    for (int i = tid; i < 768; i += 256) {
        const int cv = i >> 8, k = ks * 256 + (i & 255);
        const float cval = cv == 0 ? p.c_ctx[k] : p.c[(cv - 1) * 1024 + k];
        sc[i] = silu_f(cval);
    }
    __syncthreads();
    const float* W = (l ? p.w_mod1 : p.w_mod0) + (size_t)ks * 256 * 3072;
    const int cg4 = tid & 15, rg = tid >> 4, c0 = cc * 64 + cg4 * 4;
    f32x4 w[16];
#pragma unroll
    for (int i = 0; i < 16; ++i) w[i] = *(const f32x4*)(W + (size_t)(rg + 16 * i) * 3072 + c0);
    f32x4 a0 = {0.f, 0.f, 0.f, 0.f}, a1 = a0, a2 = a0;
#pragma unroll
    for (int i = 0; i < 16; ++i) { const int k = rg + 16 * i; a0 += sc[k] * w[i]; a1 += sc[256 + k] * w[i]; a2 += sc[512 + k] * w[i]; }
    float* red = (float*)(lds + 12288);
#pragma unroll
    for (int e = 0; e < 4; ++e) {
        red[(rg * 3 + 0) * 64 + cg4 * 4 + e] = a0[e];
        red[(rg * 3 + 1) * 64 + cg4 * 4 + e] = a1[e];
        red[(rg * 3 + 2) * 64 + cg4 * 4 + e] = a2[e];
    }
    __syncthreads();
    if (tid < 192) {
        const int cv = tid >> 6, j = tid & 63;
        float s = 0.f;
#pragma unroll
        for (int r = 0; r < 16; ++r) s += red[(r * 3 + cv) * 64 + j];
        float* modp = (float*)(p.ws + WS_MODP) + (size_t)ks * 18432;
        __hip_atomic_store(&modp[(l * 3 + cv) * 3072 + cc * 64 + j], s, __ATOMIC_RELAXED, __HIP_MEMORY_SCOPE_AGENT);
    }
    asm volatile("s_waitcnt vmcnt(0)" ::: "memory");
    __syncthreads();
    if (tid == 0) __hip_atomic_fetch_add((unsigned*)(p.ws + WS_CNT), 1u, __ATOMIC_RELAXED, __HIP_MEMORY_SCOPE_AGENT);
}

struct TrDesc { const float* src; bf16_t* dst; int N, kt, nt; };
DEVI TrDesc tr_desc(const Params& p, int idx) {
    TrDesc d;
    if (idx < 512) { d.src = p.w_in0; d.dst = (bf16_t*)(p.ws + WS_WT0IN); d.N = 2048; }
    else if (idx < 768) { idx -= 512; d.src = p.w_out0; d.dst = (bf16_t*)(p.ws + WS_WT0OUT); d.N = 1024; }
    else if (idx < 1408) { idx -= 768; d.src = p.w_in1; d.dst = (bf16_t*)(p.ws + WS_WT1IN); d.N = 2560; }
    else { idx -= 1408; d.src = p.w_out1; d.dst = (bf16_t*)(p.ws + WS_WT1OUT); d.N = 1024; }
    const int ntn = d.N >> 6;
    d.kt = idx / ntn; d.nt = idx % ntn;
    return d;
}
DEVI void transpose_items(const Params& p, int first, int end, int stride, unsigned char* lds) {
    const int tid = threadIdx.x;
    float* tl = (float*)lds;
    if (first >= end) return;
    f32x4 v[4];
    TrDesc d = tr_desc(p, first);
#pragma unroll
    for (int pass = 0; pass < 4; ++pass) v[pass] = *(const f32x4*)(d.src + (size_t)(d.kt * 64 + pass * 16 + (tid >> 4)) * d.N + d.nt * 64 + (tid & 15) * 4);
    for (int idx = first; idx < end; idx += stride) {
#pragma unroll
        for (int pass = 0; pass < 4; ++pass) {
            const int r = pass * 16 + (tid >> 4), c4 = (tid & 15) * 4;
#pragma unroll
            for (int e = 0; e < 4; ++e) tl[r * 65 + c4 + e] = v[pass][e];
        }
        const TrDesc cur = d;
        if (idx + stride < end) {
            d = tr_desc(p, idx + stride);
#pragma unroll
            for (int pass = 0; pass < 4; ++pass) v[pass] = *(const f32x4*)(d.src + (size_t)(d.kt * 64 + pass * 16 + (tid >> 4)) * d.N + d.nt * 64 + (tid & 15) * 4);
        }
        __syncthreads();
#pragma unroll
        for (int pass = 0; pass < 2; ++pass) {
            const int n = pass * 32 + (tid >> 3), kc = tid & 7;
            float x[8];
#pragma unroll
            for (int j = 0; j < 8; ++j) x[j] = tl[(kc * 8 + j) * 65 + n];
            u32x4 w;
            w.x = cvt_pk_bf16(x[0], x[1]); w.y = cvt_pk_bf16(x[2], x[3]); w.z = cvt_pk_bf16(x[4], x[5]); w.w = cvt_pk_bf16(x[6], x[7]);
            *(u32x4*)(cur.dst + (size_t)(cur.nt * 64 + n) * 1024 + cur.kt * 64 + kc * 8) = w;
        }
        __syncthreads();
    }
}

DEVI void phase0(const Params& p, unsigned char* lds) {
    for (int it = blockIdx.x; it < 384; it += gridDim.x) mod_item(p, it, lds);
    transpose_items(p, (blockIdx.x + 128) % gridDim.x, 1664, gridDim.x, lds);
    const int gt = blockIdx.x * 256 + threadIdx.x, gs = gridDim.x * 256;
    bf16_t* tw256 = (bf16_t*)(p.ws + WS_TW256);
    bf16_t* ts256 = (bf16_t*)(p.ws + WS_TS256);
    bf16_t* ts1024 = (bf16_t*)(p.ws + WS_TS1024);
    float* lut = (float*)(lds + 32768);
    __syncthreads();
    for (int r = threadIdx.x; r < 1024; r += 256) lut[r] = cospif((float)r * (1.f / 512.f));
    __syncthreads();
    for (int i = gt; i < 512 * 256; i += gs) {
        const int m = i >> 8, j = i & 255, which = m >> 8, cp = m & 255;
        const int r = ((cp * j) & 255) << 2;
        tw256[i] = f2bf(which ? lut[(r - 256) & 1023] : lut[r]);
    }
    for (int i = gt; i < 256 * 512; i += gs) {
        const int sp = i >> 9, k2 = i & 511, which = k2 >> 8, s0 = k2 & 255;
        const int r = ((sp * s0) & 255) << 2;
        ts256[i] = f2bf((which ? -lut[(r - 256) & 1023] : lut[r]) * (1.f / 256.f));
    }
    for (int i = gt; i < 1024 * 2048; i += gs) {
        const int sp = i >> 11, k2 = i & 2047, which = k2 >> 10, s0 = k2 & 1023;
        const int r = (sp * s0) & 1023;
        ts1024[i] = f2bf((which ? -lut[(r - 256) & 1023] : lut[r]) * (1.f / 512.f));
    }
    float* ropec = (float*)(p.ws + WS_ROPEC);
    float* ropes = (float*)(p.ws + WS_ROPES);
    for (int i = gt; i < 1024 * 32; i += gs) {
        const int pos = i >> 5, f = i & 31;
        const int row = pos >> 6, col = pos & 63;
        const float inv = powf(10000.f, -(float)(f & 15) * (1.f / 16.f));
        const float ang = (float)(f < 16 ? row : col) * inv;
        float s, c; sincosf(ang, &s, &c);
        ropec[i] = c; ropes[i] = s;
    }
    for (int i = gt; i < NTOK; i += gs) ((float*)(p.ws + WS_ROWSS))[i] = 0.f;
    bf16_t* kc = (bf16_t*)(p.ws + WS_KC);
    bf16_t* vct = (bf16_t*)(p.ws + WS_VCT);
    for (int i = gt; i < 2 * 256 * 256; i += gs) {
        kc[i] = f2bf(p.cache_k[i]);
        const int b = i >> 16, kvh = (i >> 14) & 3, d = (i >> 8) & 63, pp = i & 255;
        const int key = swap23(pp);
        vct[i] = f2bf(p.cache_v[((b * 256 + key) * 4 + kvh) * 64 + d]);
    }
}

DEVI void phase_norm(const Params& p, int layer, const float* lmod  ) {
    const int lane = threadIdx.x & 63, wid = threadIdx.x >> 6;
    const float* nw = layer ? p.norm_w1 : p.norm_w0;
    bf16_t* H = (bf16_t*)(p.ws + WS_H);
    const int stride = gridDim.x * 4;
    auto rowptr = [&](int row) -> const float* {
        if (layer == 0) return row < NCTX ? p.x_prompt + (size_t)row * D : p.x_sample + (size_t)(row - NCTX) * D;
        return (const float*)(p.ws + WS_X1) + (size_t)row * D;
    };
    int row = blockIdx.x * 4 + wid;
    if (row >= NTOK) return;
    f32x4 v[4], vn[4];
    {
        const float* xr = rowptr(row);
#pragma unroll
        for (int i = 0; i < 4; ++i) v[i] = *(const f32x4*)(xr + i * 256 + lane * 4);
    }
    for (; row < NTOK; row += stride) {
        const int nrow = row + stride;
        if (nrow < NTOK) {
            const float* xr = rowptr(nrow);
#pragma unroll
            for (int i = 0; i < 4; ++i) vn[i] = *(const f32x4*)(xr + i * 256 + lane * 4);
        }
        const float* mv = lmod + cond_of(row) * 2048;
        float ss = 0.f;
#pragma unroll
        for (int i = 0; i < 4; ++i) ss += v[i][0] * v[i][0] + v[i][1] * v[i][1] + v[i][2] * v[i][2] + v[i][3] * v[i][3];
        ss = wave_sum(ss);
        const float rstd = rsqrtf(ss * (1.f / 1024.f) + EPSV);
#pragma unroll
        for (int i = 0; i < 4; ++i) {
            const int k = i * 256 + lane * 4;
            const f32x4 w = *(const f32x4*)(nw + k);
            const f32x4 sh = *(const f32x4*)(mv + k);
            const f32x4 scl = *(const f32x4*)(mv + 1024 + k);
            float h[4];
#pragma unroll
            for (int e = 0; e < 4; ++e) h[e] = (v[i][e] * rstd * w[e]) * (1.f + scl[e]) + sh[e];
            u32x2 o; o.x = cvt_pk_bf16(h[0], h[1]); o.y = cvt_pk_bf16(h[2], h[3]);
            *(u32x2*)(H + (size_t)row * D + k) = o;
        }
#pragma unroll
        for (int i = 0; i < 4; ++i) v[i] = vn[i];
    }
}

DEVI void bias1_items(const Params& p, int lb, int nb) {
    const int lane = threadIdx.x & 63, gw = lb * 4 + (threadIdx.x >> 6), nw = nb * 4;
    const float* mod1 = (const float*)(p.ws + WS_MOD) + 3 * 3072;
    const bf16_t* WT = (const bf16_t*)(p.ws + WS_WT1IN);
    float* bias1 = (float*)(p.ws + WS_BIAS1);
    for (int n = gw; n < 2560; n += nw) {
        float w[16];
        const u32x4 r0 = *(const u32x4*)(WT + (size_t)n * 1024 + lane * 16), r1 = *(const u32x4*)(WT + (size_t)n * 1024 + lane * 16 + 8);
        const unsigned rr[8] = {r0.x, r0.y, r0.z, r0.w, r1.x, r1.y, r1.z, r1.w};
#pragma unroll
        for (int i = 0; i < 8; ++i) { w[2 * i] = __uint_as_float(rr[i] << 16); w[2 * i + 1] = __uint_as_float(rr[i] & 0xffff0000u); }
        float s[3];
#pragma unroll
        for (int cv = 0; cv < 3; ++cv) {
            float a = 0.f;
#pragma unroll
            for (int q = 0; q < 4; ++q) {
                const f32x4 sh = *(const f32x4*)(mod1 + cv * 3072 + lane * 16 + q * 4);
#pragma unroll
                for (int e = 0; e < 4; ++e) a += sh[e] * w[q * 4 + e];
            }
            s[cv] = wave_sum(a);
        }
        if (lane == 0) { bias1[n] = s[0]; bias1[2560 + n] = s[1]; bias1[5120 + n] = s[2]; }
    }
}

struct EpiInL0 {
    bf16_t *U, *SZ;
    DEVI void operator()(const f32x16 (&acc)[2][2], int mbase, int nbase, int fr, int fh, unsigned char* wl) const {
        const bool isz = nbase >= 1024;
        bf16_t* dst = isz ? SZ : U;
        const int nb0 = isz ? nbase - 1024 : nbase;
        u32x2 keep = {0u, 0u};
#pragma unroll
        for (int mb = 0; mb < 2; ++mb)
#pragma unroll
            for (int nb = 0; nb < 2; ++nb)
#pragma unroll
                for (int g = 0; g < 4; ++g) {
                    const int m = mbase + mb * 32 + fr, n = nb0 + nb * 32 + 8 * g + 4 * fh;
                    float v[4];
#pragma unroll
                    for (int e = 0; e < 4; ++e) { v[e] = acc[mb][nb][4 * g + e]; if (isz) v[e] = silu_f(v[e]); }
                    u32x2 o; o.x = cvt_pk_bf16(v[0], v[1]); o.y = cvt_pk_bf16(v[2], v[3]);
                    if ((g & 1) == 0) keep = o; else put8(wl, mb * 32 + fr, nb * 4 + (g - 1) + fh, keep, o);
                }
        flush8<64>(wl, fh * 32 + fr, [&](int r) { return dst + (size_t)(mbase + r) * D + nb0; });
    }
};

struct EpiChanDft {
    bf16_t* VT; int g;
    DEVI void operator()(const f32x16 (&acc)[2][2], int mbase, int nbase, int fr, int fh, unsigned char* wl) const {
        int S, bgi, s0; bf16_t* base;
        if (nbase < NCTX) { S = 256; bgi = (nbase >> 8) * 4 + g; s0 = nbase & 255; base = VT; }
        else { const int t = nbase - NCTX; S = 1024; bgi = (t >> 10) * 4 + g; s0 = t & 1023; base = VT + (size_t)64 * 256 * 512; }
        u32x2 keep = {0u, 0u};
#pragma unroll
        for (int mb = 0; mb < 2; ++mb)
#pragma unroll
            for (int nb = 0; nb < 2; ++nb)
#pragma unroll
                for (int gq = 0; gq < 4; ++gq) {
                    const int m = mbase + mb * 32 + fr, which = m >> 8, cp = m & 255;
                    const int s = s0 + nb * 32 + 8 * gq + 4 * fh;
                    u32x2 o; o.x = cvt_pk_bf16(acc[mb][nb][4 * gq], acc[mb][nb][4 * gq + 1]); o.y = cvt_pk_bf16(acc[mb][nb][4 * gq + 2], acc[mb][nb][4 * gq + 3]);
                    if ((gq & 1) == 0) keep = o; else put8(wl, mb * 32 + fr, nb * 4 + (gq - 1) + fh, keep, o);
                }
        flush8<64>(wl, fh * 32 + fr, [&](int r) { const int m = mbase + r; return base + ((size_t)bgi * 256 + (m & 255)) * (2 * S) + (m >> 8) * S + s0; });
    }
};

template <int MB> struct EpiSeqDft {
    const bf16_t* SZ; bf16_t* Y; int tok0, g;
    DEVI void operator()(const f32x16 (&acc)[MB][2], int mbase, int nbase, int fr, int fh, unsigned char* wl) const {
        u32x2 keep = {0u, 0u};
#pragma unroll
        for (int mb = 0; mb < MB; ++mb)
#pragma unroll
            for (int nb = 0; nb < 2; ++nb)
#pragma unroll
                for (int gq = 0; gq < 4; ++gq) {
                    const int tok = tok0 + mbase + mb * 32 + fr;
                    const int col = g * 256 + nbase + nb * 32 + 8 * gq + 4 * fh;
                    const u32x2 z = *(const u32x2*)(SZ + (size_t)tok * D + col);
                    const float z0 = __uint_as_float(z.x << 16), z1 = __uint_as_float(z.x & 0xffff0000u);
                    const float z2 = __uint_as_float(z.y << 16), z3 = __uint_as_float(z.y & 0xffff0000u);
                    u32x2 o; o.x = cvt_pk_bf16(acc[mb][nb][4 * gq] * z0, acc[mb][nb][4 * gq + 1] * z1);
                    o.y = cvt_pk_bf16(acc[mb][nb][4 * gq + 2] * z2, acc[mb][nb][4 * gq + 3] * z3);
                    if ((gq & 1) == 0) keep = o; else put8(wl, mb * 32 + fr, nb * 4 + (gq - 1) + fh, keep, o);
                }
        flush8<32 * MB>(wl, fh * 32 + fr, [&](int r) { return Y + (size_t)(tok0 + mbase + r) * D + g * 256 + nbase; });
    }
};

#define DPP_ADD(x, CTRL) ((x) + __uint_as_float((unsigned)__builtin_amdgcn_update_dpp(0, (int)__float_as_uint(x), CTRL, 0xF, 0xF, true)))
DEVI float row16_sum(float x) {
    x = DPP_ADD(x, 0xB1);
    x = DPP_ADD(x, 0x4E);
    x = DPP_ADD(x, 0x141);
    x = DPP_ADD(x, 0x140);
    return x;
}
template <bool NEXT, int MB> struct EpiOut {
    const float* xa; const float* xb;
    const float* mod;
    float* out;
    const float* nw1; const float* mod1; bf16_t* Hn; float* rowss;
    DEVI void operator()(const f32x16 (&acc)[MB][2], int mbase, int nbase, int fr, int fh, unsigned char* wl) const {
        const int lane = fh * 32 + fr, c4 = lane & 15, rsub = lane >> 4;
        const int cv = cond_of(mbase);
        const int n = nbase + c4 * 4;
        const f32x4 gv = *(const f32x4*)(mod + cv * 3072 + 2048 + n);
        f32x4 hv = {0.f, 0.f, 0.f, 0.f};
        if (NEXT) {
            const f32x4 w = *(const f32x4*)(nw1 + n);
            const f32x4 sc = *(const f32x4*)(mod1 + cv * 3072 + 1024 + n);
#pragma unroll
            for (int e = 0; e < 4; ++e) hv[e] = w[e] * (1.f + sc[e]);
        }
#pragma unroll
        for (int mb = 0; mb < MB; ++mb) {
#pragma unroll
            for (int nb = 0; nb < 2; ++nb)
#pragma unroll
                for (int g = 0; g < 4; ++g) {
                    f32x4 a = {acc[mb][nb][4 * g], acc[mb][nb][4 * g + 1], acc[mb][nb][4 * g + 2], acc[mb][nb][4 * g + 3]};
                    *(f32x4*)(wl + fr * 256 + (((nb * 8 + 2 * g + fh) ^ (fr & 15)) << 4)) = a;
                }
#pragma unroll
            for (int i = 0; i < 8; ++i) {
                const int r = i * 4 + rsub, m = mbase + mb * 32 + r;
                const f32x4 a = *(const f32x4*)(wl + r * 256 + ((c4 ^ (r & 15)) << 4));
                const float* xr = m < NCTX ? xa + (size_t)m * D : xb + (size_t)(m - NCTX) * D;
                const f32x4 xv = *(const f32x4*)(xr + n);
                f32x4 o;
#pragma unroll
                for (int e = 0; e < 4; ++e) o[e] = xv[e] + gv[e] * a[e];
                *(f32x4*)(out + (size_t)m * D + n) = o;
                if (NEXT) {
                    float ss = (o[0] * o[0] + o[1] * o[1]) + (o[2] * o[2] + o[3] * o[3]);
                    ss = row16_sum(ss);
                    if (c4 == 0) atomicAdd(rowss + m, ss);
                    u32x2 hb; hb.x = cvt_pk_bf16(o[0] * hv[0], o[1] * hv[1]); hb.y = cvt_pk_bf16(o[2] * hv[2], o[3] * hv[3]);
                    *(u32x2*)(Hn + (size_t)m * D + n) = hb;
                }
            }
        }
    }
};

struct EpiInL1 {
    const float *qnw, *knw, *ropec, *ropes;
    bf16_t *Q, *KB, *VTB, *SZ;
    float *outk, *outv;
    const float* rowss; const float* bias1;
    DEVI void operator()(const f32x16 (&acc_in)[2][2], int mbase, int nbase, int fr, int fh, unsigned char* wl) const {
        const bool lat = mbase >= NCTX;
        u32x2 keep1 = {0u, 0u}, keep2 = {0u, 0u};
        f32x16 acc[2][2];
        {
            const float* bp = bias1 + cond_of(mbase) * 2560 + nbase;
#pragma unroll
            for (int mb = 0; mb < 2; ++mb) {
                const float rstd = rsqrtf(rowss[mbase + mb * 32 + fr] * (1.f / 1024.f) + EPSV);
#pragma unroll
                for (int nb = 0; nb < 2; ++nb)
#pragma unroll
                    for (int g = 0; g < 4; ++g) {
                        const f32x4 bv = *(const f32x4*)(bp + nb * 32 + 8 * g + 4 * fh);
#pragma unroll
                        for (int e = 0; e < 4; ++e) acc[mb][nb][4 * g + e] = acc_in[mb][nb][4 * g + e] * rstd + bv[e];
                    }
            }
        }
        if (nbase < 1280) {
            const bool isq = nbase < 1024;
            const float* nwp = isq ? qnw : knw;
#pragma unroll
            for (int mb = 0; mb < 2; ++mb) {
                const int m = mbase + mb * 32 + fr;
                float ss = 0.f;
#pragma unroll
                for (int nb = 0; nb < 2; ++nb)
#pragma unroll
                    for (int r = 0; r < 16; ++r) ss += acc[mb][nb][r] * acc[mb][nb][r];
                ss = xhalf_sum(ss);
                const float rn = rsqrtf(ss * (1.f / 64.f) + EPSV);
                const int pos = lat ? ((m - NCTX) & 1023) : 0;
#pragma unroll
                for (int g = 0; g < 4; ++g) {
                    const int d0 = 8 * g + 4 * fh;
                    const f32x4 w1 = *(const f32x4*)(nwp + d0), w2 = *(const f32x4*)(nwp + 32 + d0);
                    float x1[4], x2[4];
#pragma unroll
                    for (int e = 0; e < 4; ++e) { x1[e] = acc[mb][0][4 * g + e] * rn * w1[e]; x2[e] = acc[mb][1][4 * g + e] * rn * w2[e]; }
                    if (lat) {
                        const f32x4 cv = *(const f32x4*)(ropec + pos * 32 + d0), sv = *(const f32x4*)(ropes + pos * 32 + d0);
#pragma unroll
                        for (int e = 0; e < 4; ++e) { const float a = x1[e], b = x2[e]; x1[e] = a * cv[e] - b * sv[e]; x2[e] = a * sv[e] + b * cv[e]; }
                    }
                    if (isq) {
                        const float qs = 0.125f * LOG2E;
                        u32x2 o1, o2;
                        o1.x = cvt_pk_bf16(x1[0] * qs, x1[1] * qs); o1.y = cvt_pk_bf16(x1[2] * qs, x1[3] * qs);
                        o2.x = cvt_pk_bf16(x2[0] * qs, x2[1] * qs); o2.y = cvt_pk_bf16(x2[2] * qs, x2[3] * qs);
                        if ((g & 1) == 0) { keep1 = o1; keep2 = o2; }
                        else { put8(wl, mb * 32 + fr, (g - 1) + fh, keep1, o1); put8(wl, mb * 32 + fr, 4 + (g - 1) + fh, keep2, o2); }
                    } else {
                        const int kc = nbase - 1024;
                        u32x2 o1, o2;
                        o1.x = cvt_pk_bf16(x1[0], x1[1]); o1.y = cvt_pk_bf16(x1[2], x1[3]);
                        o2.x = cvt_pk_bf16(x2[0], x2[1]); o2.y = cvt_pk_bf16(x2[2], x2[3]);
                        if ((g & 1) == 0) { keep1 = o1; keep2 = o2; }
                        else { put8(wl, mb * 32 + fr, (g - 1) + fh, keep1, o1); put8(wl, mb * 32 + fr, 4 + (g - 1) + fh, keep2, o2); }
                        if (!lat) {
                            f32x4 f1 = {x1[0], x1[1], x1[2], x1[3]}, f2 = {x2[0], x2[1], x2[2], x2[3]};
                            *(f32x4*)(outk + (size_t)m * 256 + kc + d0) = f1;
                            *(f32x4*)(outk + (size_t)m * 256 + kc + 32 + d0) = f2;
                        }
                    }
                }
            }
            if (isq) flush8<64>(wl, fh * 32 + fr, [&](int r) { return Q + (size_t)(mbase + r) * D + nbase; });
            else flush8<64>(wl, fh * 32 + fr, [&](int r) { return KB + (size_t)(mbase + r) * 256 + (nbase - 1024); });
        } else if (nbase < 1536) {
            const int vc = nbase - 1280, kvh = vc >> 6;
            bf16_t* vtb; int S, sbase;
            if (!lat) { S = 256; sbase = mbase & 255; vtb = VTB + ((size_t)((mbase >> 8) * 4 + kvh) * 64) * 256; }
            else { const int t = mbase - NCTX; S = 1024; sbase = t & 1023; vtb = VTB + (size_t)16 * 4 * 64 * 256 + ((size_t)((t >> 10) * 4 + kvh) * 64) * 1024; }
#pragma unroll
            for (int mb = 0; mb < 2; ++mb) {
                const int m = mbase + mb * 32 + fr;
                const int cpos = swap23(mb * 32 + fr);
                unsigned char* wcol = wl + ((cpos & 7) << 1);
                const int cch = cpos >> 3;
#pragma unroll
                for (int nb = 0; nb < 2; ++nb)
#pragma unroll
                    for (int g = 0; g < 4; ++g) {
                        const int d0 = nb * 32 + 8 * g + 4 * fh;
#pragma unroll
                        for (int e = 0; e < 4; ++e) { const int d = d0 + e; *(bf16_t*)(wcol + d * 128 + ((cch ^ (d & 7)) << 4)) = f2bf(acc[mb][nb][4 * g + e]); }
                        if (!lat) {
                            f32x4 f = {acc[mb][nb][4 * g], acc[mb][nb][4 * g + 1], acc[mb][nb][4 * g + 2], acc[mb][nb][4 * g + 3]};
                            *(f32x4*)(outv + (size_t)m * 256 + vc + d0) = f;
                        }
                    }
            }
            flush8<64>(wl, fh * 32 + fr, [&](int r) { return vtb + (size_t)r * S + sbase; });
        } else {
            const int zc = nbase - 1536;
#pragma unroll
            for (int mb = 0; mb < 2; ++mb)
#pragma unroll
                for (int nb = 0; nb < 2; ++nb)
#pragma unroll
                    for (int g = 0; g < 4; ++g) {
                        const int m = mbase + mb * 32 + fr, n = zc + nb * 32 + 8 * g + 4 * fh;
                        u32x2 o; o.x = cvt_pk_bf16(silu_f(acc[mb][nb][4 * g]), silu_f(acc[mb][nb][4 * g + 1]));
                        o.y = cvt_pk_bf16(silu_f(acc[mb][nb][4 * g + 2]), silu_f(acc[mb][nb][4 * g + 3]));
                        if ((g & 1) == 0) keep1 = o; else put8(wl, mb * 32 + fr, nb * 4 + (g - 1) + fh, keep1, o);
                    }
            flush8<64>(wl, fh * 32 + fr, [&](int r) { return SZ + (size_t)(mbase + r) * D + zc; });
        }
    }
};

DEVI void attn_item(const Params& p, int item, unsigned char* lds) {
    const int lane = threadIdx.x & 63, w = threadIdx.x >> 6, fr = lane & 31, fh = lane >> 5;
    const bf16_t* Q = (const bf16_t*)(p.ws + WS_Q);
    const bf16_t* KB = (const bf16_t*)(p.ws + WS_KB);
    const bf16_t* VTB = (const bf16_t*)(p.ws + WS_VTB);
    const bf16_t* KC = (const bf16_t*)(p.ws + WS_KC);
    const bf16_t* VCT = (const bf16_t*)(p.ws + WS_VCT);
    const bf16_t* SZ = (const bf16_t*)(p.ws + WS_SZ);
    bf16_t* Y = (bf16_t*)(p.ws + WS_Y);
    bool lat; int b, kvh, qb, tb;
    if (item < 256) { lat = true; b = item >> 7; kvh = (item >> 5) & 3; qb = item & 31; tb = NCTX + b * 1024; }
    else { const int it = item - 256; lat = false; b = it >> 5; kvh = (it >> 3) & 3; qb = it & 7; tb = b * 256; }
    const int head = kvh * 4 + w;
    const int qtok = tb + qb * 32 + fr;
    bf16x8 qf[4];
#pragma unroll
    for (int ks = 0; ks < 4; ++ks) qf[ks] = *(const bf16x8*)(Q + (size_t)qtok * D + head * 64 + ks * 16 + fh * 8);
    float m_run = p.sink[head] * LOG2E, l_run = 1.f;
    f32x16 O[2];
#pragma unroll
    for (int i = 0; i < 2; ++i)
#pragma unroll
        for (int r = 0; r < 16; ++r) O[i][r] = 0.f;

    int nloc, k_lo = 0; const bf16_t *kloc, *vloc; int ldloc;
    if (lat) {
        k_lo = qb - 4 < 0 ? 0 : qb - 4; const int k_hi = qb + 4 > 31 ? 31 : qb + 4; nloc = k_hi - k_lo + 1;
        kloc = KB + (size_t)(tb + k_lo * 32) * 256 + kvh * 64;
        vloc = VTB + (size_t)16 * 4 * 64 * 256 + ((size_t)(b * 4 + kvh) * 64) * 1024 + k_lo * 32; ldloc = 1024;
    } else {
        nloc = 8; kloc = KB + (size_t)tb * 256 + kvh * 64; vloc = VTB + ((size_t)(b * 4 + kvh) * 64) * 256; ldloc = 256;
    }
    const int nblk = lat ? nloc + 8 : 8;
    const bf16_t* kcb = KC + (size_t)(b * 256) * 256 + kvh * 64;
    const bf16_t* vcb = VCT + ((size_t)(b * 4 + kvh) * 64) * 256;
    const int tid = threadIdx.x;
    const int kkey = tid >> 3, kch = tid & 7, vd = tid >> 2, vch = tid & 3;
    const unsigned kst = kkey * 128 + ((kch ^ ((kkey >> 1) & 7)) << 4), vst = 4096 + vd * 64 + ((vch ^ ((vd >> 2) & 3)) << 4);
    const unsigned ksw = (fr >> 1) & 7, vsw = (fr >> 2) & 3;
    u32x4 kA, vA, kB, vB;
#define LOADKV(j, KR, VR) { const bf16_t *kp_, *vp_; int ldv_; \
        if ((j) < nloc) { kp_ = kloc + (size_t)(j) * 32 * 256; vp_ = vloc + (j) * 32; ldv_ = ldloc; } \
        else { const int c_ = (j) - nloc; kp_ = kcb + (size_t)c_ * 32 * 256; vp_ = vcb + c_ * 32; ldv_ = 256; } \
        KR = *(const u32x4*)(kp_ + (size_t)kkey * 256 + kch * 8); VR = *(const u32x4*)(vp_ + (size_t)vd * ldv_ + vch * 8); }
    auto compute = [&](int j) {
        const unsigned char* lb = lds + (j & 1) * 8192;
        bf16x8 kf[4], vf[4];
#pragma unroll
        for (int ks = 0; ks < 4; ++ks) kf[ks] = *(const bf16x8*)(lb + fr * 128 + (((2 * ks + fh) ^ ksw) << 4));
#pragma unroll
        for (int s2 = 0; s2 < 2; ++s2)
#pragma unroll
            for (int db = 0; db < 2; ++db) vf[s2 * 2 + db] = *(const bf16x8*)(lb + 4096 + (db * 32 + fr) * 64 + (((2 * s2 + fh) ^ vsw) << 4));
        f32x16 s;
#pragma unroll
        for (int r = 0; r < 16; ++r) s[r] = 0.f;
#pragma unroll
        for (int ks = 0; ks < 4; ++ks) s = __builtin_amdgcn_mfma_f32_32x32x16_bf16(kf[ks], qf[ks], s, 0, 0, 0);
        if (lat && j < nloc) {
            const int kb = k_lo + j;
            const int mode = (kb == qb - 4) ? 1 : (kb == qb + 4) ? 2 : 0;
            if (mode) {
                const int dpos = (kb - qb) * 32;
#pragma unroll
                for (int r = 0; r < 16; ++r) {
                    const int rel = dpos + (r & 3) + 8 * (r >> 2) + 4 * fh - fr;
                    const bool ok = mode == 1 ? (rel >= -128) : (rel <= 128);
                    if (!ok) s[r] = -1e30f;
                }
            }
        }
        float mx = s[0];
#pragma unroll
        for (int r = 1; r < 16; ++r) mx = fmaxf(mx, s[r]);
        mx = xhalf_max(mx);
        const float m_new = fmaxf(m_run, mx);
        const float alpha = __builtin_amdgcn_exp2f(m_run - m_new);
        float rs = 0.f;
#pragma unroll
        for (int r = 0; r < 16; ++r) { s[r] = __builtin_amdgcn_exp2f(s[r] - m_new); rs += s[r]; }
        rs = xhalf_sum(rs);
        l_run = l_run * alpha + rs; m_run = m_new;
#pragma unroll
        for (int i = 0; i < 2; ++i)
#pragma unroll
            for (int r = 0; r < 16; ++r) O[i][r] *= alpha;
#pragma unroll
        for (int s2 = 0; s2 < 2; ++s2) {
            union { u32x4 u; bf16x8 v; } pf;
            pf.u.x = cvt_pk_bf16(s[8 * s2 + 0], s[8 * s2 + 1]); pf.u.y = cvt_pk_bf16(s[8 * s2 + 2], s[8 * s2 + 3]);
            pf.u.z = cvt_pk_bf16(s[8 * s2 + 4], s[8 * s2 + 5]); pf.u.w = cvt_pk_bf16(s[8 * s2 + 6], s[8 * s2 + 7]);
#pragma unroll
            for (int db = 0; db < 2; ++db) O[db] = __builtin_amdgcn_mfma_f32_32x32x16_bf16(vf[s2 * 2 + db], pf.v, O[db], 0, 0, 0);
        }
    };
    LOADKV(0, kA, vA)
    *(u32x4*)(lds + kst) = kA; *(u32x4*)(lds + vst) = vA;
    if (nblk > 1) LOADKV(1, kA, vA)
    if (nblk > 2) LOADKV(2, kB, vB)
    __syncthreads();
    for (int j = 0; j < nblk; j += 2) {
        compute(j);
        if (j + 1 < nblk) { *(u32x4*)(lds + 8192 + kst) = kA; *(u32x4*)(lds + 8192 + vst) = vA; }
        if (j + 3 < nblk) LOADKV(j + 3, kA, vA)
        __syncthreads();
        if (j + 1 < nblk) {
            compute(j + 1);
            if (j + 2 < nblk) { *(u32x4*)(lds + kst) = kB; *(u32x4*)(lds + vst) = vB; }
            if (j + 4 < nblk) LOADKV(j + 4, kB, vB)
            __syncthreads();
        }
    }
#undef LOADKV
    const float il = 1.f / l_run;
    u32x2 keepy = {0u, 0u};
#pragma unroll
    for (int db = 0; db < 2; ++db)
#pragma unroll
        for (int g = 0; g < 4; ++g) {
            const int col = head * 64 + db * 32 + 8 * g + 4 * fh;
            const u32x2 z = *(const u32x2*)(SZ + (size_t)qtok * D + col);
            const float z0 = __uint_as_float(z.x << 16), z1 = __uint_as_float(z.x & 0xffff0000u);
            const float z2 = __uint_as_float(z.y << 16), z3 = __uint_as_float(z.y & 0xffff0000u);
            u32x2 o; o.x = cvt_pk_bf16(O[db][4 * g] * il * z0, O[db][4 * g + 1] * il * z1);
            o.y = cvt_pk_bf16(O[db][4 * g + 2] * il * z2, O[db][4 * g + 3] * il * z3);
            if ((g & 1) == 0) keepy = o; else put8(lds + w * 8192, fr, db * 4 + (g - 1) + fh, keepy, o);
        }
    flush8<32>(lds + w * 8192, lane, [&](int r) { return Y + (size_t)(tb + qb * 32 + r) * D + head * 64; });
    __syncthreads();
}


#define XB_TMO      128
#define XB_XCNT(j)  (256  + 64 * (j))
#define XB_XSUB(j)  (1280 + 64 * (j))
#define XB_XGEN(j)  (2304 + 64 * (j))
#define XB_TOP      3328
#define XB_TOPGEN   3392
#define XCD_BAR_WORDS 3456
#define XB_SPIN_CAP (1u << 18)
#define LAS __attribute__((address_space(3)))
DEVI unsigned xb_ld(unsigned* p)              { return __hip_atomic_load(p, __ATOMIC_RELAXED, __HIP_MEMORY_SCOPE_AGENT); }
DEVI unsigned xb_add(unsigned* p, unsigned v) { return __hip_atomic_fetch_add(p, v, __ATOMIC_RELAXED, __HIP_MEMORY_SCOPE_AGENT); }
DEVI unsigned xb_xcc_id() { return (unsigned)__builtin_amdgcn_s_getreg((3 << 11) | 20) & 0xFu; }
#define XB_SPIN(cond, bar) do { unsigned _sp = 0; while (cond) { __builtin_amdgcn_s_sleep(1); \
    if ((++_sp & 255u) == 0u) { if (xb_ld(&(bar)[XB_TMO])) break; if (_sp > XB_SPIN_CAP) { atomicAdd(&(bar)[XB_TMO], 1u); break; } } } } while (0)
struct XcdBarrier { unsigned* bar; unsigned x; volatile LAS unsigned* st; };
DEVI XcdBarrier xcd_barrier_post(unsigned* bar, volatile LAS unsigned* st) {
    XcdBarrier b; b.bar = bar; b.x = xb_xcc_id(); b.st = st;
    if (threadIdx.x == 0) (void)xb_add(&bar[XB_XCNT(b.x)], 1u);
    return b;
}
DEVI void xcd_barrier_complete(unsigned* bar, unsigned x, unsigned& nloc, unsigned& nx) {
    const unsigned G = gridDim.x * gridDim.y * gridDim.z;
    unsigned sum, cnt, mine, sp = 0u;
    for (;;) {
        sum = 0u; cnt = 0u; mine = 0u;
#pragma unroll
        for (unsigned j = 0; j < 16; ++j) { const unsigned c = xb_ld(&bar[XB_XCNT(j)]); sum += c; cnt += (c > 0u) ? 1u : 0u; mine = (j == x) ? c : mine; }
        if (sum == G) break;
        __builtin_amdgcn_s_sleep(1);
        if ((++sp & 255u) == 0u) { if (xb_ld(&bar[XB_TMO])) break; if (sp > XB_SPIN_CAP) { atomicAdd(&bar[XB_TMO], 1u); break; } }
    }
    nloc = mine > 0u ? mine : 1u; nx = cnt > 0u ? cnt : 1u;
}
DEVI void xcd_barrier(const XcdBarrier& b) {
    asm volatile("s_waitcnt vmcnt(0)" ::: "memory");
    __syncthreads();
    if (threadIdx.x == 0) {
        unsigned* bar = b.bar;
        __builtin_amdgcn_s_waitcnt(0);
        unsigned nloc = b.st[0], nx = b.st[1];
        if (nloc == 0u) { xcd_barrier_complete(bar, b.x, nloc, nx); b.st[0] = nloc; b.st[1] = nx; }
        const unsigned old = xb_add(&bar[XB_XSUB(b.x)], 1u);
        const unsigned gen = old / nloc;
        if (old + 1u == (gen + 1u) * nloc) {
            __builtin_amdgcn_fence(__ATOMIC_RELEASE, "agent");
            asm volatile("s_waitcnt vmcnt(0)" ::: "memory");
            const unsigned og = xb_add(&bar[XB_TOP], 1u);
            const unsigned tg = og / nx;
            if (og + 1u == (tg + 1u) * nx) xb_add(&bar[XB_TOPGEN], 1u);
            else XB_SPIN(xb_ld(&bar[XB_TOPGEN]) == tg, bar);
            __builtin_amdgcn_fence(__ATOMIC_ACQUIRE, "agent");
            xb_add(&bar[XB_XGEN(b.x)], 1u);
            asm volatile("s_waitcnt vmcnt(0)" ::: "memory");
        } else {
            XB_SPIN(xb_ld(&bar[XB_XGEN(b.x)]) == gen, bar);
            __builtin_amdgcn_fence(__ATOMIC_ACQUIRE, "agent");
            asm volatile("s_waitcnt vmcnt(0)" ::: "memory");
        }
    }
    __syncthreads();
}

DEVI void run_phase(const Params& p, int ph, unsigned char* lds) {
    const int G = gridDim.x;
    bf16_t* H = (bf16_t*)(p.ws + WS_H);
    bf16_t* U = (bf16_t*)(p.ws + WS_U);
    bf16_t* SZ = (bf16_t*)(p.ws + WS_SZ);
    bf16_t* VT = (bf16_t*)(p.ws + WS_VT);
    bf16_t* Y = (bf16_t*)(p.ws + WS_Y);
    float* X1 = (float*)(p.ws + WS_X1);
    const float* mod = (const float*)(p.ws + WS_MOD);
    switch (ph) {
    case 0: {
        phase0(p, lds);
        if (threadIdx.x == 0) {
            unsigned* cnt = (unsigned*)(p.ws + WS_CNT); unsigned sp = 0;
            while (__hip_atomic_load(cnt, __ATOMIC_RELAXED, __HIP_MEMORY_SCOPE_AGENT) < 384u) { __builtin_amdgcn_s_sleep(4); if (++sp > (1u << 22)) break; }
        }
        __syncthreads();
        const float* modp = (const float*)(p.ws + WS_MODP);
        if (blockIdx.x < 72) {
            const int i = blockIdx.x * 256 + threadIdx.x, l = i / 9216, j = i % 3072;
            float s = (l ? p.b_mod1 : p.b_mod0)[j];
#pragma unroll
            for (int ks = 0; ks < 4; ++ks) s += __hip_atomic_load(modp + ks * 18432 + i, __ATOMIC_RELAXED, __HIP_MEMORY_SCOPE_AGENT);
            ((float*)(p.ws + WS_MOD))[i] = s;
        }
        float* lmod = (float*)lds;
        {
            float tmp[24];
#pragma unroll
            for (int q = 0; q < 24; ++q) {
                const int i = threadIdx.x + 256 * q, src_i = (i >> 11) * 3072 + (i & 2047);
                float s = p.b_mod0[i & 2047];
#pragma unroll
                for (int ks = 0; ks < 4; ++ks) s += __hip_atomic_load(modp + ks * 18432 + src_i, __ATOMIC_RELAXED, __HIP_MEMORY_SCOPE_AGENT);
                tmp[q] = s;
            }
#pragma unroll
            for (int q = 0; q < 24; ++q) lmod[threadIdx.x + 256 * q] = tmp[q];
        }
        __syncthreads();
        phase_norm(p, 0, lmod);
    } break;
    case 2: {
        EpiInL0 e{U, SZ};
        const bf16_t* W0 = (const bf16_t*)(p.ws + WS_WT0IN);
        auto run_list = [&](int kind, int a, int bq, int cnt) {
#pragma unroll 1
            for (int i = 0; i < cnt; ++i) {
                int m0v, n0v;
                if (kind == 0) { m0v = a * 128; n0v = bq * 256 + i * 128; }
                else { const int zt = a + i; m0v = (zt >> 3) * 128; n0v = 1024 + (zt & 7) * 128; }
                asm volatile("" : "+s"(m0v), "+s"(n0v));
                gemm_tile(H, D, W0, D, 16, lds, e, m0v, n0v);
            }
            if (kind == 0) {
                __builtin_amdgcn_fence(__ATOMIC_RELEASE, "workgroup");
                asm volatile("s_waitcnt vmcnt(0)" ::: "memory");
                __syncthreads();
                __builtin_amdgcn_fence(__ATOMIC_ACQUIRE, "workgroup");
                EpiChanDft ec{VT, bq};
#pragma unroll 1
                for (int m4 = 0; m4 < 4; ++m4) {
                    int m0v = m4 * 128, n0v = a * 128;
                    asm volatile("" : "+s"(m0v), "+s"(n0v));
                    gemm_tile((const bf16_t*)(p.ws + WS_TW256), 256, U + bq * 256, D, 4, lds, ec, m0v, n0v);
                }
            }
        };
        if (G == 512) {
            const int b = blockIdx.x;
            if (b < 192) { const int tt = (b & 7) * 24 + (b >> 3); run_list(0, tt >> 2, tt & 3, 2); }
            else if (b < 256) run_list(1, 2 * (b - 192), 0, 2);
            else if (b < 448) { const int l = b - 256; run_list(1, 192 + (l & 7) * 24 + (l >> 3), 0, 1); }
            else { run_list(1, 128 + (b - 448), 0, 1); bias1_items(p, b - 448, 64); }
        } else {
            for (int it = blockIdx.x; it < 576; it += G) { if (it < 192) run_list(0, it >> 2, it & 3, 2); else run_list(1, it - 192, 0, 1); }
            bias1_items(p, blockIdx.x, G);
        }
    } break;
    case 4: {
        for (int t = blockIdx.x; t < 512; t += G) {
            if (t < 256) {
                const int nt = t & 1, mt = (t >> 1) & 15, bg = t >> 5;
                EpiSeqDft<1> e{SZ, Y, NCTX + (bg >> 2) * 1024, bg & 3};
                gemm_tile<1>((const bf16_t*)(p.ws + WS_TS1024), 2048, VT + (size_t)64 * 256 * 512 + (size_t)bg * 256 * 2048, 2048, 32, lds, e, mt * 64, nt * 128);
            } else {
                const int u = t - 256, nt = u & 1, mt = (u >> 1) & 1, bg = u >> 2;
                EpiSeqDft<2> e{SZ, Y, (bg >> 2) * 256, bg & 3};
                gemm_tile<2>((const bf16_t*)(p.ws + WS_TS256), 512, VT + (size_t)bg * 256 * 512, 512, 8, lds, e, mt * 128, nt * 128);
            }
        }
    } break;
    case 5: {
        EpiOut<true, 2> e{p.x_prompt, p.x_sample, mod, X1, p.norm_w1, mod + 3 * 3072, H, (float*)(p.ws + WS_ROWSS)};
        EpiOut<true, 1> e1{p.x_prompt, p.x_sample, mod, X1, p.norm_w1, mod + 3 * 3072, H, (float*)(p.ws + WS_ROWSS)};
        if (G == 512) {
            if (blockIdx.x < 256) { const int tt = xcd_remap(blockIdx.x, 256); gemm_tile<2>(Y, D, (const bf16_t*)(p.ws + WS_WT0OUT), D, 16, lds, e, (tt >> 3) * 128, (tt & 7) * 128); }
            else { const int tt = xcd_remap(blockIdx.x - 256, 256); gemm_tile<1>(Y, D, (const bf16_t*)(p.ws + WS_WT0OUT), D, 16, lds, e1, 4096 + (tt >> 3) * 64, (tt & 7) * 128); }
        } else
        for (int t = blockIdx.x; t < 384; t += G) {
            const int tt = xcd_remap(t, 384);
            gemm_tile(Y, D, (const bf16_t*)(p.ws + WS_WT0OUT), D, 16, lds, e, (tt >> 3) * 128, (tt & 7) * 128);
        }
    } break;
    case 7: {
        EpiInL1 e{p.qnw, p.knw, (const float*)(p.ws + WS_ROPEC), (const float*)(p.ws + WS_ROPES),
                  (bf16_t*)(p.ws + WS_Q), (bf16_t*)(p.ws + WS_KB), (bf16_t*)(p.ws + WS_VTB), SZ,
                  p.out + (size_t)NTOK * D, p.out + (size_t)NTOK * D + (size_t)NCTX * 256,
                  (const float*)(p.ws + WS_ROWSS), (const float*)(p.ws + WS_BIAS1)};
        for (int t = blockIdx.x; t < 960; t += G) {
            const int tt = xcd_remap(t, 960);
            gemm_tile(H, D, (const bf16_t*)(p.ws + WS_WT1IN), D, 16, lds, e, (tt / 20) * 128, (tt % 20) * 128);
        }
    } break;
    case 8: {
        if (G == 512) {
            if (blockIdx.x < 256) attn_item(p, blockIdx.x, lds);
            else { attn_item(p, 256 + 2 * (blockIdx.x - 256), lds); attn_item(p, 257 + 2 * (blockIdx.x - 256), lds); }
        } else
            for (int t = blockIdx.x; t < 768; t += G) attn_item(p, t, lds);
    } break;
    case 9: {
        EpiOut<false, 2> e{X1, X1 + (size_t)NCTX * D, mod + 3 * 3072, p.out, nullptr, nullptr, nullptr, nullptr};
        EpiOut<false, 1> e1{X1, X1 + (size_t)NCTX * D, mod + 3 * 3072, p.out, nullptr, nullptr, nullptr, nullptr};
        if (G == 512) {
            if (blockIdx.x < 256) { const int tt = xcd_remap(blockIdx.x, 256); gemm_tile<2>(Y, D, (const bf16_t*)(p.ws + WS_WT1OUT), D, 16, lds, e, (tt >> 3) * 128, (tt & 7) * 128); }
            else { const int tt = xcd_remap(blockIdx.x - 256, 256); gemm_tile<1>(Y, D, (const bf16_t*)(p.ws + WS_WT1OUT), D, 16, lds, e1, 4096 + (tt >> 3) * 64, (tt & 7) * 128); }
        } else
        for (int t = blockIdx.x; t < 384; t += G) {
            const int tt = xcd_remap(t, 384);
            gemm_tile(Y, D, (const bf16_t*)(p.ws + WS_WT1OUT), D, 16, lds, e, (tt >> 3) * 128, (tt & 7) * 128);
        }
    } break;
    }
}

__global__ void __launch_bounds__(256, 2) mega(Params p) {
    __shared__ __attribute__((aligned(16))) unsigned char lds[65536 + 16];
    cg::grid_group grid = cg::this_grid();
#if SINGLE_LAUNCH
    volatile LAS unsigned* st = (volatile LAS unsigned*)(lds + 65536);
    if (threadIdx.x < 4) st[threadIdx.x] = 0u;
    __syncthreads();
    XcdBarrier bar = xcd_barrier_post((unsigned*)(p.ws + WS_BAR), st);
    if (p.ph_hi == 777) grid.sync();
#ifndef REP_PH
#define REP_PH -1
#endif
#ifndef REP_SY
#define REP_SY 0
#endif
#define PH(n) run_phase(p, n, lds); if (REP_PH == n) run_phase(p, n, lds);
#define SY() xcd_barrier(bar); if (REP_SY) xcd_barrier(bar);
#else
    const int lo = (int)p.ph_lo, hi = (int)p.ph_hi;
#define PH(n) if (lo <= n && n < hi) run_phase(p, n, lds);
#define SY()
#endif
    PH(0) SY() PH(2) SY() PH(4) SY() PH(5) SY() PH(7) SY() PH(8) SY() PH(9)
}

extern "C" void kernel_launch(void* const* d_in, const int* in_sizes, int n_in, void* d_out, int out_size, void* d_ws, size_t ws_size, hipStream_t stream) {
    static int grid_blocks = 0;
    if (!grid_blocks) {
        int dev = 0, cus = 0, per_cu = 0;
        hipGetDevice(&dev);
        hipDeviceGetAttribute(&cus, hipDeviceAttributeMultiprocessorCount, dev);
        hipOccupancyMaxActiveBlocksPerMultiprocessor(&per_cu, mega, 256, 0);
        if (per_cu > 2) per_cu = 2;
        if (per_cu < 1) per_cu = 1;
        grid_blocks = cus * per_cu;
    }
    Params p{};
    const float* const* in = (const float* const*)d_in;
    p.x_prompt = in[0]; p.x_sample = in[1]; p.cache_k = in[2]; p.cache_v = in[3]; p.c = in[4]; p.c_ctx = in[5];
    p.norm_w0 = in[6]; p.w_mod0 = in[7]; p.b_mod0 = in[8]; p.w_in0 = in[9]; p.w_out0 = in[10];
    p.norm_w1 = in[11]; p.w_mod1 = in[12]; p.b_mod1 = in[13]; p.w_in1 = in[14]; p.qnw = in[15]; p.knw = in[16]; p.sink = in[17]; p.w_out1 = in[18];
    p.out = (float*)d_out; p.ws = (unsigned char*)d_ws;
#if SINGLE_LAUNCH
    p.ph_lo = 0; p.ph_hi = 10;
    hipMemsetAsync((unsigned char*)d_ws + WS_BAR, 0, 16384, stream);
    void* args[] = {&p};
    hipError_t e = hipLaunchCooperativeKernel((void*)mega, dim3(grid_blocks), dim3(256), args, 0, stream);
    if (e != hipSuccess) fprintf(stderr, "cooperative launch failed: %s (grid %d)\n", hipGetErrorString(e), grid_blocks);
#else
    for (int ph = 0; ph < 10; ++ph) {
        p.ph_lo = ph; p.ph_hi = ph + 1;
        hipLaunchKernelGGL(mega, dim3(grid_blocks), dim3(256), 0, stream, p);
    }
#endif
}
```

```cpp
#include <hip/hip_runtime.h>
#include <hip/hip_cooperative_groups.h>
#include <stdint.h>
#include <cstdio>
namespace cg = cooperative_groups;

#ifndef SINGLE_LAUNCH
#define SINGLE_LAUNCH 1
#endif

typedef unsigned short bf16_t;
typedef short bf16x8 __attribute__((ext_vector_type(8)));
typedef float f32x16 __attribute__((ext_vector_type(16)));
typedef float f32x4 __attribute__((ext_vector_type(4)));
typedef unsigned u32x4 __attribute__((ext_vector_type(4)));
typedef unsigned u32x2 __attribute__((ext_vector_type(2)));
#define DEVI __device__ __forceinline__

constexpr int NTOK = 6144, NCTX = 4096, D = 1024;
constexpr float EPSV = 1e-6f;
constexpr float LOG2E = 1.4426950408889634f;

constexpr size_t WS_MOD = 0;
constexpr size_t WS_WT0IN = 1 << 20;
constexpr size_t WS_WT0OUT = WS_WT0IN + (size_t)2048 * 1024 * 2;
constexpr size_t WS_WT1IN = WS_WT0OUT + (size_t)1024 * 1024 * 2;
constexpr size_t WS_WT1OUT = WS_WT1IN + (size_t)2560 * 1024 * 2;
constexpr size_t WS_TW256 = WS_WT1OUT + (size_t)1024 * 1024 * 2;
constexpr size_t WS_TS256 = WS_TW256 + (size_t)512 * 256 * 2;
constexpr size_t WS_TS1024 = WS_TS256 + (size_t)256 * 512 * 2;
constexpr size_t WS_ROPEC = WS_TS1024 + (size_t)1024 * 2048 * 2;
constexpr size_t WS_ROPES = WS_ROPEC + (size_t)1024 * 32 * 4;
constexpr size_t WS_KC = WS_ROPES + (size_t)1024 * 32 * 4;
constexpr size_t WS_VCT = WS_KC + (size_t)2 * 256 * 256 * 2;
constexpr size_t WS_H = WS_VCT + (size_t)2 * 256 * 256 * 2;
constexpr size_t WS_U = WS_H + (size_t)NTOK * D * 2;
constexpr size_t WS_SZ = WS_U + (size_t)NTOK * D * 2;
constexpr size_t WS_VT = WS_SZ + (size_t)NTOK * D * 2;
constexpr size_t WS_Y = WS_VT + (size_t)NTOK * 2048 * 2;
constexpr size_t WS_X1 = WS_Y + (size_t)NTOK * D * 2;
constexpr size_t WS_Q = WS_X1 + (size_t)NTOK * D * 4;
constexpr size_t WS_KB = WS_Q + (size_t)NTOK * D * 2;
constexpr size_t WS_VTB = WS_KB + (size_t)NTOK * 256 * 2;
constexpr size_t WS_BAR = WS_VTB + (size_t)NTOK * 256 * 2;
constexpr size_t WS_CNT = WS_BAR + 14336;
constexpr size_t WS_ROWSS = WS_BAR + 16384;
constexpr size_t WS_BIAS1 = WS_ROWSS + 6144 * 4;
constexpr size_t WS_MODP = WS_BIAS1 + 3 * 2560 * 4;
constexpr size_t WS_END = WS_MODP + (size_t)4 * 18432 * 4;

struct Params {
    const float *x_prompt, *x_sample, *cache_k, *cache_v, *c, *c_ctx;
    const float *norm_w0, *w_mod0, *b_mod0, *w_in0, *w_out0;
    const float *norm_w1, *w_mod1, *b_mod1, *w_in1, *qnw, *knw, *sink, *w_out1;
    float* out;
    unsigned char* ws;
    long long ph_lo, ph_hi;
};

DEVI unsigned cvt_pk_bf16(float lo, float hi) { unsigned r; asm("v_cvt_pk_bf16_f32 %0, %1, %2" : "=v"(r) : "v"(lo), "v"(hi)); return r; }
DEVI bf16_t f2bf(float f) { return (bf16_t)(cvt_pk_bf16(f, 0.f) & 0xffffu); }
DEVI float silu_f(float v) { return v * __builtin_amdgcn_rcpf(1.f + __expf(-v)); }
DEVI int swap23(int x) { return (x & ~12) | ((x & 4) << 1) | ((x & 8) >> 1); }
DEVI int cond_of(int m) { return m < NCTX ? 0 : 1 + ((m - NCTX) >> 10); }

DEVI void st8(bf16_t* p, u32x2 a, u32x2 b) {
    const auto r0 = __builtin_amdgcn_permlane32_swap(a.x, b.x, false, false);
    const auto r1 = __builtin_amdgcn_permlane32_swap(a.y, b.y, false, false);
    u32x4 w; w.x = r0[0]; w.y = r1[0]; w.z = r0[1]; w.w = r1[1];
    *(u32x4*)p = w;
}
DEVI void put8(unsigned char* wl, int r, int c, u32x2 a, u32x2 b) {
    const auto r0 = __builtin_amdgcn_permlane32_swap(a.x, b.x, false, false);
    const auto r1 = __builtin_amdgcn_permlane32_swap(a.y, b.y, false, false);
    u32x4 w; w.x = r0[0]; w.y = r1[0]; w.z = r0[1]; w.w = r1[1];
    *(u32x4*)(wl + r * 128 + ((c ^ (r & 7)) << 4)) = w;
}
template <int ROWS, class RowPtr>
DEVI void flush8(const unsigned char* wl, int lane, const RowPtr& rowptr) {
#pragma unroll
    for (int i = 0; i < ROWS / 8; ++i) {
        const int r = i * 8 + (lane >> 3), c = lane & 7;
        const u32x4 w = *(const u32x4*)(wl + r * 128 + ((c ^ (r & 7)) << 4));
        *(u32x4*)(rowptr(r) + c * 8) = w;
    }
}
#define DPP_ADD0(x, CTRL) ((x) + __uint_as_float((unsigned)__builtin_amdgcn_update_dpp(0, (int)__float_as_uint(x), CTRL, 0xF, 0xF, true)))
DEVI float wave_sum(float x) {
    x = DPP_ADD0(x, 0xB1); x = DPP_ADD0(x, 0x4E); x = DPP_ADD0(x, 0x141); x = DPP_ADD0(x, 0x140);
    const auto r = __builtin_amdgcn_permlane16_swap(__float_as_uint(x), __float_as_uint(x), false, false);
    x = __uint_as_float(r[0]) + __uint_as_float(r[1]);
    const auto q = __builtin_amdgcn_permlane32_swap(__float_as_uint(x), __float_as_uint(x), false, false);
    return __uint_as_float(q[0]) + __uint_as_float(q[1]);
}
DEVI float xhalf_sum(float x) { const auto r = __builtin_amdgcn_permlane32_swap(__float_as_uint(x), __float_as_uint(x), false, false); return __uint_as_float(r[0]) + __uint_as_float(r[1]); }
DEVI float xhalf_max(float x) { const auto r = __builtin_amdgcn_permlane32_swap(__float_as_uint(x), __float_as_uint(x), false, false); return fmaxf(__uint_as_float(r[0]), __uint_as_float(r[1])); }

DEVI void glds16(const void* g, void* l) { __builtin_amdgcn_global_load_lds(g, l, 16, 0, 0); }

template <int MB = 2, class Epi>
DEVI void gemm_tile(const bf16_t* __restrict__ A, int lda, const bf16_t* __restrict__ B, int ldb, int nk,
                    unsigned char* lds, const Epi& epi, int m0, int n0) {
    const int tid = threadIdx.x, lane = tid & 63, wid = tid >> 6, wr = wid >> 1, wc = wid & 1;
    const int srow = tid >> 3;
    const int slc = (tid & 7) ^ ((tid >> 4) & 7);
    const bf16_t* gA = A + (size_t)(m0 + srow) * lda + slc * 8;
    const bf16_t* gB = B + (size_t)(n0 + srow) * ldb + slc * 8;
    const int fr = lane & 31, fh = lane >> 5, sw = (lane >> 1) & 7;
    const unsigned aoff = (wr * 32 * MB + fr) * 128, boff = 16384 + (wc * 64 + fr) * 128;
    f32x16 acc[MB][2];
#pragma unroll
    for (int i = 0; i < MB; ++i)
#pragma unroll
        for (int j = 0; j < 2; ++j)
#pragma unroll
            for (int r = 0; r < 16; ++r) acc[i][j][r] = 0.f;
    {
        unsigned char* la = lds + tid * 16;
#pragma unroll
        for (int i = 0; i < 4; ++i) {
            if (i < 2 * MB) glds16(gA + (size_t)i * 32 * lda, la + i * 4096);
            glds16(gB + (size_t)i * 32 * ldb, la + 16384 + i * 4096);
        }
        la += 32768;
#pragma unroll
        for (int i = 0; i < 4; ++i) {
            if (i < 2 * MB) glds16(gA + (size_t)i * 32 * lda + 64, la + i * 4096);
            glds16(gB + (size_t)i * 32 * ldb + 64, la + 16384 + i * 4096);
        }
    }
    for (int kt = 0; kt < nk; ++kt) {
        if (kt == 0) {
            if (MB == 2) asm volatile("s_waitcnt vmcnt(8) lgkmcnt(0)" ::: "memory"); else asm volatile("s_waitcnt vmcnt(6) lgkmcnt(0)" ::: "memory");
            __builtin_amdgcn_sched_barrier(0); __builtin_amdgcn_s_barrier(); __builtin_amdgcn_sched_barrier(0);
        } else {
            asm volatile("s_waitcnt vmcnt(0)" ::: "memory");
            __syncthreads();
        }
        if (kt >= 1 && kt + 1 < nk) {
            unsigned char* la = lds + ((kt + 1) & 1) * 32768 + tid * 16;
            const int ko = (kt + 1) * 64;
#pragma unroll
            for (int i = 0; i < 4; ++i) {
                if (i < 2 * MB) glds16(gA + (size_t)i * 32 * lda + ko, la + i * 4096);
                glds16(gB + (size_t)i * 32 * ldb + ko, la + 16384 + i * 4096);
            }
        }
        const unsigned char* base = lds + (kt & 1) * 32768;
        bf16x8 af[4][2], bfr[4][2];
#define LDFRAG(ks) { const int ch = ((2 * (ks) + fh) ^ sw) * 16; \
            af[ks][0] = *(const bf16x8*)(base + aoff + ch); bfr[ks][0] = *(const bf16x8*)(base + boff + ch); \
            bfr[ks][1] = *(const bf16x8*)(base + boff + 4096 + ch); if (MB == 2) af[ks][1] = *(const bf16x8*)(base + aoff + 4096 + ch); }
#define MFMA4(ks) { acc[0][0] = __builtin_amdgcn_mfma_f32_32x32x16_bf16(bfr[ks][0], af[ks][0], acc[0][0], 0, 0, 0); \
            acc[0][1] = __builtin_amdgcn_mfma_f32_32x32x16_bf16(bfr[ks][1], af[ks][0], acc[0][1], 0, 0, 0); \
            if (MB == 2) { acc[MB - 1][0] = __builtin_amdgcn_mfma_f32_32x32x16_bf16(bfr[ks][0], af[ks][1], acc[MB - 1][0], 0, 0, 0); \
            acc[MB - 1][1] = __builtin_amdgcn_mfma_f32_32x32x16_bf16(bfr[ks][1], af[ks][1], acc[MB - 1][1], 0, 0, 0); } }
        LDFRAG(0) LDFRAG(1)
        __builtin_amdgcn_sched_barrier(0);
        MFMA4(0) LDFRAG(2)
        __builtin_amdgcn_sched_barrier(0);
        MFMA4(1) LDFRAG(3)
        __builtin_amdgcn_sched_barrier(0);
        MFMA4(2)
        __builtin_amdgcn_sched_barrier(0);
        MFMA4(3)
#undef LDFRAG
#undef MFMA4
    }
    epi(acc, m0 + wr * 32 * MB, n0 + wc * 64, fr, fh, lds + wid * 8192);
    __syncthreads();
}

DEVI int xcd_remap(int t, int T) { return (t & 7) * (T >> 3) + (t >> 3); }

DEVI void mod_item(const Params& p, int it, unsigned char* lds) {
    const int tid = threadIdx.x;
    const int ks = it & 3, lc = it >> 2, l = lc / 48, cc = lc % 48;
    float* sc = (float*)lds;
    for (int i = tid; i < 768; i += 256) {
        const int cv = i >> 8, k = ks * 256 + (i & 255);
        const float cval = cv == 0 ? p.c_ctx[k] : p.c[(cv - 1) * 1024 + k];
        sc[i] = silu_f(cval);
    }
    __syncthreads();
    const float* W = (l ? p.w_mod1 : p.w_mod0) + (size_t)ks * 256 * 3072;
    const int cg4 = tid & 15, rg = tid >> 4, c0 = cc * 64 + cg4 * 4;
    f32x4 w[16];
#pragma unroll
    for (int i = 0; i < 16; ++i) w[i] = *(const f32x4*)(W + (size_t)(rg + 16 * i) * 3072 + c0);
    f32x4 a0 = {0.f, 0.f, 0.f, 0.f}, a1 = a0, a2 = a0;
#pragma unroll
    for (int i = 0; i < 16; ++i) { const int k = rg + 16 * i; a0 += sc[k] * w[i]; a1 += sc[256 + k] * w[i]; a2 += sc[512 + k] * w[i]; }
    float* red = (float*)(lds + 12288);
#pragma unroll
    for (int e = 0; e < 4; ++e) {
        red[(rg * 3 + 0) * 64 + cg4 * 4 + e] = a0[e];
        red[(rg * 3 + 1) * 64 + cg4 * 4 + e] = a1[e];
        red[(rg * 3 + 2) * 64 + cg4 * 4 + e] = a2[e];
    }
    __syncthreads();
    if (tid < 192) {
        const int cv = tid >> 6, j = tid & 63;
        float s = 0.f;
#pragma unroll
        for (int r = 0; r < 16; ++r) s += red[(r * 3 + cv) * 64 + j];
        float* modp = (float*)(p.ws + WS_MODP) + (size_t)ks * 18432;
        __hip_atomic_store(&modp[(l * 3 + cv) * 3072 + cc * 64 + j], s, __ATOMIC_RELAXED, __HIP_MEMORY_SCOPE_AGENT);
    }
    asm volatile("s_waitcnt vmcnt(0)" ::: "memory");
    __syncthreads();
    if (tid == 0) __hip_atomic_fetch_add((unsigned*)(p.ws + WS_CNT), 1u, __ATOMIC_RELAXED, __HIP_MEMORY_SCOPE_AGENT);
}

struct TrDesc { const float* src; bf16_t* dst; int N, kt, nt; };
DEVI TrDesc tr_desc(const Params& p, int idx) {
    TrDesc d;
    if (idx < 512) { d.src = p.w_in0; d.dst = (bf16_t*)(p.ws + WS_WT0IN); d.N = 2048; }
    else if (idx < 768) { idx -= 512; d.src = p.w_out0; d.dst = (bf16_t*)(p.ws + WS_WT0OUT); d.N = 1024; }
    else if (idx < 1408) { idx -= 768; d.src = p.w_in1; d.dst = (bf16_t*)(p.ws + WS_WT1IN); d.N = 2560; }
    else { idx -= 1408; d.src = p.w_out1; d.dst = (bf16_t*)(p.ws + WS_WT1OUT); d.N = 1024; }
    const int ntn = d.N >> 6;
    d.kt = idx / ntn; d.nt = idx % ntn;
    return d;
}
DEVI void transpose_items(const Params& p, int first, int end, int stride, unsigned char* lds) {
    const int tid = threadIdx.x;
    float* tl = (float*)lds;
    if (first >= end) return;
    f32x4 v[4];
    TrDesc d = tr_desc(p, first);
#pragma unroll
    for (int pass = 0; pass < 4; ++pass) v[pass] = *(const f32x4*)(d.src + (size_t)(d.kt * 64 + pass * 16 + (tid >> 4)) * d.N + d.nt * 64 + (tid & 15) * 4);
    for (int idx = first; idx < end; idx += stride) {
#pragma unroll
        for (int pass = 0; pass < 4; ++pass) {
            const int r = pass * 16 + (tid >> 4), c4 = (tid & 15) * 4;
#pragma unroll
            for (int e = 0; e < 4; ++e) tl[r * 65 + c4 + e] = v[pass][e];
        }
        const TrDesc cur = d;
        if (idx + stride < end) {
            d = tr_desc(p, idx + stride);
#pragma unroll
            for (int pass = 0; pass < 4; ++pass) v[pass] = *(const f32x4*)(d.src + (size_t)(d.kt * 64 + pass * 16 + (tid >> 4)) * d.N + d.nt * 64 + (tid & 15) * 4);
        }
        __syncthreads();
#pragma unroll
        for (int pass = 0; pass < 2; ++pass) {
            const int n = pass * 32 + (tid >> 3), kc = tid & 7;
            float x[8];
#pragma unroll
            for (int j = 0; j < 8; ++j) x[j] = tl[(kc * 8 + j) * 65 + n];
            u32x4 w;
            w.x = cvt_pk_bf16(x[0], x[1]); w.y = cvt_pk_bf16(x[2], x[3]); w.z = cvt_pk_bf16(x[4], x[5]); w.w = cvt_pk_bf16(x[6], x[7]);
            *(u32x4*)(cur.dst + (size_t)(cur.nt * 64 + n) * 1024 + cur.kt * 64 + kc * 8) = w;
        }
        __syncthreads();
    }
}

DEVI void phase0(const Params& p, unsigned char* lds) {
    for (int it = blockIdx.x; it < 384; it += gridDim.x) mod_item(p, it, lds);
    transpose_items(p, (blockIdx.x + 128) % gridDim.x, 1664, gridDim.x, lds);
    const int gt = blockIdx.x * 256 + threadIdx.x, gs = gridDim.x * 256;
    bf16_t* tw256 = (bf16_t*)(p.ws + WS_TW256);
    bf16_t* ts256 = (bf16_t*)(p.ws + WS_TS256);
    bf16_t* ts1024 = (bf16_t*)(p.ws + WS_TS1024);
    float* lut = (float*)(lds + 32768);
    __syncthreads();
    for (int r = threadIdx.x; r < 1024; r += 256) lut[r] = cospif((float)r * (1.f / 512.f));
    __syncthreads();
    for (int i = gt; i < 512 * 256; i += gs) {
        const int m = i >> 8, j = i & 255, which = m >> 8, cp = m & 255;
        const int r = ((cp * j) & 255) << 2;
        tw256[i] = f2bf(which ? lut[(r - 256) & 1023] : lut[r]);
    }
    for (int i = gt; i < 256 * 512; i += gs) {
        const int sp = i >> 9, k2 = i & 511, which = k2 >> 8, s0 = k2 & 255;
        const int r = ((sp * s0) & 255) << 2;
        ts256[i] = f2bf((which ? -lut[(r - 256) & 1023] : lut[r]) * (1.f / 256.f));
    }
    for (int i = gt; i < 1024 * 2048; i += gs) {
        const int sp = i >> 11, k2 = i & 2047, which = k2 >> 10, s0 = k2 & 1023;
        const int r = (sp * s0) & 1023;
        ts1024[i] = f2bf((which ? -lut[(r - 256) & 1023] : lut[r]) * (1.f / 512.f));
    }
    float* ropec = (float*)(p.ws + WS_ROPEC);
    float* ropes = (float*)(p.ws + WS_ROPES);
    for (int i = gt; i < 1024 * 32; i += gs) {
        const int pos = i >> 5, f = i & 31;
        const int row = pos >> 6, col = pos & 63;
        const float inv = powf(10000.f, -(float)(f & 15) * (1.f / 16.f));
        const float ang = (float)(f < 16 ? row : col) * inv;
        float s, c; sincosf(ang, &s, &c);
        ropec[i] = c; ropes[i] = s;
    }
    for (int i = gt; i < NTOK; i += gs) ((float*)(p.ws + WS_ROWSS))[i] = 0.f;
    bf16_t* kc = (bf16_t*)(p.ws + WS_KC);
    bf16_t* vct = (bf16_t*)(p.ws + WS_VCT);
    for (int i = gt; i < 2 * 256 * 256; i += gs) {
        kc[i] = f2bf(p.cache_k[i]);
        const int b = i >> 16, kvh = (i >> 14) & 3, d = (i >> 8) & 63, pp = i & 255;
        const int key = swap23(pp);
        vct[i] = f2bf(p.cache_v[((b * 256 + key) * 4 + kvh) * 64 + d]);
    }
}

DEVI void phase_norm(const Params& p, int layer, const float* lmod  ) {
    const int lane = threadIdx.x & 63, wid = threadIdx.x >> 6;
    const float* nw = layer ? p.norm_w1 : p.norm_w0;
    bf16_t* H = (bf16_t*)(p.ws + WS_H);
    const int stride = gridDim.x * 4;
    auto rowptr = [&](int row) -> const float* {
        if (layer == 0) return row < NCTX ? p.x_prompt + (size_t)row * D : p.x_sample + (size_t)(row - NCTX) * D;
        return (const float*)(p.ws + WS_X1) + (size_t)row * D;
    };
    int row = blockIdx.x * 4 + wid;
    if (row >= NTOK) return;
    f32x4 v[4], vn[4];
    {
        const float* xr = rowptr(row);
#pragma unroll
        for (int i = 0; i < 4; ++i) v[i] = *(const f32x4*)(xr + i * 256 + lane * 4);
    }
    for (; row < NTOK; row += stride) {
        const int nrow = row + stride;
        if (nrow < NTOK) {
            const float* xr = rowptr(nrow);
#pragma unroll
            for (int i = 0; i < 4; ++i) vn[i] = *(const f32x4*)(xr + i * 256 + lane * 4);
        }
        const float* mv = lmod + cond_of(row) * 2048;
        float ss = 0.f;
#pragma unroll
        for (int i = 0; i < 4; ++i) ss += v[i][0] * v[i][0] + v[i][1] * v[i][1] + v[i][2] * v[i][2] + v[i][3] * v[i][3];
        ss = wave_sum(ss);
        const float rstd = rsqrtf(ss * (1.f / 1024.f) + EPSV);
#pragma unroll
        for (int i = 0; i < 4; ++i) {
            const int k = i * 256 + lane * 4;
            const f32x4 w = *(const f32x4*)(nw + k);
            const f32x4 sh = *(const f32x4*)(mv + k);
            const f32x4 scl = *(const f32x4*)(mv + 1024 + k);
            float h[4];
#pragma unroll
            for (int e = 0; e < 4; ++e) h[e] = (v[i][e] * rstd * w[e]) * (1.f + scl[e]) + sh[e];
            u32x2 o; o.x = cvt_pk_bf16(h[0], h[1]); o.y = cvt_pk_bf16(h[2], h[3]);
            *(u32x2*)(H + (size_t)row * D + k) = o;
        }
#pragma unroll
        for (int i = 0; i < 4; ++i) v[i] = vn[i];
    }
}

DEVI void bias1_items(const Params& p, int lb, int nb) {
    const int lane = threadIdx.x & 63, gw = lb * 4 + (threadIdx.x >> 6), nw = nb * 4;
    const float* mod1 = (const float*)(p.ws + WS_MOD) + 3 * 3072;
    const bf16_t* WT = (const bf16_t*)(p.ws + WS_WT1IN);
    float* bias1 = (float*)(p.ws + WS_BIAS1);
    for (int n = gw; n < 2560; n += nw) {
        float w[16];
        const u32x4 r0 = *(const u32x4*)(WT + (size_t)n * 1024 + lane * 16), r1 = *(const u32x4*)(WT + (size_t)n * 1024 + lane * 16 + 8);
        const unsigned rr[8] = {r0.x, r0.y, r0.z, r0.w, r1.x, r1.y, r1.z, r1.w};
#pragma unroll
        for (int i = 0; i < 8; ++i) { w[2 * i] = __uint_as_float(rr[i] << 16); w[2 * i + 1] = __uint_as_float(rr[i] & 0xffff0000u); }
        float s[3];
#pragma unroll
        for (int cv = 0; cv < 3; ++cv) {
            float a = 0.f;
#pragma unroll
            for (int q = 0; q < 4; ++q) {
                const f32x4 sh = *(const f32x4*)(mod1 + cv * 3072 + lane * 16 + q * 4);
#pragma unroll
                for (int e = 0; e < 4; ++e) a += sh[e] * w[q * 4 + e];
            }
            s[cv] = wave_sum(a);
        }
        if (lane == 0) { bias1[n] = s[0]; bias1[2560 + n] = s[1]; bias1[5120 + n] = s[2]; }
    }
}

struct EpiInL0 {
    bf16_t *U, *SZ;
    DEVI void operator()(const f32x16 (&acc)[2][2], int mbase, int nbase, int fr, int fh, unsigned char* wl) const {
        const bool isz = nbase >= 1024;
        bf16_t* dst = isz ? SZ : U;
        const int nb0 = isz ? nbase - 1024 : nbase;
        u32x2 keep = {0u, 0u};
#pragma unroll
        for (int mb = 0; mb < 2; ++mb)
#pragma unroll
            for (int nb = 0; nb < 2; ++nb)
#pragma unroll
                for (int g = 0; g < 4; ++g) {
                    const int m = mbase + mb * 32 + fr, n = nb0 + nb * 32 + 8 * g + 4 * fh;
                    float v[4];
#pragma unroll
                    for (int e = 0; e < 4; ++e) { v[e] = acc[mb][nb][4 * g + e]; if (isz) v[e] = silu_f(v[e]); }
                    u32x2 o; o.x = cvt_pk_bf16(v[0], v[1]); o.y = cvt_pk_bf16(v[2], v[3]);
                    if ((g & 1) == 0) keep = o; else put8(wl, mb * 32 + fr, nb * 4 + (g - 1) + fh, keep, o);
                }
        flush8<64>(wl, fh * 32 + fr, [&](int r) { return dst + (size_t)(mbase + r) * D + nb0; });
    }
};

struct EpiChanDft {
    bf16_t* VT; int g;
    DEVI void operator()(const f32x16 (&acc)[2][2], int mbase, int nbase, int fr, int fh, unsigned char* wl) const {
        int S, bgi, s0; bf16_t* base;
        if (nbase < NCTX) { S = 256; bgi = (nbase >> 8) * 4 + g; s0 = nbase & 255; base = VT; }
        else { const int t = nbase - NCTX; S = 1024; bgi = (t >> 10) * 4 + g; s0 = t & 1023; base = VT + (size_t)64 * 256 * 512; }
        u32x2 keep = {0u, 0u};
#pragma unroll
        for (int mb = 0; mb < 2; ++mb)
#pragma unroll
            for (int nb = 0; nb < 2; ++nb)
#pragma unroll
                for (int gq = 0; gq < 4; ++gq) {
                    const int m = mbase + mb * 32 + fr, which = m >> 8, cp = m & 255;
                    const int s = s0 + nb * 32 + 8 * gq + 4 * fh;
                    u32x2 o; o.x = cvt_pk_bf16(acc[mb][nb][4 * gq], acc[mb][nb][4 * gq + 1]); o.y = cvt_pk_bf16(acc[mb][nb][4 * gq + 2], acc[mb][nb][4 * gq + 3]);
                    if ((gq & 1) == 0) keep = o; else put8(wl, mb * 32 + fr, nb * 4 + (gq - 1) + fh, keep, o);
                }
        flush8<64>(wl, fh * 32 + fr, [&](int r) { const int m = mbase + r; return base + ((size_t)bgi * 256 + (m & 255)) * (2 * S) + (m >> 8) * S + s0; });
    }
};

template <int MB> struct EpiSeqDft {
    const bf16_t* SZ; bf16_t* Y; int tok0, g;
    DEVI void operator()(const f32x16 (&acc)[MB][2], int mbase, int nbase, int fr, int fh, unsigned char* wl) const {
        u32x2 keep = {0u, 0u};
#pragma unroll
        for (int mb = 0; mb < MB; ++mb)
#pragma unroll
            for (int nb = 0; nb < 2; ++nb)
#pragma unroll
                for (int gq = 0; gq < 4; ++gq) {
                    const int tok = tok0 + mbase + mb * 32 + fr;
                    const int col = g * 256 + nbase + nb * 32 + 8 * gq + 4 * fh;
                    const u32x2 z = *(const u32x2*)(SZ + (size_t)tok * D + col);
                    const float z0 = __uint_as_float(z.x << 16), z1 = __uint_as_float(z.x & 0xffff0000u);
                    const float z2 = __uint_as_float(z.y << 16), z3 = __uint_as_float(z.y & 0xffff0000u);
                    u32x2 o; o.x = cvt_pk_bf16(acc[mb][nb][4 * gq] * z0, acc[mb][nb][4 * gq + 1] * z1);
                    o.y = cvt_pk_bf16(acc[mb][nb][4 * gq + 2] * z2, acc[mb][nb][4 * gq + 3] * z3);
                    if ((gq & 1) == 0) keep = o; else put8(wl, mb * 32 + fr, nb * 4 + (gq - 1) + fh, keep, o);
                }
        flush8<32 * MB>(wl, fh * 32 + fr, [&](int r) { return Y + (size_t)(tok0 + mbase + r) * D + g * 256 + nbase; });
    }
};

#define DPP_ADD(x, CTRL) ((x) + __uint_as_float((unsigned)__builtin_amdgcn_update_dpp(0, (int)__float_as_uint(x), CTRL, 0xF, 0xF, true)))
DEVI float row16_sum(float x) {
    x = DPP_ADD(x, 0xB1);
    x = DPP_ADD(x, 0x4E);
    x = DPP_ADD(x, 0x141);
    x = DPP_ADD(x, 0x140);
    return x;
}
template <bool NEXT, int MB> struct EpiOut {
    const float* xa; const float* xb;
    const float* mod;
    float* out;
    const float* nw1; const float* mod1; bf16_t* Hn; float* rowss;
    DEVI void operator()(const f32x16 (&acc)[MB][2], int mbase, int nbase, int fr, int fh, unsigned char* wl) const {
        const int lane = fh * 32 + fr, c4 = lane & 15, rsub = lane >> 4;
        const int cv = cond_of(mbase);
        const int n = nbase + c4 * 4;
        const f32x4 gv = *(const f32x4*)(mod + cv * 3072 + 2048 + n);
        f32x4 hv = {0.f, 0.f, 0.f, 0.f};
        if (NEXT) {
            const f32x4 w = *(const f32x4*)(nw1 + n);
            const f32x4 sc = *(const f32x4*)(mod1 + cv * 3072 + 1024 + n);
#pragma unroll
            for (int e = 0; e < 4; ++e) hv[e] = w[e] * (1.f + sc[e]);
        }
#pragma unroll
        for (int mb = 0; mb < MB; ++mb) {
#pragma unroll
            for (int nb = 0; nb < 2; ++nb)
#pragma unroll
                for (int g = 0; g < 4; ++g) {
                    f32x4 a = {acc[mb][nb][4 * g], acc[mb][nb][4 * g + 1], acc[mb][nb][4 * g + 2], acc[mb][nb][4 * g + 3]};
                    *(f32x4*)(wl + fr * 256 + (((nb * 8 + 2 * g + fh) ^ (fr & 15)) << 4)) = a;
                }
#pragma unroll
            for (int i = 0; i < 8; ++i) {
                const int r = i * 4 + rsub, m = mbase + mb * 32 + r;
                const f32x4 a = *(const f32x4*)(wl + r * 256 + ((c4 ^ (r & 15)) << 4));
                const float* xr = m < NCTX ? xa + (size_t)m * D : xb + (size_t)(m - NCTX) * D;
                const f32x4 xv = *(const f32x4*)(xr + n);
                f32x4 o;
#pragma unroll
                for (int e = 0; e < 4; ++e) o[e] = xv[e] + gv[e] * a[e];
                *(f32x4*)(out + (size_t)m * D + n) = o;
                if (NEXT) {
                    float ss = (o[0] * o[0] + o[1] * o[1]) + (o[2] * o[2] + o[3] * o[3]);
                    ss = row16_sum(ss);
                    if (c4 == 0) atomicAdd(rowss + m, ss);
                    u32x2 hb; hb.x = cvt_pk_bf16(o[0] * hv[0], o[1] * hv[1]); hb.y = cvt_pk_bf16(o[2] * hv[2], o[3] * hv[3]);
                    *(u32x2*)(Hn + (size_t)m * D + n) = hb;
                }
            }
        }
    }
};

struct EpiInL1 {
    const float *qnw, *knw, *ropec, *ropes;
    bf16_t *Q, *KB, *VTB, *SZ;
    float *outk, *outv;
    const float* rowss; const float* bias1;
    DEVI void operator()(const f32x16 (&acc_in)[2][2], int mbase, int nbase, int fr, int fh, unsigned char* wl) const {
        const bool lat = mbase >= NCTX;
        u32x2 keep1 = {0u, 0u}, keep2 = {0u, 0u};
        f32x16 acc[2][2];
        {
            const float* bp = bias1 + cond_of(mbase) * 2560 + nbase;
#pragma unroll
            for (int mb = 0; mb < 2; ++mb) {
                const float rstd = rsqrtf(rowss[mbase + mb * 32 + fr] * (1.f / 1024.f) + EPSV);
#pragma unroll
                for (int nb = 0; nb < 2; ++nb)
#pragma unroll
                    for (int g = 0; g < 4; ++g) {
                        const f32x4 bv = *(const f32x4*)(bp + nb * 32 + 8 * g + 4 * fh);
#pragma unroll
                        for (int e = 0; e < 4; ++e) acc[mb][nb][4 * g + e] = acc_in[mb][nb][4 * g + e] * rstd + bv[e];
                    }
            }
        }
        if (nbase < 1280) {
            const bool isq = nbase < 1024;
            const float* nwp = isq ? qnw : knw;
#pragma unroll
            for (int mb = 0; mb < 2; ++mb) {
                const int m = mbase + mb * 32 + fr;
                float ss = 0.f;
#pragma unroll
                for (int nb = 0; nb < 2; ++nb)
#pragma unroll
                    for (int r = 0; r < 16; ++r) ss += acc[mb][nb][r] * acc[mb][nb][r];
                ss = xhalf_sum(ss);
                const float rn = rsqrtf(ss * (1.f / 64.f) + EPSV);
                const int pos = lat ? ((m - NCTX) & 1023) : 0;
#pragma unroll
                for (int g = 0; g < 4; ++g) {
                    const int d0 = 8 * g + 4 * fh;
                    const f32x4 w1 = *(const f32x4*)(nwp + d0), w2 = *(const f32x4*)(nwp + 32 + d0);
                    float x1[4], x2[4];
#pragma unroll
                    for (int e = 0; e < 4; ++e) { x1[e] = acc[mb][0][4 * g + e] * rn * w1[e]; x2[e] = acc[mb][1][4 * g + e] * rn * w2[e]; }
                    if (lat) {
                        const f32x4 cv = *(const f32x4*)(ropec + pos * 32 + d0), sv = *(const f32x4*)(ropes + pos * 32 + d0);
#pragma unroll
                        for (int e = 0; e < 4; ++e) { const float a = x1[e], b = x2[e]; x1[e] = a * cv[e] - b * sv[e]; x2[e] = a * sv[e] + b * cv[e]; }
                    }
                    if (isq) {
                        const float qs = 0.125f * LOG2E;
                        u32x2 o1, o2;
                        o1.x = cvt_pk_bf16(x1[0] * qs, x1[1] * qs); o1.y = cvt_pk_bf16(x1[2] * qs, x1[3] * qs);
                        o2.x = cvt_pk_bf16(x2[0] * qs, x2[1] * qs); o2.y = cvt_pk_bf16(x2[2] * qs, x2[3] * qs);
                        if ((g & 1) == 0) { keep1 = o1; keep2 = o2; }
                        else { put8(wl, mb * 32 + fr, (g - 1) + fh, keep1, o1); put8(wl, mb * 32 + fr, 4 + (g - 1) + fh, keep2, o2); }
                    } else {
                        const int kc = nbase - 1024;
                        u32x2 o1, o2;
                        o1.x = cvt_pk_bf16(x1[0], x1[1]); o1.y = cvt_pk_bf16(x1[2], x1[3]);
                        o2.x = cvt_pk_bf16(x2[0], x2[1]); o2.y = cvt_pk_bf16(x2[2], x2[3]);
                        if ((g & 1) == 0) { keep1 = o1; keep2 = o2; }
                        else { put8(wl, mb * 32 + fr, (g - 1) + fh, keep1, o1); put8(wl, mb * 32 + fr, 4 + (g - 1) + fh, keep2, o2); }
                        if (!lat) {
                            f32x4 f1 = {x1[0], x1[1], x1[2], x1[3]}, f2 = {x2[0], x2[1], x2[2], x2[3]};
                            *(f32x4*)(outk + (size_t)m * 256 + kc + d0) = f1;
                            *(f32x4*)(outk + (size_t)m * 256 + kc + 32 + d0) = f2;
                        }
                    }
                }
            }
            if (isq) flush8<64>(wl, fh * 32 + fr, [&](int r) { return Q + (size_t)(mbase + r) * D + nbase; });
            else flush8<64>(wl, fh * 32 + fr, [&](int r) { return KB + (size_t)(mbase + r) * 256 + (nbase - 1024); });
        } else if (nbase < 1536) {
            const int vc = nbase - 1280, kvh = vc >> 6;
            bf16_t* vtb; int S, sbase;
            if (!lat) { S = 256; sbase = mbase & 255; vtb = VTB + ((size_t)((mbase >> 8) * 4 + kvh) * 64) * 256; }
            else { const int t = mbase - NCTX; S = 1024; sbase = t & 1023; vtb = VTB + (size_t)16 * 4 * 64 * 256 + ((size_t)((t >> 10) * 4 + kvh) * 64) * 1024; }
#pragma unroll
            for (int mb = 0; mb < 2; ++mb) {
                const int m = mbase + mb * 32 + fr;
                const int cpos = swap23(mb * 32 + fr);
                unsigned char* wcol = wl + ((cpos & 7) << 1);
                const int cch = cpos >> 3;
#pragma unroll
                for (int nb = 0; nb < 2; ++nb)
#pragma unroll
                    for (int g = 0; g < 4; ++g) {
                        const int d0 = nb * 32 + 8 * g + 4 * fh;
#pragma unroll
                        for (int e = 0; e < 4; ++e) { const int d = d0 + e; *(bf16_t*)(wcol + d * 128 + ((cch ^ (d & 7)) << 4)) = f2bf(acc[mb][nb][4 * g + e]); }
                        if (!lat) {
                            f32x4 f = {acc[mb][nb][4 * g], acc[mb][nb][4 * g + 1], acc[mb][nb][4 * g + 2], acc[mb][nb][4 * g + 3]};
                            *(f32x4*)(outv + (size_t)m * 256 + vc + d0) = f;
                        }
                    }
            }
            flush8<64>(wl, fh * 32 + fr, [&](int r) { return vtb + (size_t)r * S + sbase; });
        } else {
            const int zc = nbase - 1536;
#pragma unroll
            for (int mb = 0; mb < 2; ++mb)
#pragma unroll
                for (int nb = 0; nb < 2; ++nb)
#pragma unroll
                    for (int g = 0; g < 4; ++g) {
                        const int m = mbase + mb * 32 + fr, n = zc + nb * 32 + 8 * g + 4 * fh;
                        u32x2 o; o.x = cvt_pk_bf16(silu_f(acc[mb][nb][4 * g]), silu_f(acc[mb][nb][4 * g + 1]));
                        o.y = cvt_pk_bf16(silu_f(acc[mb][nb][4 * g + 2]), silu_f(acc[mb][nb][4 * g + 3]));
                        if ((g & 1) == 0) keep1 = o; else put8(wl, mb * 32 + fr, nb * 4 + (g - 1) + fh, keep1, o);
                    }
            flush8<64>(wl, fh * 32 + fr, [&](int r) { return SZ + (size_t)(mbase + r) * D + zc; });
        }
    }
};

DEVI void attn_item(const Params& p, int item, unsigned char* lds) {
    const int lane = threadIdx.x & 63, w = threadIdx.x >> 6, fr = lane & 31, fh = lane >> 5;
    const bf16_t* Q = (const bf16_t*)(p.ws + WS_Q);
    const bf16_t* KB = (const bf16_t*)(p.ws + WS_KB);
    const bf16_t* VTB = (const bf16_t*)(p.ws + WS_VTB);
    const bf16_t* KC = (const bf16_t*)(p.ws + WS_KC);
    const bf16_t* VCT = (const bf16_t*)(p.ws + WS_VCT);
    const bf16_t* SZ = (const bf16_t*)(p.ws + WS_SZ);
    bf16_t* Y = (bf16_t*)(p.ws + WS_Y);
    bool lat; int b, kvh, qb, tb;
    if (item < 256) { lat = true; b = item >> 7; kvh = (item >> 5) & 3; qb = item & 31; tb = NCTX + b * 1024; }
    else { const int it = item - 256; lat = false; b = it >> 5; kvh = (it >> 3) & 3; qb = it & 7; tb = b * 256; }
    const int head = kvh * 4 + w;
    const int qtok = tb + qb * 32 + fr;
    bf16x8 qf[4];
#pragma unroll
    for (int ks = 0; ks < 4; ++ks) qf[ks] = *(const bf16x8*)(Q + (size_t)qtok * D + head * 64 + ks * 16 + fh * 8);
    float m_run = p.sink[head] * LOG2E, l_run = 1.f;
    f32x16 O[2];
#pragma unroll
    for (int i = 0; i < 2; ++i)
#pragma unroll
        for (int r = 0; r < 16; ++r) O[i][r] = 0.f;

    int nloc, k_lo = 0; const bf16_t *kloc, *vloc; int ldloc;
    if (lat) {
        k_lo = qb - 4 < 0 ? 0 : qb - 4; const int k_hi = qb + 4 > 31 ? 31 : qb + 4; nloc = k_hi - k_lo + 1;
        kloc = KB + (size_t)(tb + k_lo * 32) * 256 + kvh * 64;
        vloc = VTB + (size_t)16 * 4 * 64 * 256 + ((size_t)(b * 4 + kvh) * 64) * 1024 + k_lo * 32; ldloc = 1024;
    } else {
        nloc = 8; kloc = KB + (size_t)tb * 256 + kvh * 64; vloc = VTB + ((size_t)(b * 4 + kvh) * 64) * 256; ldloc = 256;
    }
    const int nblk = lat ? nloc + 8 : 8;
    const bf16_t* kcb = KC + (size_t)(b * 256) * 256 + kvh * 64;
    const bf16_t* vcb = VCT + ((size_t)(b * 4 + kvh) * 64) * 256;
    const int tid = threadIdx.x;
    const int kkey = tid >> 3, kch = tid & 7, vd = tid >> 2, vch = tid & 3;
    const unsigned kst = kkey * 128 + ((kch ^ ((kkey >> 1) & 7)) << 4), vst = 4096 + vd * 64 + ((vch ^ ((vd >> 2) & 3)) << 4);
    const unsigned ksw = (fr >> 1) & 7, vsw = (fr >> 2) & 3;
    u32x4 kA, vA, kB, vB;
#define LOADKV(j, KR, VR) { const bf16_t *kp_, *vp_; int ldv_; \
        if ((j) < nloc) { kp_ = kloc + (size_t)(j) * 32 * 256; vp_ = vloc + (j) * 32; ldv_ = ldloc; } \
        else { const int c_ = (j) - nloc; kp_ = kcb + (size_t)c_ * 32 * 256; vp_ = vcb + c_ * 32; ldv_ = 256; } \
        KR = *(const u32x4*)(kp_ + (size_t)kkey * 256 + kch * 8); VR = *(const u32x4*)(vp_ + (size_t)vd * ldv_ + vch * 8); }
    auto compute = [&](int j) {
        const unsigned char* lb = lds + (j & 1) * 8192;
        bf16x8 kf[4], vf[4];
#pragma unroll
        for (int ks = 0; ks < 4; ++ks) kf[ks] = *(const bf16x8*)(lb + fr * 128 + (((2 * ks + fh) ^ ksw) << 4));
#pragma unroll
        for (int s2 = 0; s2 < 2; ++s2)
#pragma unroll
            for (int db = 0; db < 2; ++db) vf[s2 * 2 + db] = *(const bf16x8*)(lb + 4096 + (db * 32 + fr) * 64 + (((2 * s2 + fh) ^ vsw) << 4));
        f32x16 s;
#pragma unroll
        for (int r = 0; r < 16; ++r) s[r] = 0.f;
#pragma unroll
        for (int ks = 0; ks < 4; ++ks) s = __builtin_amdgcn_mfma_f32_32x32x16_bf16(kf[ks], qf[ks], s, 0, 0, 0);
        if (lat && j < nloc) {
            const int kb = k_lo + j;
            const int mode = (kb == qb - 4) ? 1 : (kb == qb + 4) ? 2 : 0;
            if (mode) {
                const int dpos = (kb - qb) * 32;
#pragma unroll
                for (int r = 0; r < 16; ++r) {
                    const int rel = dpos + (r & 3) + 8 * (r >> 2) + 4 * fh - fr;
                    const bool ok = mode == 1 ? (rel >= -128) : (rel <= 128);
                    if (!ok) s[r] = -1e30f;
                }
            }
        }
        float mx = s[0];
#pragma unroll
        for (int r = 1; r < 16; ++r) mx = fmaxf(mx, s[r]);
        mx = xhalf_max(mx);
        const float m_new = fmaxf(m_run, mx);
        const float alpha = __builtin_amdgcn_exp2f(m_run - m_new);
        float rs = 0.f;
#pragma unroll
        for (int r = 0; r < 16; ++r) { s[r] = __builtin_amdgcn_exp2f(s[r] - m_new); rs += s[r]; }
        rs = xhalf_sum(rs);
        l_run = l_run * alpha + rs; m_run = m_new;
#pragma unroll
        for (int i = 0; i < 2; ++i)
#pragma unroll
            for (int r = 0; r < 16; ++r) O[i][r] *= alpha;
#pragma unroll
        for (int s2 = 0; s2 < 2; ++s2) {
            union { u32x4 u; bf16x8 v; } pf;
            pf.u.x = cvt_pk_bf16(s[8 * s2 + 0], s[8 * s2 + 1]); pf.u.y = cvt_pk_bf16(s[8 * s2 + 2], s[8 * s2 + 3]);
            pf.u.z = cvt_pk_bf16(s[8 * s2 + 4], s[8 * s2 + 5]); pf.u.w = cvt_pk_bf16(s[8 * s2 + 6], s[8 * s2 + 7]);
#pragma unroll
            for (int db = 0; db < 2; ++db) O[db] = __builtin_amdgcn_mfma_f32_32x32x16_bf16(vf[s2 * 2 + db], pf.v, O[db], 0, 0, 0);
        }
    };
    LOADKV(0, kA, vA)
    *(u32x4*)(lds + kst) = kA; *(u32x4*)(lds + vst) = vA;
    if (nblk > 1) LOADKV(1, kA, vA)
    if (nblk > 2) LOADKV(2, kB, vB)
    __syncthreads();
    for (int j = 0; j < nblk; j += 2) {
        compute(j);
        if (j + 1 < nblk) { *(u32x4*)(lds + 8192 + kst) = kA; *(u32x4*)(lds + 8192 + vst) = vA; }
        if (j + 3 < nblk) LOADKV(j + 3, kA, vA)
        __syncthreads();
        if (j + 1 < nblk) {
            compute(j + 1);
            if (j + 2 < nblk) { *(u32x4*)(lds + kst) = kB; *(u32x4*)(lds + vst) = vB; }
            if (j + 4 < nblk) LOADKV(j + 4, kB, vB)
            __syncthreads();
        }
    }
#undef LOADKV
    const float il = 1.f / l_run;
    u32x2 keepy = {0u, 0u};
#pragma unroll
    for (int db = 0; db < 2; ++db)
#pragma unroll
        for (int g = 0; g < 4; ++g) {
            const int col = head * 64 + db * 32 + 8 * g + 4 * fh;
            const u32x2 z = *(const u32x2*)(SZ + (size_t)qtok * D + col);
            const float z0 = __uint_as_float(z.x << 16), z1 = __uint_as_float(z.x & 0xffff0000u);
            const float z2 = __uint_as_float(z.y << 16), z3 = __uint_as_float(z.y & 0xffff0000u);
            u32x2 o; o.x = cvt_pk_bf16(O[db][4 * g] * il * z0, O[db][4 * g + 1] * il * z1);
            o.y = cvt_pk_bf16(O[db][4 * g + 2] * il * z2, O[db][4 * g + 3] * il * z3);
            if ((g & 1) == 0) keepy = o; else put8(lds + w * 8192, fr, db * 4 + (g - 1) + fh, keepy, o);
        }
    flush8<32>(lds + w * 8192, lane, [&](int r) { return Y + (size_t)(tb + qb * 32 + r) * D + head * 64; });
    __syncthreads();
}


#define XB_TMO      128
#define XB_XCNT(j)  (256  + 64 * (j))
#define XB_XSUB(j)  (1280 + 64 * (j))
#define XB_XGEN(j)  (2304 + 64 * (j))
#define XB_TOP      3328
#define XB_TOPGEN   3392
#define XCD_BAR_WORDS 3456
#define XB_SPIN_CAP (1u << 18)
#define LAS __attribute__((address_space(3)))
DEVI unsigned xb_ld(unsigned* p)              { return __hip_atomic_load(p, __ATOMIC_RELAXED, __HIP_MEMORY_SCOPE_AGENT); }
DEVI unsigned xb_add(unsigned* p, unsigned v) { return __hip_atomic_fetch_add(p, v, __ATOMIC_RELAXED, __HIP_MEMORY_SCOPE_AGENT); }
DEVI unsigned xb_xcc_id() { return (unsigned)__builtin_amdgcn_s_getreg((3 << 11) | 20) & 0xFu; }
#define XB_SPIN(cond, bar) do { unsigned _sp = 0; while (cond) { __builtin_amdgcn_s_sleep(1); \
    if ((++_sp & 255u) == 0u) { if (xb_ld(&(bar)[XB_TMO])) break; if (_sp > XB_SPIN_CAP) { atomicAdd(&(bar)[XB_TMO], 1u); break; } } } } while (0)
struct XcdBarrier { unsigned* bar; unsigned x; volatile LAS unsigned* st; };
DEVI XcdBarrier xcd_barrier_post(unsigned* bar, volatile LAS unsigned* st) {
    XcdBarrier b; b.bar = bar; b.x = xb_xcc_id(); b.st = st;
    if (threadIdx.x == 0) (void)xb_add(&bar[XB_XCNT(b.x)], 1u);
    return b;
}
DEVI void xcd_barrier_complete(unsigned* bar, unsigned x, unsigned& nloc, unsigned& nx) {
    const unsigned G = gridDim.x * gridDim.y * gridDim.z;
    unsigned sum, cnt, mine, sp = 0u;
    for (;;) {
        sum = 0u; cnt = 0u; mine = 0u;
#pragma unroll
        for (unsigned j = 0; j < 16; ++j) { const unsigned c = xb_ld(&bar[XB_XCNT(j)]); sum += c; cnt += (c > 0u) ? 1u : 0u; mine = (j == x) ? c : mine; }
        if (sum == G) break;
        __builtin_amdgcn_s_sleep(1);
        if ((++sp & 255u) == 0u) { if (xb_ld(&bar[XB_TMO])) break; if (sp > XB_SPIN_CAP) { atomicAdd(&bar[XB_TMO], 1u); break; } }
    }
    nloc = mine > 0u ? mine : 1u; nx = cnt > 0u ? cnt : 1u;
}
DEVI void xcd_barrier(const XcdBarrier& b) {
    asm volatile("s_waitcnt vmcnt(0)" ::: "memory");
    __syncthreads();
    if (threadIdx.x == 0) {
        unsigned* bar = b.bar;
        __builtin_amdgcn_s_waitcnt(0);
        unsigned nloc = b.st[0], nx = b.st[1];
        if (nloc == 0u) { xcd_barrier_complete(bar, b.x, nloc, nx); b.st[0] = nloc; b.st[1] = nx; }
        const unsigned old = xb_add(&bar[XB_XSUB(b.x)], 1u);
        const unsigned gen = old / nloc;
        if (old + 1u == (gen + 1u) * nloc) {
            __builtin_amdgcn_fence(__ATOMIC_RELEASE, "agent");
            asm volatile("s_waitcnt vmcnt(0)" ::: "memory");
            const unsigned og = xb_add(&bar[XB_TOP], 1u);
            const unsigned tg = og / nx;
            if (og + 1u == (tg + 1u) * nx) xb_add(&bar[XB_TOPGEN], 1u);
            else XB_SPIN(xb_ld(&bar[XB_TOPGEN]) == tg, bar);
            __builtin_amdgcn_fence(__ATOMIC_ACQUIRE, "agent");
            xb_add(&bar[XB_XGEN(b.x)], 1u);
            asm volatile("s_waitcnt vmcnt(0)" ::: "memory");
        } else {
            XB_SPIN(xb_ld(&bar[XB_XGEN(b.x)]) == gen, bar);
            __builtin_amdgcn_fence(__ATOMIC_ACQUIRE, "agent");
            asm volatile("s_waitcnt vmcnt(0)" ::: "memory");
        }
    }
    __syncthreads();
}

DEVI void run_phase(const Params& p, int ph, unsigned char* lds) {
    const int G = gridDim.x;
    bf16_t* H = (bf16_t*)(p.ws + WS_H);
    bf16_t* U = (bf16_t*)(p.ws + WS_U);
    bf16_t* SZ = (bf16_t*)(p.ws + WS_SZ);
    bf16_t* VT = (bf16_t*)(p.ws + WS_VT);
    bf16_t* Y = (bf16_t*)(p.ws + WS_Y);
    float* X1 = (float*)(p.ws + WS_X1);
    const float* mod = (const float*)(p.ws + WS_MOD);
    switch (ph) {
    case 0: {
        phase0(p, lds);
        if (threadIdx.x == 0) {
            unsigned* cnt = (unsigned*)(p.ws + WS_CNT); unsigned sp = 0;
            while (__hip_atomic_load(cnt, __ATOMIC_RELAXED, __HIP_MEMORY_SCOPE_AGENT) < 384u) { __builtin_amdgcn_s_sleep(4); if (++sp > (1u << 22)) break; }
        }
        __syncthreads();
        const float* modp = (const float*)(p.ws + WS_MODP);
        if (blockIdx.x < 72) {
            const int i = blockIdx.x * 256 + threadIdx.x, l = i / 9216, j = i % 3072;
            float s = (l ? p.b_mod1 : p.b_mod0)[j];
#pragma unroll
            for (int ks = 0; ks < 4; ++ks) s += __hip_atomic_load(modp + ks * 18432 + i, __ATOMIC_RELAXED, __HIP_MEMORY_SCOPE_AGENT);
            ((float*)(p.ws + WS_MOD))[i] = s;
        }
        float* lmod = (float*)lds;
        {
            float tmp[24];
#pragma unroll
            for (int q = 0; q < 24; ++q) {
                const int i = threadIdx.x + 256 * q, src_i = (i >> 11) * 3072 + (i & 2047);
                float s = p.b_mod0[i & 2047];
#pragma unroll
                for (int ks = 0; ks < 4; ++ks) s += __hip_atomic_load(modp + ks * 18432 + src_i, __ATOMIC_RELAXED, __HIP_MEMORY_SCOPE_AGENT);
                tmp[q] = s;
            }
#pragma unroll
            for (int q = 0; q < 24; ++q) lmod[threadIdx.x + 256 * q] = tmp[q];
        }
        __syncthreads();
        phase_norm(p, 0, lmod);
    } break;
    case 2: {
        EpiInL0 e{U, SZ};
        const bf16_t* W0 = (const bf16_t*)(p.ws + WS_WT0IN);
        auto run_list = [&](int kind, int a, int bq, int cnt) {
#pragma unroll 1
            for (int i = 0; i < cnt; ++i) {
                int m0v, n0v;
                if (kind == 0) { m0v = a * 128; n0v = bq * 256 + i * 128; }
                else { const int zt = a + i; m0v = (zt >> 3) * 128; n0v = 1024 + (zt & 7) * 128; }
                asm volatile("" : "+s"(m0v), "+s"(n0v));
                gemm_tile(H, D, W0, D, 16, lds, e, m0v, n0v);
            }
            if (kind == 0) {
                __builtin_amdgcn_fence(__ATOMIC_RELEASE, "workgroup");
                asm volatile("s_waitcnt vmcnt(0)" ::: "memory");
                __syncthreads();
                __builtin_amdgcn_fence(__ATOMIC_ACQUIRE, "workgroup");
                EpiChanDft ec{VT, bq};
#pragma unroll 1
                for (int m4 = 0; m4 < 4; ++m4) {
                    int m0v = m4 * 128, n0v = a * 128;
                    asm volatile("" : "+s"(m0v), "+s"(n0v));
                    gemm_tile((const bf16_t*)(p.ws + WS_TW256), 256, U + bq * 256, D, 4, lds, ec, m0v, n0v);
                }
            }
        };
        if (G == 512) {
            const int b = blockIdx.x;
            if (b < 192) { const int tt = (b & 7) * 24 + (b >> 3); run_list(0, tt >> 2, tt & 3, 2); }
            else if (b < 256) run_list(1, 2 * (b - 192), 0, 2);
            else if (b < 448) { const int l = b - 256; run_list(1, 192 + (l & 7) * 24 + (l >> 3), 0, 1); }
            else { run_list(1, 128 + (b - 448), 0, 1); bias1_items(p, b - 448, 64); }
        } else {
            for (int it = blockIdx.x; it < 576; it += G) { if (it < 192) run_list(0, it >> 2, it & 3, 2); else run_list(1, it - 192, 0, 1); }
            bias1_items(p, blockIdx.x, G);
        }
    } break;
    case 4: {
        for (int t = blockIdx.x; t < 512; t += G) {
            if (t < 256) {
                const int nt = t & 1, mt = (t >> 1) & 15, bg = t >> 5;
                EpiSeqDft<1> e{SZ, Y, NCTX + (bg >> 2) * 1024, bg & 3};
                gemm_tile<1>((const bf16_t*)(p.ws + WS_TS1024), 2048, VT + (size_t)64 * 256 * 512 + (size_t)bg * 256 * 2048, 2048, 32, lds, e, mt * 64, nt * 128);
            } else {
                const int u = t - 256, nt = u & 1, mt = (u >> 1) & 1, bg = u >> 2;
                EpiSeqDft<2> e{SZ, Y, (bg >> 2) * 256, bg & 3};
                gemm_tile<2>((const bf16_t*)(p.ws + WS_TS256), 512, VT + (size_t)bg * 256 * 512, 512, 8, lds, e, mt * 128, nt * 128);
            }
        }
    } break;
    case 5: {
        EpiOut<true, 2> e{p.x_prompt, p.x_sample, mod, X1, p.norm_w1, mod + 3 * 3072, H, (float*)(p.ws + WS_ROWSS)};
        EpiOut<true, 1> e1{p.x_prompt, p.x_sample, mod, X1, p.norm_w1, mod + 3 * 3072, H, (float*)(p.ws + WS_ROWSS)};
        if (G == 512) {
            if (blockIdx.x < 256) { const int tt = xcd_remap(blockIdx.x, 256); gemm_tile<2>(Y, D, (const bf16_t*)(p.ws + WS_WT0OUT), D, 16, lds, e, (tt >> 3) * 128, (tt & 7) * 128); }
            else { const int tt = xcd_remap(blockIdx.x - 256, 256); gemm_tile<1>(Y, D, (const bf16_t*)(p.ws + WS_WT0OUT), D, 16, lds, e1, 4096 + (tt >> 3) * 64, (tt & 7) * 128); }
        } else
        for (int t = blockIdx.x; t < 384; t += G) {
            const int tt = xcd_remap(t, 384);
            gemm_tile(Y, D, (const bf16_t*)(p.ws + WS_WT0OUT), D, 16, lds, e, (tt >> 3) * 128, (tt & 7) * 128);
        }
    } break;
    case 7: {
        EpiInL1 e{p.qnw, p.knw, (const float*)(p.ws + WS_ROPEC), (const float*)(p.ws + WS_ROPES),
                  (bf16_t*)(p.ws + WS_Q), (bf16_t*)(p.ws + WS_KB), (bf16_t*)(p.ws + WS_VTB), SZ,
                  p.out + (size_t)NTOK * D, p.out + (size_t)NTOK * D + (size_t)NCTX * 256,
                  (const float*)(p.ws + WS_ROWSS), (const float*)(p.ws + WS_BIAS1)};
        for (int t = blockIdx.x; t < 960; t += G) {
            const int x = t & 7, j = t >> 3;
            const int mtile = x * 6 + j % 6, ntile = j / 6;
            gemm_tile(H, D, (const bf16_t*)(p.ws + WS_WT1IN), D, 16, lds, e, mtile * 128, ntile * 128);
        }
    } break;
    case 8: {
        if (G == 512) {
            if (blockIdx.x < 256) attn_item(p, blockIdx.x, lds);
            else { attn_item(p, 256 + 2 * (blockIdx.x - 256), lds); attn_item(p, 257 + 2 * (blockIdx.x - 256), lds); }
        } else
            for (int t = blockIdx.x; t < 768; t += G) attn_item(p, t, lds);
    } break;
    case 9: {
        EpiOut<false, 2> e{X1, X1 + (size_t)NCTX * D, mod + 3 * 3072, p.out, nullptr, nullptr, nullptr, nullptr};
        EpiOut<false, 1> e1{X1, X1 + (size_t)NCTX * D, mod + 3 * 3072, p.out, nullptr, nullptr, nullptr, nullptr};
        if (G == 512) {
            if (blockIdx.x < 256) { const int tt = xcd_remap(blockIdx.x, 256); gemm_tile<2>(Y, D, (const bf16_t*)(p.ws + WS_WT1OUT), D, 16, lds, e, (tt >> 3) * 128, (tt & 7) * 128); }
            else { const int tt = xcd_remap(blockIdx.x - 256, 256); gemm_tile<1>(Y, D, (const bf16_t*)(p.ws + WS_WT1OUT), D, 16, lds, e1, 4096 + (tt >> 3) * 64, (tt & 7) * 128); }
        } else
        for (int t = blockIdx.x; t < 384; t += G) {
            const int tt = xcd_remap(t, 384);
            gemm_tile(Y, D, (const bf16_t*)(p.ws + WS_WT1OUT), D, 16, lds, e, (tt >> 3) * 128, (tt & 7) * 128);
        }
    } break;
    }
}

__global__ void __launch_bounds__(256, 2) mega(Params p) {
    __shared__ __attribute__((aligned(16))) unsigned char lds[65536 + 16];
    cg::grid_group grid = cg::this_grid();
#if SINGLE_LAUNCH
    volatile LAS unsigned* st = (volatile LAS unsigned*)(lds + 65536);
    if (threadIdx.x < 4) st[threadIdx.x] = 0u;
    __syncthreads();
    XcdBarrier bar = xcd_barrier_post((unsigned*)(p.ws + WS_BAR), st);
    if (p.ph_hi == 777) grid.sync();
#ifndef REP_PH
#define REP_PH -1
#endif
#ifndef REP_SY
#define REP_SY 0
#endif
#define PH(n) run_phase(p, n, lds); if (REP_PH == n) run_phase(p, n, lds);
#define SY() xcd_barrier(bar); if (REP_SY) xcd_barrier(bar);
#else
    const int lo = (int)p.ph_lo, hi = (int)p.ph_hi;
#define PH(n) if (lo <= n && n < hi) run_phase(p, n, lds);
#define SY()
#endif
    PH(0) SY() PH(2) SY() PH(4) SY() PH(5) SY() PH(7) SY() PH(8) SY() PH(9)
}

extern "C" void kernel_launch(void* const* d_in, const int* in_sizes, int n_in, void* d_out, int out_size, void* d_ws, size_t ws_size, hipStream_t stream) {
    static int grid_blocks = 0;
    if (!grid_blocks) {
        int dev = 0, cus = 0, per_cu = 0;
        hipGetDevice(&dev);
        hipDeviceGetAttribute(&cus, hipDeviceAttributeMultiprocessorCount, dev);
        hipOccupancyMaxActiveBlocksPerMultiprocessor(&per_cu, mega, 256, 0);
        if (per_cu > 2) per_cu = 2;
        if (per_cu < 1) per_cu = 1;
        grid_blocks = cus * per_cu;
    }
    Params p{};
    const float* const* in = (const float* const*)d_in;
    p.x_prompt = in[0]; p.x_sample = in[1]; p.cache_k = in[2]; p.cache_v = in[3]; p.c = in[4]; p.c_ctx = in[5];
    p.norm_w0 = in[6]; p.w_mod0 = in[7]; p.b_mod0 = in[8]; p.w_in0 = in[9]; p.w_out0 = in[10];
    p.norm_w1 = in[11]; p.w_mod1 = in[12]; p.b_mod1 = in[13]; p.w_in1 = in[14]; p.qnw = in[15]; p.knw = in[16]; p.sink = in[17]; p.w_out1 = in[18];
    p.out = (float*)d_out; p.ws = (unsigned char*)d_ws;
#if SINGLE_LAUNCH
    p.ph_lo = 0; p.ph_hi = 10;
    hipMemsetAsync((unsigned char*)d_ws + WS_BAR, 0, 16384, stream);
    void* args[] = {&p};
    hipError_t e = hipLaunchCooperativeKernel((void*)mega, dim3(grid_blocks), dim3(256), args, 0, stream);
    if (e != hipSuccess) fprintf(stderr, "cooperative launch failed: %s (grid %d)\n", hipGetErrorString(e), grid_blocks);
#else
    for (int ph = 0; ph < 10; ++ph) {
        p.ph_lo = ph; p.ph_hi = ph + 1;
        hipLaunchKernelGGL(mega, dim3(grid_blocks), dim3(256), 0, stream, p);
    }
#endif
}
```

```cpp
#include <hip/hip_runtime.h>
#include <hip/hip_cooperative_groups.h>
#include <stdint.h>
#include <cstdio>
namespace cg = cooperative_groups;

#ifndef SINGLE_LAUNCH
#define SINGLE_LAUNCH 1
#endif

typedef unsigned short bf16_t;
typedef short bf16x8 __attribute__((ext_vector_type(8)));
typedef float f32x16 __attribute__((ext_vector_type(16)));
typedef float f32x4 __attribute__((ext_vector_type(4)));
typedef unsigned u32x4 __attribute__((ext_vector_type(4)));
typedef unsigned u32x2 __attribute__((ext_vector_type(2)));
#define DEVI __device__ __forceinline__

constexpr int NTOK = 6144, NCTX = 4096, D = 1024;
constexpr float EPSV = 1e-6f;
constexpr float LOG2E = 1.4426950408889634f;

constexpr size_t WS_MOD = 0;
constexpr size_t WS_WT0IN = 1 << 20;
constexpr size_t WS_WT0OUT = WS_WT0IN + (size_t)2048 * 1024 * 2;
constexpr size_t WS_WT1IN = WS_WT0OUT + (size_t)1024 * 1024 * 2;
constexpr size_t WS_WT1OUT = WS_WT1IN + (size_t)2560 * 1024 * 2;
constexpr size_t WS_TW256 = WS_WT1OUT + (size_t)1024 * 1024 * 2;
constexpr size_t WS_TS256 = WS_TW256 + (size_t)512 * 256 * 2;
constexpr size_t WS_TS1024 = WS_TS256 + (size_t)256 * 512 * 2;
constexpr size_t WS_ROPEC = WS_TS1024 + (size_t)1024 * 2048 * 2;
constexpr size_t WS_ROPES = WS_ROPEC + (size_t)1024 * 32 * 4;
constexpr size_t WS_KC = WS_ROPES + (size_t)1024 * 32 * 4;
constexpr size_t WS_VCT = WS_KC + (size_t)2 * 256 * 256 * 2;
constexpr size_t WS_H = WS_VCT + (size_t)2 * 256 * 256 * 2;
constexpr size_t WS_U = WS_H + (size_t)NTOK * D * 2;
constexpr size_t WS_SZ = WS_U + (size_t)NTOK * D * 2;
constexpr size_t WS_VT = WS_SZ + (size_t)NTOK * D * 2;
constexpr size_t WS_Y = WS_VT + (size_t)NTOK * 2048 * 2;
constexpr size_t WS_X1 = WS_Y + (size_t)NTOK * D * 2;
constexpr size_t WS_Q = WS_X1 + (size_t)NTOK * D * 4;
constexpr size_t WS_KB = WS_Q + (size_t)NTOK * D * 2;
constexpr size_t WS_VTB = WS_KB + (size_t)NTOK * 256 * 2;
constexpr size_t WS_BAR = WS_VTB + (size_t)NTOK * 256 * 2;
constexpr size_t WS_CNT = WS_BAR + 14336;
constexpr size_t WS_ROWSS = WS_BAR + 16384;
constexpr size_t WS_BIAS1 = WS_ROWSS + 6144 * 4;
constexpr size_t WS_MODP = WS_BIAS1 + 3 * 2560 * 4;
constexpr size_t WS_END = WS_MODP + (size_t)4 * 18432 * 4;

struct Params {
    const float *x_prompt, *x_sample, *cache_k, *cache_v, *c, *c_ctx;
    const float *norm_w0, *w_mod0, *b_mod0, *w_in0, *w_out0;
    const float *norm_w1, *w_mod1, *b_mod1, *w_in1, *qnw, *knw, *sink, *w_out1;
    float* out;
    unsigned char* ws;
    long long ph_lo, ph_hi;
};

DEVI unsigned cvt_pk_bf16(float lo, float hi) { unsigned r; asm("v_cvt_pk_bf16_f32 %0, %1, %2" : "=v"(r) : "v"(lo), "v"(hi)); return r; }
DEVI bf16_t f2bf(float f) { return (bf16_t)(cvt_pk_bf16(f, 0.f) & 0xffffu); }
DEVI float silu_f(float v) { return v * __builtin_amdgcn_rcpf(1.f + __expf(-v)); }
DEVI int swap23(int x) { return (x & ~12) | ((x & 4) << 1) | ((x & 8) >> 1); }
DEVI int cond_of(int m) { return m < NCTX ? 0 : 1 + ((m - NCTX) >> 10); }

DEVI void st8(bf16_t* p, u32x2 a, u32x2 b) {
    const auto r0 = __builtin_amdgcn_permlane32_swap(a.x, b.x, false, false);
    const auto r1 = __builtin_amdgcn_permlane32_swap(a.y, b.y, false, false);
    u32x4 w; w.x = r0[0]; w.y = r1[0]; w.z = r0[1]; w.w = r1[1];
    *(u32x4*)p = w;
}
DEVI void put8(unsigned char* wl, int r, int c, u32x2 a, u32x2 b) {
    const auto r0 = __builtin_amdgcn_permlane32_swap(a.x, b.x, false, false);
    const auto r1 = __builtin_amdgcn_permlane32_swap(a.y, b.y, false, false);
    u32x4 w; w.x = r0[0]; w.y = r1[0]; w.z = r0[1]; w.w = r1[1];
    *(u32x4*)(wl + r * 128 + ((c ^ (r & 7)) << 4)) = w;
}
template <int ROWS, class RowPtr>
DEVI void flush8(const unsigned char* wl, int lane, const RowPtr& rowptr) {
#pragma unroll
    for (int i = 0; i < ROWS / 8; ++i) {
        const int r = i * 8 + (lane >> 3), c = lane & 7;
        const u32x4 w = *(const u32x4*)(wl + r * 128 + ((c ^ (r & 7)) << 4));
        *(u32x4*)(rowptr(r) + c * 8) = w;
    }
}
#define DPP_ADD0(x, CTRL) ((x) + __uint_as_float((unsigned)__builtin_amdgcn_update_dpp(0, (int)__float_as_uint(x), CTRL, 0xF, 0xF, true)))
DEVI float wave_sum(float x) {
    x = DPP_ADD0(x, 0xB1); x = DPP_ADD0(x, 0x4E); x = DPP_ADD0(x, 0x141); x = DPP_ADD0(x, 0x140);
    const auto r = __builtin_amdgcn_permlane16_swap(__float_as_uint(x), __float_as_uint(x), false, false);
    x = __uint_as_float(r[0]) + __uint_as_float(r[1]);
    const auto q = __builtin_amdgcn_permlane32_swap(__float_as_uint(x), __float_as_uint(x), false, false);
    return __uint_as_float(q[0]) + __uint_as_float(q[1]);
}
DEVI float xhalf_sum(float x) { const auto r = __builtin_amdgcn_permlane32_swap(__float_as_uint(x), __float_as_uint(x), false, false); return __uint_as_float(r[0]) + __uint_as_float(r[1]); }
DEVI float xhalf_max(float x) { const auto r = __builtin_amdgcn_permlane32_swap(__float_as_uint(x), __float_as_uint(x), false, false); return fmaxf(__uint_as_float(r[0]), __uint_as_float(r[1])); }

DEVI void glds16(const void* g, void* l) { __builtin_amdgcn_global_load_lds(g, l, 16, 0, 0); }

template <int MB = 2, class Epi>
DEVI void gemm_tile(const bf16_t* __restrict__ A, int lda, const bf16_t* __restrict__ B, int ldb, int nk,
                    unsigned char* lds, const Epi& epi, int m0, int n0) {
    const int tid = threadIdx.x, lane = tid & 63, wid = tid >> 6, wr = wid >> 1, wc = wid & 1;
    const int srow = tid >> 3;
    const int slc = (tid & 7) ^ ((tid >> 4) & 7);
    const bf16_t* gA = A + (size_t)(m0 + srow) * lda + slc * 8;
    const bf16_t* gB = B + (size_t)(n0 + srow) * ldb + slc * 8;
    const int fr = lane & 31, fh = lane >> 5, sw = (lane >> 1) & 7;
    const unsigned aoff = (wr * 32 * MB + fr) * 128, boff = 16384 + (wc * 64 + fr) * 128;
    f32x16 acc[MB][2];
#pragma unroll
    for (int i = 0; i < MB; ++i)
#pragma unroll
        for (int j = 0; j < 2; ++j)
#pragma unroll
            for (int r = 0; r < 16; ++r) acc[i][j][r] = 0.f;
    {
        unsigned char* la = lds + tid * 16;
#pragma unroll
        for (int i = 0; i < 4; ++i) {
            if (i < 2 * MB) glds16(gA + (size_t)i * 32 * lda, la + i * 4096);
            glds16(gB + (size_t)i * 32 * ldb, la + 16384 + i * 4096);
        }
        la += 32768;
#pragma unroll
        for (int i = 0; i < 4; ++i) {
            if (i < 2 * MB) glds16(gA + (size_t)i * 32 * lda + 64, la + i * 4096);
            glds16(gB + (size_t)i * 32 * ldb + 64, la + 16384 + i * 4096);
        }
    }
    for (int kt = 0; kt < nk; ++kt) {
        if (kt == 0) {
            if (MB == 2) asm volatile("s_waitcnt vmcnt(8) lgkmcnt(0)" ::: "memory"); else asm volatile("s_waitcnt vmcnt(6) lgkmcnt(0)" ::: "memory");
            __builtin_amdgcn_sched_barrier(0); __builtin_amdgcn_s_barrier(); __builtin_amdgcn_sched_barrier(0);
        } else {
            asm volatile("s_waitcnt vmcnt(0)" ::: "memory");
            __syncthreads();
        }
        if (kt >= 1 && kt + 1 < nk) {
            unsigned char* la = lds + ((kt + 1) & 1) * 32768 + tid * 16;
            const int ko = (kt + 1) * 64;
#pragma unroll
            for (int i = 0; i < 4; ++i) {
                if (i < 2 * MB) glds16(gA + (size_t)i * 32 * lda + ko, la + i * 4096);
                glds16(gB + (size_t)i * 32 * ldb + ko, la + 16384 + i * 4096);
            }
        }
        const unsigned char* base = lds + (kt & 1) * 32768;
        bf16x8 af[4][2], bfr[4][2];
#define LDFRAG(ks) { const int ch = ((2 * (ks) + fh) ^ sw) * 16; \
            af[ks][0] = *(const bf16x8*)(base + aoff + ch); bfr[ks][0] = *(const bf16x8*)(base + boff + ch); \
            bfr[ks][1] = *(const bf16x8*)(base + boff + 4096 + ch); if (MB == 2) af[ks][1] = *(const bf16x8*)(base + aoff + 4096 + ch); }
#define MFMA4(ks) { acc[0][0] = __builtin_amdgcn_mfma_f32_32x32x16_bf16(bfr[ks][0], af[ks][0], acc[0][0], 0, 0, 0); \
            acc[0][1] = __builtin_amdgcn_mfma_f32_32x32x16_bf16(bfr[ks][1], af[ks][0], acc[0][1], 0, 0, 0); \
            if (MB == 2) { acc[MB - 1][0] = __builtin_amdgcn_mfma_f32_32x32x16_bf16(bfr[ks][0], af[ks][1], acc[MB - 1][0], 0, 0, 0); \
            acc[MB - 1][1] = __builtin_amdgcn_mfma_f32_32x32x16_bf16(bfr[ks][1], af[ks][1], acc[MB - 1][1], 0, 0, 0); } }
        LDFRAG(0) LDFRAG(1)
        __builtin_amdgcn_sched_barrier(0);
        MFMA4(0) LDFRAG(2)
        __builtin_amdgcn_sched_barrier(0);
        MFMA4(1) LDFRAG(3)
        __builtin_amdgcn_sched_barrier(0);
        MFMA4(2)
        __builtin_amdgcn_sched_barrier(0);
        MFMA4(3)
#undef LDFRAG
#undef MFMA4
    }
    epi(acc, m0 + wr * 32 * MB, n0 + wc * 64, fr, fh, lds + wid * 8192);
    __syncthreads();
}

DEVI int xcd_remap(int t, int T) { return (t & 7) * (T >> 3) + (t >> 3); }

DEVI void mod_item(const Params& p, int it, unsigned char* lds) {
    const int tid = threadIdx.x;
    const int ks = it & 3, lc = it >> 2, l = lc / 48, cc = lc % 48;
    float* sc = (float*)lds;
    for (int i = tid; i < 768; i += 256) {
        const int cv = i >> 8, k = ks * 256 + (i & 255);
        const float cval = cv == 0 ? p.c_ctx[k] : p.c[(cv - 1) * 1024 + k];
        sc[i] = silu_f(cval);
    }
    __syncthreads();
    const float* W = (l ? p.w_mod1 : p.w_mod0) + (size_t)ks * 256 * 3072;
    const int cg4 = tid & 15, rg = tid >> 4, c0 = cc * 64 + cg4 * 4;
    f32x4 w[16];
#pragma unroll
    for (int i = 0; i < 16; ++i) w[i] = *(const f32x4*)(W + (size_t)(rg + 16 * i) * 3072 + c0);
    f32x4 a0 = {0.f, 0.f, 0.f, 0.f}, a1 = a0, a2 = a0;
#pragma unroll
    for (int i = 0; i < 16; ++i) { const int k = rg + 16 * i; a0 += sc[k] * w[i]; a1 += sc[256 + k] * w[i]; a2 += sc[512 + k] * w[i]; }
    float* red = (float*)(lds + 12288);
#pragma unroll
    for (int e = 0; e < 4; ++e) {
        red[(rg * 3 + 0) * 64 + cg4 * 4 + e] = a0[e];
        red[(rg * 3 + 1) * 64 + cg4 * 4 + e] = a1[e];
        red[(rg * 3 + 2) * 64 + cg4 * 4 + e] = a2[e];
    }
    __syncthreads();
    if (tid < 192) {
        const int cv = tid >> 6, j = tid & 63;
        float s = 0.f;
#pragma unroll
        for (int r = 0; r < 16; ++r) s += red[(r * 3 + cv) * 64 + j];
        float* modp = (float*)(p.ws + WS_MODP) + (size_t)ks * 18432;
        __hip_atomic_store(&modp[(l * 3 + cv) * 3072 + cc * 64 + j], s, __ATOMIC_RELAXED, __HIP_MEMORY_SCOPE_AGENT);
    }
    asm volatile("s_waitcnt vmcnt(0)" ::: "memory");
    __syncthreads();
    if (tid == 0) __hip_atomic_fetch_add((unsigned*)(p.ws + WS_CNT), 1u, __ATOMIC_RELAXED, __HIP_MEMORY_SCOPE_AGENT);
}

struct TrDesc { const float* src; bf16_t* dst; int N, kt, nt; };
DEVI TrDesc tr_desc(const Params& p, int idx) {
    TrDesc d;
    if (idx < 512) { d.src = p.w_in0; d.dst = (bf16_t*)(p.ws + WS_WT0IN); d.N = 2048; }
    else if (idx < 768) { idx -= 512; d.src = p.w_out0; d.dst = (bf16_t*)(p.ws + WS_WT0OUT); d.N = 1024; }
    else if (idx < 1408) { idx -= 768; d.src = p.w_in1; d.dst = (bf16_t*)(p.ws + WS_WT1IN); d.N = 2560; }
    else { idx -= 1408; d.src = p.w_out1; d.dst = (bf16_t*)(p.ws + WS_WT1OUT); d.N = 1024; }
    const int ntn = d.N >> 6;
    d.kt = idx / ntn; d.nt = idx % ntn;
    return d;
}
DEVI void transpose_items(const Params& p, int first, int end, int stride, unsigned char* lds) {
    const int tid = threadIdx.x;
    float* tl = (float*)lds;
    if (first >= end) return;
    f32x4 v[4];
    TrDesc d = tr_desc(p, first);
#pragma unroll
    for (int pass = 0; pass < 4; ++pass) v[pass] = *(const f32x4*)(d.src + (size_t)(d.kt * 64 + pass * 16 + (tid >> 4)) * d.N + d.nt * 64 + (tid & 15) * 4);
    for (int idx = first; idx < end; idx += stride) {
#pragma unroll
        for (int pass = 0; pass < 4; ++pass) {
            const int r = pass * 16 + (tid >> 4), c4 = (tid & 15) * 4;
#pragma unroll
            for (int e = 0; e < 4; ++e) tl[r * 65 + c4 + e] = v[pass][e];
        }
        const TrDesc cur = d;
        if (idx + stride < end) {
            d = tr_desc(p, idx + stride);
#pragma unroll
            for (int pass = 0; pass < 4; ++pass) v[pass] = *(const f32x4*)(d.src + (size_t)(d.kt * 64 + pass * 16 + (tid >> 4)) * d.N + d.nt * 64 + (tid & 15) * 4);
        }
        __syncthreads();
#pragma unroll
        for (int pass = 0; pass < 2; ++pass) {
            const int n = pass * 32 + (tid >> 3), kc = tid & 7;
            float x[8];
#pragma unroll
            for (int j = 0; j < 8; ++j) x[j] = tl[(kc * 8 + j) * 65 + n];
            u32x4 w;
            w.x = cvt_pk_bf16(x[0], x[1]); w.y = cvt_pk_bf16(x[2], x[3]); w.z = cvt_pk_bf16(x[4], x[5]); w.w = cvt_pk_bf16(x[6], x[7]);
            *(u32x4*)(cur.dst + (size_t)(cur.nt * 64 + n) * 1024 + cur.kt * 64 + kc * 8) = w;
        }
        __syncthreads();
    }
}

DEVI void phase0(const Params& p, unsigned char* lds) {
    for (int it = blockIdx.x; it < 384; it += gridDim.x) mod_item(p, it, lds);
    transpose_items(p, (blockIdx.x + 128) % gridDim.x, 1664, gridDim.x, lds);
    const int gt = blockIdx.x * 256 + threadIdx.x, gs = gridDim.x * 256;
    bf16_t* tw256 = (bf16_t*)(p.ws + WS_TW256);
    bf16_t* ts256 = (bf16_t*)(p.ws + WS_TS256);
    bf16_t* ts1024 = (bf16_t*)(p.ws + WS_TS1024);
    float* lut = (float*)(lds + 32768);
    __syncthreads();
    for (int r = threadIdx.x; r < 1024; r += 256) lut[r] = cospif((float)r * (1.f / 512.f));
    __syncthreads();
    for (int i = gt; i < 512 * 256; i += gs) {
        const int m = i >> 8, j = i & 255, which = m >> 8, cp = m & 255;
        const int r = ((cp * j) & 255) << 2;
        tw256[i] = f2bf(which ? lut[(r - 256) & 1023] : lut[r]);
    }
    for (int i = gt; i < 256 * 512; i += gs) {
        const int sp = i >> 9, k2 = i & 511, which = k2 >> 8, s0 = k2 & 255;
        const int r = ((sp * s0) & 255) << 2;
        ts256[i] = f2bf((which ? -lut[(r - 256) & 1023] : lut[r]) * (1.f / 256.f));
    }
    for (int i = gt; i < 1024 * 2048; i += gs) {
        const int sp = i >> 11, k2 = i & 2047, which = k2 >> 10, s0 = k2 & 1023;
        const int r = (sp * s0) & 1023;
        ts1024[i] = f2bf((which ? -lut[(r - 256) & 1023] : lut[r]) * (1.f / 512.f));
    }
    float* ropec = (float*)(p.ws + WS_ROPEC);
    float* ropes = (float*)(p.ws + WS_ROPES);
    for (int i = gt; i < 1024 * 32; i += gs) {
        const int pos = i >> 5, f = i & 31;
        const int row = pos >> 6, col = pos & 63;
        const float inv = powf(10000.f, -(float)(f & 15) * (1.f / 16.f));
        const float ang = (float)(f < 16 ? row : col) * inv;
        float s, c; sincosf(ang, &s, &c);
        ropec[i] = c; ropes[i] = s;
    }
    for (int i = gt; i < NTOK; i += gs) ((float*)(p.ws + WS_ROWSS))[i] = 0.f;
    bf16_t* kc = (bf16_t*)(p.ws + WS_KC);
    bf16_t* vct = (bf16_t*)(p.ws + WS_VCT);
    for (int i = gt; i < 2 * 256 * 256; i += gs) {
        kc[i] = f2bf(p.cache_k[i]);
        const int b = i >> 16, kvh = (i >> 14) & 3, d = (i >> 8) & 63, pp = i & 255;
        const int key = swap23(pp);
        vct[i] = f2bf(p.cache_v[((b * 256 + key) * 4 + kvh) * 64 + d]);
    }
}

DEVI void phase_norm(const Params& p, int layer, const float* lmod  ) {
    const int lane = threadIdx.x & 63, wid = threadIdx.x >> 6;
    const float* nw = layer ? p.norm_w1 : p.norm_w0;
    bf16_t* H = (bf16_t*)(p.ws + WS_H);
    const int stride = gridDim.x * 4;
    auto rowptr = [&](int row) -> const float* {
        if (layer == 0) return row < NCTX ? p.x_prompt + (size_t)row * D : p.x_sample + (size_t)(row - NCTX) * D;
        return (const float*)(p.ws + WS_X1) + (size_t)row * D;
    };
    int row = blockIdx.x * 4 + wid;
    if (row >= NTOK) return;
    f32x4 v[4], vn[4];
    {
        const float* xr = rowptr(row);
#pragma unroll
        for (int i = 0; i < 4; ++i) v[i] = *(const f32x4*)(xr + i * 256 + lane * 4);
    }
    for (; row < NTOK; row += stride) {
        const int nrow = row + stride;
        if (nrow < NTOK) {
            const float* xr = rowptr(nrow);
#pragma unroll
            for (int i = 0; i < 4; ++i) vn[i] = *(const f32x4*)(xr + i * 256 + lane * 4);
        }
        const float* mv = lmod + cond_of(row) * 2048;
        float ss = 0.f;
#pragma unroll
        for (int i = 0; i < 4; ++i) ss += v[i][0] * v[i][0] + v[i][1] * v[i][1] + v[i][2] * v[i][2] + v[i][3] * v[i][3];
        ss = wave_sum(ss);
        const float rstd = rsqrtf(ss * (1.f / 1024.f) + EPSV);
#pragma unroll
        for (int i = 0; i < 4; ++i) {
            const int k = i * 256 + lane * 4;
            const f32x4 w = *(const f32x4*)(nw + k);
            const f32x4 sh = *(const f32x4*)(mv + k);
            const f32x4 scl = *(const f32x4*)(mv + 1024 + k);
            float h[4];
#pragma unroll
            for (int e = 0; e < 4; ++e) h[e] = (v[i][e] * rstd * w[e]) * (1.f + scl[e]) + sh[e];
            u32x2 o; o.x = cvt_pk_bf16(h[0], h[1]); o.y = cvt_pk_bf16(h[2], h[3]);
            *(u32x2*)(H + (size_t)row * D + k) = o;
        }
#pragma unroll
        for (int i = 0; i < 4; ++i) v[i] = vn[i];
    }
}

DEVI void bias1_items(const Params& p, int lb, int nb) {
    const int lane = threadIdx.x & 63, gw = lb * 4 + (threadIdx.x >> 6), nw = nb * 4;
    const float* mod1 = (const float*)(p.ws + WS_MOD) + 3 * 3072;
    const bf16_t* WT = (const bf16_t*)(p.ws + WS_WT1IN);
    float* bias1 = (float*)(p.ws + WS_BIAS1);
    for (int n = gw; n < 2560; n += nw) {
        float w[16];
        const u32x4 r0 = *(const u32x4*)(WT + (size_t)n * 1024 + lane * 16), r1 = *(const u32x4*)(WT + (size_t)n * 1024 + lane * 16 + 8);
        const unsigned rr[8] = {r0.x, r0.y, r0.z, r0.w, r1.x, r1.y, r1.z, r1.w};
#pragma unroll
        for (int i = 0; i < 8; ++i) { w[2 * i] = __uint_as_float(rr[i] << 16); w[2 * i + 1] = __uint_as_float(rr[i] & 0xffff0000u); }
        float s[3];
#pragma unroll
        for (int cv = 0; cv < 3; ++cv) {
            float a = 0.f;
#pragma unroll
            for (int q = 0; q < 4; ++q) {
                const f32x4 sh = *(const f32x4*)(mod1 + cv * 3072 + lane * 16 + q * 4);
#pragma unroll
                for (int e = 0; e < 4; ++e) a += sh[e] * w[q * 4 + e];
            }
            s[cv] = wave_sum(a);
        }
        if (lane == 0) { bias1[n] = s[0]; bias1[2560 + n] = s[1]; bias1[5120 + n] = s[2]; }
    }
}

struct EpiInL0 {
    bf16_t *U, *SZ;
    DEVI void operator()(const f32x16 (&acc)[2][2], int mbase, int nbase, int fr, int fh, unsigned char* wl) const {
        const bool isz = nbase >= 1024;
        bf16_t* dst = isz ? SZ : U;
        const int nb0 = isz ? nbase - 1024 : nbase;
        u32x2 keep = {0u, 0u};
#pragma unroll
        for (int mb = 0; mb < 2; ++mb)
#pragma unroll
            for (int nb = 0; nb < 2; ++nb)
#pragma unroll
                for (int g = 0; g < 4; ++g) {
                    const int m = mbase + mb * 32 + fr, n = nb0 + nb * 32 + 8 * g + 4 * fh;
                    float v[4];
#pragma unroll
                    for (int e = 0; e < 4; ++e) { v[e] = acc[mb][nb][4 * g + e]; if (isz) v[e] = silu_f(v[e]); }
                    u32x2 o; o.x = cvt_pk_bf16(v[0], v[1]); o.y = cvt_pk_bf16(v[2], v[3]);
                    if ((g & 1) == 0) keep = o; else put8(wl, mb * 32 + fr, nb * 4 + (g - 1) + fh, keep, o);
                }
        flush8<64>(wl, fh * 32 + fr, [&](int r) { return dst + (size_t)(mbase + r) * D + nb0; });
    }
};

struct EpiChanDft {
    bf16_t* VT; int g;
    DEVI void operator()(const f32x16 (&acc)[2][2], int mbase, int nbase, int fr, int fh, unsigned char* wl) const {
        int S, bgi, s0; bf16_t* base;
        if (nbase < NCTX) { S = 256; bgi = (nbase >> 8) * 4 + g; s0 = nbase & 255; base = VT; }
        else { const int t = nbase - NCTX; S = 1024; bgi = (t >> 10) * 4 + g; s0 = t & 1023; base = VT + (size_t)64 * 256 * 512; }
        u32x2 keep = {0u, 0u};
#pragma unroll
        for (int mb = 0; mb < 2; ++mb)
#pragma unroll
            for (int nb = 0; nb < 2; ++nb)
#pragma unroll
                for (int gq = 0; gq < 4; ++gq) {
                    const int m = mbase + mb * 32 + fr, which = m >> 8, cp = m & 255;
                    const int s = s0 + nb * 32 + 8 * gq + 4 * fh;
                    u32x2 o; o.x = cvt_pk_bf16(acc[mb][nb][4 * gq], acc[mb][nb][4 * gq + 1]); o.y = cvt_pk_bf16(acc[mb][nb][4 * gq + 2], acc[mb][nb][4 * gq + 3]);
                    if ((gq & 1) == 0) keep = o; else put8(wl, mb * 32 + fr, nb * 4 + (gq - 1) + fh, keep, o);
                }
        flush8<64>(wl, fh * 32 + fr, [&](int r) { const int m = mbase + r; return base + ((size_t)bgi * 256 + (m & 255)) * (2 * S) + (m >> 8) * S + s0; });
    }
};

template <int MB> struct EpiSeqDft {
    const bf16_t* SZ; bf16_t* Y; int tok0, g;
    DEVI void operator()(const f32x16 (&acc)[MB][2], int mbase, int nbase, int fr, int fh, unsigned char* wl) const {
        u32x2 keep = {0u, 0u};
#pragma unroll
        for (int mb = 0; mb < MB; ++mb)
#pragma unroll
            for (int nb = 0; nb < 2; ++nb)
#pragma unroll
                for (int gq = 0; gq < 4; ++gq) {
                    const int tok = tok0 + mbase + mb * 32 + fr;
                    const int col = g * 256 + nbase + nb * 32 + 8 * gq + 4 * fh;
                    const u32x2 z = *(const u32x2*)(SZ + (size_t)tok * D + col);
                    const float z0 = __uint_as_float(z.x << 16), z1 = __uint_as_float(z.x & 0xffff0000u);
                    const float z2 = __uint_as_float(z.y << 16), z3 = __uint_as_float(z.y & 0xffff0000u);
                    u32x2 o; o.x = cvt_pk_bf16(acc[mb][nb][4 * gq] * z0, acc[mb][nb][4 * gq + 1] * z1);
                    o.y = cvt_pk_bf16(acc[mb][nb][4 * gq + 2] * z2, acc[mb][nb][4 * gq + 3] * z3);
                    if ((gq & 1) == 0) keep = o; else put8(wl, mb * 32 + fr, nb * 4 + (gq - 1) + fh, keep, o);
                }
        flush8<32 * MB>(wl, fh * 32 + fr, [&](int r) { return Y + (size_t)(tok0 + mbase + r) * D + g * 256 + nbase; });
    }
};

#define DPP_ADD(x, CTRL) ((x) + __uint_as_float((unsigned)__builtin_amdgcn_update_dpp(0, (int)__float_as_uint(x), CTRL, 0xF, 0xF, true)))
DEVI float row16_sum(float x) {
    x = DPP_ADD(x, 0xB1);
    x = DPP_ADD(x, 0x4E);
    x = DPP_ADD(x, 0x141);
    x = DPP_ADD(x, 0x140);
    return x;
}
template <bool NEXT, int MB> struct EpiOut {
    const float* xa; const float* xb;
    const float* mod;
    float* out;
    const float* nw1; const float* mod1; bf16_t* Hn; float* rowss;
    DEVI void operator()(const f32x16 (&acc)[MB][2], int mbase, int nbase, int fr, int fh, unsigned char* wl) const {
        const int lane = fh * 32 + fr, c4 = lane & 15, rsub = lane >> 4;
        const int cv = cond_of(mbase);
        const int n = nbase + c4 * 4;
        const f32x4 gv = *(const f32x4*)(mod + cv * 3072 + 2048 + n);
        f32x4 hv = {0.f, 0.f, 0.f, 0.f};
        if (NEXT) {
            const f32x4 w = *(const f32x4*)(nw1 + n);
            const f32x4 sc = *(const f32x4*)(mod1 + cv * 3072 + 1024 + n);
#pragma unroll
            for (int e = 0; e < 4; ++e) hv[e] = w[e] * (1.f + sc[e]);
        }
#pragma unroll
        for (int mb = 0; mb < MB; ++mb) {
#pragma unroll
            for (int nb = 0; nb < 2; ++nb)
#pragma unroll
                for (int g = 0; g < 4; ++g) {
                    f32x4 a = {acc[mb][nb][4 * g], acc[mb][nb][4 * g + 1], acc[mb][nb][4 * g + 2], acc[mb][nb][4 * g + 3]};
                    *(f32x4*)(wl + fr * 256 + (((nb * 8 + 2 * g + fh) ^ (fr & 15)) << 4)) = a;
                }
#pragma unroll
            for (int i = 0; i < 8; ++i) {
                const int r = i * 4 + rsub, m = mbase + mb * 32 + r;
                const f32x4 a = *(const f32x4*)(wl + r * 256 + ((c4 ^ (r & 15)) << 4));
                const float* xr = m < NCTX ? xa + (size_t)m * D : xb + (size_t)(m - NCTX) * D;
                const f32x4 xv = *(const f32x4*)(xr + n);
                f32x4 o;
#pragma unroll
                for (int e = 0; e < 4; ++e) o[e] = xv[e] + gv[e] * a[e];
                *(f32x4*)(out + (size_t)m * D + n) = o;
                if (NEXT) {
                    float ss = (o[0] * o[0] + o[1] * o[1]) + (o[2] * o[2] + o[3] * o[3]);
                    ss = row16_sum(ss);
                    if (c4 == 0) atomicAdd(rowss + m, ss);
                    u32x2 hb; hb.x = cvt_pk_bf16(o[0] * hv[0], o[1] * hv[1]); hb.y = cvt_pk_bf16(o[2] * hv[2], o[3] * hv[3]);
                    *(u32x2*)(Hn + (size_t)m * D + n) = hb;
                }
            }
        }
    }
};

struct EpiInL1 {
    const float *qnw, *knw, *ropec, *ropes;
    bf16_t *Q, *KB, *VTB, *SZ;
    float *outk, *outv;
    const float* rowss; const float* bias1;
    DEVI void operator()(const f32x16 (&acc_in)[2][2], int mbase, int nbase, int fr, int fh, unsigned char* wl) const {
        const bool lat = mbase >= NCTX;
        u32x2 keep1 = {0u, 0u}, keep2 = {0u, 0u};
        f32x16 acc[2][2];
        {
            const float* bp = bias1 + cond_of(mbase) * 2560 + nbase;
#pragma unroll
            for (int mb = 0; mb < 2; ++mb) {
                const float rstd = rsqrtf(rowss[mbase + mb * 32 + fr] * (1.f / 1024.f) + EPSV);
#pragma unroll
                for (int nb = 0; nb < 2; ++nb)
#pragma unroll
                    for (int g = 0; g < 4; ++g) {
                        const f32x4 bv = *(const f32x4*)(bp + nb * 32 + 8 * g + 4 * fh);
#pragma unroll
                        for (int e = 0; e < 4; ++e) acc[mb][nb][4 * g + e] = acc_in[mb][nb][4 * g + e] * rstd + bv[e];
                    }
            }
        }
        if (nbase < 1280) {
            const bool isq = nbase < 1024;
            const float* nwp = isq ? qnw : knw;
#pragma unroll
            for (int mb = 0; mb < 2; ++mb) {
                const int m = mbase + mb * 32 + fr;
                float ss = 0.f;
#pragma unroll
                for (int nb = 0; nb < 2; ++nb)
#pragma unroll
                    for (int r = 0; r < 16; ++r) ss += acc[mb][nb][r] * acc[mb][nb][r];
                ss = xhalf_sum(ss);
                const float rn = rsqrtf(ss * (1.f / 64.f) + EPSV);
                const int pos = lat ? ((m - NCTX) & 1023) : 0;
#pragma unroll
                for (int g = 0; g < 4; ++g) {
                    const int d0 = 8 * g + 4 * fh;
                    const f32x4 w1 = *(const f32x4*)(nwp + d0), w2 = *(const f32x4*)(nwp + 32 + d0);
                    float x1[4], x2[4];
#pragma unroll
                    for (int e = 0; e < 4; ++e) { x1[e] = acc[mb][0][4 * g + e] * rn * w1[e]; x2[e] = acc[mb][1][4 * g + e] * rn * w2[e]; }
                    if (lat) {
                        const f32x4 cv = *(const f32x4*)(ropec + pos * 32 + d0), sv = *(const f32x4*)(ropes + pos * 32 + d0);
#pragma unroll
                        for (int e = 0; e < 4; ++e) { const float a = x1[e], b = x2[e]; x1[e] = a * cv[e] - b * sv[e]; x2[e] = a * sv[e] + b * cv[e]; }
                    }
                    if (isq) {
                        const float qs = 0.125f * LOG2E;
                        u32x2 o1, o2;
                        o1.x = cvt_pk_bf16(x1[0] * qs, x1[1] * qs); o1.y = cvt_pk_bf16(x1[2] * qs, x1[3] * qs);
                        o2.x = cvt_pk_bf16(x2[0] * qs, x2[1] * qs); o2.y = cvt_pk_bf16(x2[2] * qs, x2[3] * qs);
                        if ((g & 1) == 0) { keep1 = o1; keep2 = o2; }
                        else { put8(wl, mb * 32 + fr, (g - 1) + fh, keep1, o1); put8(wl, mb * 32 + fr, 4 + (g - 1) + fh, keep2, o2); }
                    } else {
                        const int kc = nbase - 1024;
                        u32x2 o1, o2;
                        o1.x = cvt_pk_bf16(x1[0], x1[1]); o1.y = cvt_pk_bf16(x1[2], x1[3]);
                        o2.x = cvt_pk_bf16(x2[0], x2[1]); o2.y = cvt_pk_bf16(x2[2], x2[3]);
                        if ((g & 1) == 0) { keep1 = o1; keep2 = o2; }
                        else { put8(wl, mb * 32 + fr, (g - 1) + fh, keep1, o1); put8(wl, mb * 32 + fr, 4 + (g - 1) + fh, keep2, o2); }
                        if (!lat) {
                            f32x4 f1 = {x1[0], x1[1], x1[2], x1[3]}, f2 = {x2[0], x2[1], x2[2], x2[3]};
                            *(f32x4*)(outk + (size_t)m * 256 + kc + d0) = f1;
                            *(f32x4*)(outk + (size_t)m * 256 + kc + 32 + d0) = f2;
                        }
                    }
                }
            }
            if (isq) flush8<64>(wl, fh * 32 + fr, [&](int r) { return Q + (size_t)(mbase + r) * D + nbase; });
            else flush8<64>(wl, fh * 32 + fr, [&](int r) { return KB + (size_t)(mbase + r) * 256 + (nbase - 1024); });
        } else if (nbase < 1536) {
            const int vc = nbase - 1280, kvh = vc >> 6;
            bf16_t* vtb; int S, sbase;
            if (!lat) { S = 256; sbase = mbase & 255; vtb = VTB + ((size_t)((mbase >> 8) * 4 + kvh) * 64) * 256; }
            else { const int t = mbase - NCTX; S = 1024; sbase = t & 1023; vtb = VTB + (size_t)16 * 4 * 64 * 256 + ((size_t)((t >> 10) * 4 + kvh) * 64) * 1024; }
#pragma unroll
            for (int mb = 0; mb < 2; ++mb) {
                const int m = mbase + mb * 32 + fr;
                const int cpos = swap23(mb * 32 + fr);
                unsigned char* wcol = wl + ((cpos & 7) << 1);
                const int cch = cpos >> 3;
#pragma unroll
                for (int nb = 0; nb < 2; ++nb)
#pragma unroll
                    for (int g = 0; g < 4; ++g) {
                        const int d0 = nb * 32 + 8 * g + 4 * fh;
#pragma unroll
                        for (int e = 0; e < 4; ++e) { const int d = d0 + e; *(bf16_t*)(wcol + d * 128 + ((cch ^ (d & 7)) << 4)) = f2bf(acc[mb][nb][4 * g + e]); }
                        if (!lat) {
                            f32x4 f = {acc[mb][nb][4 * g], acc[mb][nb][4 * g + 1], acc[mb][nb][4 * g + 2], acc[mb][nb][4 * g + 3]};
                            *(f32x4*)(outv + (size_t)m * 256 + vc + d0) = f;
                        }
                    }
            }
            flush8<64>(wl, fh * 32 + fr, [&](int r) { return vtb + (size_t)r * S + sbase; });
        } else {
            const int zc = nbase - 1536;
#pragma unroll
            for (int mb = 0; mb < 2; ++mb)
#pragma unroll
                for (int nb = 0; nb < 2; ++nb)
#pragma unroll
                    for (int g = 0; g < 4; ++g) {
                        const int m = mbase + mb * 32 + fr, n = zc + nb * 32 + 8 * g + 4 * fh;
                        u32x2 o; o.x = cvt_pk_bf16(silu_f(acc[mb][nb][4 * g]), silu_f(acc[mb][nb][4 * g + 1]));
                        o.y = cvt_pk_bf16(silu_f(acc[mb][nb][4 * g + 2]), silu_f(acc[mb][nb][4 * g + 3]));
                        if ((g & 1) == 0) keep1 = o; else put8(wl, mb * 32 + fr, nb * 4 + (g - 1) + fh, keep1, o);
                    }
            flush8<64>(wl, fh * 32 + fr, [&](int r) { return SZ + (size_t)(mbase + r) * D + zc; });
        }
    }
};

DEVI void attn_item(const Params& p, int item, unsigned char* lds) {
    const int lane = threadIdx.x & 63, w = threadIdx.x >> 6, fr = lane & 31, fh = lane >> 5;
    const bf16_t* Q = (const bf16_t*)(p.ws + WS_Q);
    const bf16_t* KB = (const bf16_t*)(p.ws + WS_KB);
    const bf16_t* VTB = (const bf16_t*)(p.ws + WS_VTB);
    const bf16_t* KC = (const bf16_t*)(p.ws + WS_KC);
    const bf16_t* VCT = (const bf16_t*)(p.ws + WS_VCT);
    const bf16_t* SZ = (const bf16_t*)(p.ws + WS_SZ);
    bf16_t* Y = (bf16_t*)(p.ws + WS_Y);
    bool lat; int b, kvh, qb, tb;
    if (item < 256) { lat = true; b = item >> 7; kvh = (item >> 5) & 3; qb = item & 31; tb = NCTX + b * 1024; }
    else { const int it = item - 256; lat = false; b = it >> 5; kvh = (it >> 3) & 3; qb = it & 7; tb = b * 256; }
    const int head = kvh * 4 + w;
    const int qtok = tb + qb * 32 + fr;
    bf16x8 qf[4];
#pragma unroll
    for (int ks = 0; ks < 4; ++ks) qf[ks] = *(const bf16x8*)(Q + (size_t)qtok * D + head * 64 + ks * 16 + fh * 8);
    float m_run = p.sink[head] * LOG2E, l_run = 1.f;
    f32x16 O[2];
#pragma unroll
    for (int i = 0; i < 2; ++i)
#pragma unroll
        for (int r = 0; r < 16; ++r) O[i][r] = 0.f;

    int nloc, k_lo = 0; const bf16_t *kloc, *vloc; int ldloc;
    if (lat) {
        k_lo = qb - 4 < 0 ? 0 : qb - 4; const int k_hi = qb + 4 > 31 ? 31 : qb + 4; nloc = k_hi - k_lo + 1;
        kloc = KB + (size_t)(tb + k_lo * 32) * 256 + kvh * 64;
        vloc = VTB + (size_t)16 * 4 * 64 * 256 + ((size_t)(b * 4 + kvh) * 64) * 1024 + k_lo * 32; ldloc = 1024;
    } else {
        nloc = 8; kloc = KB + (size_t)tb * 256 + kvh * 64; vloc = VTB + ((size_t)(b * 4 + kvh) * 64) * 256; ldloc = 256;
    }
    const int nblk = lat ? nloc + 8 : 8;
    const bf16_t* kcb = KC + (size_t)(b * 256) * 256 + kvh * 64;
    const bf16_t* vcb = VCT + ((size_t)(b * 4 + kvh) * 64) * 256;
    const int tid = threadIdx.x;
    const int kkey = tid >> 3, kch = tid & 7, vd = tid >> 2, vch = tid & 3;
    const unsigned kst = kkey * 128 + ((kch ^ ((kkey >> 1) & 7)) << 4), vst = 4096 + vd * 64 + ((vch ^ ((vd >> 2) & 3)) << 4);
    const unsigned ksw = (fr >> 1) & 7, vsw = (fr >> 2) & 3;
    u32x4 kA, vA, kB, vB;
#define LOADKV(j, KR, VR) { const bf16_t *kp_, *vp_; int ldv_; \
        if ((j) < nloc) { kp_ = kloc + (size_t)(j) * 32 * 256; vp_ = vloc + (j) * 32; ldv_ = ldloc; } \
        else { const int c_ = (j) - nloc; kp_ = kcb + (size_t)c_ * 32 * 256; vp_ = vcb + c_ * 32; ldv_ = 256; } \
        KR = *(const u32x4*)(kp_ + (size_t)kkey * 256 + kch * 8); VR = *(const u32x4*)(vp_ + (size_t)vd * ldv_ + vch * 8); }
    auto compute = [&](int j) {
        const unsigned char* lb = lds + (j & 1) * 8192;
        bf16x8 kf[4], vf[4];
#pragma unroll
        for (int ks = 0; ks < 4; ++ks) kf[ks] = *(const bf16x8*)(lb + fr * 128 + (((2 * ks + fh) ^ ksw) << 4));
#pragma unroll
        for (int s2 = 0; s2 < 2; ++s2)
#pragma unroll
            for (int db = 0; db < 2; ++db) vf[s2 * 2 + db] = *(const bf16x8*)(lb + 4096 + (db * 32 + fr) * 64 + (((2 * s2 + fh) ^ vsw) << 4));
        f32x16 s;
#pragma unroll
        for (int r = 0; r < 16; ++r) s[r] = 0.f;
#pragma unroll
        for (int ks = 0; ks < 4; ++ks) s = __builtin_amdgcn_mfma_f32_32x32x16_bf16(kf[ks], qf[ks], s, 0, 0, 0);
        if (lat && j < nloc) {
            const int kb = k_lo + j;
            const int mode = (kb == qb - 4) ? 1 : (kb == qb + 4) ? 2 : 0;
            if (mode) {
                const int dpos = (kb - qb) * 32;
#pragma unroll
                for (int r = 0; r < 16; ++r) {
                    const int rel = dpos + (r & 3) + 8 * (r >> 2) + 4 * fh - fr;
                    const bool ok = mode == 1 ? (rel >= -128) : (rel <= 128);
                    if (!ok) s[r] = -1e30f;
                }
            }
        }
        float mx = s[0];
#pragma unroll
        for (int r = 1; r < 16; ++r) mx = fmaxf(mx, s[r]);
        mx = xhalf_max(mx);
        const float m_new = fmaxf(m_run, mx);
        const float alpha = __builtin_amdgcn_exp2f(m_run - m_new);
        float rs = 0.f;
#pragma unroll
        for (int r = 0; r < 16; ++r) { s[r] = __builtin_amdgcn_exp2f(s[r] - m_new); rs += s[r]; }
        rs = xhalf_sum(rs);
        l_run = l_run * alpha + rs; m_run = m_new;
#pragma unroll
        for (int i = 0; i < 2; ++i)
#pragma unroll
            for (int r = 0; r < 16; ++r) O[i][r] *= alpha;
#pragma unroll
        for (int s2 = 0; s2 < 2; ++s2) {
            union { u32x4 u; bf16x8 v; } pf;
            pf.u.x = cvt_pk_bf16(s[8 * s2 + 0], s[8 * s2 + 1]); pf.u.y = cvt_pk_bf16(s[8 * s2 + 2], s[8 * s2 + 3]);
            pf.u.z = cvt_pk_bf16(s[8 * s2 + 4], s[8 * s2 + 5]); pf.u.w = cvt_pk_bf16(s[8 * s2 + 6], s[8 * s2 + 7]);
#pragma unroll
            for (int db = 0; db < 2; ++db) O[db] = __builtin_amdgcn_mfma_f32_32x32x16_bf16(vf[s2 * 2 + db], pf.v, O[db], 0, 0, 0);
        }
    };
    LOADKV(0, kA, vA)
    *(u32x4*)(lds + kst) = kA; *(u32x4*)(lds + vst) = vA;
    if (nblk > 1) LOADKV(1, kA, vA)
    if (nblk > 2) LOADKV(2, kB, vB)
    __syncthreads();
    for (int j = 0; j < nblk; j += 2) {
        compute(j);
        if (j + 1 < nblk) { *(u32x4*)(lds + 8192 + kst) = kA; *(u32x4*)(lds + 8192 + vst) = vA; }
        if (j + 3 < nblk) LOADKV(j + 3, kA, vA)
        __syncthreads();
        if (j + 1 < nblk) {
            compute(j + 1);
            if (j + 2 < nblk) { *(u32x4*)(lds + kst) = kB; *(u32x4*)(lds + vst) = vB; }
            if (j + 4 < nblk) LOADKV(j + 4, kB, vB)
            __syncthreads();
        }
    }
#undef LOADKV
    const float il = 1.f / l_run;
    u32x2 keepy = {0u, 0u};
#pragma unroll
    for (int db = 0; db < 2; ++db)
#pragma unroll
        for (int g = 0; g < 4; ++g) {
            const int col = head * 64 + db * 32 + 8 * g + 4 * fh;
            const u32x2 z = *(const u32x2*)(SZ + (size_t)qtok * D + col);
            const float z0 = __uint_as_float(z.x << 16), z1 = __uint_as_float(z.x & 0xffff0000u);
            const float z2 = __uint_as_float(z.y << 16), z3 = __uint_as_float(z.y & 0xffff0000u);
            u32x2 o; o.x = cvt_pk_bf16(O[db][4 * g] * il * z0, O[db][4 * g + 1] * il * z1);
            o.y = cvt_pk_bf16(O[db][4 * g + 2] * il * z2, O[db][4 * g + 3] * il * z3);
            if ((g & 1) == 0) keepy = o; else put8(lds + w * 8192, fr, db * 4 + (g - 1) + fh, keepy, o);
        }
    flush8<32>(lds + w * 8192, lane, [&](int r) { return Y + (size_t)(tb + qb * 32 + r) * D + head * 64; });
    __syncthreads();
}


#define XB_TMO      128
#define XB_XCNT(j)  (256  + 64 * (j))
#define XB_XSUB(j)  (1280 + 64 * (j))
#define XB_XGEN(j)  (2304 + 64 * (j))
#define XB_TOP      3328
#define XB_TOPGEN   3392
#define XCD_BAR_WORDS 3456
#define XB_SPIN_CAP (1u << 18)
#define LAS __attribute__((address_space(3)))
DEVI unsigned xb_ld(unsigned* p)              { return __hip_atomic_load(p, __ATOMIC_RELAXED, __HIP_MEMORY_SCOPE_AGENT); }
DEVI unsigned xb_add(unsigned* p, unsigned v) { return __hip_atomic_fetch_add(p, v, __ATOMIC_RELAXED, __HIP_MEMORY_SCOPE_AGENT); }
DEVI unsigned xb_xcc_id() { return (unsigned)__builtin_amdgcn_s_getreg((3 << 11) | 20) & 0xFu; }
#define XB_SPIN(cond, bar) do { unsigned _sp = 0; while (cond) { __builtin_amdgcn_s_sleep(1); \
    if ((++_sp & 255u) == 0u) { if (xb_ld(&(bar)[XB_TMO])) break; if (_sp > XB_SPIN_CAP) { atomicAdd(&(bar)[XB_TMO], 1u); break; } } } } while (0)
struct XcdBarrier { unsigned* bar; unsigned x; volatile LAS unsigned* st; };
DEVI XcdBarrier xcd_barrier_post(unsigned* bar, volatile LAS unsigned* st) {
    XcdBarrier b; b.bar = bar; b.x = xb_xcc_id(); b.st = st;
    if (threadIdx.x == 0) (void)xb_add(&bar[XB_XCNT(b.x)], 1u);
    return b;
}
DEVI void xcd_barrier_complete(unsigned* bar, unsigned x, unsigned& nloc, unsigned& nx) {
    const unsigned G = gridDim.x * gridDim.y * gridDim.z;
    unsigned sum, cnt, mine, sp = 0u;
    for (;;) {
        sum = 0u; cnt = 0u; mine = 0u;
#pragma unroll
        for (unsigned j = 0; j < 16; ++j) { const unsigned c = xb_ld(&bar[XB_XCNT(j)]); sum += c; cnt += (c > 0u) ? 1u : 0u; mine = (j == x) ? c : mine; }
        if (sum == G) break;
        __builtin_amdgcn_s_sleep(1);
        if ((++sp & 255u) == 0u) { if (xb_ld(&bar[XB_TMO])) break; if (sp > XB_SPIN_CAP) { atomicAdd(&bar[XB_TMO], 1u); break; } }
    }
    nloc = mine > 0u ? mine : 1u; nx = cnt > 0u ? cnt : 1u;
}
DEVI void xcd_barrier(const XcdBarrier& b) {
    asm volatile("s_waitcnt vmcnt(0)" ::: "memory");
    __syncthreads();
    if (threadIdx.x == 0) {
        unsigned* bar = b.bar;
        __builtin_amdgcn_s_waitcnt(0);
        unsigned nloc = b.st[0], nx = b.st[1];
        if (nloc == 0u) { xcd_barrier_complete(bar, b.x, nloc, nx); b.st[0] = nloc; b.st[1] = nx; }
        const unsigned old = xb_add(&bar[XB_XSUB(b.x)], 1u);
        const unsigned gen = old / nloc;
        if (old + 1u == (gen + 1u) * nloc) {
            __builtin_amdgcn_fence(__ATOMIC_RELEASE, "agent");
            asm volatile("s_waitcnt vmcnt(0)" ::: "memory");
            const unsigned og = xb_add(&bar[XB_TOP], 1u);
            const unsigned tg = og / nx;
            if (og + 1u == (tg + 1u) * nx) xb_add(&bar[XB_TOPGEN], 1u);
            else XB_SPIN(xb_ld(&bar[XB_TOPGEN]) == tg, bar);
            __builtin_amdgcn_fence(__ATOMIC_ACQUIRE, "agent");
            xb_add(&bar[XB_XGEN(b.x)], 1u);
            asm volatile("s_waitcnt vmcnt(0)" ::: "memory");
        } else {
            XB_SPIN(xb_ld(&bar[XB_XGEN(b.x)]) == gen, bar);
            __builtin_amdgcn_fence(__ATOMIC_ACQUIRE, "agent");
            asm volatile("s_waitcnt vmcnt(0)" ::: "memory");
        }
    }
    __syncthreads();
}

DEVI void run_phase(const Params& p, int ph, unsigned char* lds) {
    const int G = gridDim.x;
    bf16_t* H = (bf16_t*)(p.ws + WS_H);
    bf16_t* U = (bf16_t*)(p.ws + WS_U);
    bf16_t* SZ = (bf16_t*)(p.ws + WS_SZ);
    bf16_t* VT = (bf16_t*)(p.ws + WS_VT);
    bf16_t* Y = (bf16_t*)(p.ws + WS_Y);
    float* X1 = (float*)(p.ws + WS_X1);
    const float* mod = (const float*)(p.ws + WS_MOD);
    switch (ph) {
    case 0: {
        phase0(p, lds);
        if (threadIdx.x == 0) {
            unsigned* cnt = (unsigned*)(p.ws + WS_CNT); unsigned sp = 0;
            while (__hip_atomic_load(cnt, __ATOMIC_RELAXED, __HIP_MEMORY_SCOPE_AGENT) < 384u) { __builtin_amdgcn_s_sleep(4); if (++sp > (1u << 22)) break; }
        }
        __syncthreads();
        const float* modp = (const float*)(p.ws + WS_MODP);
        if (blockIdx.x < 72) {
            const int i = blockIdx.x * 256 + threadIdx.x, l = i / 9216, j = i % 3072;
            float s = (l ? p.b_mod1 : p.b_mod0)[j];
#pragma unroll
            for (int ks = 0; ks < 4; ++ks) s += __hip_atomic_load(modp + ks * 18432 + i, __ATOMIC_RELAXED, __HIP_MEMORY_SCOPE_AGENT);
            ((float*)(p.ws + WS_MOD))[i] = s;
        }
        float* lmod = (float*)lds;
        {
            float tmp[24];
#pragma unroll
            for (int q = 0; q < 24; ++q) {
                const int i = threadIdx.x + 256 * q, src_i = (i >> 11) * 3072 + (i & 2047);
                float s = p.b_mod0[i & 2047];
#pragma unroll
                for (int ks = 0; ks < 4; ++ks) s += __hip_atomic_load(modp + ks * 18432 + src_i, __ATOMIC_RELAXED, __HIP_MEMORY_SCOPE_AGENT);
                tmp[q] = s;
            }
#pragma unroll
            for (int q = 0; q < 24; ++q) lmod[threadIdx.x + 256 * q] = tmp[q];
        }
        __syncthreads();
        phase_norm(p, 0, lmod);
    } break;
    case 2: {
        EpiInL0 e{U, SZ};
        const bf16_t* W0 = (const bf16_t*)(p.ws + WS_WT0IN);
        auto run_list = [&](int kind, int a, int bq, int cnt) {
#pragma unroll 1
            for (int i = 0; i < cnt; ++i) {
                int m0v, n0v;
                if (kind == 0) { m0v = a * 128; n0v = bq * 256 + i * 128; }
                else { const int zt = a + i; m0v = (zt >> 3) * 128; n0v = 1024 + (zt & 7) * 128; }
                asm volatile("" : "+s"(m0v), "+s"(n0v));
                gemm_tile(H, D, W0, D, 16, lds, e, m0v, n0v);
            }
            if (kind == 0) {
                __builtin_amdgcn_fence(__ATOMIC_RELEASE, "workgroup");
                asm volatile("s_waitcnt vmcnt(0)" ::: "memory");
                __syncthreads();
                __builtin_amdgcn_fence(__ATOMIC_ACQUIRE, "workgroup");
                EpiChanDft ec{VT, bq};
#pragma unroll 1
                for (int m4 = 0; m4 < 4; ++m4) {
                    int m0v = m4 * 128, n0v = a * 128;
                    asm volatile("" : "+s"(m0v), "+s"(n0v));
                    gemm_tile((const bf16_t*)(p.ws + WS_TW256), 256, U + bq * 256, D, 4, lds, ec, m0v, n0v);
                }
            }
        };
        if (G == 512) {
            const int b = blockIdx.x;
            if (b < 192) { const int tt = (b & 7) * 24 + (b >> 3); run_list(0, tt >> 2, tt & 3, 2); }
            else if (b < 256) run_list(1, 2 * (b - 192), 0, 2);
            else if (b < 448) { const int l = b - 256; run_list(1, 192 + (l & 7) * 24 + (l >> 3), 0, 1); }
            else { run_list(1, 128 + (b - 448), 0, 1); bias1_items(p, b - 448, 64); }
        } else {
            for (int it = blockIdx.x; it < 576; it += G) { if (it < 192) run_list(0, it >> 2, it & 3, 2); else run_list(1, it - 192, 0, 1); }
            bias1_items(p, blockIdx.x, G);
        }
    } break;
    case 4: {
        for (int t = blockIdx.x; t < 512; t += G) {
            if (t < 256) {
                const int nt = t & 1, mt = (t >> 1) & 15, bg = t >> 5;
                EpiSeqDft<1> e{SZ, Y, NCTX + (bg >> 2) * 1024, bg & 3};
                gemm_tile<1>((const bf16_t*)(p.ws + WS_TS1024), 2048, VT + (size_t)64 * 256 * 512 + (size_t)bg * 256 * 2048, 2048, 32, lds, e, mt * 64, nt * 128);
            } else {
                const int u = t - 256, nt = u & 1, mt = (u >> 1) & 1, bg = u >> 2;
                EpiSeqDft<2> e{SZ, Y, (bg >> 2) * 256, bg & 3};
                gemm_tile<2>((const bf16_t*)(p.ws + WS_TS256), 512, VT + (size_t)bg * 256 * 512, 512, 8, lds, e, mt * 128, nt * 128);
            }
        }
    } break;
    case 5: {
        EpiOut<true, 2> e{p.x_prompt, p.x_sample, mod, X1, p.norm_w1, mod + 3 * 3072, H, (float*)(p.ws + WS_ROWSS)};
        EpiOut<true, 1> e1{p.x_prompt, p.x_sample, mod, X1, p.norm_w1, mod + 3 * 3072, H, (float*)(p.ws + WS_ROWSS)};
        if (G == 512) {
            if (blockIdx.x < 256) { const int tt = xcd_remap(blockIdx.x, 256); gemm_tile<2>(Y, D, (const bf16_t*)(p.ws + WS_WT0OUT), D, 16, lds, e, (tt >> 3) * 128, (tt & 7) * 128); }
            else { const int tt = xcd_remap(blockIdx.x - 256, 256); gemm_tile<1>(Y, D, (const bf16_t*)(p.ws + WS_WT0OUT), D, 16, lds, e1, 4096 + (tt >> 3) * 64, (tt & 7) * 128); }
        } else
        for (int t = blockIdx.x; t < 384; t += G) {
            const int tt = xcd_remap(t, 384);
            gemm_tile(Y, D, (const bf16_t*)(p.ws + WS_WT0OUT), D, 16, lds, e, (tt >> 3) * 128, (tt & 7) * 128);
        }
    } break;
    case 7: {
        EpiInL1 e{p.qnw, p.knw, (const float*)(p.ws + WS_ROPEC), (const float*)(p.ws + WS_ROPES),
                  (bf16_t*)(p.ws + WS_Q), (bf16_t*)(p.ws + WS_KB), (bf16_t*)(p.ws + WS_VTB), SZ,
                  p.out + (size_t)NTOK * D, p.out + (size_t)NTOK * D + (size_t)NCTX * 256,
                  (const float*)(p.ws + WS_ROWSS), (const float*)(p.ws + WS_BIAS1)};
        if (G == 512) {
            const int x = blockIdx.x & 7;
            unsigned* qctr = (unsigned*)(p.ws + WS_BAR + 14592) + 16 * x;
            volatile LAS unsigned* tick = (volatile LAS unsigned*)(lds + 65536) + 2;
            unsigned ticket = 0;
            if (threadIdx.x == 0) ticket = __hip_atomic_fetch_add(qctr, 1u, __ATOMIC_RELAXED, __HIP_MEMORY_SCOPE_AGENT);
            { const int j = blockIdx.x >> 3; gemm_tile(H, D, (const bf16_t*)(p.ws + WS_WT1IN), D, 16, lds, e, (x * 6 + j % 6) * 128, (j / 6) * 128); }
            if (threadIdx.x == 0) tick[0] = ticket;
            __syncthreads();
            const unsigned tk = (unsigned)__builtin_amdgcn_readfirstlane((int)tick[0]);
            if (tk < 56u) { int j = 64 + (int)tk; asm volatile("" : "+s"(j)); gemm_tile(H, D, (const bf16_t*)(p.ws + WS_WT1IN), D, 16, lds, e, (x * 6 + j % 6) * 128, (j / 6) * 128); }
        } else
        for (int t = blockIdx.x; t < 960; t += G) {
            const int x = t & 7, j = t >> 3;
            const int mtile = x * 6 + j % 6, ntile = j / 6;
            gemm_tile(H, D, (const bf16_t*)(p.ws + WS_WT1IN), D, 16, lds, e, mtile * 128, ntile * 128);
        }
    } break;
    case 8: {
        if (G == 512) {
            if (blockIdx.x < 256) attn_item(p, blockIdx.x, lds);
            else { attn_item(p, 256 + 2 * (blockIdx.x - 256), lds); attn_item(p, 257 + 2 * (blockIdx.x - 256), lds); }
        } else
            for (int t = blockIdx.x; t < 768; t += G) attn_item(p, t, lds);
    } break;
    case 9: {
        EpiOut<false, 2> e{X1, X1 + (size_t)NCTX * D, mod + 3 * 3072, p.out, nullptr, nullptr, nullptr, nullptr};
        EpiOut<false, 1> e1{X1, X1 + (size_t)NCTX * D, mod + 3 * 3072, p.out, nullptr, nullptr, nullptr, nullptr};
        if (G == 512) {
            if (blockIdx.x < 256) { const int tt = xcd_remap(blockIdx.x, 256); gemm_tile<2>(Y, D, (const bf16_t*)(p.ws + WS_WT1OUT), D, 16, lds, e, (tt >> 3) * 128, (tt & 7) * 128); }
            else { const int tt = xcd_remap(blockIdx.x - 256, 256); gemm_tile<1>(Y, D, (const bf16_t*)(p.ws + WS_WT1OUT), D, 16, lds, e1, 4096 + (tt >> 3) * 64, (tt & 7) * 128); }
        } else
        for (int t = blockIdx.x; t < 384; t += G) {
            const int tt = xcd_remap(t, 384);
            gemm_tile(Y, D, (const bf16_t*)(p.ws + WS_WT1OUT), D, 16, lds, e, (tt >> 3) * 128, (tt & 7) * 128);
        }
    } break;
    }
}

__global__ void __launch_bounds__(256, 2) mega(Params p) {
    __shared__ __attribute__((aligned(16))) unsigned char lds[65536 + 16];
    cg::grid_group grid = cg::this_grid();
#if SINGLE_LAUNCH
    volatile LAS unsigned* st = (volatile LAS unsigned*)(lds + 65536);
    if (threadIdx.x < 4) st[threadIdx.x] = 0u;
    __syncthreads();
    XcdBarrier bar = xcd_barrier_post((unsigned*)(p.ws + WS_BAR), st);
    if (p.ph_hi == 777) grid.sync();
#ifndef REP_PH
#define REP_PH -1
#endif
#ifndef REP_SY
#define REP_SY 0
#endif
#define PH(n) run_phase(p, n, lds); if (REP_PH == n) run_phase(p, n, lds);
#define SY() xcd_barrier(bar); if (REP_SY) xcd_barrier(bar);
#else
    const int lo = (int)p.ph_lo, hi = (int)p.ph_hi;
#define PH(n) if (lo <= n && n < hi) run_phase(p, n, lds);
#define SY()
#endif
    PH(0) SY() PH(2) SY() PH(4) SY() PH(5) SY() PH(7) SY() PH(8) SY() PH(9)
}

extern "C" void kernel_launch(void* const* d_in, const int* in_sizes, int n_in, void* d_out, int out_size, void* d_ws, size_t ws_size, hipStream_t stream) {
    static int grid_blocks = 0;
    if (!grid_blocks) {
        int dev = 0, cus = 0, per_cu = 0;
        hipGetDevice(&dev);
        hipDeviceGetAttribute(&cus, hipDeviceAttributeMultiprocessorCount, dev);
        hipOccupancyMaxActiveBlocksPerMultiprocessor(&per_cu, mega, 256, 0);
        if (per_cu > 2) per_cu = 2;
        if (per_cu < 1) per_cu = 1;
        grid_blocks = cus * per_cu;
    }
    Params p{};
    const float* const* in = (const float* const*)d_in;
    p.x_prompt = in[0]; p.x_sample = in[1]; p.cache_k = in[2]; p.cache_v = in[3]; p.c = in[4]; p.c_ctx = in[5];
    p.norm_w0 = in[6]; p.w_mod0 = in[7]; p.b_mod0 = in[8]; p.w_in0 = in[9]; p.w_out0 = in[10];
    p.norm_w1 = in[11]; p.w_mod1 = in[12]; p.b_mod1 = in[13]; p.w_in1 = in[14]; p.qnw = in[15]; p.knw = in[16]; p.sink = in[17]; p.w_out1 = in[18];
    p.out = (float*)d_out; p.ws = (unsigned char*)d_ws;
#if SINGLE_LAUNCH
    p.ph_lo = 0; p.ph_hi = 10;
    hipMemsetAsync((unsigned char*)d_ws + WS_BAR, 0, 16384, stream);
    void* args[] = {&p};
    hipError_t e = hipLaunchCooperativeKernel((void*)mega, dim3(grid_blocks), dim3(256), args, 0, stream);
    if (e != hipSuccess) fprintf(stderr, "cooperative launch failed: %s (grid %d)\n", hipGetErrorString(e), grid_blocks);
#else
    for (int ph = 0; ph < 10; ++ph) {
        p.ph_lo = ph; p.ph_hi = ph + 1;
        hipLaunchKernelGGL(mega, dim3(grid_blocks), dim3(256), 0, stream, p);
    }
#endif
}
```
